# Optimizing an MI355X kernel written in HIP

```python
import jax, jax.numpy as jnp
from jax import lax
import numpy as np

D_MODEL = 1024
BATCH = 8
SEQ = 2048
DEPTH = 1

GRID_W = 64
CTX_LEN = 256
D_MIX = D_MODEL
SGU_HEADS = 4
SGU_HEAD_DIM = 128
SGU_WIDTH = SGU_HEADS * SGU_HEAD_DIM
SGU_CHUNK = 2 * GRID_W
HGRN_HEADS = 4
HGRN_HEAD_DIM = 128
HGRN_WIDTH = HGRN_HEADS * HGRN_HEAD_DIM
HGRN_CHUNK = 64
N_PROJ = 7
D_IN = N_PROJ * SGU_WIDTH
N_EXPERTS = 32
TOP_K = 4
D_EXPERT = 1024
SWIGLU_LIMIT = 7.0
SWIGLU_ALPHA = 1.702
MOE_BLOCK = 128
EPS = 1e-6

kernel_name = "hybrid_sgu_hgrn2_moe_dit_block"


def rms_norm(x, g):
    xf = x.astype(jnp.float32)
    y = xf * lax.rsqrt(jnp.mean(xf * xf, axis=-1, keepdims=True) + EPS)
    return (y * g.astype(jnp.float32)).astype(x.dtype)


def modulate(h, shift, scale):
    return h * (1.0 + scale) + shift


def flip(a):
    return jnp.flip(a, axis=1)


def lower_bound(table, layer):
    return jnp.cumsum(jax.nn.softmax(table.astype(jnp.float32), axis=0), axis=0)[layer]


def chunk_sgu(u, v, ln_g, w_s, b_s):
    bsz, n, _ = u.shape
    u = jax.nn.gelu(u)
    v = jax.nn.gelu(v)
    vh = v.reshape(bsz, n // SGU_CHUNK, SGU_CHUNK, SGU_HEADS, SGU_HEAD_DIM).astype(jnp.float32)
    mu = jnp.mean(vh, axis=-1, keepdims=True)
    var = jnp.mean(jnp.square(vh - mu), axis=-1, keepdims=True)
    vn = ((vh - mu) * lax.rsqrt(var + EPS) * ln_g.astype(jnp.float32)).astype(v.dtype)
    z = jnp.einsum('hts,bnshd->bnthd', w_s, vn) + b_s.T[:, :, None]
    return u * z.reshape(bsz, n, SGU_WIDTH)


def hgrn_chunk_scan(q, k, v, log_f, s0):
    bsz, n, nh, dk = q.shape
    n_chunks = n // HGRN_CHUNK

    def to_chunks(a):
        return a.reshape(bsz, n_chunks, HGRN_CHUNK, nh, a.shape[-1]).transpose(1, 0, 3, 2, 4)

    mask = jnp.tril(jnp.ones((HGRN_CHUNK, HGRN_CHUNK), dtype=bool))[:, :, None]

    def step(s, inp):
        qc, kc, vc, gc = inp
        b = jnp.cumsum(gc, axis=2)
        diff = b[:, :, :, None, :] - b[:, :, None, :, :]
        decay = jnp.exp(jnp.where(mask, diff, -jnp.inf))
        scores = jnp.einsum('bhtk,bhsk,bhtsk->bhts', qc, kc, decay)
        o = jnp.einsum('bhts,bhsv->bhtv', scores, vc) \
            + jnp.einsum('bhtk,bhkv->bhtv', qc * jnp.exp(b), s)
        b_last = b[:, :, -1:, :]
        s_new = jnp.exp(b_last[:, :, 0, :])[..., None] * s \
            + jnp.einsum('bhsk,bhsv->bhkv', kc * jnp.exp(b_last - b), vc)
        return s_new, o

    s_fin, o = lax.scan(step, s0, (to_chunks(q), to_chunks(k), to_chunks(v), to_chunks(log_f)))
    o = o.transpose(1, 0, 3, 2, 4).reshape(bsz, n, nh, v.shape[-1])
    return o, s_fin


def hgrn_direction(q, i, z, lb, s0):
    bsz, n, _ = q.shape
    f = lb + (1.0 - lb) * jax.nn.sigmoid(z.astype(jnp.float32))
    k = 1.0 - f
    sh = (bsz, n, HGRN_HEADS, HGRN_HEAD_DIM)
    return hgrn_chunk_scan(q.astype(jnp.float32).reshape(sh), k.reshape(sh),
                           i.astype(jnp.float32).reshape(sh), jnp.log(f).reshape(sh), s0)


def merge_heads(u, v, o, g, sgu_ln_l, sgu_w_l, sgu_b_l, hgrn_norm_l, w_out_l):
    y_a = chunk_sgu(u, v, sgu_ln_l, sgu_w_l, sgu_b_l)
    bsz, n = o.shape[:2]
    on = o * lax.rsqrt(jnp.mean(o * o, axis=-1, keepdims=True) + EPS)
    y_b = (on.reshape(bsz, n, HGRN_WIDTH) * hgrn_norm_l.astype(jnp.float32)).astype(g.dtype) \
        * jax.nn.silu(g)
    return jnp.concatenate([y_a, y_b], axis=-1) @ w_out_l


def moe(h, router_w, router_b, w1, b1, w2, b2):
    bsz, n, d = h.shape
    n_tok = bsz * n
    hf = h.reshape(n_tok, d)
    logits = (hf @ router_w + router_b).astype(jnp.float32)
    top_val, top_idx = lax.top_k(logits, TOP_K)
    gate_w = jax.nn.softmax(top_val, axis=-1)
    n_assign = n_tok * TOP_K
    e_flat = top_idx.reshape(-1)
    tok_flat = jnp.repeat(jnp.arange(n_tok, dtype=jnp.int32), TOP_K)
    w_flat = gate_w.reshape(-1)
    order = jnp.argsort(e_flat)
    e_s, tok_s, w_s = e_flat[order], tok_flat[order], w_flat[order]
    counts = jnp.bincount(e_flat, length=N_EXPERTS)
    padded = (counts + MOE_BLOCK - 1) // MOE_BLOCK * MOE_BLOCK
    start = jnp.cumsum(counts) - counts
    pend = jnp.cumsum(padded)
    pstart = pend - padded
    dest = pstart[e_s] + jnp.arange(n_assign, dtype=jnp.int32) - start[e_s]
    n_blocks = -(-(n_assign + N_EXPERTS * (MOE_BLOCK - 1)) // MOE_BLOCK)
    n_rows = n_blocks * MOE_BLOCK
    row_tok = jnp.zeros((n_rows,), jnp.int32).at[dest].set(tok_s)
    row_w = jnp.zeros((n_rows,), jnp.float32).at[dest].set(w_s)
    block_start = jnp.arange(n_blocks, dtype=jnp.int32) * MOE_BLOCK
    block_e = jnp.minimum(jnp.sum(block_start[:, None] >= pend[None, :], axis=1), N_EXPERTS - 1)

    def expert_block(args):
        toks, e = args
        xb = hf[toks]
        gu = xb @ w1[e] + b1[e]
        gate, up = jnp.split(gu, 2, axis=-1)
        gate = jnp.minimum(gate, SWIGLU_LIMIT)
        up = jnp.clip(up, -SWIGLU_LIMIT, SWIGLU_LIMIT)
        act = gate * jax.nn.sigmoid(SWIGLU_ALPHA * gate) * (up + 1.0)
        return act @ w2[e] + b2[e]

    out = lax.map(expert_block, (row_tok.reshape(n_blocks, MOE_BLOCK), block_e))
    out = out.reshape(n_rows, d) * row_w[:, None].astype(h.dtype)
    y = jnp.zeros_like(hf).at[row_tok].add(out)
    return y.reshape(bsz, n, d)


def setup_inputs(seed: int = 0) -> dict:
    key = jax.random.key(seed)
    ks = jax.random.split(key, 24)
    nrm = jax.random.normal
    f32 = jnp.float32
    d = D_MODEL
    return {
        "x": nrm(ks[0], (BATCH, SEQ, d), f32),
        "c": nrm(ks[1], (BATCH, d), f32),
        "ctx": nrm(ks[2], (BATCH, CTX_LEN, d), f32),
        "c_ctx": nrm(ks[3], (d,), f32),
        "w_mod": nrm(ks[4], (DEPTH, d, 6 * d), f32) * (0.5 * d ** -0.5),
        "b_mod": nrm(ks[5], (DEPTH, 6 * d), f32) * 0.02,
        "norm1": 1.0 + 0.02 * nrm(ks[6], (DEPTH, d), f32),
        "w_in": nrm(ks[7], (DEPTH, d, D_IN), f32) * d ** -0.5,
        "sgu_ln": 1.0 + 0.02 * nrm(ks[8], (DEPTH, SGU_HEADS, SGU_HEAD_DIM), f32),
        "sgu_w": nrm(ks[9], (DEPTH, SGU_HEADS, SGU_CHUNK, SGU_CHUNK), f32) * SGU_CHUNK ** -0.5,
        "sgu_b": 1.0 + 0.02 * nrm(ks[10], (DEPTH, SGU_HEADS, SGU_CHUNK), f32),
        "lb_fwd": nrm(ks[11], (DEPTH + 1, HGRN_WIDTH), f32),
        "lb_bwd": nrm(ks[12], (DEPTH + 1, HGRN_WIDTH), f32),
        "hgrn_norm": 1.0 + 0.02 * nrm(ks[13], (DEPTH, HGRN_WIDTH), f32),
        "w_out": nrm(ks[14], (DEPTH, D_MIX, d), f32) * D_MIX ** -0.5,
        "norm2": 1.0 + 0.02 * nrm(ks[15], (DEPTH, d), f32),
        "router_w": nrm(ks[16], (DEPTH, d, N_EXPERTS), f32) * d ** -0.5,
        "router_b": nrm(ks[17], (DEPTH, N_EXPERTS), f32) * 0.01,
        "w1": nrm(ks[18], (DEPTH, N_EXPERTS, d, 2 * D_EXPERT), f32) * d ** -0.5,
        "b1": nrm(ks[19], (DEPTH, N_EXPERTS, 2 * D_EXPERT), f32) * 0.01,
        "w2": nrm(ks[20], (DEPTH, N_EXPERTS, D_EXPERT, d), f32) * D_EXPERT ** -0.5,
        "b2": nrm(ks[21], (DEPTH, N_EXPERTS, d), f32) * 0.01,
        "final_norm": 1.0 + 0.02 * nrm(ks[22], (d,), f32),
    }


def reference(x, c, ctx, c_ctx, w_mod, b_mod, norm1, w_in, sgu_ln, sgu_w, sgu_b,
              lb_fwd, lb_bwd, hgrn_norm, w_out, norm2, router_w, router_b,
              w1, b1, w2, b2, final_norm):
    bsz = x.shape[0]
    s_zero = jnp.zeros((bsz, HGRN_HEADS, HGRN_HEAD_DIM, HGRN_HEAD_DIM), jnp.float32)
    x_ctx = ctx
    for l in range(DEPTH):
        mod = jax.nn.silu(c) @ w_mod[l] + b_mod[l]
        sh1, sc1, g1, sh2, sc2, g2 = jnp.split(mod[:, None, :], 6, axis=-1)
        mod_c = jax.nn.silu(c_ctx) @ w_mod[l] + b_mod[l]
        csh1, csc1, cg1, csh2, csc2, cg2 = jnp.split(mod_c, 6, axis=-1)
        lbf = lower_bound(lb_fwd, l)
        lbb = lower_bound(lb_bwd, l)

        hc = modulate(rms_norm(x_ctx, norm1[l]), csh1, csc1)
        uc, vc, qc, zfc, zbc, ic, gc = jnp.split(hc @ w_in[l], N_PROJ, axis=-1)
        oc_f, st_f = hgrn_direction(qc, ic, zfc, lbf, s_zero)
        oc_b, st_b = hgrn_direction(flip(qc), flip(ic), flip(zbc), lbb, s_zero)

        h = modulate(rms_norm(x, norm1[l]), sh1, sc1)
        u, v, q, zf, zb, i, g = jnp.split(h @ w_in[l], N_PROJ, axis=-1)
        o_f, _ = hgrn_direction(q, i, zf, lbf, st_f)
        o_b, _ = hgrn_direction(flip(q), flip(i), flip(zb), lbb, st_b)
        y = merge_heads(u, v, o_f + flip(o_b), g, sgu_ln[l], sgu_w[l], sgu_b[l],
                        hgrn_norm[l], w_out[l])
        x = x + g1 * y
        h2 = modulate(rms_norm(x, norm2[l]), sh2, sc2)
        x = x + g2 * moe(h2, router_w[l], router_b[l], w1[l], b1[l], w2[l], b2[l])

        if l < DEPTH - 1:
            yc = merge_heads(uc, vc, oc_f + flip(oc_b), gc, sgu_ln[l], sgu_w[l], sgu_b[l],
                             hgrn_norm[l], w_out[l])
            x_ctx = x_ctx + cg1 * yc
            hc2 = modulate(rms_norm(x_ctx, norm2[l]), csh2, csc2)
            x_ctx = x_ctx + cg2 * moe(hc2, router_w[l], router_b[l], w1[l], b1[l], w2[l], b2[l])
    return rms_norm(x, final_norm)
```

```cpp
#include <hip/hip_runtime.h>
#include <cstdio>
#include <cstdint>

#ifndef N_LAUNCH_MODE
#define N_LAUNCH_MODE 1
#endif

#ifndef DBG_NO_MOE
#define DBG_NO_MOE 0
#endif
#ifndef DBG_MIX
#define DBG_MIX 1
#endif
#define LAS __attribute__((address_space(3)))
typedef unsigned short bf16_t;
typedef short bf16x8 __attribute__((ext_vector_type(8)));
typedef float f32x4 __attribute__((ext_vector_type(4)));
typedef float f32x2 __attribute__((ext_vector_type(2)));
typedef unsigned u32x4 __attribute__((ext_vector_type(4)));
typedef unsigned u32x2 __attribute__((ext_vector_type(2)));

constexpr int D = 1024, NB = 8, SEQ = 2048, CTXL = 256;
constexpr int NTOK = NB * SEQ;
constexpr int NCTX = NB * CTXL;
constexpr int NROW = NTOK + NCTX;
constexpr int DIN = 3584, GW = 512, NE = 32, DE = 1024, TOPK = 4;
constexpr int ACT_ROWS = NTOK * TOPK + NE * 256;
constexpr float EPS = 1e-6f;
constexpr int NTHREADS = 512;

constexpr int LDS_STAGE = 131072;
constexpr int LDS_EXTRA_OFF = LDS_STAGE;
constexpr int LDS_MISC_OFF = 155648;
constexpr int LDS_BYTES = LDS_MISC_OFF + 256;

constexpr size_t al256(size_t x) { return (x + 255) & ~(size_t)255; }
constexpr size_t WS_CTL = 0;
constexpr size_t CTL_BYTES = 65536;
constexpr int CW_BAR = 0;
constexpr int CW_CNT = 4096;
constexpr size_t WS_MOD = WS_CTL + CTL_BYTES;
constexpr size_t WS_WIN = WS_MOD + al256((size_t)9 * 6144 * 4);
constexpr size_t WS_WOUT = WS_WIN + (size_t)DIN * D * 2;
constexpr size_t WS_W1 = WS_WOUT + (size_t)D * D * 2;
constexpr size_t WS_W2 = WS_W1 + (size_t)NE * 2 * DE * D * 2;
constexpr size_t WS_YCAT = WS_W2 + (size_t)NE * D * DE * 2;
constexpr size_t WS_OF = WS_YCAT + (size_t)NTOK * D * 2;
constexpr size_t WS_OB = WS_OF + (size_t)NTOK * GW * 4;
constexpr size_t WS_X1 = WS_OB + (size_t)NTOK * GW * 4;
constexpr size_t WS_SS = WS_X1 + (size_t)NTOK * D * 4;
constexpr size_t WS_H2 = WS_SS + (size_t)NTOK * 16 * 4;
constexpr size_t WS_LIST = WS_H2 + (size_t)NTOK * D * 2;
constexpr size_t WS_TSLOT = WS_LIST + (size_t)NE * NTOK * 4;
constexpr size_t WS_TW = WS_TSLOT + (size_t)NTOK * 4 * 4;
constexpr size_t WS_ACT = WS_TW + (size_t)NTOK * 4 * 4;
constexpr size_t WS_REGA = WS_ACT + (size_t)ACT_ROWS * DE * 2;
constexpr size_t WS_H = WS_REGA;
constexpr size_t WS_U = WS_H + (size_t)NROW * D * 2;
constexpr size_t WS_VG = WS_U + (size_t)NTOK * GW * 2;
constexpr size_t WS_Q = WS_VG + (size_t)NTOK * GW * 2;
constexpr size_t WS_GS = WS_Q + (size_t)NTOK * GW * 2;
constexpr size_t WS_I = WS_GS + (size_t)NTOK * GW * 2;
constexpr size_t WS_GF = WS_I + (size_t)NROW * GW * 2;
constexpr size_t WS_KF = WS_GF + (size_t)NROW * GW * 2;
constexpr size_t WS_GB = WS_KF + (size_t)NROW * GW * 2;
constexpr size_t WS_KB = WS_GB + (size_t)NROW * GW * 2;
constexpr size_t WS_REGA_END = WS_KB + (size_t)NROW * GW * 2;
constexpr size_t WS_DOUT = WS_REGA;
constexpr size_t WS_END0 = WS_DOUT + (size_t)ACT_ROWS * D * 2;
constexpr size_t WS_END = WS_END0 > WS_REGA_END ? WS_END0 : WS_REGA_END;

typedef __bf16 bf16x2_t __attribute__((ext_vector_type(2)));
__device__ __forceinline__ unsigned cvt_pk_bf16(float lo, float hi) { bf16x2_t v; v[0] = (__bf16)lo; v[1] = (__bf16)hi; return __builtin_bit_cast(unsigned, v); }
__device__ __forceinline__ float bf2f(unsigned b) { return __uint_as_float(b << 16); }
__device__ __forceinline__ float bflo(unsigned w) { return __uint_as_float(w << 16); }
__device__ __forceinline__ float bfhi(unsigned w) { return __uint_as_float(w & 0xffff0000u); }
__device__ __forceinline__ float fast_exp(float x) { return __builtin_amdgcn_exp2f(x * 1.44269504089f); }
__device__ __forceinline__ float fast_rcp(float x) { return __builtin_amdgcn_rcpf(x); }
__device__ __forceinline__ float sigmoidf_(float x) { return fast_rcp(1.0f + fast_exp(-x)); }
__device__ __forceinline__ float gelu_tanh(float x) { const float u = 1.5957691216f * (x + 0.044715f * x * x * x); return x * fast_rcp(1.0f + fast_exp(-u)); }
__device__ __forceinline__ float clampf(float x, float lo, float hi) { return fminf(fmaxf(x, lo), hi); }
__device__ __forceinline__ float wave_sum(float v) {
#pragma unroll
    for (int o = 32; o >= 1; o >>= 1) v += __shfl_xor(v, o);
    return v;
}
#define VM_WAIT() asm volatile("s_waitcnt vmcnt(0)" ::: "memory")
#define LDS_WAIT() asm volatile("s_waitcnt lgkmcnt(0)" ::: "memory")

#define XB_TMO      128
#define XB_XCNT(j)  (256  + 64 * (j))
#define XB_XSUB(j)  (1280 + 64 * (j))
#define XB_XGEN(j)  (2304 + 64 * (j))
#define XB_TOP      3328
#define XB_TOPGEN   3392
#define XCD_BAR_WORDS 3456
#define XB_SPIN_CAP (1u << 18)
__device__ __forceinline__ unsigned xb_ld(unsigned* p)              { return __hip_atomic_load(p, __ATOMIC_RELAXED, __HIP_MEMORY_SCOPE_AGENT); }
__device__ __forceinline__ unsigned xb_add(unsigned* p, unsigned v) { return __hip_atomic_fetch_add(p, v, __ATOMIC_RELAXED, __HIP_MEMORY_SCOPE_AGENT); }
__device__ __forceinline__ unsigned xb_xcc_id() { return (unsigned)__builtin_amdgcn_s_getreg((3 << 11) | 20) & 0xFu; }
#define XB_SPIN(cond, bar) do { unsigned _sp = 0; while (cond) { __builtin_amdgcn_s_sleep(1); \
    if ((++_sp & 255u) == 0u) { if (xb_ld(&(bar)[XB_TMO])) break; if (_sp > XB_SPIN_CAP) { atomicAdd(&(bar)[XB_TMO], 1u); break; } } } } while (0)
struct XcdBarrier { unsigned* bar; unsigned x; volatile LAS unsigned* st; };
__device__ __forceinline__ XcdBarrier xcd_barrier_post(unsigned* bar, volatile LAS unsigned* st) {
    XcdBarrier b; b.bar = bar; b.x = xb_xcc_id(); b.st = st;
    if (threadIdx.x == 0) (void)xb_add(&bar[XB_XCNT(b.x)], 1u);
    return b;
}
__device__ __forceinline__ void xcd_barrier_complete(unsigned* bar, unsigned x, unsigned& nloc, unsigned& nx) {
    const unsigned G = gridDim.x * gridDim.y * gridDim.z;
    unsigned sum, cnt, mine, sp = 0u;
    for (;;) {
        sum = 0u; cnt = 0u; mine = 0u;
#pragma unroll
        for (unsigned j = 0; j < 16; ++j) { const unsigned c = xb_ld(&bar[XB_XCNT(j)]); sum += c; cnt += (c > 0u) ? 1u : 0u; mine = (j == x) ? c : mine; }
        if (sum == G) break;
        __builtin_amdgcn_s_sleep(1);
        if ((++sp & 255u) == 0u) { if (xb_ld(&bar[XB_TMO])) break; if (sp > XB_SPIN_CAP) { atomicAdd(&bar[XB_TMO], 1u); break; } }
    }
    nloc = mine > 0u ? mine : 1u; nx = cnt > 0u ? cnt : 1u;
}
__device__ __forceinline__ void xcd_barrier(const XcdBarrier& b) {
    asm volatile("s_waitcnt vmcnt(0)" ::: "memory");
    __syncthreads();
    if (threadIdx.x == 0) {
        unsigned* bar = b.bar;
        __builtin_amdgcn_s_waitcnt(0);
        unsigned nloc = b.st[0], nx = b.st[1];
        if (nloc == 0u) { xcd_barrier_complete(bar, b.x, nloc, nx); b.st[0] = nloc; b.st[1] = nx; }
        const unsigned old = xb_add(&bar[XB_XSUB(b.x)], 1u);
        const unsigned gen = old / nloc;
        if (old + 1u == (gen + 1u) * nloc) {
            __builtin_amdgcn_fence(__ATOMIC_RELEASE, "agent");
            asm volatile("s_waitcnt vmcnt(0)" ::: "memory");
            const unsigned og = xb_add(&bar[XB_TOP], 1u);
            const unsigned tg = og / nx;
            if (og + 1u == (tg + 1u) * nx) xb_add(&bar[XB_TOPGEN], 1u);
            else XB_SPIN(xb_ld(&bar[XB_TOPGEN]) == tg, bar);
            __builtin_amdgcn_fence(__ATOMIC_ACQUIRE, "agent");
            xb_add(&bar[XB_XGEN(b.x)], 1u);
            asm volatile("s_waitcnt vmcnt(0)" ::: "memory");
        } else {
            XB_SPIN(xb_ld(&bar[XB_XGEN(b.x)]) == gen, bar);
            __builtin_amdgcn_fence(__ATOMIC_ACQUIRE, "agent");
            asm volatile("s_waitcnt vmcnt(0)" ::: "memory");
        }
    }
    __syncthreads();
}

struct Args { const float* in[23]; float* out; unsigned char* ws; int ph_lo, ph_hi; };
struct Frame {
    const float *x, *c, *ctx, *c_ctx, *w_mod, *b_mod, *norm1, *w_in, *sgu_ln, *sgu_w, *sgu_b, *lb_fwd, *lb_bwd, *hgrn_norm, *w_out, *norm2,
                *router_w, *router_b, *w1, *b1, *w2, *b2, *final_norm;
    float* out; unsigned char* ws;
    unsigned* ctl; float* mod;
    bf16_t *WinT, *WoutT, *W1T, *W2T, *H, *U, *VG, *Q, *GS, *I, *GF, *KF, *GB, *KB, *YCAT, *H2, *ACT, *DOUT;
    float *OF, *OB, *X1, *SS, *TW;
    int *LIST, *TSLOT;
    LAS unsigned char* lds;
};

namespace pg {
constexpr int BM = 256, BK = 64, HALF = 128, HTB = HALF * BK * 2, NXCD = 8, WGM = 8;
__device__ __forceinline__ int lds_byte(int r, int c) { const int st = (r >> 4) * 2 + (c >> 5), rr = r & 15, cc = c & 31, ob = rr * 64 + cc * 2; return st * 1024 + (ob ^ (((ob >> 9) & 1) << 5)); }
__device__ __forceinline__ void stage_rc(int b, int& R, int& C) { const int st = b / 1024, sb = b % 1024, swz = sb ^ (((sb >> 9) & 1) << 5); R = (st >> 1) * 16 + swz / 64; C = (st & 1) * 32 + (swz % 64) / 2; }
__device__ __forceinline__ int perm32(int rho) { const int n = rho >> 4, i = rho & 15; return 8 * (i >> 2) + 4 * n + (i & 3); }

struct Unit { const char* bptr; int arow, orow, pn, e, cnt, pad; };

__device__ __forceinline__ bool static_order(int nM, int nN, int L, int& pm, int& pn) {
    const int nwg = nM * nN; if (L >= nwg) return false;
    int wgid = L; { const int q = nwg / NXCD, r = nwg % NXCD, xcd = wgid % NXCD, off = wgid / NXCD; wgid = (xcd < r ? xcd * (q + 1) : r * (q + 1) + (xcd - r) * q) + off; }
    const int nig = WGM * nN, gid = wgid / nig, fm = gid * WGM, gsz = (nM - fm) < WGM ? (nM - fm) : WGM;
    pm = fm + ((wgid % nig) % gsz); pn = (wgid % nig) / gsz; return true;
}

template <class Epi, class Sched>
__device__ __forceinline__ void gemm_phase(LAS unsigned char* lds, const char* Abase, const int K, const Sched& S, const Epi& E) {
    const int tid = threadIdx.x, wid = __builtin_amdgcn_readfirstlane(tid >> 6), lane = tid & 63, wr = wid >> 2, wc = wid & 3, fr = lane & 15, fq = lane >> 4;
    const int nt = K / BK;
    int sR[2], sC[2]; unsigned voffB[2];
#pragma unroll
    for (int i = 0; i < 2; ++i) { stage_rc(tid * 16 + i * 8192, sR[i], sC[i]); const int Rb = Epi::PERM ? ((sR[i] & ~31) + perm32(sR[i] & 31)) : sR[i]; voffB[i] = (unsigned)(Rb * K + sC[i]) * 2u; }
    const size_t kstep = (size_t)(BK * 2);
    const size_t hstep = (size_t)HALF * K * 2;
    const unsigned ldsw = (unsigned)wid * 1024u;
    const int aoff = lds_byte(wr * 64 + fr, fq * 8), boff = lds_byte(wc * 32 + fr, fq * 8);
#define PG_SA(b, h) (((b) * 2 + (h)) * HTB)
#define PG_SB(b, h) ((4 + (b) * 2 + (h)) * HTB)
#define PG_STAGE(bufoff, gbase, voff) do { _Pragma("unroll") for (int _i = 0; _i < 2; ++_i) \
        __builtin_amdgcn_global_load_lds((const unsigned*)((const char*)(gbase) + (voff)[_i]), (LAS unsigned*)(lds + (bufoff) + ldsw + _i * 8192), 16, 0, 0); } while (0)
#define PG_LDA(dst, b, h) do { _Pragma("unroll") for (int m = 0; m < 4; ++m) _Pragma("unroll") for (int k = 0; k < 2; ++k) dst[m][k] = *(const LAS bf16x8*)(lds + PG_SA(b, h) + aoff + m * 2048 + k * 1024); } while (0)
#define PG_LDB(dst, b, h) do { _Pragma("unroll") for (int n = 0; n < 2; ++n) _Pragma("unroll") for (int k = 0; k < 2; ++k) dst[n][k] = *(const LAS bf16x8*)(lds + PG_SB(b, h) + boff + n * 2048 + k * 1024); } while (0)
#define PG_MMA(ai, bj, At, Bt) do { __builtin_amdgcn_s_setprio(1); _Pragma("unroll") for (int m = 0; m < 4; ++m) _Pragma("unroll") for (int n = 0; n < 2; ++n) _Pragma("unroll") for (int k = 0; k < 2; ++k) \
        acc[ai][bj][m][n] = __builtin_amdgcn_mfma_f32_16x16x32_bf16(Bt[n][k], At[m][k], acc[ai][bj][m][n], 0, 0, 0); __builtin_amdgcn_s_setprio(0); } while (0)
#define PG_WAIT_V(n) asm volatile("s_waitcnt vmcnt(" #n ")" ::: "memory")
#define PG_WAIT_L(n) asm volatile("s_waitcnt lgkmcnt(" #n ")" ::: "memory")
#define PG_BAR __builtin_amdgcn_s_barrier()
#define PG_SCHED __builtin_amdgcn_sched_barrier(0)
    Unit cur, nxt, nn; int ui = 0;
    if (!S.next(0, cur)) return;
    bool has_next = S.next(1, nxt);
    unsigned vA[2][2], vN[2][2];
    S.aoff(cur, sR, sC, vA);
    if (has_next) S.aoff(nxt, sR, sC, vN); else { vN[0][0] = vA[0][0]; vN[0][1] = vA[0][1]; vN[1][0] = vA[1][0]; vN[1][1] = vA[1][1]; }
    f32x4 acc[2][2][4][2];
#pragma unroll
    for (int a = 0; a < 2; ++a)
#pragma unroll
        for (int b = 0; b < 2; ++b)
#pragma unroll
            for (int m = 0; m < 4; ++m)
#pragma unroll
                for (int n = 0; n < 2; ++n) acc[a][b][m][n] = (f32x4){0.f, 0.f, 0.f, 0.f};
    bf16x8 At[4][2], B0[2][2], B1[2][2];
    const char* cB = cur.bptr;
    PG_STAGE(PG_SB(0, 0), cB, voffB); PG_STAGE(PG_SA(0, 0), Abase, vA[0]); PG_STAGE(PG_SB(0, 1), cB + hstep, voffB); PG_STAGE(PG_SA(0, 1), Abase, vA[1]);
    if (wr == 1) PG_BAR;
    PG_WAIT_V(4); PG_BAR;
    PG_STAGE(PG_SB(1, 0), cB + kstep, voffB); PG_STAGE(PG_SA(1, 0), Abase + kstep, vA[0]); PG_STAGE(PG_SB(1, 1), cB + hstep + kstep, voffB);
    PG_WAIT_V(6); PG_BAR;
    for (;;) {
        const char* nB = has_next ? nxt.bptr : cB;
        for (int t = 0; t < nt; t += 2) {
            const bool last = (t == nt - 2);
            const char* a1 = Abase + (size_t)(t + 1) * kstep;
            const char* a2 = last ? Abase : Abase + (size_t)(t + 2) * kstep; const char* b2 = last ? nB : cB + (size_t)(t + 2) * kstep;
            const char* a3 = a2 + kstep; const char* b3 = b2 + kstep;
            PG_LDB(B0, 0, 0); PG_SCHED; PG_LDA(At, 0, 0); PG_STAGE(PG_SA(1, 1), a1, vA[1]);
            if (last) { vA[0][0] = vN[0][0]; vA[0][1] = vN[0][1]; vA[1][0] = vN[1][0]; vA[1][1] = vN[1][1]; }
            PG_WAIT_L(8); PG_BAR; PG_WAIT_L(0); PG_MMA(0, 0, At, B0); PG_BAR; PG_SCHED;
            PG_LDB(B1, 0, 1); PG_STAGE(PG_SB(0, 0), b2, voffB);
            PG_BAR; PG_WAIT_L(0); PG_MMA(0, 1, At, B1); PG_BAR;
            PG_LDA(At, 0, 1); PG_STAGE(PG_SA(0, 0), a2, vA[0]);
            PG_BAR; PG_WAIT_L(0); PG_MMA(1, 0, At, B0); PG_BAR; PG_SCHED;
            PG_STAGE(PG_SB(0, 1), b2 + hstep, voffB);
            PG_WAIT_V(6); PG_BAR; PG_MMA(1, 1, At, B1); PG_BAR;
            PG_LDB(B0, 1, 0); PG_SCHED; PG_LDA(At, 1, 0); PG_STAGE(PG_SA(0, 1), a2, vA[1]);
            PG_WAIT_L(8); PG_BAR; PG_WAIT_L(0); PG_MMA(0, 0, At, B0); PG_BAR; PG_SCHED;
            PG_LDB(B1, 1, 1); PG_STAGE(PG_SB(1, 0), b3, voffB);
            PG_BAR; PG_WAIT_L(0); PG_MMA(0, 1, At, B1); PG_BAR;
            PG_LDA(At, 1, 1); PG_STAGE(PG_SA(1, 0), a3, vA[0]);
            PG_BAR; PG_WAIT_L(0); PG_MMA(1, 0, At, B0); PG_BAR; PG_SCHED;
            PG_STAGE(PG_SB(1, 1), b3 + hstep, voffB);
            PG_WAIT_V(6); PG_BAR; PG_MMA(1, 1, At, B1); PG_BAR;
        }
        E(acc, cur, wr, wc, fr, fq);
        if (!has_next) break;
#pragma unroll
        for (int a = 0; a < 2; ++a)
#pragma unroll
            for (int b = 0; b < 2; ++b)
#pragma unroll
                for (int m = 0; m < 4; ++m)
#pragma unroll
                    for (int n = 0; n < 2; ++n) acc[a][b][m][n] = (f32x4){0.f, 0.f, 0.f, 0.f};
        cur = nxt; cB = nB; ++ui;
        has_next = S.next(ui + 1, nn);
        if (has_next) { nxt = nn; S.aoff(nxt, sR, sC, vN); }
    }
    PG_WAIT_V(0);
    if (wr == 0) PG_BAR;
    PG_BAR;
#undef PG_SA
#undef PG_SB
#undef PG_STAGE
#undef PG_LDA
#undef PG_LDB
#undef PG_MMA
#undef PG_WAIT_V
#undef PG_WAIT_L
#undef PG_BAR
#undef PG_SCHED
}
}

typedef f32x4 Acc[2][2][4][2];

struct SchedInProj {
    const bf16_t* WinT; int G, c;
    __device__ __forceinline__ bool next(int i, pg::Unit& u) const {
        const int L = i * G + c; int pm, pn;
        if (L < 64 * 14) { pg::static_order(64, 14, L, pm, pn); }
        else { const int x = L - 64 * 14; if (x >= 48) return false; pm = 64 + (x & 7); pn = 6 + (x >> 3); }
        u.bptr = (const char*)(WinT + (size_t)pn * 256 * D); u.arow = pm * 256; u.orow = pm * 256; u.pn = pn; u.e = 0; u.cnt = 0; u.pad = 0; return true;
    }
    __device__ __forceinline__ void aoff(const pg::Unit& u, const int (&R)[2], const int (&C)[2], unsigned (&v)[2][2]) const {
#pragma unroll
        for (int h = 0; h < 2; ++h)
#pragma unroll
            for (int i = 0; i < 2; ++i) v[h][i] = (unsigned)((u.arow + h * 128 + R[i]) * D + C[i]) * 2u;
    }
};
struct EpiInProj {
    static constexpr bool PERM = true;
    bf16_t *U, *VG, *Q, *GS, *I, *GF, *KF, *GB, *KB; const float *lb_fwd, *lb_bwd;
    __device__ __forceinline__ void operator()(const Acc& acc, const pg::Unit& u, int wr, int wc, int fr, int fq) const {
        const int cg = u.pn >> 1;
        const int cbase = (u.pn & 1) * 256 + wc * 32 + 8 * fq;
        const int row0 = u.orow + wr * 64 + fr;
        if (cg == 3 || cg == 4) {
            const float* tab = (cg == 3) ? lb_fwd : lb_bwd; bf16_t* Gd = (cg == 3) ? GF : GB; bf16_t* Kd = (cg == 3) ? KF : KB;
#pragma unroll
            for (int bj = 0; bj < 2; ++bj) {
                const int col = cbase + bj * 128;
                float lb[8], omlb[8];
#pragma unroll
                for (int j = 0; j < 8; ++j) { const float t0 = tab[col + j], t1 = tab[GW + col + j]; lb[j] = fast_rcp(1.0f + __expf(t1 - t0)); omlb[j] = 1.0f - lb[j]; }
#pragma unroll
                for (int ai = 0; ai < 2; ++ai)
#pragma unroll
                    for (int m = 0; m < 4; ++m) {
                        const size_t off = (size_t)(row0 + ai * 128 + m * 16) * GW + col;
                        float gv[8], kv[8];
#pragma unroll
                        for (int n = 0; n < 2; ++n)
#pragma unroll
                            for (int j = 0; j < 4; ++j) {
                                const float z = clampf(acc[ai][bj][m][n][j], -30.f, 30.f);
                                const float e = __expf(-z), s = fast_rcp(1.0f + e), oms = e * s;
                                const float f = lb[4 * n + j] + omlb[4 * n + j] * s;
                                gv[4 * n + j] = __logf(f); kv[4 * n + j] = omlb[4 * n + j] * oms;
                            }
                        u32x4 wg, wk;
                        wg.x = cvt_pk_bf16(gv[0], gv[1]); wg.y = cvt_pk_bf16(gv[2], gv[3]); wg.z = cvt_pk_bf16(gv[4], gv[5]); wg.w = cvt_pk_bf16(gv[6], gv[7]);
                        wk.x = cvt_pk_bf16(kv[0], kv[1]); wk.y = cvt_pk_bf16(kv[2], kv[3]); wk.z = cvt_pk_bf16(kv[4], kv[5]); wk.w = cvt_pk_bf16(kv[6], kv[7]);
                        *(u32x4*)(Gd + off) = wg; *(u32x4*)(Kd + off) = wk;
                    }
            }
        } else {
            bf16_t* Od = (cg == 0) ? U : (cg == 1) ? VG : (cg == 2) ? Q : (cg == 5) ? I : GS;
            const int act = (cg <= 1) ? 1 : (cg == 6) ? 2 : 0;
#pragma unroll
            for (int ai = 0; ai < 2; ++ai)
#pragma unroll
                for (int m = 0; m < 4; ++m)
#pragma unroll
                    for (int bj = 0; bj < 2; ++bj) {
                        const size_t off = (size_t)(row0 + ai * 128 + m * 16) * GW + cbase + bj * 128;
                        float v[8];
#pragma unroll
                        for (int n = 0; n < 2; ++n)
#pragma unroll
                            for (int j = 0; j < 4; ++j) { float z = acc[ai][bj][m][n][j]; if (act == 1) z = gelu_tanh(z); else if (act == 2) z = z * sigmoidf_(z); v[4 * n + j] = z; }
                        u32x4 w; w.x = cvt_pk_bf16(v[0], v[1]); w.y = cvt_pk_bf16(v[2], v[3]); w.z = cvt_pk_bf16(v[4], v[5]); w.w = cvt_pk_bf16(v[6], v[7]);
                        *(u32x4*)(Od + off) = w;
                    }
        }
    }
};

struct SchedOutProj {
    const bf16_t* WoutT; int G, c;
    __device__ __forceinline__ bool next(int i, pg::Unit& u) const {
        const int L = i * G + c; int pm, pn; if (!pg::static_order(64, 4, L, pm, pn)) return false;
        u.bptr = (const char*)(WoutT + (size_t)pn * 256 * D); u.arow = pm * 256; u.orow = pm * 256; u.pn = pn; u.e = 0; u.cnt = 0; u.pad = 0; return true;
    }
    __device__ __forceinline__ void aoff(const pg::Unit& u, const int (&R)[2], const int (&C)[2], unsigned (&v)[2][2]) const {
#pragma unroll
        for (int h = 0; h < 2; ++h)
#pragma unroll
            for (int i = 0; i < 2; ++i) v[h][i] = (unsigned)((u.arow + h * 128 + R[i]) * D + C[i]) * 2u;
    }
};
struct EpiOutProj {
    static constexpr bool PERM = false;
    const float* x; const float* mod; float* X1; float* SS;
    __device__ __forceinline__ void operator()(const Acc& acc, const pg::Unit& u, int wr, int wc, int fr, int fq) const {
        const int row0 = u.orow + wr * 64 + fr, col0 = u.pn * 256 + wc * 32 + 4 * fq;
        const float* g1 = mod + (size_t)(u.orow >> 11) * 6144 + 2048;
        f32x4 gv[2][2];
#pragma unroll
        for (int bj = 0; bj < 2; ++bj)
#pragma unroll
            for (int n = 0; n < 2; ++n) gv[bj][n] = *(const f32x4*)(g1 + col0 + bj * 128 + n * 16);
#pragma unroll
        for (int ai = 0; ai < 2; ++ai)
#pragma unroll
            for (int m = 0; m < 4; ++m) {
                const int row = row0 + ai * 128 + m * 16; const size_t off = (size_t)row * D + col0; float s = 0.f;
#pragma unroll
                for (int bj = 0; bj < 2; ++bj)
#pragma unroll
                    for (int n = 0; n < 2; ++n) {
                        const f32x4 xv = *(const f32x4*)(x + off + bj * 128 + n * 16);
                        const f32x4 o = xv + gv[bj][n] * acc[ai][bj][m][n] * (float)DBG_MIX;
                        *(f32x4*)(X1 + off + bj * 128 + n * 16) = o;
                        s += (o[0] * o[0] + o[1] * o[1]) + (o[2] * o[2] + o[3] * o[3]);
                    }
                s += __shfl_xor(s, 16); s += __shfl_xor(s, 32);
                if (fq == 0) SS[(size_t)row * 16 + u.pn * 4 + wc] = s;
            }
    }
};

struct MoeTab { LAS int* cnt; LAS int* tstart; LAS int* ent; };
__device__ __forceinline__ MoeTab moe_tab(LAS unsigned char* lds) { MoeTab t; t.cnt = (LAS int*)(lds + LDS_EXTRA_OFF); t.tstart = t.cnt + 32; t.ent = t.tstart + 64; return t; }
__device__ __forceinline__ void moe_tables(const Frame& F) {
    const MoeTab T = moe_tab(F.lds);
    if (threadIdx.x < 64) {
        const int lane = threadIdx.x;
        const int c = (lane < NE) ? (int)__hip_atomic_load(F.ctl + CW_CNT + lane, __ATOMIC_RELAXED, __HIP_MEMORY_SCOPE_AGENT) : 0;
        const int t = (c + 255) >> 8;
        int incl = t;
#pragma unroll
        for (int o = 1; o < 64; o <<= 1) { const int v = __shfl_up(incl, o); if (lane >= o) incl += v; }
        const int start = incl - t;
        if (lane < NE) { T.cnt[lane] = c; T.tstart[lane] = start; for (int k = 0; k < t; ++k) T.ent[start + k] = lane; }
        if (lane == NE) T.tstart[NE] = start;
    }
    __syncthreads();
}
struct SchedGateUp {
    const bf16_t* W1T; const int* LIST; MoeTab T; int G, c;
    __device__ __forceinline__ bool next(int i, pg::Unit& u) const {
        int idx, pn; const int total = __builtin_amdgcn_readfirstlane(T.tstart[32]);
        if ((G & 7) == 0) { pn = c & 7; idx = (c >> 3) + (G >> 3) * i; if (idx >= total) return false; }
        else { const int L = i * G + c; if (L >= total * 8) return false; idx = L >> 3; pn = L & 7; }
        const int e = __builtin_amdgcn_readfirstlane(T.ent[idx]); const int ts = __builtin_amdgcn_readfirstlane(T.tstart[e]); const int mt = idx - ts;
        u.bptr = (const char*)(W1T + ((size_t)e * 2048 + (size_t)pn * 256) * D); u.arow = mt * 256; u.orow = ts * 256 + mt * 256; u.pn = pn; u.e = e;
        u.cnt = __builtin_amdgcn_readfirstlane(T.cnt[e]); u.pad = 0; return true;
    }
    __device__ __forceinline__ void aoff(const pg::Unit& u, const int (&R)[2], const int (&C)[2], unsigned (&v)[2][2]) const {
#pragma unroll
        for (int h = 0; h < 2; ++h)
#pragma unroll
            for (int i = 0; i < 2; ++i) {
                int s = u.arow + h * 128 + R[i]; s = s < u.cnt ? s : u.cnt - 1;
                const int tok = LIST[u.e * NTOK + s];
                v[h][i] = (unsigned)(tok * D + C[i]) * 2u;
            }
    }
};
struct EpiGateUp {
    static constexpr bool PERM = true;
    const float* b1; bf16_t* ACT;
    __device__ __forceinline__ void operator()(const Acc& acc, const pg::Unit& u, int wr, int wc, int fr, int fq) const {
        const int col = u.pn * 128 + wc * 32 + 8 * fq;
        const float* bg = b1 + (size_t)u.e * 2048 + col; const float* bu = bg + 1024;
        float vg[8], vu[8];
#pragma unroll
        for (int j = 0; j < 8; ++j) { vg[j] = bg[j]; vu[j] = bu[j]; }
        const int row0 = u.orow + wr * 64 + fr;
#pragma unroll
        for (int ai = 0; ai < 2; ++ai)
#pragma unroll
            for (int m = 0; m < 4; ++m) {
                float a[8];
#pragma unroll
                for (int n = 0; n < 2; ++n)
#pragma unroll
                    for (int j = 0; j < 4; ++j) {
                        float g = acc[ai][0][m][n][j] + vg[4 * n + j], up = acc[ai][1][m][n][j] + vu[4 * n + j];
                        g = fminf(g, 7.0f); up = clampf(up, -7.0f, 7.0f);
                        a[4 * n + j] = g * fast_rcp(1.0f + __expf(-1.702f * g)) * (up + 1.0f);
                    }
                u32x4 w; w.x = cvt_pk_bf16(a[0], a[1]); w.y = cvt_pk_bf16(a[2], a[3]); w.z = cvt_pk_bf16(a[4], a[5]); w.w = cvt_pk_bf16(a[6], a[7]);
                *(u32x4*)(ACT + (size_t)(row0 + ai * 128 + m * 16) * DE + col) = w;
            }
    }
};
struct SchedDown {
    const bf16_t* W2T; MoeTab T; int G, c;
    __device__ __forceinline__ bool next(int i, pg::Unit& u) const {
        int idx, pn; const int total = __builtin_amdgcn_readfirstlane(T.tstart[32]);
        if ((G & 7) == 0) { const int x = c & 7; pn = x & 3; idx = 2 * ((c >> 3) + (G >> 3) * i) + (x >> 2); if (idx >= total) return false; }
        else { const int L = i * G + c; if (L >= total * 4) return false; idx = L >> 2; pn = L & 3; }
        const int e = __builtin_amdgcn_readfirstlane(T.ent[idx]); const int ts = __builtin_amdgcn_readfirstlane(T.tstart[e]); const int mt = idx - ts;
        u.bptr = (const char*)(W2T + ((size_t)e * 1024 + (size_t)pn * 256) * DE); u.arow = ts * 256 + mt * 256; u.orow = u.arow; u.pn = pn; u.e = e; u.cnt = 0; u.pad = 0; return true;
    }
    __device__ __forceinline__ void aoff(const pg::Unit& u, const int (&R)[2], const int (&C)[2], unsigned (&v)[2][2]) const {
#pragma unroll
        for (int h = 0; h < 2; ++h)
#pragma unroll
            for (int i = 0; i < 2; ++i) v[h][i] = (unsigned)((u.arow + h * 128 + R[i]) * DE + C[i]) * 2u;
    }
};
struct EpiDown {
    static constexpr bool PERM = true;
    const float* b2; bf16_t* DOUT;
    __device__ __forceinline__ void operator()(const Acc& acc, const pg::Unit& u, int wr, int wc, int fr, int fq) const {
        const int col0 = u.pn * 256 + wc * 32 + 8 * fq; const int row0 = u.orow + wr * 64 + fr;
        float bv[2][8];
#pragma unroll
        for (int bj = 0; bj < 2; ++bj)
#pragma unroll
            for (int j = 0; j < 8; ++j) bv[bj][j] = b2[(size_t)u.e * D + col0 + bj * 128 + j];
#pragma unroll
        for (int ai = 0; ai < 2; ++ai)
#pragma unroll
            for (int m = 0; m < 4; ++m)
#pragma unroll
                for (int bj = 0; bj < 2; ++bj) {
                    const f32x4 v0 = acc[ai][bj][m][0], v1 = acc[ai][bj][m][1];
                    u32x4 w; w.x = cvt_pk_bf16(v0[0] + bv[bj][0], v0[1] + bv[bj][1]); w.y = cvt_pk_bf16(v0[2] + bv[bj][2], v0[3] + bv[bj][3]);
                    w.z = cvt_pk_bf16(v1[0] + bv[bj][4], v1[1] + bv[bj][5]); w.w = cvt_pk_bf16(v1[2] + bv[bj][6], v1[3] + bv[bj][7]);
                    *(u32x4*)(DOUT + (size_t)(row0 + ai * 128 + m * 16) * D + col0 + bj * 128) = w;
                }
    }
};

__device__ __forceinline__ void conv_tile(const float* src, int ld, int k0, int n0, bf16_t* dst, int drow0, LAS unsigned char* lds) {
    const int tid = threadIdx.x, p = tid >> 4, q = tid & 15;
    f32x4 v[4];
#pragma unroll
    for (int r = 0; r < 4; ++r) v[r] = *(const f32x4*)(src + (size_t)(k0 + 4 * p + r) * ld + n0 + 4 * q);
#pragma unroll
    for (int i = 0; i < 4; ++i) {
        u32x2 w; w.x = cvt_pk_bf16(v[0][i], v[1][i]); w.y = cvt_pk_bf16(v[2][i], v[3][i]);
        *(LAS u32x2*)(lds + (4 * q + i) * 256 + ((p ^ q) * 8)) = w;
    }
    __syncthreads();
#pragma unroll
    for (int jj = 0; jj < 2; ++jj) {
        const int n = (tid >> 4) + 32 * jj, c = tid & 15, qn = (n >> 2) & 15;
        u32x4 w = *(const LAS u32x4*)(lds + n * 256 + ((c ^ (qn >> 1)) * 16));
        if (qn & 1) { const unsigned t0 = w.x, t1 = w.y; w.x = w.z; w.y = w.w; w.z = t0; w.w = t1; }
        *(u32x4*)(dst + (size_t)(drow0 + n) * 1024 + k0 + 8 * c) = w;
    }
    __syncthreads();
}
__device__ __forceinline__ void conv_item_w1(const Frame& F, int it) {
    const int e = it >> 8, r = it & 255, nt = r & 31, kt = r >> 5, n0 = nt * 64;
    const int drow = (n0 < 1024) ? ((n0 >> 7) * 256 + (n0 & 127)) : (((n0 - 1024) >> 7) * 256 + 128 + ((n0 - 1024) & 127));
    conv_tile(F.w1 + (size_t)e * D * 2048, 2048, kt * 128, n0, F.W1T + (size_t)e * 2048 * D, drow, F.lds);
}
__device__ __forceinline__ void conv_item_w2(const Frame& F, int it) {
    const int e = it >> 7, r = it & 127, nt = r & 15, kt = r >> 4;
    conv_tile(F.w2 + (size_t)e * DE * D, 1024, kt * 128, nt * 64, F.W2T + (size_t)e * D * DE, nt * 64, F.lds);
}

__device__ __forceinline__ void mod_item(const Frame& F, int item) {
    LAS float* S = (LAS float*)F.lds;
    LAS float* RED = (LAS float*)(F.lds + 40960);
    const int tid = threadIdx.x, lane = tid & 63, wv = tid >> 6, c0 = item * 64;
    for (int idx = tid; idx < 9 * 1024; idx += NTHREADS) { const int r = idx >> 10, k = idx & 1023; const float v = (r < 8) ? F.c[r * 1024 + k] : F.c_ctx[k]; S[idx] = v * sigmoidf_(v); }
    __syncthreads();
    const int cq = tid & 15, kg = tid >> 4;
    f32x4 acc[9];
#pragma unroll
    for (int r = 0; r < 9; ++r) acc[r] = (f32x4){0.f, 0.f, 0.f, 0.f};
    for (int k = kg; k < 1024; k += 32) {
        const f32x4 wv4 = *(const f32x4*)(F.w_mod + (size_t)k * 6144 + c0 + 4 * cq);
#pragma unroll
        for (int r = 0; r < 9; ++r) acc[r] += S[r * 1024 + k] * wv4;
    }
#pragma unroll
    for (int r = 0; r < 9; ++r)
#pragma unroll
        for (int j = 0; j < 4; ++j) { float v = acc[r][j]; v += __shfl_xor(v, 16); v += __shfl_xor(v, 32); if (lane < 16) RED[(wv * 9 + r) * 64 + 4 * cq + j] = v; }
    __syncthreads();
    for (int idx = tid; idx < 9 * 64; idx += NTHREADS) {
        const int r = idx >> 6, cc = idx & 63; float s = F.b_mod[c0 + cc];
#pragma unroll
        for (int w8 = 0; w8 < 8; ++w8) s += RED[(w8 * 9 + r) * 64 + cc];
        F.mod[r * 6144 + c0 + cc] = s;
    }
    __syncthreads();
}
__device__ __forceinline__ void phase0(const Frame& F) {
    for (int item = blockIdx.x; item < 96 + 448 + 128; item += gridDim.x) {
        if (item < 96) mod_item(F, item);
        else if (item < 96 + 448) { const int it = item - 96, nt = it % 56, kt = it / 56; conv_tile(F.w_in, DIN, kt * 128, nt * 64, F.WinT, nt * 64, F.lds); }
        else { const int it = item - 544, nt = it & 15, kt = it >> 4; conv_tile(F.w_out, D, kt * 128, nt * 64, F.WoutT, nt * 64, F.lds); }
    }
}

__device__ __forceinline__ void phase1(const Frame& F) {
    const int lane = threadIdx.x & 63, wv = threadIdx.x >> 6;
    for (int r = blockIdx.x * 8 + wv; r < NROW; r += gridDim.x * 8) {
        const float* src; const float* md;
        if (r < NTOK) { src = F.x + (size_t)r * D; md = F.mod + (size_t)(r >> 11) * 6144; } else { src = F.ctx + (size_t)(r - NTOK) * D; md = F.mod + (size_t)8 * 6144; }
        f32x4 v[4]; float ss = 0.f;
#pragma unroll
        for (int j = 0; j < 4; ++j) { v[j] = *(const f32x4*)(src + 4 * lane + 256 * j); ss += (v[j][0] * v[j][0] + v[j][1] * v[j][1]) + (v[j][2] * v[j][2] + v[j][3] * v[j][3]); }
        ss = wave_sum(ss);
        const float rstd = __builtin_amdgcn_rsqf(ss * (1.0f / 1024.0f) + EPS);
#pragma unroll
        for (int j = 0; j < 4; ++j) {
            const int c = 4 * lane + 256 * j;
            const f32x4 nw = *(const f32x4*)(F.norm1 + c), sh = *(const f32x4*)(md + c), sc = *(const f32x4*)(md + 1024 + c);
            const f32x4 o = v[j] * rstd * nw * (1.0f + sc) + sh;
            u32x2 w; w.x = cvt_pk_bf16(o[0], o[1]); w.y = cvt_pk_bf16(o[2], o[3]);
            *(u32x2*)(F.H + (size_t)r * D + c) = w;
        }
    }
}

__device__ __forceinline__ void phase4(const Frame& F) {
    const int lane = threadIdx.x & 63, wv = threadIdx.x >> 6;
    for (int t = blockIdx.x * 8 + wv; t < NTOK; t += gridDim.x * 8) {
        const size_t o = (size_t)t * GW + 8 * lane;
        const f32x4 a0 = *(const f32x4*)(F.OF + o), a1 = *(const f32x4*)(F.OF + o + 4), b0 = *(const f32x4*)(F.OB + o), b1 = *(const f32x4*)(F.OB + o + 4);
        const f32x4 s0 = a0 + b0, s1 = a1 + b1;
        float ss = (s0[0] * s0[0] + s0[1] * s0[1]) + (s0[2] * s0[2] + s0[3] * s0[3]) + (s1[0] * s1[0] + s1[1] * s1[1]) + (s1[2] * s1[2] + s1[3] * s1[3]);
        ss += __shfl_xor(ss, 1); ss += __shfl_xor(ss, 2); ss += __shfl_xor(ss, 4); ss += __shfl_xor(ss, 8);
        const float rstd = __builtin_amdgcn_rsqf(ss * (1.0f / 128.0f) + EPS);
        const f32x4 n0 = *(const f32x4*)(F.hgrn_norm + 8 * lane), n1 = *(const f32x4*)(F.hgrn_norm + 8 * lane + 4);
        const u32x4 g = *(const u32x4*)(F.GS + o);
        u32x4 w;
        w.x = cvt_pk_bf16(s0[0] * rstd * n0[0] * bflo(g.x), s0[1] * rstd * n0[1] * bfhi(g.x));
        w.y = cvt_pk_bf16(s0[2] * rstd * n0[2] * bflo(g.y), s0[3] * rstd * n0[3] * bfhi(g.y));
        w.z = cvt_pk_bf16(s1[0] * rstd * n1[0] * bflo(g.z), s1[1] * rstd * n1[1] * bfhi(g.z));
        w.w = cvt_pk_bf16(s1[2] * rstd * n1[2] * bflo(g.w), s1[3] * rstd * n1[3] * bfhi(g.w));
        *(u32x4*)(F.YCAT + (size_t)t * D + GW + 8 * lane) = w;
    }
}

constexpr int RT_STRIDE = 1028;
__device__ __forceinline__ void phase6(const Frame& F) {
    LAS float* RT = (LAS float*)F.lds;
    const int tid = threadIdx.x, lane = tid & 63, wv = tid >> 6;
    for (int idx = tid; idx < D * NE; idx += NTHREADS) { const int c = idx >> 5, e = idx & 31; RT[e * RT_STRIDE + c] = F.router_w[idx]; }
    __syncthreads();
    for (int t = blockIdx.x * 8 + wv; t < NTOK; t += gridDim.x * 8) {
        const float* md = F.mod + (size_t)(t >> 11) * 6144;
        f32x4 hv[4];
        float ss = (lane < 16) ? F.SS[(size_t)t * 16 + lane] : 0.f;
        ss = wave_sum(ss);
        const float rstd = __builtin_amdgcn_rsqf(ss * (1.0f / 1024.0f) + EPS);
#pragma unroll
        for (int j = 0; j < 4; ++j) {
            const int c = 4 * lane + 256 * j;
            const f32x4 xv = *(const f32x4*)(F.X1 + (size_t)t * D + c), nw = *(const f32x4*)(F.norm2 + c), sh = *(const f32x4*)(md + 3072 + c), sc = *(const f32x4*)(md + 4096 + c);
            hv[j] = xv * rstd * nw * (1.0f + sc) + sh;
            u32x2 w; w.x = cvt_pk_bf16(hv[j][0], hv[j][1]); w.y = cvt_pk_bf16(hv[j][2], hv[j][3]);
            *(u32x2*)(F.H2 + (size_t)t * D + c) = w;
        }
        float mylogit = -3.0e38f;
        for (int e = 0; e < NE; ++e) {
            float p = 0.f;
#pragma unroll
            for (int j = 0; j < 4; ++j) { const f32x4 rw = *(const LAS f32x4*)(RT + e * RT_STRIDE + 4 * lane + 256 * j); p += (hv[j][0] * rw[0] + hv[j][1] * rw[1]) + (hv[j][2] * rw[2] + hv[j][3] * rw[3]); }
            p = wave_sum(p);
            if (lane == e) mylogit = p + F.router_b[e];
        }
        float v = mylogit, tv[4]; int te[4];
#pragma unroll
        for (int k = 0; k < 4; ++k) {
            float m = v;
#pragma unroll
            for (int o = 32; o >= 1; o >>= 1) m = fmaxf(m, __shfl_xor(m, o));
            const unsigned long long bal = __ballot(v == m);
            const int src = __ffsll((long long)bal) - 1;
            tv[k] = m; te[k] = src;
            if (lane == src) v = -3.0e38f;
        }
        const float e1 = __expf(tv[1] - tv[0]), e2 = __expf(tv[2] - tv[0]), e3 = __expf(tv[3] - tv[0]);
        const float inv = 1.0f / (1.0f + e1 + e2 + e3);
        if (lane < 4) {
            const int e = (lane == 0) ? te[0] : (lane == 1) ? te[1] : (lane == 2) ? te[2] : te[3];
            const float wgt = ((lane == 0) ? 1.0f : (lane == 1) ? e1 : (lane == 2) ? e2 : e3) * inv;
            const int idx = (int)__hip_atomic_fetch_add(F.ctl + CW_CNT + e, 1u, __ATOMIC_RELAXED, __HIP_MEMORY_SCOPE_AGENT);
            F.LIST[e * NTOK + idx] = t; F.TSLOT[t * 4 + lane] = e * NTOK + idx; F.TW[t * 4 + lane] = wgt;
        }
    }
    __syncthreads();
}

__device__ __forceinline__ void phase9(const Frame& F) {
    moe_tables(F);
    const MoeTab T = moe_tab(F.lds);
    const int lane = threadIdx.x & 63, wv = threadIdx.x >> 6;
    for (int t = blockIdx.x * 8 + wv; t < NTOK; t += gridDim.x * 8) {
        const float* g2 = F.mod + (size_t)(t >> 11) * 6144 + 5120;
        float y[2][8];
#pragma unroll
        for (int j = 0; j < 2; ++j)
#pragma unroll
            for (int i = 0; i < 8; ++i) y[j][i] = 0.f;
#pragma unroll
        for (int k = 0; k < (DBG_NO_MOE ? 0 : 4); ++k) {
            const int sl = F.TSLOT[t * 4 + k]; const float wk = F.TW[t * 4 + k];
            const int e = sl >> 14, idx = sl & (NTOK - 1);
            const size_t row = (size_t)(T.tstart[e] * 256 + idx);
#pragma unroll
            for (int j = 0; j < 2; ++j) {
                const u32x4 d = *(const u32x4*)(F.DOUT + row * D + 8 * lane + 512 * j);
                y[j][0] += wk * bflo(d.x); y[j][1] += wk * bfhi(d.x); y[j][2] += wk * bflo(d.y); y[j][3] += wk * bfhi(d.y);
                y[j][4] += wk * bflo(d.z); y[j][5] += wk * bfhi(d.z); y[j][6] += wk * bflo(d.w); y[j][7] += wk * bfhi(d.w);
            }
        }
        float xf[2][8]; float ss = 0.f;
#pragma unroll
        for (int j = 0; j < 2; ++j) {
            const int c = 8 * lane + 512 * j;
            const f32x4 x0 = *(const f32x4*)(F.X1 + (size_t)t * D + c), x1v = *(const f32x4*)(F.X1 + (size_t)t * D + c + 4);
            const f32x4 ga = *(const f32x4*)(g2 + c), gb = *(const f32x4*)(g2 + c + 4);
#pragma unroll
            for (int i = 0; i < 4; ++i) { xf[j][i] = x0[i] + ga[i] * y[j][i]; xf[j][4 + i] = x1v[i] + gb[i] * y[j][4 + i]; }
#pragma unroll
            for (int i = 0; i < 8; ++i) ss += xf[j][i] * xf[j][i];
        }
        ss = wave_sum(ss);
        const float rstd = __builtin_amdgcn_rsqf(ss * (1.0f / 1024.0f) + EPS);
#pragma unroll
        for (int j = 0; j < 2; ++j) {
            const int c = 8 * lane + 512 * j;
            const f32x4 fa = *(const f32x4*)(F.final_norm + c), fb = *(const f32x4*)(F.final_norm + c + 4);
            f32x4 o0, o1;
#pragma unroll
            for (int i = 0; i < 4; ++i) { o0[i] = xf[j][i] * rstd * fa[i]; o1[i] = xf[j][4 + i] * rstd * fb[i]; }
            *(f32x4*)(F.out + (size_t)t * D + c) = o0; *(f32x4*)(F.out + (size_t)t * D + c + 4) = o1;
        }
    }
}

__device__ __forceinline__ void sgu_item(const Frame& F, int item) {
    constexpr int RS = 272;
    LAS unsigned char* WL = F.lds;
    LAS unsigned char* VT = F.lds + 128 * RS;
    const int tid = threadIdx.x, lane = tid & 63, wv = __builtin_amdgcn_readfirstlane(tid >> 6), fr = lane & 15, fq = lane >> 4;
    const int h = item & 3, n = (item >> 2) & 15, b = item >> 6;
    const int row0 = b * SEQ + n * 128;
    {
        const int t = tid >> 2, s0 = (tid & 3) * 32;
        const float* wp = F.sgu_w + ((size_t)h * 128 + t) * 128 + s0;
#pragma unroll
        for (int j = 0; j < 4; ++j) {
            const f32x4 a = *(const f32x4*)(wp + 8 * j), c = *(const f32x4*)(wp + 8 * j + 4);
            u32x4 w; w.x = cvt_pk_bf16(a[0], a[1]); w.y = cvt_pk_bf16(a[2], a[3]); w.z = cvt_pk_bf16(c[0], c[1]); w.w = cvt_pk_bf16(c[2], c[3]);
            *(LAS u32x4*)(WL + t * RS + (s0 + 8 * j) * 2) = w;
        }
    }
    {
        const int s = tid >> 2, d0 = (tid & 3) * 32;
        const bf16_t* vp = F.VG + (size_t)(row0 + s) * GW + h * 128 + d0;
        float v[32];
#pragma unroll
        for (int j = 0; j < 4; ++j) { const u32x4 w = *(const u32x4*)(vp + 8 * j);
            v[8 * j + 0] = bflo(w.x); v[8 * j + 1] = bfhi(w.x); v[8 * j + 2] = bflo(w.y); v[8 * j + 3] = bfhi(w.y); v[8 * j + 4] = bflo(w.z); v[8 * j + 5] = bfhi(w.z); v[8 * j + 6] = bflo(w.w); v[8 * j + 7] = bfhi(w.w); }
        float sm = 0.f;
#pragma unroll
        for (int i = 0; i < 32; ++i) sm += v[i];
        sm += __shfl_xor(sm, 1); sm += __shfl_xor(sm, 2);
        const float mu = sm * (1.0f / 128.0f); float q = 0.f;
#pragma unroll
        for (int i = 0; i < 32; ++i) { const float dd = v[i] - mu; q += dd * dd; }
        q += __shfl_xor(q, 1); q += __shfl_xor(q, 2);
        const float rstd = __builtin_amdgcn_rsqf(q * (1.0f / 128.0f) + EPS);
        const float* lg = F.sgu_ln + h * 128 + d0;
#pragma unroll
        for (int i = 0; i < 32; i += 2) {
            const unsigned pk = cvt_pk_bf16((v[i] - mu) * rstd * lg[i], (v[i + 1] - mu) * rstd * lg[i + 1]);
            *(LAS unsigned short*)(VT + (d0 + i) * RS + s * 2) = (unsigned short)(pk & 0xffffu);
            *(LAS unsigned short*)(VT + (d0 + i + 1) * RS + s * 2) = (unsigned short)(pk >> 16);
        }
    }
    __syncthreads();
    f32x4 acc[8];
#pragma unroll
    for (int nt = 0; nt < 8; ++nt) acc[nt] = (f32x4){0.f, 0.f, 0.f, 0.f};
#pragma unroll
    for (int a = 0; a < 4; ++a) {
        const bf16x8 wf = *(const LAS bf16x8*)(WL + (16 * wv + fr) * RS + (32 * a + 8 * fq) * 2);
#pragma unroll
        for (int nt = 0; nt < 8; ++nt) {
            const bf16x8 vf = *(const LAS bf16x8*)(VT + (16 * nt + fr) * RS + (32 * a + 8 * fq) * 2);
            acc[nt] = __builtin_amdgcn_mfma_f32_16x16x32_bf16(vf, wf, acc[nt], 0, 0, 0);
        }
    }
    {
        const int t = 16 * wv + fr; const size_t row = (size_t)(row0 + t);
        const float bias = F.sgu_b[h * 128 + t];
#pragma unroll
        for (int nt = 0; nt < 8; ++nt) {
            const int d = h * 128 + 16 * nt + 4 * fq;
            const u32x2 uu = *(const u32x2*)(F.U + row * GW + d);
            u32x2 w; w.x = cvt_pk_bf16(bflo(uu.x) * (acc[nt][0] + bias), bfhi(uu.x) * (acc[nt][1] + bias)); w.y = cvt_pk_bf16(bflo(uu.y) * (acc[nt][2] + bias), bfhi(uu.y) * (acc[nt][3] + bias));
            *(u32x2*)(F.YCAT + row * D + d) = w;
        }
    }
    __syncthreads();
}

__device__ __forceinline__ float hexp(float x) { return fast_exp(clampf(x, -87.0f, 60.0f)); }
__device__ __forceinline__ void hgrn_chain(const Frame& F, int chain) {
    constexpr int RS = 272, OFF_QP = 0, OFF_QA = 8704, OFF_QB = OFF_QA + 4352, OFF_QC = OFF_QB + 4352, OFF_KA = OFF_QC + 4352, OFF_KB = OFF_KA + 4352, OFF_KC = OFF_KB + 4352,
                  OFF_KDT = OFF_KC + 4352, OFF_D = OFF_KDT + 10240, BUF = OFF_D + 512;
    LAS unsigned char* lds = F.lds;
    const int tid = threadIdx.x, lane = tid & 63, w = __builtin_amdgcn_readfirstlane(tid >> 6), fr = lane & 15, fq = lane >> 4;
    const int dir = chain & 1, h = (chain >> 1) & 3, b = chain >> 3;
    const bf16_t* Gp = dir ? F.GB : F.GF; const bf16_t* Kp = dir ? F.KB : F.KF; float* Op = dir ? F.OB : F.OF;
    const int sgn = dir ? -1 : 1;
    const int colw = h * 128 + 16 * w;
    bf16x8 tri0, tri1;
#pragma unroll
    for (int jj = 0; jj < 8; ++jj) {
        tri0[jj] = (jj < 4 && 4 * fq + jj <= fr) ? (short)0x3F80 : (short)0;
        tri1[jj] = (jj < 4) ? (short)0x3F80 : ((4 * fq + jj - 4 <= fr) ? (short)0x3F80 : (short)0);
    }
    int ptok[8];
#pragma unroll
    for (int jj = 0; jj < 8; ++jj) ptok[jj] = (jj < 4) ? (4 * fq + jj) : (16 + 4 * fq + jj - 4);
    const int slot0 = 8 * (fr >> 2) + (fr & 3);
    f32x4 S[8];
#pragma unroll
    for (int kt = 0; kt < 8; ++kt) S[kt] = (f32x4){0.f, 0.f, 0.f, 0.f};
    unsigned gs[8], vs[8]; u32x2 kk2[2], q2[2];
#define HG_BASE(c) ((c) < 8 ? (NTOK + b * CTXL + (dir ? (CTXL - 1 - 32 * (c)) : 32 * (c))) : (b * SEQ + (dir ? (SEQ - 1 - 32 * ((c) - 8)) : 32 * ((c) - 8))))
#define HG_LOAD(c) do { const int _base = HG_BASE(c); \
        _Pragma("unroll") for (int jj = 0; jj < 8; ++jj) { const size_t _o = (size_t)(_base + sgn * ptok[jj]) * GW + colw + fr; gs[jj] = Gp[_o]; vs[jj] = F.I[_o]; } \
        _Pragma("unroll") for (int j = 0; j < 2; ++j) { const size_t _o = (size_t)(_base + sgn * (fr + 16 * j)) * GW + colw + 4 * fq; kk2[j] = *(const u32x2*)(Kp + _o); \
            if ((c) >= 8) q2[j] = *(const u32x2*)(F.Q + _o); else q2[j] = (u32x2){0u, 0u}; } } while (0)
    HG_LOAD(0);
    for (int c = 0; c < 72; ++c) {
        LAS unsigned char* buf = lds + (c & 1) * BUF;
        const bool lat = (c >= 8);
        bf16x8 gT, VTf;
        { u32x4 t; t.x = gs[0] | (gs[1] << 16); t.y = gs[2] | (gs[3] << 16); t.z = gs[4] | (gs[5] << 16); t.w = gs[6] | (gs[7] << 16); gT = __builtin_bit_cast(bf16x8, t);
          u32x4 u; u.x = vs[0] | (vs[1] << 16); u.y = vs[2] | (vs[3] << 16); u.z = vs[4] | (vs[5] << 16); u.w = vs[6] | (vs[7] << 16); VTf = __builtin_bit_cast(bf16x8, u); }
        const f32x4 z4 = (f32x4){0.f, 0.f, 0.f, 0.f};
        f32x4 bT[2];
        bT[0] = __builtin_amdgcn_mfma_f32_16x16x32_bf16(gT, tri0, z4, 0, 0, 0);
        bT[1] = __builtin_amdgcn_mfma_f32_16x16x32_bf16(gT, tri1, z4, 0, 0, 0);
        f32x4 b7, b15, b23, b31;
#pragma unroll
        for (int r = 0; r < 4; ++r) { b7[r] = __shfl(bT[0][r], 16 * fq + 7); b15[r] = __shfl(bT[0][r], 16 * fq + 15); b23[r] = __shfl(bT[1][r], 16 * fq + 7); b31[r] = __shfl(bT[1][r], 16 * fq + 15); }
#pragma unroll
        for (int j = 0; j < 2; ++j) {
            const float kv[4] = {bflo(kk2[j].x), bfhi(kk2[j].x), bflo(kk2[j].y), bfhi(kk2[j].y)};
            const float qv[4] = {bflo(q2[j].x), bfhi(q2[j].x), bflo(q2[j].y), bfhi(q2[j].y)};
            float kd[4], qp[4], qi[4], ki[4], x2[4];
#pragma unroll
            for (int r = 0; r < 4; ++r) {
                const float bt = bT[j][r], mref = (j == 0) ? b7[r] : b23[r];
                kd[r] = kv[r] * hexp(b31[r] - bt);
                qp[r] = qv[r] * hexp(bt);
                qi[r] = qv[r] * hexp(bt - mref);
                ki[r] = kv[r] * hexp(mref - bt);
                x2[r] = (j == 0) ? kv[r] * hexp(b15[r] - bt) : qv[r] * hexp(bt - b15[r]);
            }
            const int trow = fr + 16 * j;
            const unsigned kd01 = cvt_pk_bf16(kd[0], kd[1]), kd23 = cvt_pk_bf16(kd[2], kd[3]);
            LAS unsigned char* kdp = buf + OFF_KDT + (16 * w + 4 * fq) * 80 + (slot0 + 4 * j) * 2;
            *(LAS unsigned short*)(kdp) = (unsigned short)(kd01 & 0xffffu); *(LAS unsigned short*)(kdp + 80) = (unsigned short)(kd01 >> 16);
            *(LAS unsigned short*)(kdp + 160) = (unsigned short)(kd23 & 0xffffu); *(LAS unsigned short*)(kdp + 240) = (unsigned short)(kd23 >> 16);
            { u32x2 wv; wv.x = cvt_pk_bf16(ki[0], ki[1]); wv.y = cvt_pk_bf16(ki[2], ki[3]); *(LAS u32x2*)(buf + (j == 0 ? OFF_KA : OFF_KB) + fr * RS + (16 * w + 4 * fq) * 2) = wv; }
            if (lat) {
                { u32x2 wv; wv.x = cvt_pk_bf16(qp[0], qp[1]); wv.y = cvt_pk_bf16(qp[2], qp[3]); *(LAS u32x2*)(buf + OFF_QP + trow * RS + (32 * (w >> 1) + 8 * fq + 4 * (w & 1)) * 2) = wv; }
                { u32x2 wv; wv.x = cvt_pk_bf16(qi[0], qi[1]); wv.y = cvt_pk_bf16(qi[2], qi[3]); *(LAS u32x2*)(buf + (j == 0 ? OFF_QA : OFF_QB) + fr * RS + (16 * w + 4 * fq) * 2) = wv; }
                { u32x2 wv; wv.x = cvt_pk_bf16(x2[0], x2[1]); wv.y = cvt_pk_bf16(x2[2], x2[3]); *(LAS u32x2*)(buf + (j == 0 ? OFF_KC : OFF_QC) + fr * RS + (16 * w + 4 * fq) * 2) = wv; }
            }
        }
        if (fr == 0) { f32x4 dv; dv[0] = hexp(b31[0]); dv[1] = hexp(b31[1]); dv[2] = hexp(b31[2]); dv[3] = hexp(b31[3]); *(LAS f32x4*)(buf + OFF_D + (16 * w + 4 * fq) * 4) = dv; }
        if (c + 1 < 72) HG_LOAD(c + 1);
        __syncthreads();
        if (lat) {
            f32x4 X00 = z4, X11 = z4, X01 = z4;
#pragma unroll
            for (int a = 0; a < 4; ++a) {
                const int co = fr * RS + (32 * a + 8 * fq) * 2;
                const bf16x8 ka = *(const LAS bf16x8*)(buf + OFF_KA + co), qa = *(const LAS bf16x8*)(buf + OFF_QA + co);
                const bf16x8 kb = *(const LAS bf16x8*)(buf + OFF_KB + co), qb = *(const LAS bf16x8*)(buf + OFF_QB + co);
                const bf16x8 kc = *(const LAS bf16x8*)(buf + OFF_KC + co), qc = *(const LAS bf16x8*)(buf + OFF_QC + co);
                X00 = __builtin_amdgcn_mfma_f32_16x16x32_bf16(ka, qa, X00, 0, 0, 0);
                X11 = __builtin_amdgcn_mfma_f32_16x16x32_bf16(kb, qb, X11, 0, 0, 0);
                X01 = __builtin_amdgcn_mfma_f32_16x16x32_bf16(kc, qc, X01, 0, 0, 0);
            }
#pragma unroll
            for (int r = 0; r < 4; ++r) { const bool keep = (4 * fq + r) <= fr; X00[r] = keep ? X00[r] : 0.f; X11[r] = keep ? X11[r] : 0.f; }
            bf16x8 P0, P1;
            { u32x4 t; t.x = cvt_pk_bf16(X00[0], X00[1]); t.y = cvt_pk_bf16(X00[2], X00[3]); t.z = 0u; t.w = 0u; P0 = __builtin_bit_cast(bf16x8, t);
              u32x4 u; u.x = cvt_pk_bf16(X01[0], X01[1]); u.y = cvt_pk_bf16(X01[2], X01[3]); u.z = cvt_pk_bf16(X11[0], X11[1]); u.w = cvt_pk_bf16(X11[2], X11[3]); P1 = __builtin_bit_cast(bf16x8, u); }
            f32x4 o0 = __builtin_amdgcn_mfma_f32_16x16x32_bf16(VTf, P0, z4, 0, 0, 0);
            f32x4 o1 = __builtin_amdgcn_mfma_f32_16x16x32_bf16(VTf, P1, z4, 0, 0, 0);
#pragma unroll
            for (int a = 0; a < 4; ++a) {
                u32x4 t; t.x = cvt_pk_bf16(S[2 * a][0], S[2 * a][1]); t.y = cvt_pk_bf16(S[2 * a][2], S[2 * a][3]); t.z = cvt_pk_bf16(S[2 * a + 1][0], S[2 * a + 1][1]); t.w = cvt_pk_bf16(S[2 * a + 1][2], S[2 * a + 1][3]);
                const bf16x8 Sb = __builtin_bit_cast(bf16x8, t);
                const bf16x8 qp0 = *(const LAS bf16x8*)(buf + OFF_QP + fr * RS + (32 * a + 8 * fq) * 2), qp1 = *(const LAS bf16x8*)(buf + OFF_QP + (16 + fr) * RS + (32 * a + 8 * fq) * 2);
                o0 = __builtin_amdgcn_mfma_f32_16x16x32_bf16(Sb, qp0, o0, 0, 0, 0);
                o1 = __builtin_amdgcn_mfma_f32_16x16x32_bf16(Sb, qp1, o1, 0, 0, 0);
            }
            const int base = HG_BASE(c);
            *(f32x4*)(Op + (size_t)(base + sgn * fr) * GW + colw + 4 * fq) = o0;
            *(f32x4*)(Op + (size_t)(base + sgn * (fr + 16)) * GW + colw + 4 * fq) = o1;
        }
#pragma unroll
        for (int kt = 0; kt < 8; ++kt) {
            const bf16x8 kdf = *(const LAS bf16x8*)(buf + OFF_KDT + (16 * kt + fr) * 80 + 16 * fq);
            const f32x4 dv = *(const LAS f32x4*)(buf + OFF_D + (16 * kt + 4 * fq) * 4);
            S[kt] = __builtin_amdgcn_mfma_f32_16x16x32_bf16(kdf, VTf, S[kt] * dv, 0, 0, 0);
        }
    }
#undef HG_BASE
#undef HG_LOAD
    __syncthreads();
}

__device__ __forceinline__ void phase3(const Frame& F) {
    const int G = gridDim.x;
    if ((int)blockIdx.x < 64) { hgrn_chain(F, blockIdx.x); return; }
    for (int item = blockIdx.x - 64; item < 512 + 8192 + 4096; item += G - 64) {
        if (item < 512) sgu_item(F, item);
        else if (item < 512 + 8192) conv_item_w1(F, item - 512);
        else conv_item_w2(F, item - 512 - 8192);
    }
}

constexpr int N_PHASES = 10;
#ifndef DBG_NO_MOE
#define DBG_NO_MOE 0
#endif
#ifndef DBG_MAX_PHASE
#define DBG_MAX_PHASE 9
#endif
__global__ void __launch_bounds__(NTHREADS, 2) fwd_kernel(Args a) {
    extern __shared__ __attribute__((aligned(16))) unsigned char lds_raw[];
    Frame F;
    F.x = a.in[0]; F.c = a.in[1]; F.ctx = a.in[2]; F.c_ctx = a.in[3]; F.w_mod = a.in[4]; F.b_mod = a.in[5]; F.norm1 = a.in[6]; F.w_in = a.in[7]; F.sgu_ln = a.in[8]; F.sgu_w = a.in[9];
    F.sgu_b = a.in[10]; F.lb_fwd = a.in[11]; F.lb_bwd = a.in[12]; F.hgrn_norm = a.in[13]; F.w_out = a.in[14]; F.norm2 = a.in[15]; F.router_w = a.in[16]; F.router_b = a.in[17];
    F.w1 = a.in[18]; F.b1 = a.in[19]; F.w2 = a.in[20]; F.b2 = a.in[21]; F.final_norm = a.in[22];
    F.out = a.out; F.ws = a.ws; unsigned char* ws = a.ws;
    F.ctl = (unsigned*)(ws + WS_CTL); F.mod = (float*)(ws + WS_MOD);
    F.WinT = (bf16_t*)(ws + WS_WIN); F.WoutT = (bf16_t*)(ws + WS_WOUT); F.W1T = (bf16_t*)(ws + WS_W1); F.W2T = (bf16_t*)(ws + WS_W2);
    F.H = (bf16_t*)(ws + WS_H); F.U = (bf16_t*)(ws + WS_U); F.VG = (bf16_t*)(ws + WS_VG); F.Q = (bf16_t*)(ws + WS_Q); F.GS = (bf16_t*)(ws + WS_GS); F.I = (bf16_t*)(ws + WS_I);
    F.GF = (bf16_t*)(ws + WS_GF); F.KF = (bf16_t*)(ws + WS_KF); F.GB = (bf16_t*)(ws + WS_GB); F.KB = (bf16_t*)(ws + WS_KB);
    F.YCAT = (bf16_t*)(ws + WS_YCAT); F.H2 = (bf16_t*)(ws + WS_H2); F.ACT = (bf16_t*)(ws + WS_ACT); F.DOUT = (bf16_t*)(ws + WS_DOUT);
    F.OF = (float*)(ws + WS_OF); F.OB = (float*)(ws + WS_OB); F.X1 = (float*)(ws + WS_X1); F.SS = (float*)(ws + WS_SS); F.TW = (float*)(ws + WS_TW);
    F.LIST = (int*)(ws + WS_LIST); F.TSLOT = (int*)(ws + WS_TSLOT);
    F.lds = (LAS unsigned char*)lds_raw;
    if (threadIdx.x < 64) ((LAS unsigned*)(F.lds + LDS_MISC_OFF))[threadIdx.x] = 0u;
    __syncthreads();
    const int lo = a.ph_lo, hi = a.ph_hi, G = gridDim.x, cid = blockIdx.x;
    XcdBarrier bar; bar.bar = F.ctl + CW_BAR; bar.x = 0; bar.st = nullptr;
    if (hi - lo > 1) bar = xcd_barrier_post(F.ctl + CW_BAR, (volatile LAS unsigned*)(F.lds + LDS_MISC_OFF));
#define IN(k) (lo <= (k) && (k) < hi)
#define SEAM(k) do { if (IN(k) && IN((k) + 1)) xcd_barrier(bar); } while (0)
    if (IN(0)) phase0(F);
    SEAM(0);
    if (IN(1)) phase1(F);
    SEAM(1);
    if (IN(2)) {
        SchedInProj S{F.WinT, G, cid}; EpiInProj E{F.U, F.VG, F.Q, F.GS, F.I, F.GF, F.KF, F.GB, F.KB, F.lb_fwd, F.lb_bwd};
        pg::gemm_phase(F.lds, (const char*)F.H, D, S, E);
    }
    SEAM(2);
    if (IN(3)) phase3(F);
    SEAM(3);
    if (IN(4)) phase4(F);
    SEAM(4);
    if (IN(5)) {
        SchedOutProj S{F.WoutT, G, cid}; EpiOutProj E{F.x, F.mod, F.X1, F.SS};
        pg::gemm_phase(F.lds, (const char*)F.YCAT, D, S, E);
    }
    SEAM(5);
    if (IN(6)) phase6(F);
    SEAM(6);
    if (IN(7)) {
        moe_tables(F);
        SchedGateUp S{F.W1T, F.LIST, moe_tab(F.lds), G, cid}; EpiGateUp E{F.b1, F.ACT};
        pg::gemm_phase(F.lds, (const char*)F.H2, D, S, E);
    }
    SEAM(7);
    if (IN(8)) {
        moe_tables(F);
        SchedDown S{F.W2T, moe_tab(F.lds), G, cid}; EpiDown E{F.b2, F.DOUT};
        pg::gemm_phase(F.lds, (const char*)F.ACT, DE, S, E);
    }
    SEAM(8);
    if (IN(9)) phase9(F);
#undef IN
#undef SEAM
}

extern "C" void kernel_launch(void* const* d_in, const int* in_sizes, int n_in, void* d_out, int out_size, void* d_ws, size_t ws_size, hipStream_t stream) {
    static int grid = 0;
    if (grid == 0) {
        if (n_in != 23 || in_sizes[0] != NTOK * D || out_size != NTOK * D || ws_size < WS_END) {
            fprintf(stderr, "kernel_launch: unexpected shapes / workspace (n_in %d, in0 %d, out %d, ws %zu, need %zu); nothing launched\n", n_in, n_in > 0 ? in_sizes[0] : -1, out_size, ws_size, (size_t)WS_END);
            grid = -1; return;
        }
        int dev = 0, cus = 0;
        if (hipGetDevice(&dev) != hipSuccess || hipDeviceGetAttribute(&cus, hipDeviceAttributeMultiprocessorCount, dev) != hipSuccess) { grid = -1; return; }
        if (hipFuncSetAttribute((const void*)fwd_kernel, hipFuncAttributeMaxDynamicSharedMemorySize, LDS_BYTES) != hipSuccess) { fprintf(stderr, "kernel_launch: hipFuncSetAttribute failed\n"); grid = -1; return; }
        (void)hipGetLastError();
        grid = cus;
        if (grid < 128) { fprintf(stderr, "kernel_launch: needs >= 128 CUs\n"); grid = -1; return; }
    }
    if (grid < 0) return;
    (void)hipMemsetAsync((char*)d_ws + WS_CTL, 0, CTL_BYTES, stream);
    Args a{};
    for (int i = 0; i < 23; ++i) a.in[i] = (const float*)d_in[i];
    a.out = (float*)d_out; a.ws = (unsigned char*)d_ws;
#if N_LAUNCH_MODE == 1
    a.ph_lo = 0; a.ph_hi = N_PHASES;
    hipLaunchKernelGGL(fwd_kernel, dim3(grid), dim3(NTHREADS), LDS_BYTES, stream, a);
#else
    for (int p = 0; p < N_PHASES; ++p) { if (DBG_NO_MOE && p >= 6 && p <= 8) continue; a.ph_lo = p; a.ph_hi = p + 1; hipLaunchKernelGGL(fwd_kernel, dim3(grid), dim3(NTHREADS), LDS_BYTES, stream, a); }
#endif
}
```

```cpp
#include <hip/hip_runtime.h>
#include <cstdio>
#include <cstdint>

#ifndef N_LAUNCH_MODE
#define N_LAUNCH_MODE 1
#endif

#ifndef DBG_NO_MOE
#define DBG_NO_MOE 0
#endif
#ifndef DBG_REP
#define DBG_REP 0
#endif
#ifndef DBG_REP3
#define DBG_REP3 0
#endif
#ifndef DBG_REP6
#define DBG_REP6 0
#endif
#ifndef DBG_BARX
#define DBG_BARX 0
#endif
#ifndef DBG_MIX
#define DBG_MIX 1
#endif
#define LAS __attribute__((address_space(3)))
typedef unsigned short bf16_t;
typedef short bf16x8 __attribute__((ext_vector_type(8)));
typedef float f32x4 __attribute__((ext_vector_type(4)));
typedef float f32x2 __attribute__((ext_vector_type(2)));
typedef unsigned u32x4 __attribute__((ext_vector_type(4)));
typedef unsigned u32x2 __attribute__((ext_vector_type(2)));

constexpr int D = 1024, NB = 8, SEQ = 2048, CTXL = 256;
constexpr int NTOK = NB * SEQ;
constexpr int NCTX = NB * CTXL;
constexpr int NROW = NTOK + NCTX;
constexpr int DIN = 3584, GW = 512, NE = 32, DE = 1024, TOPK = 4;
constexpr int ACT_ROWS = NTOK * TOPK + NE * 256;
constexpr float EPS = 1e-6f;
constexpr int NTHREADS = 512;

constexpr int LDS_STAGE = 131072;
constexpr int LDS_EXTRA_OFF = LDS_STAGE;
constexpr int LDS_MISC_OFF = 155648;
constexpr int LDS_BYTES = LDS_MISC_OFF + 256;

constexpr size_t al256(size_t x) { return (x + 255) & ~(size_t)255; }
constexpr size_t WS_CTL = 0;
constexpr size_t CTL_BYTES = 65536;
constexpr int CW_BAR = 0;
constexpr int CW_CNT = 4096;
constexpr size_t WS_MOD = WS_CTL + CTL_BYTES;
constexpr size_t WS_WIN = WS_MOD + al256((size_t)9 * 6144 * 4);
constexpr size_t WS_WOUT = WS_WIN + (size_t)DIN * D * 2;
constexpr size_t WS_W1 = WS_WOUT + (size_t)D * D * 2;
constexpr size_t WS_W2 = WS_W1 + (size_t)NE * 2 * DE * D * 2;
constexpr size_t WS_YCAT = WS_W2 + (size_t)NE * D * DE * 2;
constexpr size_t WS_OF = WS_YCAT + (size_t)NTOK * D * 2;
constexpr size_t WS_OB = WS_OF + (size_t)NTOK * GW * 4;
constexpr size_t WS_X1 = WS_OB + (size_t)NTOK * GW * 4;
constexpr size_t WS_SS = WS_X1 + (size_t)NTOK * D * 4;
constexpr size_t WS_H2 = WS_SS + (size_t)NTOK * 16 * 4;
constexpr size_t WS_LIST = WS_H2 + (size_t)NTOK * D * 2;
constexpr size_t WS_TSLOT = WS_LIST + (size_t)NE * NTOK * 4;
constexpr size_t WS_TW = WS_TSLOT + (size_t)NTOK * 4 * 4;
constexpr size_t WS_ACT = WS_TW + (size_t)NTOK * 4 * 4;
constexpr size_t WS_REGA = WS_ACT + (size_t)ACT_ROWS * DE * 2;
constexpr size_t WS_H = WS_REGA;
constexpr size_t WS_U = WS_H + (size_t)NROW * D * 2;
constexpr size_t WS_VG = WS_U + (size_t)NTOK * GW * 2;
constexpr size_t WS_Q = WS_VG + (size_t)NTOK * GW * 2;
constexpr size_t WS_GS = WS_Q + (size_t)NTOK * GW * 2;
constexpr size_t WS_I = WS_GS + (size_t)NTOK * GW * 2;
constexpr size_t WS_GF = WS_I + (size_t)NROW * GW * 2;
constexpr size_t WS_KF = WS_GF + (size_t)NROW * GW * 2;
constexpr size_t WS_GB = WS_KF + (size_t)NROW * GW * 2;
constexpr size_t WS_KB = WS_GB + (size_t)NROW * GW * 2;
constexpr size_t WS_REGA_END = WS_KB + (size_t)NROW * GW * 2;
constexpr size_t WS_DOUT = WS_REGA;
constexpr size_t WS_END0 = WS_DOUT + (size_t)ACT_ROWS * D * 2;
constexpr size_t WS_END = WS_END0 > WS_REGA_END ? WS_END0 : WS_REGA_END;

typedef __bf16 bf16x2_t __attribute__((ext_vector_type(2)));
__device__ __forceinline__ unsigned cvt_pk_bf16(float lo, float hi) { bf16x2_t v; v[0] = (__bf16)lo; v[1] = (__bf16)hi; return __builtin_bit_cast(unsigned, v); }
__device__ __forceinline__ float bf2f(unsigned b) { return __uint_as_float(b << 16); }
__device__ __forceinline__ float bflo(unsigned w) { return __uint_as_float(w << 16); }
__device__ __forceinline__ float bfhi(unsigned w) { return __uint_as_float(w & 0xffff0000u); }
__device__ __forceinline__ float fast_exp(float x) { return __builtin_amdgcn_exp2f(x * 1.44269504089f); }
__device__ __forceinline__ float fast_rcp(float x) { return __builtin_amdgcn_rcpf(x); }
__device__ __forceinline__ float sigmoidf_(float x) { return fast_rcp(1.0f + fast_exp(-x)); }
__device__ __forceinline__ float gelu_tanh(float x) { const float u = 1.5957691216f * (x + 0.044715f * x * x * x); return x * fast_rcp(1.0f + fast_exp(-u)); }
__device__ __forceinline__ float clampf(float x, float lo, float hi) { return fminf(fmaxf(x, lo), hi); }
__device__ __forceinline__ float wave_sum(float v) {
#pragma unroll
    for (int o = 32; o >= 1; o >>= 1) v += __shfl_xor(v, o);
    return v;
}
__device__ __forceinline__ unsigned pack_fp8x4(float a, float b, float c, float d) {
    a = __builtin_amdgcn_fmed3f(a, -448.f, 448.f); b = __builtin_amdgcn_fmed3f(b, -448.f, 448.f); c = __builtin_amdgcn_fmed3f(c, -448.f, 448.f); d = __builtin_amdgcn_fmed3f(d, -448.f, 448.f);
    int p = __builtin_amdgcn_cvt_pk_fp8_f32(a, b, 0, false); p = __builtin_amdgcn_cvt_pk_fp8_f32(c, d, p, true); return (unsigned)p;
}
#define VM_WAIT() asm volatile("s_waitcnt vmcnt(0)" ::: "memory")
#define LDS_WAIT() asm volatile("s_waitcnt lgkmcnt(0)" ::: "memory")

#define XB_TMO      128
#define XB_XCNT(j)  (256  + 64 * (j))
#define XB_XSUB(j)  (1280 + 64 * (j))
#define XB_XGEN(j)  (2304 + 64 * (j))
#define XB_TOP      3328
#define XB_TOPGEN   3392
#define XCD_BAR_WORDS 3456
#define XB_SPIN_CAP (1u << 18)
__device__ __forceinline__ unsigned xb_ld(unsigned* p)              { return __hip_atomic_load(p, __ATOMIC_RELAXED, __HIP_MEMORY_SCOPE_AGENT); }
__device__ __forceinline__ unsigned xb_add(unsigned* p, unsigned v) { return __hip_atomic_fetch_add(p, v, __ATOMIC_RELAXED, __HIP_MEMORY_SCOPE_AGENT); }
__device__ __forceinline__ unsigned xb_xcc_id() { return (unsigned)__builtin_amdgcn_s_getreg((3 << 11) | 20) & 0xFu; }
#define XB_SPIN(cond, bar) do { unsigned _sp = 0; while (cond) { __builtin_amdgcn_s_sleep(1); \
    if ((++_sp & 255u) == 0u) { if (xb_ld(&(bar)[XB_TMO])) break; if (_sp > XB_SPIN_CAP) { atomicAdd(&(bar)[XB_TMO], 1u); break; } } } } while (0)
struct XcdBarrier { unsigned* bar; unsigned x; volatile LAS unsigned* st; };
__device__ __forceinline__ XcdBarrier xcd_barrier_post(unsigned* bar, volatile LAS unsigned* st) {
    XcdBarrier b; b.bar = bar; b.x = xb_xcc_id(); b.st = st;
    if (threadIdx.x == 0) (void)xb_add(&bar[XB_XCNT(b.x)], 1u);
    return b;
}
__device__ __forceinline__ void xcd_barrier_complete(unsigned* bar, unsigned x, unsigned& nloc, unsigned& nx) {
    const unsigned G = gridDim.x * gridDim.y * gridDim.z;
    unsigned sum, cnt, mine, sp = 0u;
    for (;;) {
        sum = 0u; cnt = 0u; mine = 0u;
#pragma unroll
        for (unsigned j = 0; j < 16; ++j) { const unsigned c = xb_ld(&bar[XB_XCNT(j)]); sum += c; cnt += (c > 0u) ? 1u : 0u; mine = (j == x) ? c : mine; }
        if (sum == G) break;
        __builtin_amdgcn_s_sleep(1);
        if ((++sp & 255u) == 0u) { if (xb_ld(&bar[XB_TMO])) break; if (sp > XB_SPIN_CAP) { atomicAdd(&bar[XB_TMO], 1u); break; } }
    }
    nloc = mine > 0u ? mine : 1u; nx = cnt > 0u ? cnt : 1u;
}
__device__ __forceinline__ void xcd_barrier(const XcdBarrier& b) {
    asm volatile("s_waitcnt vmcnt(0)" ::: "memory");
    __syncthreads();
    if (threadIdx.x == 0) {
        unsigned* bar = b.bar;
        __builtin_amdgcn_s_waitcnt(0);
        unsigned nloc = b.st[0], nx = b.st[1];
        if (nloc == 0u) { xcd_barrier_complete(bar, b.x, nloc, nx); b.st[0] = nloc; b.st[1] = nx; }
        const unsigned old = xb_add(&bar[XB_XSUB(b.x)], 1u);
        const unsigned gen = old / nloc;
        if (old + 1u == (gen + 1u) * nloc) {
            __builtin_amdgcn_fence(__ATOMIC_RELEASE, "agent");
            asm volatile("s_waitcnt vmcnt(0)" ::: "memory");
            const unsigned og = xb_add(&bar[XB_TOP], 1u);
            const unsigned tg = og / nx;
            if (og + 1u == (tg + 1u) * nx) xb_add(&bar[XB_TOPGEN], 1u);
            else XB_SPIN(xb_ld(&bar[XB_TOPGEN]) == tg, bar);
            __builtin_amdgcn_fence(__ATOMIC_ACQUIRE, "agent");
            xb_add(&bar[XB_XGEN(b.x)], 1u);
            asm volatile("s_waitcnt vmcnt(0)" ::: "memory");
        } else {
            XB_SPIN(xb_ld(&bar[XB_XGEN(b.x)]) == gen, bar);
            __builtin_amdgcn_fence(__ATOMIC_ACQUIRE, "agent");
            asm volatile("s_waitcnt vmcnt(0)" ::: "memory");
        }
    }
    __syncthreads();
}

struct Args { const float* in[23]; float* out; unsigned char* ws; int ph_lo, ph_hi; };
struct Frame {
    const float *x, *c, *ctx, *c_ctx, *w_mod, *b_mod, *norm1, *w_in, *sgu_ln, *sgu_w, *sgu_b, *lb_fwd, *lb_bwd, *hgrn_norm, *w_out, *norm2,
                *router_w, *router_b, *w1, *b1, *w2, *b2, *final_norm;
    float* out; unsigned char* ws;
    unsigned* ctl; float* mod;
    bf16_t *WinT, *WoutT, *H, *U, *VG, *Q, *GS, *I, *GF, *KF, *GB, *KB, *YCAT, *DOUT;
    unsigned char *W1T, *W2T, *H2, *ACT;
    float *OF, *OB, *X1, *SS, *TW;
    int *LIST, *TSLOT;
    LAS unsigned char* lds;
};

namespace pg {
constexpr int BM = 256, BK = 64, HALF = 128, HTB = HALF * BK * 2, NXCD = 8, WGM = 8;
__device__ __forceinline__ int lds_byte(int r, int c) { const int st = (r >> 4) * 2 + (c >> 5), rr = r & 15, cc = c & 31, ob = rr * 64 + cc * 2; return st * 1024 + (ob ^ (((ob >> 9) & 1) << 5)); }
__device__ __forceinline__ void stage_rc(int b, int& R, int& C) { const int st = b / 1024, sb = b % 1024, swz = sb ^ (((sb >> 9) & 1) << 5); R = (st >> 1) * 16 + swz / 64; C = (st & 1) * 32 + (swz % 64) / 2; }
__device__ __forceinline__ int perm32(int rho) { const int n = rho >> 4, i = rho & 15; return 8 * (i >> 2) + 4 * n + (i & 3); }

struct Unit { const char* bptr; int arow, orow, pn, e, cnt, pad; };

__device__ __forceinline__ bool static_order(int nM, int nN, int L, int& pm, int& pn) {
    const int nwg = nM * nN; if (L >= nwg) return false;
    int wgid = L; { const int q = nwg / NXCD, r = nwg % NXCD, xcd = wgid % NXCD, off = wgid / NXCD; wgid = (xcd < r ? xcd * (q + 1) : r * (q + 1) + (xcd - r) * q) + off; }
    const int nig = WGM * nN, gid = wgid / nig, fm = gid * WGM, gsz = (nM - fm) < WGM ? (nM - fm) : WGM;
    pm = fm + ((wgid % nig) % gsz); pn = (wgid % nig) / gsz; return true;
}

typedef int v8i __attribute__((ext_vector_type(8)));
typedef int v4i __attribute__((ext_vector_type(4)));
template <class Epi, class Sched, bool FP8>
__device__ __forceinline__ void gemm_phase(LAS unsigned char* lds, const char* Abase, const int K, const Sched& S, const Epi& E) {
    const int tid = threadIdx.x, wid = __builtin_amdgcn_readfirstlane(tid >> 6), lane = tid & 63, wr = wid >> 2, wc = wid & 3, fr = lane & 15, fq = lane >> 4;
    const int pitch = FP8 ? K : 2 * K;
    const int nt = pitch / 128;
    int sR[2], sC[2]; unsigned voffB[2];
#pragma unroll
    for (int i = 0; i < 2; ++i) { stage_rc(tid * 16 + i * 8192, sR[i], sC[i]); const int Rb = Epi::PERM ? ((sR[i] & ~31) + perm32(sR[i] & 31)) : sR[i]; voffB[i] = (unsigned)(Rb * pitch + 2 * sC[i]); }
    const size_t kstep = (size_t)(BK * 2);
    const size_t hstep = (size_t)HALF * pitch;
    const unsigned ldsw = (unsigned)wid * 1024u;
    const int aoff = lds_byte(wr * 64 + fr, fq * 8), boff = lds_byte(wc * 32 + fr, fq * 8);
#define PG_SA(b, h) (((b) * 2 + (h)) * HTB)
#define PG_SB(b, h) ((4 + (b) * 2 + (h)) * HTB)
#define PG_STAGE(bufoff, gbase, voff) do { _Pragma("unroll") for (int _i = 0; _i < 2; ++_i) \
        __builtin_amdgcn_global_load_lds((const unsigned*)((const char*)(gbase) + (voff)[_i]), (LAS unsigned*)(lds + (bufoff) + ldsw + _i * 8192), 16, 0, 0); } while (0)
#define PG_LDA(dst, b, h) do { _Pragma("unroll") for (int m = 0; m < 4; ++m) { dst[m].lo = *(const LAS v4i*)(lds + PG_SA(b, h) + aoff + m * 2048); dst[m].hi = *(const LAS v4i*)(lds + PG_SA(b, h) + aoff + m * 2048 + 1024); } } while (0)
#define PG_LDB(dst, b, h) do { _Pragma("unroll") for (int n = 0; n < 2; ++n) { dst[n].lo = *(const LAS v4i*)(lds + PG_SB(b, h) + boff + n * 2048); dst[n].hi = *(const LAS v4i*)(lds + PG_SB(b, h) + boff + n * 2048 + 1024); } } while (0)
#define PG_MMA(ai, bj, At, Bt) do { __builtin_amdgcn_s_setprio(1); _Pragma("unroll") for (int m = 0; m < 4; ++m) _Pragma("unroll") for (int n = 0; n < 2; ++n) { \
        if constexpr (FP8) acc[ai][bj][m][n] = __builtin_amdgcn_mfma_scale_f32_16x16x128_f8f6f4(Bt[n], At[m], acc[ai][bj][m][n], 0, 0, 0, 0x7a7a7a7a, 0, 0x7f7f7f7f); \
        else { const v4i _bl = Bt[n].lo, _bh = Bt[n].hi, _al = At[m].lo, _ah = At[m].hi;     \
               acc[ai][bj][m][n] = __builtin_amdgcn_mfma_f32_16x16x32_bf16(__builtin_bit_cast(bf16x8, _bl), __builtin_bit_cast(bf16x8, _al), acc[ai][bj][m][n], 0, 0, 0); \
               acc[ai][bj][m][n] = __builtin_amdgcn_mfma_f32_16x16x32_bf16(__builtin_bit_cast(bf16x8, _bh), __builtin_bit_cast(bf16x8, _ah), acc[ai][bj][m][n], 0, 0, 0); } } \
        __builtin_amdgcn_s_setprio(0); } while (0)
#define PG_WAIT_V(n) asm volatile("s_waitcnt vmcnt(" #n ")" ::: "memory")
#define PG_WAIT_L(n) asm volatile("s_waitcnt lgkmcnt(" #n ")" ::: "memory")
#define PG_BAR __builtin_amdgcn_s_barrier()
#define PG_SCHED __builtin_amdgcn_sched_barrier(0)
    Unit cur, nxt, nn; int ui = 0;
    if (!S.next(0, cur)) return;
    bool has_next = S.next(1, nxt);
    unsigned vA[2][2], vN[2][2];
    S.aoff(cur, sR, sC, vA);
    if (has_next) S.aoff(nxt, sR, sC, vN); else { vN[0][0] = vA[0][0]; vN[0][1] = vA[0][1]; vN[1][0] = vA[1][0]; vN[1][1] = vA[1][1]; }
    f32x4 acc[2][2][4][2];
#pragma unroll
    for (int a = 0; a < 2; ++a)
#pragma unroll
        for (int b = 0; b < 2; ++b)
#pragma unroll
            for (int m = 0; m < 4; ++m)
#pragma unroll
                for (int n = 0; n < 2; ++n) acc[a][b][m][n] = (f32x4){0.f, 0.f, 0.f, 0.f};
    v8i At[4], B0[2], B1[2];
    const char* cB = cur.bptr;
    PG_STAGE(PG_SB(0, 0), cB, voffB); PG_STAGE(PG_SA(0, 0), Abase, vA[0]); PG_STAGE(PG_SB(0, 1), cB + hstep, voffB); PG_STAGE(PG_SA(0, 1), Abase, vA[1]);
    if (wr == 1) PG_BAR;
    PG_WAIT_V(4); PG_BAR;
    PG_STAGE(PG_SB(1, 0), cB + kstep, voffB); PG_STAGE(PG_SA(1, 0), Abase + kstep, vA[0]); PG_STAGE(PG_SB(1, 1), cB + hstep + kstep, voffB);
    PG_WAIT_V(6); PG_BAR;
    for (;;) {
        const char* nB = has_next ? nxt.bptr : cB;
#pragma unroll 1
        for (int t = 0; t < nt; t += 2) {
            const bool last = (t == nt - 2);
            const char* a1 = Abase + (size_t)(t + 1) * kstep;
            const char* a2 = last ? Abase : Abase + (size_t)(t + 2) * kstep; const char* b2 = last ? nB : cB + (size_t)(t + 2) * kstep;
            const char* a3 = a2 + kstep; const char* b3 = b2 + kstep;
            PG_LDB(B0, 0, 0); PG_SCHED; PG_LDA(At, 0, 0); PG_STAGE(PG_SA(1, 1), a1, vA[1]);
            if (last) { vA[0][0] = vN[0][0]; vA[0][1] = vN[0][1]; vA[1][0] = vN[1][0]; vA[1][1] = vN[1][1]; }
            PG_WAIT_L(8); PG_BAR; PG_WAIT_L(0); PG_MMA(0, 0, At, B0); PG_BAR; PG_SCHED;
            PG_LDB(B1, 0, 1); PG_STAGE(PG_SB(0, 0), b2, voffB);
            PG_BAR; PG_WAIT_L(0); PG_MMA(0, 1, At, B1); PG_BAR;
            PG_LDA(At, 0, 1); PG_STAGE(PG_SA(0, 0), a2, vA[0]);
            PG_BAR; PG_WAIT_L(0); PG_MMA(1, 0, At, B0); PG_BAR; PG_SCHED;
            PG_STAGE(PG_SB(0, 1), b2 + hstep, voffB);
            PG_WAIT_V(6); PG_BAR; PG_MMA(1, 1, At, B1); PG_BAR;
            PG_LDB(B0, 1, 0); PG_SCHED; PG_LDA(At, 1, 0); PG_STAGE(PG_SA(0, 1), a2, vA[1]);
            PG_WAIT_L(8); PG_BAR; PG_WAIT_L(0); PG_MMA(0, 0, At, B0); PG_BAR; PG_SCHED;
            PG_LDB(B1, 1, 1); PG_STAGE(PG_SB(1, 0), b3, voffB);
            PG_BAR; PG_WAIT_L(0); PG_MMA(0, 1, At, B1); PG_BAR;
            PG_LDA(At, 1, 1); PG_STAGE(PG_SA(1, 0), a3, vA[0]);
            PG_BAR; PG_WAIT_L(0); PG_MMA(1, 0, At, B0); PG_BAR; PG_SCHED;
            PG_STAGE(PG_SB(1, 1), b3 + hstep, voffB);
            PG_WAIT_V(6); PG_BAR; PG_MMA(1, 1, At, B1); PG_BAR;
        }
        E(acc, cur, wr, wc, fr, fq);
        if (!has_next) break;
#pragma unroll
        for (int a = 0; a < 2; ++a)
#pragma unroll
            for (int b = 0; b < 2; ++b)
#pragma unroll
                for (int m = 0; m < 4; ++m)
#pragma unroll
                    for (int n = 0; n < 2; ++n) acc[a][b][m][n] = (f32x4){0.f, 0.f, 0.f, 0.f};
        cur = nxt; cB = nB; ++ui;
        has_next = S.next(ui + 1, nn);
        if (has_next) { nxt = nn; S.aoff(nxt, sR, sC, vN); }
    }
    PG_WAIT_V(0);
    if (wr == 0) PG_BAR;
    PG_BAR;
#undef PG_SA
#undef PG_SB
#undef PG_STAGE
#undef PG_LDA
#undef PG_LDB
#undef PG_MMA
#undef PG_WAIT_V
#undef PG_WAIT_L
#undef PG_BAR
#undef PG_SCHED
}
}

typedef f32x4 Acc[2][2][4][2];

struct SchedInProj {
    const bf16_t* WinT; int G, c;
    __device__ __forceinline__ bool next(int i, pg::Unit& u) const {
        const int L = i * G + c; int pm, pn;
        if (L < 64 * 14) { pg::static_order(64, 14, L, pm, pn); }
        else { const int x = L - 64 * 14; if (x >= 48) return false; pm = 64 + (x & 7); pn = 6 + (x >> 3); }
        u.bptr = (const char*)(WinT + (size_t)pn * 256 * D); u.arow = pm * 256; u.orow = pm * 256; u.pn = pn; u.e = 0; u.cnt = 0; u.pad = 0; return true;
    }
    __device__ __forceinline__ void aoff(const pg::Unit& u, const int (&R)[2], const int (&C)[2], unsigned (&v)[2][2]) const {
#pragma unroll
        for (int h = 0; h < 2; ++h)
#pragma unroll
            for (int i = 0; i < 2; ++i) v[h][i] = (unsigned)((u.arow + h * 128 + R[i]) * D + C[i]) * 2u;
    }
};
struct EpiInProj {
    static constexpr bool PERM = true;
    bf16_t *U, *VG, *Q, *GS, *I, *GF, *KF, *GB, *KB; const float *lb_fwd, *lb_bwd;
    __device__ __forceinline__ void operator()(const Acc& acc, const pg::Unit& u, int wr, int wc, int fr, int fq) const {
        const int cg = u.pn >> 1;
        const int cbase = (u.pn & 1) * 256 + wc * 32 + 8 * fq;
        const int row0 = u.orow + wr * 64 + fr;
        if (cg == 3 || cg == 4) {
            const float* tab = (cg == 3) ? lb_fwd : lb_bwd; bf16_t* Gd = (cg == 3) ? GF : GB; bf16_t* Kd = (cg == 3) ? KF : KB;
#pragma unroll
            for (int bj = 0; bj < 2; ++bj) {
                const int col = cbase + bj * 128;
                float lb[8], omlb[8];
#pragma unroll
                for (int j = 0; j < 8; ++j) { const float t0 = tab[col + j], t1 = tab[GW + col + j]; lb[j] = fast_rcp(1.0f + __expf(t1 - t0)); omlb[j] = 1.0f - lb[j]; }
#pragma unroll
                for (int ai = 0; ai < 2; ++ai)
#pragma unroll
                    for (int m = 0; m < 4; ++m) {
                        const size_t off = (size_t)(row0 + ai * 128 + m * 16) * GW + col;
                        float gv[8], kv[8];
#pragma unroll
                        for (int n = 0; n < 2; ++n)
#pragma unroll
                            for (int j = 0; j < 4; ++j) {
                                const float z = clampf(acc[ai][bj][m][n][j], -30.f, 30.f);
                                const float e = __expf(-z), s = fast_rcp(1.0f + e), oms = e * s;
                                const float f = lb[4 * n + j] + omlb[4 * n + j] * s;
                                gv[4 * n + j] = __logf(f); kv[4 * n + j] = omlb[4 * n + j] * oms;
                            }
                        u32x4 wg, wk;
                        wg.x = cvt_pk_bf16(gv[0], gv[1]); wg.y = cvt_pk_bf16(gv[2], gv[3]); wg.z = cvt_pk_bf16(gv[4], gv[5]); wg.w = cvt_pk_bf16(gv[6], gv[7]);
                        wk.x = cvt_pk_bf16(kv[0], kv[1]); wk.y = cvt_pk_bf16(kv[2], kv[3]); wk.z = cvt_pk_bf16(kv[4], kv[5]); wk.w = cvt_pk_bf16(kv[6], kv[7]);
                        *(u32x4*)(Gd + off) = wg; *(u32x4*)(Kd + off) = wk;
                    }
            }
        } else {
            bf16_t* Od = (cg == 0) ? U : (cg == 1) ? VG : (cg == 2) ? Q : (cg == 5) ? I : GS;
            const int act = (cg <= 1) ? 1 : (cg == 6) ? 2 : 0;
#pragma unroll
            for (int ai = 0; ai < 2; ++ai)
#pragma unroll
                for (int m = 0; m < 4; ++m)
#pragma unroll
                    for (int bj = 0; bj < 2; ++bj) {
                        const size_t off = (size_t)(row0 + ai * 128 + m * 16) * GW + cbase + bj * 128;
                        float v[8];
#pragma unroll
                        for (int n = 0; n < 2; ++n)
#pragma unroll
                            for (int j = 0; j < 4; ++j) { float z = acc[ai][bj][m][n][j]; if (act == 1) z = gelu_tanh(z); else if (act == 2) z = z * sigmoidf_(z); v[4 * n + j] = z; }
                        u32x4 w; w.x = cvt_pk_bf16(v[0], v[1]); w.y = cvt_pk_bf16(v[2], v[3]); w.z = cvt_pk_bf16(v[4], v[5]); w.w = cvt_pk_bf16(v[6], v[7]);
                        *(u32x4*)(Od + off) = w;
                    }
        }
    }
};

struct SchedOutProj {
    const bf16_t* WoutT; int G, c;
    __device__ __forceinline__ bool next(int i, pg::Unit& u) const {
        const int L = i * G + c; int pm, pn; if (!pg::static_order(64, 4, L, pm, pn)) return false;
        u.bptr = (const char*)(WoutT + (size_t)pn * 256 * D); u.arow = pm * 256; u.orow = pm * 256; u.pn = pn; u.e = 0; u.cnt = 0; u.pad = 0; return true;
    }
    __device__ __forceinline__ void aoff(const pg::Unit& u, const int (&R)[2], const int (&C)[2], unsigned (&v)[2][2]) const {
#pragma unroll
        for (int h = 0; h < 2; ++h)
#pragma unroll
            for (int i = 0; i < 2; ++i) v[h][i] = (unsigned)((u.arow + h * 128 + R[i]) * D + C[i]) * 2u;
    }
};
struct EpiOutProj {
    static constexpr bool PERM = false;
    const float* x; const float* mod; float* X1; float* SS;
    __device__ __forceinline__ void operator()(const Acc& acc, const pg::Unit& u, int wr, int wc, int fr, int fq) const {
        const int row0 = u.orow + wr * 64 + fr, col0 = u.pn * 256 + wc * 32 + 4 * fq;
        const float* g1 = mod + (size_t)(u.orow >> 11) * 6144 + 2048;
        f32x4 gv[2][2];
#pragma unroll
        for (int bj = 0; bj < 2; ++bj)
#pragma unroll
            for (int n = 0; n < 2; ++n) gv[bj][n] = *(const f32x4*)(g1 + col0 + bj * 128 + n * 16);
#pragma unroll
        for (int ai = 0; ai < 2; ++ai)
#pragma unroll
            for (int m = 0; m < 4; ++m) {
                const int row = row0 + ai * 128 + m * 16; const size_t off = (size_t)row * D + col0; float s = 0.f;
#pragma unroll
                for (int bj = 0; bj < 2; ++bj)
#pragma unroll
                    for (int n = 0; n < 2; ++n) {
                        const f32x4 xv = *(const f32x4*)(x + off + bj * 128 + n * 16);
                        const f32x4 o = xv + gv[bj][n] * acc[ai][bj][m][n] * (float)DBG_MIX;
                        *(f32x4*)(X1 + off + bj * 128 + n * 16) = o;
                        s += (o[0] * o[0] + o[1] * o[1]) + (o[2] * o[2] + o[3] * o[3]);
                    }
                s += __shfl_xor(s, 16); s += __shfl_xor(s, 32);
                if (fq == 0) SS[(size_t)row * 16 + u.pn * 4 + wc] = s;
            }
    }
};

struct MoeTab { LAS int* cnt; LAS int* tstart; LAS int* ent; };
__device__ __forceinline__ MoeTab moe_tab(LAS unsigned char* lds) { MoeTab t; t.cnt = (LAS int*)(lds + LDS_EXTRA_OFF); t.tstart = t.cnt + 32; t.ent = t.tstart + 64; return t; }
__device__ __forceinline__ void moe_tables(const Frame& F) {
    const MoeTab T = moe_tab(F.lds);
    if (threadIdx.x < 64) {
        const int lane = threadIdx.x;
        const int c = (lane < NE) ? (int)__hip_atomic_load(F.ctl + CW_CNT + 64 * lane, __ATOMIC_RELAXED, __HIP_MEMORY_SCOPE_AGENT) : 0;
        const int t = (c + 255) >> 8;
        int incl = t;
#pragma unroll
        for (int o = 1; o < 64; o <<= 1) { const int v = __shfl_up(incl, o); if (lane >= o) incl += v; }
        const int start = incl - t;
        if (lane < NE) { T.cnt[lane] = c; T.tstart[lane] = start; for (int k = 0; k < t; ++k) T.ent[start + k] = lane; }
        if (lane == NE) T.tstart[NE] = start;
    }
    __syncthreads();
}
struct SchedGateUp {
    const unsigned char* W1T; const int* LIST; MoeTab T; int G, c;
    __device__ __forceinline__ bool next(int i, pg::Unit& u) const {
        int idx, pn; const int total = __builtin_amdgcn_readfirstlane(T.tstart[32]);
        if ((G & 7) == 0) { pn = c & 7; idx = (c >> 3) + (G >> 3) * i; if (idx >= total) return false; }
        else { const int L = i * G + c; if (L >= total * 8) return false; idx = L >> 3; pn = L & 7; }
        const int e = __builtin_amdgcn_readfirstlane(T.ent[idx]); const int ts = __builtin_amdgcn_readfirstlane(T.tstart[e]); const int mt = idx - ts;
        u.bptr = (const char*)(W1T + ((size_t)e * 2048 + (size_t)pn * 256) * D);     u.arow = mt * 256; u.orow = ts * 256 + mt * 256; u.pn = pn; u.e = e;
        u.cnt = __builtin_amdgcn_readfirstlane(T.cnt[e]); u.pad = 0; return true;
    }
    __device__ __forceinline__ void aoff(const pg::Unit& u, const int (&R)[2], const int (&C)[2], unsigned (&v)[2][2]) const {
#pragma unroll
        for (int h = 0; h < 2; ++h)
#pragma unroll
            for (int i = 0; i < 2; ++i) {
                int s = u.arow + h * 128 + R[i]; s = s < u.cnt ? s : u.cnt - 1;
                const int tok = LIST[u.e * NTOK + s];
                v[h][i] = (unsigned)(tok * D + 2 * C[i]);
            }
    }
};
struct EpiGateUp {
    static constexpr bool PERM = true;
    const float* b1; unsigned char* ACT;
    __device__ __forceinline__ void operator()(const Acc& acc, const pg::Unit& u, int wr, int wc, int fr, int fq) const {
        const int col = u.pn * 128 + wc * 32 + 8 * fq;
        const float* bg = b1 + (size_t)u.e * 2048 + col; const float* bu = bg + 1024;
        float vg[8], vu[8];
#pragma unroll
        for (int j = 0; j < 8; ++j) { vg[j] = bg[j]; vu[j] = bu[j]; }
        const int row0 = u.orow + wr * 64 + fr;
#pragma unroll
        for (int ai = 0; ai < 2; ++ai)
#pragma unroll
            for (int m = 0; m < 4; ++m) {
                float a[8];
#pragma unroll
                for (int n = 0; n < 2; ++n)
#pragma unroll
                    for (int j = 0; j < 4; ++j) {
                        float g = acc[ai][0][m][n][j] + vg[4 * n + j], up = acc[ai][1][m][n][j] + vu[4 * n + j];
                        g = fminf(g, 7.0f); up = clampf(up, -7.0f, 7.0f);
                        a[4 * n + j] = g * fast_rcp(1.0f + __expf(-1.702f * g)) * (up + 1.0f);
                    }
                u32x2 w; w.x = pack_fp8x4(a[0], a[1], a[2], a[3]); w.y = pack_fp8x4(a[4], a[5], a[6], a[7]);
                *(u32x2*)(ACT + (size_t)(row0 + ai * 128 + m * 16) * DE + col) = w;
            }
    }
};
struct SchedDown {
    const unsigned char* W2T; MoeTab T; int G, c;
    __device__ __forceinline__ bool next(int i, pg::Unit& u) const {
        int idx, pn; const int total = __builtin_amdgcn_readfirstlane(T.tstart[32]);
        if ((G & 7) == 0) { const int x = c & 7; pn = x & 3; idx = 2 * ((c >> 3) + (G >> 3) * i) + (x >> 2); if (idx >= total) return false; }
        else { const int L = i * G + c; if (L >= total * 4) return false; idx = L >> 2; pn = L & 3; }
        const int e = __builtin_amdgcn_readfirstlane(T.ent[idx]); const int ts = __builtin_amdgcn_readfirstlane(T.tstart[e]); const int mt = idx - ts;
        u.bptr = (const char*)(W2T + ((size_t)e * 1024 + (size_t)pn * 256) * DE); u.arow = ts * 256 + mt * 256; u.orow = u.arow; u.pn = pn; u.e = e; u.cnt = 0; u.pad = 0; return true;
    }
    __device__ __forceinline__ void aoff(const pg::Unit& u, const int (&R)[2], const int (&C)[2], unsigned (&v)[2][2]) const {
#pragma unroll
        for (int h = 0; h < 2; ++h)
#pragma unroll
            for (int i = 0; i < 2; ++i) v[h][i] = (unsigned)((u.arow + h * 128 + R[i]) * DE + 2 * C[i]);
    }
};
struct EpiDown {
    static constexpr bool PERM = true;
    const float* b2; bf16_t* DOUT;
    __device__ __forceinline__ void operator()(const Acc& acc, const pg::Unit& u, int wr, int wc, int fr, int fq) const {
        const int col0 = u.pn * 256 + wc * 32 + 8 * fq; const int row0 = u.orow + wr * 64 + fr;
        float bv[2][8];
#pragma unroll
        for (int bj = 0; bj < 2; ++bj)
#pragma unroll
            for (int j = 0; j < 8; ++j) bv[bj][j] = b2[(size_t)u.e * D + col0 + bj * 128 + j];
#pragma unroll
        for (int ai = 0; ai < 2; ++ai)
#pragma unroll
            for (int m = 0; m < 4; ++m)
#pragma unroll
                for (int bj = 0; bj < 2; ++bj) {
                    const f32x4 v0 = acc[ai][bj][m][0], v1 = acc[ai][bj][m][1];
                    u32x4 w; w.x = cvt_pk_bf16(v0[0] + bv[bj][0], v0[1] + bv[bj][1]); w.y = cvt_pk_bf16(v0[2] + bv[bj][2], v0[3] + bv[bj][3]);
                    w.z = cvt_pk_bf16(v1[0] + bv[bj][4], v1[1] + bv[bj][5]); w.w = cvt_pk_bf16(v1[2] + bv[bj][6], v1[3] + bv[bj][7]);
                    *(u32x4*)(DOUT + (size_t)(row0 + ai * 128 + m * 16) * D + col0 + bj * 128) = w;
                }
    }
};

__device__ __forceinline__ void conv_tile(const float* src, int ld, int k0, int n0, bf16_t* dst, int drow0, LAS unsigned char* lds) {
    const int tid = threadIdx.x, p = tid >> 4, q = tid & 15;
    f32x4 v[4];
#pragma unroll
    for (int r = 0; r < 4; ++r) v[r] = *(const f32x4*)(src + (size_t)(k0 + 4 * p + r) * ld + n0 + 4 * q);
#pragma unroll
    for (int i = 0; i < 4; ++i) {
        u32x2 w; w.x = cvt_pk_bf16(v[0][i], v[1][i]); w.y = cvt_pk_bf16(v[2][i], v[3][i]);
        *(LAS u32x2*)(lds + (4 * q + i) * 256 + ((p ^ q) * 8)) = w;
    }
    __syncthreads();
#pragma unroll
    for (int jj = 0; jj < 2; ++jj) {
        const int n = (tid >> 4) + 32 * jj, c = tid & 15, qn = (n >> 2) & 15;
        u32x4 w = *(const LAS u32x4*)(lds + n * 256 + ((c ^ (qn >> 1)) * 16));
        if (qn & 1) { const unsigned t0 = w.x, t1 = w.y; w.x = w.z; w.y = w.w; w.z = t0; w.w = t1; }
        *(u32x4*)(dst + (size_t)(drow0 + n) * 1024 + k0 + 8 * c) = w;
    }
    __syncthreads();
}
struct ConvDesc { const float* src; unsigned char* dst; int ld, k0, n0, drow0; };
__device__ __forceinline__ ConvDesc conv8_desc(const Frame& F, int it) {
    ConvDesc d;
    if (it < 8192) { const int e = it >> 8, r = it & 255, nt = r & 31, kt = r >> 5, n0 = nt * 64;
        d.src = F.w1 + (size_t)e * D * 2048; d.ld = 2048; d.k0 = kt * 128; d.n0 = n0; d.dst = F.W1T + (size_t)e * 2048 * D;
        d.drow0 = (n0 < 1024) ? ((n0 >> 7) * 256 + (n0 & 127)) : (((n0 - 1024) >> 7) * 256 + 128 + ((n0 - 1024) & 127)); }
    else { const int i2 = it - 8192, e = i2 >> 7, r = i2 & 127, nt = r & 15, kt = r >> 4;
        d.src = F.w2 + (size_t)e * DE * D; d.ld = 1024; d.k0 = kt * 128; d.n0 = nt * 64; d.dst = F.W2T + (size_t)e * D * DE; d.drow0 = nt * 64; }
    return d;
}
__device__ __forceinline__ void conv8_load(const ConvDesc& d, f32x4 (&v)[4]) {
    const int p = threadIdx.x >> 4, q = threadIdx.x & 15;
#pragma unroll
    for (int r = 0; r < 4; ++r) v[r] = *(const f32x4*)(d.src + (size_t)(d.k0 + 4 * p + r) * d.ld + d.n0 + 4 * q);
}
__device__ __forceinline__ void conv8_lds_write(const f32x4 (&v)[4], LAS unsigned char* buf) {
    const int p = threadIdx.x >> 4, q = threadIdx.x & 15;
#pragma unroll
    for (int i = 0; i < 4; ++i) *(LAS unsigned*)(buf + (4 * q + i) * 128 + ((p ^ q) * 4)) = pack_fp8x4(32.f * v[0][i], 32.f * v[1][i], 32.f * v[2][i], 32.f * v[3][i]);
}
__device__ __forceinline__ void conv8_store(const ConvDesc& d, const LAS unsigned char* buf) {
    const int n = threadIdx.x >> 3, c = threadIdx.x & 7, qn = (n >> 2) & 15;
    u32x4 w = *(const LAS u32x4*)(buf + n * 128 + ((c ^ (qn >> 2)) * 16));
    if (qn & 1) { unsigned t = w.x; w.x = w.y; w.y = t; t = w.z; w.z = w.w; w.w = t; }
    if (qn & 2) { unsigned t = w.x; w.x = w.z; w.z = t; t = w.y; w.y = w.w; w.w = t; }
    *(u32x4*)(d.dst + (size_t)(d.drow0 + n) * 1024 + d.k0 + 16 * c) = w;
}
__device__ __forceinline__ void conv8_run(const Frame& F, int first, int stride) {
    constexpr int NIT = 8192 + 4096;
    if (first >= NIT) return;
    f32x4 v[4]; int it = first, b = 0;
    ConvDesc d = conv8_desc(F, it);
    conv8_load(d, v);
    while (it < NIT) {
        LAS unsigned char* buf = F.lds + b * 8192;
        conv8_lds_write(v, buf);
        const int nxt = it + stride;
        const ConvDesc dn = conv8_desc(F, nxt < NIT ? nxt : it);
        conv8_load(dn, v);
        asm volatile("s_waitcnt lgkmcnt(0)" ::: "memory"); __builtin_amdgcn_s_barrier(); asm volatile("" ::: "memory");
        conv8_store(d, buf);
        d = dn; it = nxt; b ^= 1;
    }
    __syncthreads();
}

__device__ __forceinline__ void mod_item(const Frame& F, int item) {
    LAS float* S = (LAS float*)F.lds;
    LAS float* RED = (LAS float*)(F.lds + 40960);
    const int tid = threadIdx.x, lane = tid & 63, wv = tid >> 6, c0 = item * 64;
    for (int idx = tid; idx < 9 * 1024; idx += NTHREADS) { const int r = idx >> 10, k = idx & 1023; const float v = (r < 8) ? F.c[r * 1024 + k] : F.c_ctx[k]; S[idx] = v * sigmoidf_(v); }
    __syncthreads();
    const int cq = tid & 15, kg = tid >> 4;
    f32x4 acc[9];
#pragma unroll
    for (int r = 0; r < 9; ++r) acc[r] = (f32x4){0.f, 0.f, 0.f, 0.f};
    for (int k = kg; k < 1024; k += 32) {
        const f32x4 wv4 = *(const f32x4*)(F.w_mod + (size_t)k * 6144 + c0 + 4 * cq);
#pragma unroll
        for (int r = 0; r < 9; ++r) acc[r] += S[r * 1024 + k] * wv4;
    }
#pragma unroll
    for (int r = 0; r < 9; ++r)
#pragma unroll
        for (int j = 0; j < 4; ++j) { float v = acc[r][j]; v += __shfl_xor(v, 16); v += __shfl_xor(v, 32); if (lane < 16) RED[(wv * 9 + r) * 64 + 4 * cq + j] = v; }
    __syncthreads();
    for (int idx = tid; idx < 9 * 64; idx += NTHREADS) {
        const int r = idx >> 6, cc = idx & 63; float s = F.b_mod[c0 + cc];
#pragma unroll
        for (int w8 = 0; w8 < 8; ++w8) s += RED[(w8 * 9 + r) * 64 + cc];
        F.mod[r * 6144 + c0 + cc] = s;
    }
    __syncthreads();
}
__device__ __forceinline__ void phase0(const Frame& F) {
    for (int item = blockIdx.x; item < 96 + 448 + 128; item += gridDim.x) {
        if (item < 96) mod_item(F, item);
        else if (item < 96 + 448) { const int it = item - 96, nt = it % 56, kt = it / 56; conv_tile(F.w_in, DIN, kt * 128, nt * 64, F.WinT, nt * 64, F.lds); }
        else { const int it = item - 544, nt = it & 15, kt = it >> 4; conv_tile(F.w_out, D, kt * 128, nt * 64, F.WoutT, nt * 64, F.lds); }
    }
}

__device__ __forceinline__ void phase1(const Frame& F) {
    const int lane = threadIdx.x & 63, wv = threadIdx.x >> 6;
    for (int r = blockIdx.x * 8 + wv; r < NROW; r += gridDim.x * 8) {
        const float* src; const float* md;
        if (r < NTOK) { src = F.x + (size_t)r * D; md = F.mod + (size_t)(r >> 11) * 6144; } else { src = F.ctx + (size_t)(r - NTOK) * D; md = F.mod + (size_t)8 * 6144; }
        f32x4 v[4]; float ss = 0.f;
#pragma unroll
        for (int j = 0; j < 4; ++j) { v[j] = *(const f32x4*)(src + 4 * lane + 256 * j); ss += (v[j][0] * v[j][0] + v[j][1] * v[j][1]) + (v[j][2] * v[j][2] + v[j][3] * v[j][3]); }
        ss = wave_sum(ss);
        const float rstd = __builtin_amdgcn_rsqf(ss * (1.0f / 1024.0f) + EPS);
#pragma unroll
        for (int j = 0; j < 4; ++j) {
            const int c = 4 * lane + 256 * j;
            const f32x4 nw = *(const f32x4*)(F.norm1 + c), sh = *(const f32x4*)(md + c), sc = *(const f32x4*)(md + 1024 + c);
            const f32x4 o = v[j] * rstd * nw * (1.0f + sc) + sh;
            u32x2 w; w.x = cvt_pk_bf16(o[0], o[1]); w.y = cvt_pk_bf16(o[2], o[3]);
            *(u32x2*)(F.H + (size_t)r * D + c) = w;
        }
    }
}

__device__ __forceinline__ void phase4(const Frame& F) {
    const int lane = threadIdx.x & 63, wv = threadIdx.x >> 6;
    for (int t = blockIdx.x * 8 + wv; t < NTOK; t += gridDim.x * 8) {
        const size_t o = (size_t)t * GW + 8 * lane;
        const f32x4 a0 = *(const f32x4*)(F.OF + o), a1 = *(const f32x4*)(F.OF + o + 4), b0 = *(const f32x4*)(F.OB + o), b1 = *(const f32x4*)(F.OB + o + 4);
        const f32x4 s0 = a0 + b0, s1 = a1 + b1;
        float ss = (s0[0] * s0[0] + s0[1] * s0[1]) + (s0[2] * s0[2] + s0[3] * s0[3]) + (s1[0] * s1[0] + s1[1] * s1[1]) + (s1[2] * s1[2] + s1[3] * s1[3]);
        ss += __shfl_xor(ss, 1); ss += __shfl_xor(ss, 2); ss += __shfl_xor(ss, 4); ss += __shfl_xor(ss, 8);
        const float rstd = __builtin_amdgcn_rsqf(ss * (1.0f / 128.0f) + EPS);
        const f32x4 n0 = *(const f32x4*)(F.hgrn_norm + 8 * lane), n1 = *(const f32x4*)(F.hgrn_norm + 8 * lane + 4);
        const u32x4 g = *(const u32x4*)(F.GS + o);
        u32x4 w;
        w.x = cvt_pk_bf16(s0[0] * rstd * n0[0] * bflo(g.x), s0[1] * rstd * n0[1] * bfhi(g.x));
        w.y = cvt_pk_bf16(s0[2] * rstd * n0[2] * bflo(g.y), s0[3] * rstd * n0[3] * bfhi(g.y));
        w.z = cvt_pk_bf16(s1[0] * rstd * n1[0] * bflo(g.z), s1[1] * rstd * n1[1] * bfhi(g.z));
        w.w = cvt_pk_bf16(s1[2] * rstd * n1[2] * bflo(g.w), s1[3] * rstd * n1[3] * bfhi(g.w));
        *(u32x4*)(F.YCAT + (size_t)t * D + GW + 8 * lane) = w;
    }
}

constexpr int RT_STRIDE = 1028;
__device__ __forceinline__ void phase6(const Frame& F) {
    LAS float* RT = (LAS float*)F.lds;
    LAS int* lcnt = (LAS int*)(F.lds + 132096);
    LAS int* lbase = lcnt + 32;
    LAS int* sel = lbase + 32;
    LAS float* selw = (LAS float*)(sel + 256);
    const int tid = threadIdx.x, lane = tid & 63, wv = tid >> 6;
    for (int idx = tid; idx < D * NE; idx += NTHREADS) { const int c = idx >> 5, e = idx & 31; RT[e * RT_STRIDE + c] = F.router_w[idx]; }
    if (tid < 32) lcnt[tid] = 0;
    __syncthreads();
    for (int rep6 = 0; rep6 < (DBG_REP6 ? 2 : 1); ++rep6)
    for (int grp = blockIdx.x; grp < NTOK / 64; grp += gridDim.x) {
        for (int i = 0; i < 4; ++i) {
            const int tl0 = wv * 8 + 2 * i, t0 = grp * 64 + tl0;
            const float* md = F.mod + (size_t)(t0 >> 11) * 6144;
            f32x4 hv[2][4];
#pragma unroll
            for (int u = 0; u < 2; ++u) {
                const int t = t0 + u;
                float ss = (lane < 16) ? F.SS[(size_t)t * 16 + lane] : 0.f;
                ss = wave_sum(ss);
                const float rstd = __builtin_amdgcn_rsqf(ss * (1.0f / 1024.0f) + EPS);
#pragma unroll
                for (int j = 0; j < 4; ++j) {
                    const int c = 4 * lane + 256 * j;
                    const f32x4 xv = *(const f32x4*)(F.X1 + (size_t)t * D + c), nw = *(const f32x4*)(F.norm2 + c), sh = *(const f32x4*)(md + 3072 + c), sc = *(const f32x4*)(md + 4096 + c);
                    hv[u][j] = xv * rstd * nw * (1.0f + sc) + sh;
                    *(unsigned*)(F.H2 + (size_t)t * D + c) = pack_fp8x4(hv[u][j][0], hv[u][j][1], hv[u][j][2], hv[u][j][3]);
                }
            }
            float p[2][16];
            const bool hi32 = (lane & 32) != 0;
#pragma unroll
            for (int q = 0; q < 16; ++q) {
                float a[2][2] = {{0.f, 0.f}, {0.f, 0.f}};
#pragma unroll
                for (int hh = 0; hh < 2; ++hh)
#pragma unroll
                    for (int j = 0; j < 4; ++j) {
                        const f32x4 rw = *(const LAS f32x4*)(RT + (q + 16 * hh) * RT_STRIDE + 4 * lane + 256 * j);
                        a[0][hh] += (hv[0][j][0] * rw[0] + hv[0][j][1] * rw[1]) + (hv[0][j][2] * rw[2] + hv[0][j][3] * rw[3]);
                        a[1][hh] += (hv[1][j][0] * rw[0] + hv[1][j][1] * rw[1]) + (hv[1][j][2] * rw[2] + hv[1][j][3] * rw[3]);
                    }
#pragma unroll
                for (int u = 0; u < 2; ++u) { const float keep = hi32 ? a[u][1] : a[u][0], send = hi32 ? a[u][0] : a[u][1]; p[u][q] = keep + __shfl_xor(send, 32); }
                __builtin_amdgcn_sched_barrier(0);
            }
#pragma unroll
            for (int u = 0; u < 2; ++u) {
#pragma unroll
                for (int st = 1; st < 5; ++st) {
                    const int o = 32 >> st, n = 16 >> st; const bool hi = (lane & o) != 0;
#pragma unroll
                    for (int q = 0; q < n; ++q) { const float keep = hi ? p[u][n + q] : p[u][q], send = hi ? p[u][q] : p[u][n + q]; p[u][q] = keep + __shfl_xor(send, o); }
                }
                p[u][0] += __shfl_xor(p[u][0], 1);
            }
            const int myexp = (lane >> 1) & 31; const float rb = F.router_b[myexp];
#pragma unroll
            for (int u = 0; u < 2; ++u) {
                const float v = p[u][0] + rb;
                int rank = 0;
#pragma unroll
                for (int e = 0; e < NE; ++e) { const float o = __builtin_bit_cast(float, __builtin_amdgcn_readlane(__builtin_bit_cast(int, v), 2 * e)); rank += (o > v || (o == v && e < myexp)) ? 1 : 0; }
                const bool even = (lane & 1) == 0;
                float tv[4]; int te[4];
#pragma unroll
                for (int k = 0; k < 4; ++k) { const unsigned long long bal = __ballot(even && rank == k); const int src = (__ffsll((long long)bal) - 1) & 63; tv[k] = __shfl(v, src); te[k] = src >> 1; }
                const float e1 = __expf(tv[1] - tv[0]), e2 = __expf(tv[2] - tv[0]), e3 = __expf(tv[3] - tv[0]);
                const float inv = 1.0f / (1.0f + e1 + e2 + e3);
                if (lane < 4 && rep6 == 0) {
                    const int e = (lane == 0) ? te[0] : (lane == 1) ? te[1] : (lane == 2) ? te[2] : te[3];
                    const float wgt = ((lane == 0) ? 1.0f : (lane == 1) ? e1 : (lane == 2) ? e2 : e3) * inv;
                    const int rk = __hip_atomic_fetch_add(lcnt + e, 1, __ATOMIC_RELAXED, __HIP_MEMORY_SCOPE_WORKGROUP);
                    sel[(tl0 + u) * 4 + lane] = e | (rk << 8); selw[(tl0 + u) * 4 + lane] = wgt;
                }
            }
        }
        __syncthreads();
        if (tid < 32 && rep6 == 0) { const int n = lcnt[tid]; lbase[tid] = n ? (int)__hip_atomic_fetch_add(F.ctl + CW_CNT + 64 * tid, (unsigned)n, __ATOMIC_RELAXED, __HIP_MEMORY_SCOPE_AGENT) : 0; lcnt[tid] = 0; }
        __syncthreads();
        if (tid < 256 && rep6 == 0) {
            const int sv = sel[tid], e = sv & 255, idx = lbase[e] + (sv >> 8), t = grp * 64 + (tid >> 2);
            F.LIST[e * NTOK + idx] = t; F.TSLOT[t * 4 + (tid & 3)] = e * NTOK + idx; F.TW[t * 4 + (tid & 3)] = selw[tid];
        }
        __syncthreads();
    }
}

__device__ __forceinline__ void phase9(const Frame& F) {
    moe_tables(F);
    const MoeTab T = moe_tab(F.lds);
    const int lane = threadIdx.x & 63, wv = threadIdx.x >> 6;
    for (int t = blockIdx.x * 8 + wv; t < NTOK; t += gridDim.x * 8) {
        const float* g2 = F.mod + (size_t)(t >> 11) * 6144 + 5120;
        float y[2][8];
#pragma unroll
        for (int j = 0; j < 2; ++j)
#pragma unroll
            for (int i = 0; i < 8; ++i) y[j][i] = 0.f;
#pragma unroll
        for (int k = 0; k < (DBG_NO_MOE ? 0 : 4); ++k) {
            const int sl = F.TSLOT[t * 4 + k]; const float wk = F.TW[t * 4 + k];
            const int e = sl >> 14, idx = sl & (NTOK - 1);
            const size_t row = (size_t)(T.tstart[e] * 256 + idx);
#pragma unroll
            for (int j = 0; j < 2; ++j) {
                const u32x4 d = *(const u32x4*)(F.DOUT + row * D + 8 * lane + 512 * j);
                y[j][0] += wk * bflo(d.x); y[j][1] += wk * bfhi(d.x); y[j][2] += wk * bflo(d.y); y[j][3] += wk * bfhi(d.y);
                y[j][4] += wk * bflo(d.z); y[j][5] += wk * bfhi(d.z); y[j][6] += wk * bflo(d.w); y[j][7] += wk * bfhi(d.w);
            }
        }
        float xf[2][8]; float ss = 0.f;
#pragma unroll
        for (int j = 0; j < 2; ++j) {
            const int c = 8 * lane + 512 * j;
            const f32x4 x0 = *(const f32x4*)(F.X1 + (size_t)t * D + c), x1v = *(const f32x4*)(F.X1 + (size_t)t * D + c + 4);
            const f32x4 ga = *(const f32x4*)(g2 + c), gb = *(const f32x4*)(g2 + c + 4);
#pragma unroll
            for (int i = 0; i < 4; ++i) { xf[j][i] = x0[i] + ga[i] * y[j][i]; xf[j][4 + i] = x1v[i] + gb[i] * y[j][4 + i]; }
#pragma unroll
            for (int i = 0; i < 8; ++i) ss += xf[j][i] * xf[j][i];
        }
        ss = wave_sum(ss);
        const float rstd = __builtin_amdgcn_rsqf(ss * (1.0f / 1024.0f) + EPS);
#pragma unroll
        for (int j = 0; j < 2; ++j) {
            const int c = 8 * lane + 512 * j;
            const f32x4 fa = *(const f32x4*)(F.final_norm + c), fb = *(const f32x4*)(F.final_norm + c + 4);
            f32x4 o0, o1;
#pragma unroll
            for (int i = 0; i < 4; ++i) { o0[i] = xf[j][i] * rstd * fa[i]; o1[i] = xf[j][4 + i] * rstd * fb[i]; }
            *(f32x4*)(F.out + (size_t)t * D + c) = o0; *(f32x4*)(F.out + (size_t)t * D + c + 4) = o1;
        }
    }
}

__device__ __forceinline__ void sgu_item(const Frame& F, int item) {
    constexpr int RS = 272;
    LAS unsigned char* WL = F.lds;
    LAS unsigned char* VT = F.lds + 128 * RS;
    const int tid = threadIdx.x, lane = tid & 63, wv = __builtin_amdgcn_readfirstlane(tid >> 6), fr = lane & 15, fq = lane >> 4;
    const int h = item & 3, n = (item >> 2) & 15, b = item >> 6;
    const int row0 = b * SEQ + n * 128;
    {
        const int t = tid >> 2, s0 = (tid & 3) * 32;
        const float* wp = F.sgu_w + ((size_t)h * 128 + t) * 128 + s0;
#pragma unroll
        for (int j = 0; j < 4; ++j) {
            const f32x4 a = *(const f32x4*)(wp + 8 * j), c = *(const f32x4*)(wp + 8 * j + 4);
            u32x4 w; w.x = cvt_pk_bf16(a[0], a[1]); w.y = cvt_pk_bf16(a[2], a[3]); w.z = cvt_pk_bf16(c[0], c[1]); w.w = cvt_pk_bf16(c[2], c[3]);
            *(LAS u32x4*)(WL + t * RS + (s0 + 8 * j) * 2) = w;
        }
    }
    {
        const int s = tid >> 2, d0 = (tid & 3) * 32;
        const bf16_t* vp = F.VG + (size_t)(row0 + s) * GW + h * 128 + d0;
        float v[32];
#pragma unroll
        for (int j = 0; j < 4; ++j) { const u32x4 w = *(const u32x4*)(vp + 8 * j);
            v[8 * j + 0] = bflo(w.x); v[8 * j + 1] = bfhi(w.x); v[8 * j + 2] = bflo(w.y); v[8 * j + 3] = bfhi(w.y); v[8 * j + 4] = bflo(w.z); v[8 * j + 5] = bfhi(w.z); v[8 * j + 6] = bflo(w.w); v[8 * j + 7] = bfhi(w.w); }
        float sm = 0.f;
#pragma unroll
        for (int i = 0; i < 32; ++i) sm += v[i];
        sm += __shfl_xor(sm, 1); sm += __shfl_xor(sm, 2);
        const float mu = sm * (1.0f / 128.0f); float q = 0.f;
#pragma unroll
        for (int i = 0; i < 32; ++i) { const float dd = v[i] - mu; q += dd * dd; }
        q += __shfl_xor(q, 1); q += __shfl_xor(q, 2);
        const float rstd = __builtin_amdgcn_rsqf(q * (1.0f / 128.0f) + EPS);
        const float* lg = F.sgu_ln + h * 128 + d0;
#pragma unroll
        for (int i = 0; i < 32; i += 2) {
            const unsigned pk = cvt_pk_bf16((v[i] - mu) * rstd * lg[i], (v[i + 1] - mu) * rstd * lg[i + 1]);
            *(LAS unsigned short*)(VT + (d0 + i) * RS + s * 2) = (unsigned short)(pk & 0xffffu);
            *(LAS unsigned short*)(VT + (d0 + i + 1) * RS + s * 2) = (unsigned short)(pk >> 16);
        }
    }
    __syncthreads();
    f32x4 acc[8];
#pragma unroll
    for (int nt = 0; nt < 8; ++nt) acc[nt] = (f32x4){0.f, 0.f, 0.f, 0.f};
#pragma unroll
    for (int a = 0; a < 4; ++a) {
        const bf16x8 wf = *(const LAS bf16x8*)(WL + (16 * wv + fr) * RS + (32 * a + 8 * fq) * 2);
#pragma unroll
        for (int nt = 0; nt < 8; ++nt) {
            const bf16x8 vf = *(const LAS bf16x8*)(VT + (16 * nt + fr) * RS + (32 * a + 8 * fq) * 2);
            acc[nt] = __builtin_amdgcn_mfma_f32_16x16x32_bf16(vf, wf, acc[nt], 0, 0, 0);
        }
    }
    {
        const int t = 16 * wv + fr; const size_t row = (size_t)(row0 + t);
        const float bias = F.sgu_b[h * 128 + t];
#pragma unroll
        for (int nt = 0; nt < 8; ++nt) {
            const int d = h * 128 + 16 * nt + 4 * fq;
            const u32x2 uu = *(const u32x2*)(F.U + row * GW + d);
            u32x2 w; w.x = cvt_pk_bf16(bflo(uu.x) * (acc[nt][0] + bias), bfhi(uu.x) * (acc[nt][1] + bias)); w.y = cvt_pk_bf16(bflo(uu.y) * (acc[nt][2] + bias), bfhi(uu.y) * (acc[nt][3] + bias));
            *(u32x2*)(F.YCAT + row * D + d) = w;
        }
    }
    __syncthreads();
}

__device__ __forceinline__ float hexp(float x) { return fast_exp(clampf(x, -87.0f, 60.0f)); }
namespace hg {
constexpr int RS = 272, OFF_QP = 0, OFF_QA = 8704, OFF_QB = OFF_QA + 4352, OFF_QC = OFF_QB + 4352, OFF_KA = OFF_QC + 4352, OFF_KB = OFF_KA + 4352, OFF_KC = OFF_KB + 4352,
              OFF_KDT = OFF_KC + 4352, OFF_D = OFF_KDT + 10240, BUF = OFF_D + 512;
constexpr int RAW_OFF = 2 * BUF, RAWBUF = 2 * 32 * RS;
struct QK { u32x2 kk[2], q[2]; };
struct GV { u32x4 g, v; };
struct Ctx {
    LAS unsigned char* lds; const bf16_t *Gp, *Kp, *Ip, *Qp; float* Op;
    int b, dir, sgn, colw, h, w, fr, fq, tid, slot0;
    bf16x8 tri0, tri1;
};
__device__ __forceinline__ int base_row(const Ctx& X, int c) {
    return c < 8 ? (NTOK + X.b * CTXL + (X.dir ? (CTXL - 1 - 32 * c) : 32 * c)) : (X.b * SEQ + (X.dir ? (SEQ - 1 - 32 * (c - 8)) : 32 * (c - 8)));
}
__device__ __forceinline__ void load_qk(const Ctx& X, int c, QK& r) {
    const int base = base_row(X, c);
#pragma unroll
    for (int j = 0; j < 2; ++j) {
        const int row = base + X.sgn * (X.fr + 16 * j);
        const size_t o = (size_t)row * GW + X.colw + 4 * X.fq;
        const size_t oq = (size_t)(row < NTOK ? row : row - NTOK) * GW + X.colw + 4 * X.fq;
        r.kk[j] = *(const u32x2*)(X.Kp + o);
        r.q[j] = *(const u32x2*)(X.Qp + oq);
    }
}
__device__ __forceinline__ void load_gv(const Ctx& X, int c, GV& r) {
    const int base = base_row(X, c);
    const size_t o = (size_t)(base + X.sgn * (X.tid >> 4)) * GW + X.h * 128 + 8 * (X.tid & 15);
    r.g = *(const u32x4*)(X.Gp + o); r.v = *(const u32x4*)(X.Ip + o);
}
__device__ __forceinline__ void raw_write(const Ctx& X, int c, const GV& r) {
    LAS unsigned char* rb = X.lds + RAW_OFF + (c & 1) * RAWBUF + (X.tid >> 4) * RS + (X.tid & 15) * 16;
    *(LAS u32x4*)(rb) = r.g; *(LAS u32x4*)(rb + 32 * RS) = r.v;
}
template <bool LAT> __device__ __forceinline__ bf16x8 stage(const Ctx& X, int c, const QK& qk) {
    LAS unsigned char* buf = X.lds + (c & 1) * BUF;
    const LAS unsigned char* rg = X.lds + RAW_OFF + (c & 1) * RAWBUF + (16 * X.w + X.fr) * 2;
    const int fr = X.fr, fq = X.fq, w = X.w;
    constexpr bool lat = LAT;
    unsigned gs[8], vs[8];
#pragma unroll
    for (int jj = 0; jj < 8; ++jj) {
        const int p = (jj < 4) ? (4 * fq + jj) : (16 + 4 * fq + jj - 4);
        gs[jj] = *(const LAS unsigned short*)(rg + p * RS); vs[jj] = *(const LAS unsigned short*)(rg + 32 * RS + p * RS);
    }
    bf16x8 gT, VTf;
    { u32x4 t; t.x = gs[0] | (gs[1] << 16); t.y = gs[2] | (gs[3] << 16); t.z = gs[4] | (gs[5] << 16); t.w = gs[6] | (gs[7] << 16); gT = __builtin_bit_cast(bf16x8, t);
      u32x4 u; u.x = vs[0] | (vs[1] << 16); u.y = vs[2] | (vs[3] << 16); u.z = vs[4] | (vs[5] << 16); u.w = vs[6] | (vs[7] << 16); VTf = __builtin_bit_cast(bf16x8, u); }
    const f32x4 z4 = (f32x4){0.f, 0.f, 0.f, 0.f};
    f32x4 bT[2];
    bT[0] = __builtin_amdgcn_mfma_f32_16x16x32_bf16(gT, X.tri0, z4, 0, 0, 0);
    bT[1] = __builtin_amdgcn_mfma_f32_16x16x32_bf16(gT, X.tri1, z4, 0, 0, 0);
    f32x4 b7, b15, b23, b31;
#pragma unroll
    for (int r = 0; r < 4; ++r) { b7[r] = __shfl(bT[0][r], 16 * fq + 7); b15[r] = __shfl(bT[0][r], 16 * fq + 15); b23[r] = __shfl(bT[1][r], 16 * fq + 7); b31[r] = __shfl(bT[1][r], 16 * fq + 15); }
#pragma unroll
    for (int j = 0; j < 2; ++j) {
        const float kv[4] = {bflo(qk.kk[j].x), bfhi(qk.kk[j].x), bflo(qk.kk[j].y), bfhi(qk.kk[j].y)};
        const float qv[4] = {bflo(qk.q[j].x), bfhi(qk.q[j].x), bflo(qk.q[j].y), bfhi(qk.q[j].y)};
        float kd[4], qp[4], qi[4], ki[4], x2[4];
#pragma unroll
        for (int r = 0; r < 4; ++r) {
            const float bt = bT[j][r], mref = (j == 0) ? b7[r] : b23[r];
            kd[r] = kv[r] * hexp(b31[r] - bt);
            qp[r] = qv[r] * hexp(bt);
            qi[r] = qv[r] * hexp(bt - mref);
            ki[r] = kv[r] * hexp(mref - bt);
            x2[r] = (j == 0) ? kv[r] * hexp(b15[r] - bt) : qv[r] * hexp(bt - b15[r]);
        }
        const int trow = fr + 16 * j;
        const unsigned kd01 = cvt_pk_bf16(kd[0], kd[1]), kd23 = cvt_pk_bf16(kd[2], kd[3]);
        LAS unsigned char* kdp = buf + OFF_KDT + (16 * w + 4 * fq) * 80 + (X.slot0 + 4 * j) * 2;
        *(LAS unsigned short*)(kdp) = (unsigned short)(kd01 & 0xffffu); *(LAS unsigned short*)(kdp + 80) = (unsigned short)(kd01 >> 16);
        *(LAS unsigned short*)(kdp + 160) = (unsigned short)(kd23 & 0xffffu); *(LAS unsigned short*)(kdp + 240) = (unsigned short)(kd23 >> 16);
        if (lat) {
            { u32x2 wv; wv.x = cvt_pk_bf16(ki[0], ki[1]); wv.y = cvt_pk_bf16(ki[2], ki[3]); *(LAS u32x2*)(buf + (j == 0 ? OFF_KA : OFF_KB) + fr * RS + (16 * w + 4 * fq) * 2) = wv; }
            { u32x2 wv; wv.x = cvt_pk_bf16(qp[0], qp[1]); wv.y = cvt_pk_bf16(qp[2], qp[3]); *(LAS u32x2*)(buf + OFF_QP + trow * RS + (32 * (w >> 1) + 8 * fq + 4 * (w & 1)) * 2) = wv; }
            { u32x2 wv; wv.x = cvt_pk_bf16(qi[0], qi[1]); wv.y = cvt_pk_bf16(qi[2], qi[3]); *(LAS u32x2*)(buf + (j == 0 ? OFF_QA : OFF_QB) + fr * RS + (16 * w + 4 * fq) * 2) = wv; }
            { u32x2 wv; wv.x = cvt_pk_bf16(x2[0], x2[1]); wv.y = cvt_pk_bf16(x2[2], x2[3]); *(LAS u32x2*)(buf + (j == 0 ? OFF_KC : OFF_QC) + fr * RS + (16 * w + 4 * fq) * 2) = wv; }
        }
    }
    if (fr == 0) { f32x4 dv; dv[0] = hexp(b31[0]); dv[1] = hexp(b31[1]); dv[2] = hexp(b31[2]); dv[3] = hexp(b31[3]); *(LAS f32x4*)(buf + OFF_D + (16 * w + 4 * fq) * 4) = dv; }
    return VTf;
}
template <bool LAT> __device__ __forceinline__ void products(const Ctx& X, int c, const bf16x8 VTf, f32x4 (&S)[8]) {
    const LAS unsigned char* buf = X.lds + (c & 1) * BUF;
    const int fr = X.fr, fq = X.fq;
    const f32x4 z4 = (f32x4){0.f, 0.f, 0.f, 0.f};
    if (LAT) {
        f32x4 X00 = z4, X11 = z4, X01 = z4;
#pragma unroll
        for (int a = 0; a < 4; ++a) {
            const int co = fr * RS + (32 * a + 8 * fq) * 2;
            const bf16x8 ka = *(const LAS bf16x8*)(buf + OFF_KA + co), qa = *(const LAS bf16x8*)(buf + OFF_QA + co);
            const bf16x8 kb = *(const LAS bf16x8*)(buf + OFF_KB + co), qb = *(const LAS bf16x8*)(buf + OFF_QB + co);
            const bf16x8 kc = *(const LAS bf16x8*)(buf + OFF_KC + co), qc = *(const LAS bf16x8*)(buf + OFF_QC + co);
            X00 = __builtin_amdgcn_mfma_f32_16x16x32_bf16(ka, qa, X00, 0, 0, 0);
            X11 = __builtin_amdgcn_mfma_f32_16x16x32_bf16(kb, qb, X11, 0, 0, 0);
            X01 = __builtin_amdgcn_mfma_f32_16x16x32_bf16(kc, qc, X01, 0, 0, 0);
        }
#pragma unroll
        for (int r = 0; r < 4; ++r) { const bool keep = (4 * fq + r) <= fr; X00[r] = keep ? X00[r] : 0.f; X11[r] = keep ? X11[r] : 0.f; }
        bf16x8 P0, P1;
        { u32x4 t; t.x = cvt_pk_bf16(X00[0], X00[1]); t.y = cvt_pk_bf16(X00[2], X00[3]); t.z = 0u; t.w = 0u; P0 = __builtin_bit_cast(bf16x8, t);
          u32x4 u; u.x = cvt_pk_bf16(X01[0], X01[1]); u.y = cvt_pk_bf16(X01[2], X01[3]); u.z = cvt_pk_bf16(X11[0], X11[1]); u.w = cvt_pk_bf16(X11[2], X11[3]); P1 = __builtin_bit_cast(bf16x8, u); }
        f32x4 o0 = __builtin_amdgcn_mfma_f32_16x16x32_bf16(VTf, P0, z4, 0, 0, 0);
        f32x4 o1 = __builtin_amdgcn_mfma_f32_16x16x32_bf16(VTf, P1, z4, 0, 0, 0);
#pragma unroll
        for (int a = 0; a < 4; ++a) {
            u32x4 t; t.x = cvt_pk_bf16(S[2 * a][0], S[2 * a][1]); t.y = cvt_pk_bf16(S[2 * a][2], S[2 * a][3]); t.z = cvt_pk_bf16(S[2 * a + 1][0], S[2 * a + 1][1]); t.w = cvt_pk_bf16(S[2 * a + 1][2], S[2 * a + 1][3]);
            const bf16x8 Sb = __builtin_bit_cast(bf16x8, t);
            const bf16x8 qp0 = *(const LAS bf16x8*)(buf + OFF_QP + fr * RS + (32 * a + 8 * fq) * 2), qp1 = *(const LAS bf16x8*)(buf + OFF_QP + (16 + fr) * RS + (32 * a + 8 * fq) * 2);
            o0 = __builtin_amdgcn_mfma_f32_16x16x32_bf16(Sb, qp0, o0, 0, 0, 0);
            o1 = __builtin_amdgcn_mfma_f32_16x16x32_bf16(Sb, qp1, o1, 0, 0, 0);
        }
        const int base = base_row(X, c);
        *(f32x4*)(X.Op + (size_t)(base + X.sgn * fr) * GW + X.colw + 4 * fq) = o0;
        *(f32x4*)(X.Op + (size_t)(base + X.sgn * (fr + 16)) * GW + X.colw + 4 * fq) = o1;
    }
#pragma unroll
    for (int kt = 0; kt < 8; ++kt) {
        const bf16x8 kdf = *(const LAS bf16x8*)(buf + OFF_KDT + (16 * kt + fr) * 80 + 16 * fq);
        const f32x4 dv = *(const LAS f32x4*)(buf + OFF_D + (16 * kt + 4 * fq) * 4);
        S[kt] = __builtin_amdgcn_mfma_f32_16x16x32_bf16(kdf, VTf, S[kt] * dv, 0, 0, 0);
    }
}
__device__ __forceinline__ void lds_barrier() {
    asm volatile("s_waitcnt lgkmcnt(0)" ::: "memory"); __builtin_amdgcn_s_barrier(); asm volatile("" ::: "memory");
}
template <bool PL, bool SL> __device__ __forceinline__ void iter(const Ctx& X, int c, QK& qk, GV& gv, bf16x8& VTcur, f32x4 (&S)[8]) {
    lds_barrier();
    products<PL>(X, c, VTcur, S);
    VTcur = stage<SL>(X, c + 1, qk);
    load_qk(X, c + 3 < 72 ? c + 3 : 71, qk);
    if (c + 2 < 72) raw_write(X, c + 2, gv);
    load_gv(X, c + 4 < 72 ? c + 4 : 71, gv);
}
}
__device__ __forceinline__ void hgrn_chain(const Frame& F, int chain) {
    using namespace hg;
    Ctx X;
    X.lds = F.lds; X.tid = threadIdx.x; const int lane = X.tid & 63; X.w = __builtin_amdgcn_readfirstlane(X.tid >> 6); X.fr = lane & 15; X.fq = lane >> 4;
    X.dir = chain & 1; X.h = (chain >> 1) & 3; X.b = chain >> 3; X.sgn = X.dir ? -1 : 1; X.colw = X.h * 128 + 16 * X.w;
    X.Gp = X.dir ? F.GB : F.GF; X.Kp = X.dir ? F.KB : F.KF; X.Ip = F.I; X.Qp = F.Q; X.Op = X.dir ? F.OB : F.OF;
    X.slot0 = 8 * (X.fr >> 2) + (X.fr & 3);
#pragma unroll
    for (int jj = 0; jj < 8; ++jj) {
        X.tri0[jj] = (jj < 4 && 4 * X.fq + jj <= X.fr) ? (short)0x3F80 : (short)0;
        X.tri1[jj] = (jj < 4) ? (short)0x3F80 : ((4 * X.fq + jj - 4 <= X.fr) ? (short)0x3F80 : (short)0);
    }
    f32x4 S[8];
#pragma unroll
    for (int kt = 0; kt < 8; ++kt) S[kt] = (f32x4){0.f, 0.f, 0.f, 0.f};
    QK qkA, qkB; GV gvA, gvB;
    load_gv(X, 0, gvA); load_gv(X, 1, gvB); load_qk(X, 0, qkA); load_qk(X, 1, qkB);
    raw_write(X, 0, gvA); load_gv(X, 2, gvA);
    lds_barrier();
    bf16x8 VTcur = stage<false>(X, 0, qkA); load_qk(X, 2, qkA);
    raw_write(X, 1, gvB); load_gv(X, 3, gvB);
    for (int c = 0; c < 6; c += 2) { iter<false, false>(X, c, qkB, gvA, VTcur, S); iter<false, false>(X, c + 1, qkA, gvB, VTcur, S); }
    iter<false, false>(X, 6, qkB, gvA, VTcur, S); iter<false, true>(X, 7, qkA, gvB, VTcur, S);
    for (int c = 8; c < 70; c += 2) { iter<true, true>(X, c, qkB, gvA, VTcur, S); iter<true, true>(X, c + 1, qkA, gvB, VTcur, S); }
    iter<true, true>(X, 70, qkB, gvA, VTcur, S);
    lds_barrier();
    products<true>(X, 71, VTcur, S);
    __syncthreads();
}

__device__ __forceinline__ void phase3(const Frame& F) {
    const int G = gridDim.x;
    if ((int)blockIdx.x < 64) { hgrn_chain(F, blockIdx.x); if (DBG_REP3 & 1) hgrn_chain(F, blockIdx.x); return; }
    for (int rep = 0; rep < ((DBG_REP3 & 2) ? 2 : 1); ++rep) {
        for (int item = blockIdx.x - 64; item < 512; item += G - 64) sgu_item(F, item);
        conv8_run(F, blockIdx.x - 64, G - 64);
    }
}

constexpr int N_PHASES = 10;
#ifndef DBG_NO_MOE
#define DBG_NO_MOE 0
#endif
#ifndef DBG_MAX_PHASE
#define DBG_MAX_PHASE 9
#endif
__global__ void __launch_bounds__(NTHREADS, 2) fwd_kernel(Args a) {
    extern __shared__ __attribute__((aligned(16))) unsigned char lds_raw[];
    Frame F;
    F.x = a.in[0]; F.c = a.in[1]; F.ctx = a.in[2]; F.c_ctx = a.in[3]; F.w_mod = a.in[4]; F.b_mod = a.in[5]; F.norm1 = a.in[6]; F.w_in = a.in[7]; F.sgu_ln = a.in[8]; F.sgu_w = a.in[9];
    F.sgu_b = a.in[10]; F.lb_fwd = a.in[11]; F.lb_bwd = a.in[12]; F.hgrn_norm = a.in[13]; F.w_out = a.in[14]; F.norm2 = a.in[15]; F.router_w = a.in[16]; F.router_b = a.in[17];
    F.w1 = a.in[18]; F.b1 = a.in[19]; F.w2 = a.in[20]; F.b2 = a.in[21]; F.final_norm = a.in[22];
    F.out = a.out; F.ws = a.ws; unsigned char* ws = a.ws;
    F.ctl = (unsigned*)(ws + WS_CTL); F.mod = (float*)(ws + WS_MOD);
    F.WinT = (bf16_t*)(ws + WS_WIN); F.WoutT = (bf16_t*)(ws + WS_WOUT); F.W1T = ws + WS_W1; F.W2T = ws + WS_W2;
    F.H = (bf16_t*)(ws + WS_H); F.U = (bf16_t*)(ws + WS_U); F.VG = (bf16_t*)(ws + WS_VG); F.Q = (bf16_t*)(ws + WS_Q); F.GS = (bf16_t*)(ws + WS_GS); F.I = (bf16_t*)(ws + WS_I);
    F.GF = (bf16_t*)(ws + WS_GF); F.KF = (bf16_t*)(ws + WS_KF); F.GB = (bf16_t*)(ws + WS_GB); F.KB = (bf16_t*)(ws + WS_KB);
    F.YCAT = (bf16_t*)(ws + WS_YCAT); F.H2 = ws + WS_H2; F.ACT = ws + WS_ACT; F.DOUT = (bf16_t*)(ws + WS_DOUT);
    F.OF = (float*)(ws + WS_OF); F.OB = (float*)(ws + WS_OB); F.X1 = (float*)(ws + WS_X1); F.SS = (float*)(ws + WS_SS); F.TW = (float*)(ws + WS_TW);
    F.LIST = (int*)(ws + WS_LIST); F.TSLOT = (int*)(ws + WS_TSLOT);
    F.lds = (LAS unsigned char*)lds_raw;
    if (threadIdx.x < 64) ((LAS unsigned*)(F.lds + LDS_MISC_OFF))[threadIdx.x] = 0u;
    __syncthreads();
    const int lo = a.ph_lo, hi = a.ph_hi, G = gridDim.x, cid = blockIdx.x;
    XcdBarrier bar; bar.bar = F.ctl + CW_BAR; bar.x = 0; bar.st = nullptr;
    if (hi - lo > 1) bar = xcd_barrier_post(F.ctl + CW_BAR, (volatile LAS unsigned*)(F.lds + LDS_MISC_OFF));
#define IN(k) (lo <= (k) && (k) < hi)
#define SEAM(k) do { if (IN(k) && IN((k) + 1)) xcd_barrier(bar); } while (0)
#define REP(k) for (int _r = 0; _r < (((DBG_REP >> (k)) & 1) ? 2 : 1); ++_r)
    if (IN(0)) REP(0) phase0(F);
    SEAM(0);
    if (IN(1)) REP(1) phase1(F);
    SEAM(1);
    for (int _b = 0; _b < DBG_BARX; ++_b) xcd_barrier(bar);
    if (IN(2)) REP(2) {
        SchedInProj S{F.WinT, G, cid}; EpiInProj E{F.U, F.VG, F.Q, F.GS, F.I, F.GF, F.KF, F.GB, F.KB, F.lb_fwd, F.lb_bwd};
        pg::gemm_phase<EpiInProj, SchedInProj, false>(F.lds, (const char*)F.H, D, S, E);
    }
    SEAM(2);
    if (IN(3)) REP(3) phase3(F);
    SEAM(3);
    if (IN(4)) REP(4) phase4(F);
    SEAM(4);
    if (IN(5)) REP(5) {
        SchedOutProj S{F.WoutT, G, cid}; EpiOutProj E{F.x, F.mod, F.X1, F.SS};
        pg::gemm_phase<EpiOutProj, SchedOutProj, false>(F.lds, (const char*)F.YCAT, D, S, E);
    }
    SEAM(5);
    if (IN(6)) phase6(F);
    SEAM(6);
    if (IN(7)) REP(7) {
        moe_tables(F);
        SchedGateUp S{F.W1T, F.LIST, moe_tab(F.lds), G, cid}; EpiGateUp E{F.b1, F.ACT};
        pg::gemm_phase<EpiGateUp, SchedGateUp, true>(F.lds, (const char*)F.H2, D, S, E);
    }
    SEAM(7);
    if (IN(8)) REP(8) {
        moe_tables(F);
        SchedDown S{F.W2T, moe_tab(F.lds), G, cid}; EpiDown E{F.b2, F.DOUT};
        pg::gemm_phase<EpiDown, SchedDown, true>(F.lds, (const char*)F.ACT, DE, S, E);
    }
    SEAM(8);
    if (IN(9)) REP(9) phase9(F);
#undef IN
#undef SEAM
}

extern "C" void kernel_launch(void* const* d_in, const int* in_sizes, int n_in, void* d_out, int out_size, void* d_ws, size_t ws_size, hipStream_t stream) {
    static int grid = 0;
    if (grid == 0) {
        if (n_in != 23 || in_sizes[0] != NTOK * D || out_size != NTOK * D || ws_size < WS_END) {
            fprintf(stderr, "kernel_launch: unexpected shapes / workspace (n_in %d, in0 %d, out %d, ws %zu, need %zu); nothing launched\n", n_in, n_in > 0 ? in_sizes[0] : -1, out_size, ws_size, (size_t)WS_END);
            grid = -1; return;
        }
        int dev = 0, cus = 0;
        if (hipGetDevice(&dev) != hipSuccess || hipDeviceGetAttribute(&cus, hipDeviceAttributeMultiprocessorCount, dev) != hipSuccess) { grid = -1; return; }
        if (hipFuncSetAttribute((const void*)fwd_kernel, hipFuncAttributeMaxDynamicSharedMemorySize, LDS_BYTES) != hipSuccess) { fprintf(stderr, "kernel_launch: hipFuncSetAttribute failed\n"); grid = -1; return; }
        (void)hipGetLastError();
        grid = cus;
        if (grid < 128) { fprintf(stderr, "kernel_launch: needs >= 128 CUs\n"); grid = -1; return; }
    }
    if (grid < 0) return;
    (void)hipMemsetAsync((char*)d_ws + WS_CTL, 0, CTL_BYTES, stream);
    Args a{};
    for (int i = 0; i < 23; ++i) a.in[i] = (const float*)d_in[i];
    a.out = (float*)d_out; a.ws = (unsigned char*)d_ws;
#if N_LAUNCH_MODE == 1
    a.ph_lo = 0; a.ph_hi = N_PHASES;
    hipLaunchKernelGGL(fwd_kernel, dim3(grid), dim3(NTHREADS), LDS_BYTES, stream, a);
#else
    for (int p = 0; p < N_PHASES; ++p) { if (DBG_NO_MOE && p >= 6 && p <= 8) continue; a.ph_lo = p; a.ph_hi = p + 1; hipLaunchKernelGGL(fwd_kernel, dim3(grid), dim3(NTHREADS), LDS_BYTES, stream, a); }
#endif
}
```

```cpp
#include <hip/hip_runtime.h>
#include <cstdio>
#include <cstdint>

#ifndef N_LAUNCH_MODE
#define N_LAUNCH_MODE 1
#endif

#ifndef DBG_NO_MOE
#define DBG_NO_MOE 0
#endif
#ifndef DBG_REP
#define DBG_REP 0
#endif
#ifndef DBG_REP3
#define DBG_REP3 0
#endif
#ifndef DBG_REP6
#define DBG_REP6 0
#endif
#ifndef DBG_BARX
#define DBG_BARX 0
#endif
#ifndef INPROJ_FP8
#define INPROJ_FP8 0
#endif
#ifndef DBG_MIX
#define DBG_MIX 1
#endif
#define LAS __attribute__((address_space(3)))
typedef unsigned short bf16_t;
typedef short bf16x8 __attribute__((ext_vector_type(8)));
typedef float f32x4 __attribute__((ext_vector_type(4)));
typedef float f32x2 __attribute__((ext_vector_type(2)));
typedef unsigned u32x4 __attribute__((ext_vector_type(4)));
typedef unsigned u32x2 __attribute__((ext_vector_type(2)));

constexpr int D = 1024, NB = 8, SEQ = 2048, CTXL = 256;
constexpr int NTOK = NB * SEQ;
constexpr int NCTX = NB * CTXL;
constexpr int NROW = NTOK + NCTX;
constexpr int DIN = 3584, GW = 512, NE = 32, DE = 1024, TOPK = 4;
constexpr int ACT_ROWS = NTOK * TOPK + NE * 256;
constexpr float EPS = 1e-6f;
constexpr int NTHREADS = 512;

constexpr int LDS_STAGE = 131072;
constexpr int LDS_EXTRA_OFF = LDS_STAGE;
constexpr int LDS_MISC_OFF = 155648;
constexpr int LDS_BYTES = LDS_MISC_OFF + 256;

constexpr size_t al256(size_t x) { return (x + 255) & ~(size_t)255; }
constexpr size_t WS_CTL = 0;
constexpr size_t CTL_BYTES = 65536;
constexpr int CW_BAR = 0;
constexpr int CW_HFLAG = 8192;
constexpr int CW_CNT = 4096;
constexpr size_t WS_MOD = WS_CTL + CTL_BYTES;
constexpr size_t WS_WIN = WS_MOD + al256((size_t)9 * 6144 * 4);
constexpr size_t WS_WOUT = WS_WIN + (size_t)DIN * D * 2;
constexpr size_t WS_W1 = WS_WOUT + (size_t)D * D * 2;
constexpr size_t WS_W2 = WS_W1 + (size_t)NE * 2 * DE * D * 2;
constexpr size_t WS_YCAT = WS_W2 + (size_t)NE * D * DE * 2;
constexpr size_t WS_OF = WS_YCAT + (size_t)NTOK * D * 2;
constexpr size_t WS_OB = WS_OF + (size_t)NTOK * GW * 4;
constexpr size_t WS_X1 = WS_OB + (size_t)NTOK * GW * 4;
constexpr size_t WS_SS = WS_X1 + (size_t)NTOK * D * 4;
constexpr size_t WS_H2 = WS_SS + (size_t)NTOK * 16 * 4;
constexpr size_t WS_LIST = WS_H2 + (size_t)NTOK * D * 2;
constexpr size_t WS_TSLOT = WS_LIST + (size_t)NE * NTOK * 4;
constexpr size_t WS_TW = WS_TSLOT + (size_t)NTOK * 4 * 4;
constexpr size_t WS_QCUM = WS_TW + (size_t)NTOK * 4 * 4;
constexpr size_t WS_SMID = WS_QCUM + (size_t)64 * 1152 * 128 * 2;
constexpr size_t WS_ACT = WS_SMID + (size_t)64 * 8 * 4 * 64 * 16;
constexpr size_t WS_REGA = WS_ACT + (size_t)ACT_ROWS * DE * 2;
constexpr size_t WS_H = WS_REGA;
constexpr size_t WS_U = WS_H + (size_t)NROW * D * 2;
constexpr size_t WS_VG = WS_U + (size_t)NTOK * GW * 2;
constexpr size_t WS_Q = WS_VG + (size_t)NTOK * GW * 2;
constexpr size_t WS_GS = WS_Q + (size_t)NTOK * GW * 2;
constexpr size_t WS_I = WS_GS + (size_t)NTOK * GW * 2;
constexpr size_t WS_GF = WS_I + (size_t)NROW * GW * 2;
constexpr size_t WS_KF = WS_GF + (size_t)NROW * GW * 2;
constexpr size_t WS_GB = WS_KF + (size_t)NROW * GW * 2;
constexpr size_t WS_KB = WS_GB + (size_t)NROW * GW * 2;
constexpr size_t WS_REGA_END = WS_KB + (size_t)NROW * GW * 2;
constexpr size_t WS_DOUT = WS_REGA;
constexpr size_t WS_END0 = WS_DOUT + (size_t)ACT_ROWS * D * 2;
constexpr size_t WS_END = WS_END0 > WS_REGA_END ? WS_END0 : WS_REGA_END;

typedef __bf16 bf16x2_t __attribute__((ext_vector_type(2)));
__device__ __forceinline__ unsigned cvt_pk_bf16(float lo, float hi) { bf16x2_t v; v[0] = (__bf16)lo; v[1] = (__bf16)hi; return __builtin_bit_cast(unsigned, v); }
__device__ __forceinline__ float bf2f(unsigned b) { return __uint_as_float(b << 16); }
__device__ __forceinline__ float bflo(unsigned w) { return __uint_as_float(w << 16); }
__device__ __forceinline__ float bfhi(unsigned w) { return __uint_as_float(w & 0xffff0000u); }
__device__ __forceinline__ float fast_exp(float x) { return __builtin_amdgcn_exp2f(x * 1.44269504089f); }
__device__ __forceinline__ float fast_rcp(float x) { return __builtin_amdgcn_rcpf(x); }
__device__ __forceinline__ float sigmoidf_(float x) { return fast_rcp(1.0f + fast_exp(-x)); }
__device__ __forceinline__ float gelu_tanh(float x) { const float u = 1.5957691216f * (x + 0.044715f * x * x * x); return x * fast_rcp(1.0f + fast_exp(-u)); }
__device__ __forceinline__ float clampf(float x, float lo, float hi) { return fminf(fmaxf(x, lo), hi); }
__device__ __forceinline__ float wave_sum(float v) {
#pragma unroll
    for (int o = 32; o >= 1; o >>= 1) v += __shfl_xor(v, o);
    return v;
}
__device__ __forceinline__ unsigned pack_fp8x4(float a, float b, float c, float d) {
    a = __builtin_amdgcn_fmed3f(a, -448.f, 448.f); b = __builtin_amdgcn_fmed3f(b, -448.f, 448.f); c = __builtin_amdgcn_fmed3f(c, -448.f, 448.f); d = __builtin_amdgcn_fmed3f(d, -448.f, 448.f);
    int p = __builtin_amdgcn_cvt_pk_fp8_f32(a, b, 0, false); p = __builtin_amdgcn_cvt_pk_fp8_f32(c, d, p, true); return (unsigned)p;
}
#define VM_WAIT() asm volatile("s_waitcnt vmcnt(0)" ::: "memory")
#define LDS_WAIT() asm volatile("s_waitcnt lgkmcnt(0)" ::: "memory")

#define XB_TMO      128
#define XB_XCNT(j)  (256  + 64 * (j))
#define XB_XSUB(j)  (1280 + 64 * (j))
#define XB_XGEN(j)  (2304 + 64 * (j))
#define XB_TOP      3328
#define XB_TOPGEN   3392
#define XCD_BAR_WORDS 3456
#define XB_SPIN_CAP (1u << 18)
__device__ __forceinline__ unsigned xb_ld(unsigned* p)              { return __hip_atomic_load(p, __ATOMIC_RELAXED, __HIP_MEMORY_SCOPE_AGENT); }
__device__ __forceinline__ unsigned xb_add(unsigned* p, unsigned v) { return __hip_atomic_fetch_add(p, v, __ATOMIC_RELAXED, __HIP_MEMORY_SCOPE_AGENT); }
__device__ __forceinline__ unsigned xb_xcc_id() { return (unsigned)__builtin_amdgcn_s_getreg((3 << 11) | 20) & 0xFu; }
#define XB_SPIN(cond, bar) do { unsigned _sp = 0; while (cond) { __builtin_amdgcn_s_sleep(1); \
    if ((++_sp & 255u) == 0u) { if (xb_ld(&(bar)[XB_TMO])) break; if (_sp > XB_SPIN_CAP) { atomicAdd(&(bar)[XB_TMO], 1u); break; } } } } while (0)
struct XcdBarrier { unsigned* bar; unsigned x; volatile LAS unsigned* st; };
__device__ __forceinline__ XcdBarrier xcd_barrier_post(unsigned* bar, volatile LAS unsigned* st) {
    XcdBarrier b; b.bar = bar; b.x = xb_xcc_id(); b.st = st;
    if (threadIdx.x == 0) (void)xb_add(&bar[XB_XCNT(b.x)], 1u);
    return b;
}
__device__ __forceinline__ void xcd_barrier_complete(unsigned* bar, unsigned x, unsigned& nloc, unsigned& nx) {
    const unsigned G = gridDim.x * gridDim.y * gridDim.z;
    unsigned sum, cnt, mine, sp = 0u;
    for (;;) {
        sum = 0u; cnt = 0u; mine = 0u;
#pragma unroll
        for (unsigned j = 0; j < 16; ++j) { const unsigned c = xb_ld(&bar[XB_XCNT(j)]); sum += c; cnt += (c > 0u) ? 1u : 0u; mine = (j == x) ? c : mine; }
        if (sum == G) break;
        __builtin_amdgcn_s_sleep(1);
        if ((++sp & 255u) == 0u) { if (xb_ld(&bar[XB_TMO])) break; if (sp > XB_SPIN_CAP) { atomicAdd(&bar[XB_TMO], 1u); break; } }
    }
    nloc = mine > 0u ? mine : 1u; nx = cnt > 0u ? cnt : 1u;
}
__device__ __forceinline__ void xcd_barrier(const XcdBarrier& b) {
    asm volatile("s_waitcnt vmcnt(0)" ::: "memory");
    __syncthreads();
    if (threadIdx.x == 0) {
        unsigned* bar = b.bar;
        __builtin_amdgcn_s_waitcnt(0);
        unsigned nloc = b.st[0], nx = b.st[1];
        if (nloc == 0u) { xcd_barrier_complete(bar, b.x, nloc, nx); b.st[0] = nloc; b.st[1] = nx; }
        const unsigned old = xb_add(&bar[XB_XSUB(b.x)], 1u);
        const unsigned gen = old / nloc;
        if (old + 1u == (gen + 1u) * nloc) {
            __builtin_amdgcn_fence(__ATOMIC_RELEASE, "agent");
            asm volatile("s_waitcnt vmcnt(0)" ::: "memory");
            const unsigned og = xb_add(&bar[XB_TOP], 1u);
            const unsigned tg = og / nx;
            if (og + 1u == (tg + 1u) * nx) xb_add(&bar[XB_TOPGEN], 1u);
            else XB_SPIN(xb_ld(&bar[XB_TOPGEN]) == tg, bar);
            __builtin_amdgcn_fence(__ATOMIC_ACQUIRE, "agent");
            xb_add(&bar[XB_XGEN(b.x)], 1u);
            asm volatile("s_waitcnt vmcnt(0)" ::: "memory");
        } else {
            XB_SPIN(xb_ld(&bar[XB_XGEN(b.x)]) == gen, bar);
            __builtin_amdgcn_fence(__ATOMIC_ACQUIRE, "agent");
            asm volatile("s_waitcnt vmcnt(0)" ::: "memory");
        }
    }
    __syncthreads();
}

struct Args { const float* in[23]; float* out; unsigned char* ws; int ph_lo, ph_hi; };
struct Frame {
    const float *x, *c, *ctx, *c_ctx, *w_mod, *b_mod, *norm1, *w_in, *sgu_ln, *sgu_w, *sgu_b, *lb_fwd, *lb_bwd, *hgrn_norm, *w_out, *norm2,
                *router_w, *router_b, *w1, *b1, *w2, *b2, *final_norm;
    float* out; unsigned char* ws;
    unsigned* ctl; float* mod;
    bf16_t *WinT, *WoutT, *H, *U, *VG, *Q, *GS, *I, *GF, *KF, *GB, *KB, *YCAT, *DOUT;
    unsigned char *W1T, *W2T, *H2, *ACT;
    float *OF, *OB, *X1, *SS, *TW;
    bf16_t* QCUM; unsigned char* SMID;
    int *LIST, *TSLOT;
    LAS unsigned char* lds;
};

namespace pg {
constexpr int BM = 256, BK = 64, HALF = 128, HTB = HALF * BK * 2, NXCD = 8, WGM = 8;
__device__ __forceinline__ int lds_byte(int r, int c) { const int st = (r >> 4) * 2 + (c >> 5), rr = r & 15, cc = c & 31, ob = rr * 64 + cc * 2; return st * 1024 + (ob ^ (((ob >> 9) & 1) << 5)); }
__device__ __forceinline__ void stage_rc(int b, int& R, int& C) { const int st = b / 1024, sb = b % 1024, swz = sb ^ (((sb >> 9) & 1) << 5); R = (st >> 1) * 16 + swz / 64; C = (st & 1) * 32 + (swz % 64) / 2; }
__device__ __forceinline__ int perm32(int rho) { const int n = rho >> 4, i = rho & 15; return 8 * (i >> 2) + 4 * n + (i & 3); }

struct Unit { const char* bptr; int arow, orow, pn, e, cnt, pad; };

__device__ __forceinline__ bool static_order(int nM, int nN, int L, int& pm, int& pn) {
    const int nwg = nM * nN; if (L >= nwg) return false;
    int wgid = L; { const int q = nwg / NXCD, r = nwg % NXCD, xcd = wgid % NXCD, off = wgid / NXCD; wgid = (xcd < r ? xcd * (q + 1) : r * (q + 1) + (xcd - r) * q) + off; }
    const int nig = WGM * nN, gid = wgid / nig, fm = gid * WGM, gsz = (nM - fm) < WGM ? (nM - fm) : WGM;
    pm = fm + ((wgid % nig) % gsz); pn = (wgid % nig) / gsz; return true;
}

typedef int v8i __attribute__((ext_vector_type(8)));
typedef int v4i __attribute__((ext_vector_type(4)));
template <class Epi, class Sched, bool FP8>
__device__ __forceinline__ void gemm_phase(LAS unsigned char* lds, const char* Abase, const int K, const Sched& S, const Epi& E) {
    const int tid = threadIdx.x, wid = __builtin_amdgcn_readfirstlane(tid >> 6), lane = tid & 63, wr = wid >> 2, wc = wid & 3, fr = lane & 15, fq = lane >> 4;
    const int pitch = FP8 ? K : 2 * K;
    const int nt = pitch / 128;
    int sR[2], sC[2]; unsigned voffB[2];
#pragma unroll
    for (int i = 0; i < 2; ++i) { stage_rc(tid * 16 + i * 8192, sR[i], sC[i]); const int Rb = Epi::PERM ? ((sR[i] & ~31) + perm32(sR[i] & 31)) : sR[i]; voffB[i] = (unsigned)(Rb * pitch + 2 * sC[i]); }
    const size_t kstep = (size_t)(BK * 2);
    const size_t hstep = (size_t)HALF * pitch;
    const unsigned ldsw = (unsigned)wid * 1024u;
    const int aoff = lds_byte(wr * 64 + fr, fq * 8), boff = lds_byte(wc * 32 + fr, fq * 8);
#define PG_SA(b, h) (((b) * 2 + (h)) * HTB)
#define PG_SB(b, h) ((4 + (b) * 2 + (h)) * HTB)
#define PG_STAGE(bufoff, gbase, voff) do { _Pragma("unroll") for (int _i = 0; _i < 2; ++_i) \
        __builtin_amdgcn_global_load_lds((const unsigned*)((const char*)(gbase) + (voff)[_i]), (LAS unsigned*)(lds + (bufoff) + ldsw + _i * 8192), 16, 0, 0); } while (0)
#define PG_LDA(dst, b, h) do { _Pragma("unroll") for (int m = 0; m < 4; ++m) { dst[m].lo = *(const LAS v4i*)(lds + PG_SA(b, h) + aoff + m * 2048); dst[m].hi = *(const LAS v4i*)(lds + PG_SA(b, h) + aoff + m * 2048 + 1024); } } while (0)
#define PG_LDB(dst, b, h) do { _Pragma("unroll") for (int n = 0; n < 2; ++n) { dst[n].lo = *(const LAS v4i*)(lds + PG_SB(b, h) + boff + n * 2048); dst[n].hi = *(const LAS v4i*)(lds + PG_SB(b, h) + boff + n * 2048 + 1024); } } while (0)
#define PG_MMA(ai, bj, At, Bt) do { __builtin_amdgcn_s_setprio(1); _Pragma("unroll") for (int m = 0; m < 4; ++m) _Pragma("unroll") for (int n = 0; n < 2; ++n) { \
        if constexpr (FP8) acc[ai][bj][m][n] = __builtin_amdgcn_mfma_scale_f32_16x16x128_f8f6f4(Bt[n], At[m], acc[ai][bj][m][n], 0, 0, 0, 0x7a7a7a7a, 0, 0x7f7f7f7f); \
        else { const v4i _bl = Bt[n].lo, _bh = Bt[n].hi, _al = At[m].lo, _ah = At[m].hi;     \
               acc[ai][bj][m][n] = __builtin_amdgcn_mfma_f32_16x16x32_bf16(__builtin_bit_cast(bf16x8, _bl), __builtin_bit_cast(bf16x8, _al), acc[ai][bj][m][n], 0, 0, 0); \
               acc[ai][bj][m][n] = __builtin_amdgcn_mfma_f32_16x16x32_bf16(__builtin_bit_cast(bf16x8, _bh), __builtin_bit_cast(bf16x8, _ah), acc[ai][bj][m][n], 0, 0, 0); } } \
        __builtin_amdgcn_s_setprio(0); } while (0)
#define PG_WAIT_V(n) asm volatile("s_waitcnt vmcnt(" #n ")" ::: "memory")
#define PG_WAIT_L(n) asm volatile("s_waitcnt lgkmcnt(" #n ")" ::: "memory")
#define PG_BAR __builtin_amdgcn_s_barrier()
#define PG_SCHED __builtin_amdgcn_sched_barrier(0)
    Unit cur, nxt, nn; int ui = 0;
    if (!S.next(0, cur)) return;
    bool has_next = S.next(1, nxt);
    unsigned vA[2][2], vN[2][2];
    S.aoff(cur, sR, sC, vA);
    if (has_next) S.aoff(nxt, sR, sC, vN); else { vN[0][0] = vA[0][0]; vN[0][1] = vA[0][1]; vN[1][0] = vA[1][0]; vN[1][1] = vA[1][1]; }
    f32x4 acc[2][2][4][2];
#pragma unroll
    for (int a = 0; a < 2; ++a)
#pragma unroll
        for (int b = 0; b < 2; ++b)
#pragma unroll
            for (int m = 0; m < 4; ++m)
#pragma unroll
                for (int n = 0; n < 2; ++n) acc[a][b][m][n] = (f32x4){0.f, 0.f, 0.f, 0.f};
    v8i At[4], B0[2], B1[2];
    const char* cB = cur.bptr;
    PG_STAGE(PG_SB(0, 0), cB, voffB); PG_STAGE(PG_SA(0, 0), Abase, vA[0]); PG_STAGE(PG_SB(0, 1), cB + hstep, voffB); PG_STAGE(PG_SA(0, 1), Abase, vA[1]);
    if (wr == 1) PG_BAR;
    PG_WAIT_V(4); PG_BAR;
    PG_STAGE(PG_SB(1, 0), cB + kstep, voffB); PG_STAGE(PG_SA(1, 0), Abase + kstep, vA[0]); PG_STAGE(PG_SB(1, 1), cB + hstep + kstep, voffB);
    PG_WAIT_V(6); PG_BAR;
    for (;;) {
        const char* nB = has_next ? nxt.bptr : cB;
#pragma unroll 1
        for (int t = 0; t < nt; t += 2) {
            const bool last = (t == nt - 2);
            const char* a1 = Abase + (size_t)(t + 1) * kstep;
            const char* a2 = last ? Abase : Abase + (size_t)(t + 2) * kstep; const char* b2 = last ? nB : cB + (size_t)(t + 2) * kstep;
            const char* a3 = a2 + kstep; const char* b3 = b2 + kstep;
            PG_LDB(B0, 0, 0); PG_SCHED; PG_LDA(At, 0, 0); PG_STAGE(PG_SA(1, 1), a1, vA[1]);
            if (last) { vA[0][0] = vN[0][0]; vA[0][1] = vN[0][1]; vA[1][0] = vN[1][0]; vA[1][1] = vN[1][1]; }
            PG_WAIT_L(8); PG_BAR; PG_WAIT_L(0); PG_MMA(0, 0, At, B0); PG_BAR; PG_SCHED;
            PG_LDB(B1, 0, 1); PG_STAGE(PG_SB(0, 0), b2, voffB);
            PG_BAR; PG_WAIT_L(0); PG_MMA(0, 1, At, B1); PG_BAR;
            PG_LDA(At, 0, 1); PG_STAGE(PG_SA(0, 0), a2, vA[0]);
            PG_BAR; PG_WAIT_L(0); PG_MMA(1, 0, At, B0); PG_BAR; PG_SCHED;
            PG_STAGE(PG_SB(0, 1), b2 + hstep, voffB);
            PG_WAIT_V(6); PG_BAR; PG_MMA(1, 1, At, B1); PG_BAR;
            PG_LDB(B0, 1, 0); PG_SCHED; PG_LDA(At, 1, 0); PG_STAGE(PG_SA(0, 1), a2, vA[1]);
            PG_WAIT_L(8); PG_BAR; PG_WAIT_L(0); PG_MMA(0, 0, At, B0); PG_BAR; PG_SCHED;
            PG_LDB(B1, 1, 1); PG_STAGE(PG_SB(1, 0), b3, voffB);
            PG_BAR; PG_WAIT_L(0); PG_MMA(0, 1, At, B1); PG_BAR;
            PG_LDA(At, 1, 1); PG_STAGE(PG_SA(1, 0), a3, vA[0]);
            PG_BAR; PG_WAIT_L(0); PG_MMA(1, 0, At, B0); PG_BAR; PG_SCHED;
            PG_STAGE(PG_SB(1, 1), b3 + hstep, voffB);
            PG_WAIT_V(6); PG_BAR; PG_MMA(1, 1, At, B1); PG_BAR;
        }
        E(acc, cur, wr, wc, fr, fq);
        if (!has_next) break;
#pragma unroll
        for (int a = 0; a < 2; ++a)
#pragma unroll
            for (int b = 0; b < 2; ++b)
#pragma unroll
                for (int m = 0; m < 4; ++m)
#pragma unroll
                    for (int n = 0; n < 2; ++n) acc[a][b][m][n] = (f32x4){0.f, 0.f, 0.f, 0.f};
        cur = nxt; cB = nB; ++ui;
        has_next = S.next(ui + 1, nn);
        if (has_next) { nxt = nn; S.aoff(nxt, sR, sC, vN); }
    }
    PG_WAIT_V(0);
    if (wr == 0) PG_BAR;
    PG_BAR;
#undef PG_SA
#undef PG_SB
#undef PG_STAGE
#undef PG_LDA
#undef PG_LDB
#undef PG_MMA
#undef PG_WAIT_V
#undef PG_WAIT_L
#undef PG_BAR
#undef PG_SCHED
}
}

typedef f32x4 Acc[2][2][4][2];

struct SchedInProj {
    const unsigned char* WinT; int G, c;
    static constexpr int ESZ = INPROJ_FP8 ? 1 : 2;
    __device__ __forceinline__ bool next(int i, pg::Unit& u) const {
        const int L = i * G + c; int pm, pn;
        if (L < 64 * 14) { pg::static_order(64, 14, L, pm, pn); }
        else { const int x = L - 64 * 14; if (x >= 48) return false; pm = 64 + (x & 7); pn = 6 + (x >> 3); }
        u.bptr = (const char*)(WinT + (size_t)pn * 256 * D * ESZ); u.arow = pm * 256; u.orow = pm * 256; u.pn = pn; u.e = 0; u.cnt = 0; u.pad = 0; return true;
    }
    __device__ __forceinline__ void aoff(const pg::Unit& u, const int (&R)[2], const int (&C)[2], unsigned (&v)[2][2]) const {
#pragma unroll
        for (int h = 0; h < 2; ++h)
#pragma unroll
            for (int i = 0; i < 2; ++i) v[h][i] = (unsigned)((u.arow + h * 128 + R[i]) * D * ESZ + 2 * C[i]);
    }
};
struct EpiInProj {
    static constexpr bool PERM = true;
    bf16_t *U, *VG, *Q, *GS, *I, *GF, *KF, *GB, *KB; const float *lb_fwd, *lb_bwd;
    __device__ __forceinline__ void operator()(const Acc& acc, const pg::Unit& u, int wr, int wc, int fr, int fq) const {
        const int cg = u.pn >> 1;
        const int cbase = (u.pn & 1) * 256 + wc * 32 + 8 * fq;
        const int row0 = u.orow + wr * 64 + fr;
        if (cg == 3 || cg == 4) {
            const float* tab = (cg == 3) ? lb_fwd : lb_bwd; bf16_t* Gd = (cg == 3) ? GF : GB; bf16_t* Kd = (cg == 3) ? KF : KB;
#pragma unroll
            for (int bj = 0; bj < 2; ++bj) {
                const int col = cbase + bj * 128;
                float lb[8], omlb[8];
#pragma unroll
                for (int j = 0; j < 8; ++j) { const float t0 = tab[col + j], t1 = tab[GW + col + j]; lb[j] = fast_rcp(1.0f + __expf(t1 - t0)); omlb[j] = 1.0f - lb[j]; }
#pragma unroll
                for (int ai = 0; ai < 2; ++ai)
#pragma unroll
                    for (int m = 0; m < 4; ++m) {
                        const size_t off = (size_t)(row0 + ai * 128 + m * 16) * GW + col;
                        float gv[8], kv[8];
#pragma unroll
                        for (int n = 0; n < 2; ++n)
#pragma unroll
                            for (int j = 0; j < 4; ++j) {
                                const float z = clampf(acc[ai][bj][m][n][j], -30.f, 30.f);
                                const float e = __expf(-z), s = fast_rcp(1.0f + e), oms = e * s;
                                const float f = lb[4 * n + j] + omlb[4 * n + j] * s;
                                gv[4 * n + j] = __logf(f); kv[4 * n + j] = omlb[4 * n + j] * oms;
                            }
                        u32x4 wg, wk;
                        wg.x = cvt_pk_bf16(gv[0], gv[1]); wg.y = cvt_pk_bf16(gv[2], gv[3]); wg.z = cvt_pk_bf16(gv[4], gv[5]); wg.w = cvt_pk_bf16(gv[6], gv[7]);
                        wk.x = cvt_pk_bf16(kv[0], kv[1]); wk.y = cvt_pk_bf16(kv[2], kv[3]); wk.z = cvt_pk_bf16(kv[4], kv[5]); wk.w = cvt_pk_bf16(kv[6], kv[7]);
                        *(u32x4*)(Gd + off) = wg; *(u32x4*)(Kd + off) = wk;
                    }
            }
        } else {
            bf16_t* Od = (cg == 0) ? U : (cg == 1) ? VG : (cg == 2) ? Q : (cg == 5) ? I : GS;
            const int act = (cg <= 1) ? 1 : (cg == 6) ? 2 : 0;
#pragma unroll
            for (int ai = 0; ai < 2; ++ai)
#pragma unroll
                for (int m = 0; m < 4; ++m)
#pragma unroll
                    for (int bj = 0; bj < 2; ++bj) {
                        const size_t off = (size_t)(row0 + ai * 128 + m * 16) * GW + cbase + bj * 128;
                        float v[8];
#pragma unroll
                        for (int n = 0; n < 2; ++n)
#pragma unroll
                            for (int j = 0; j < 4; ++j) { float z = acc[ai][bj][m][n][j]; if (act == 1) z = gelu_tanh(z); else if (act == 2) z = z * sigmoidf_(z); v[4 * n + j] = z; }
                        u32x4 w; w.x = cvt_pk_bf16(v[0], v[1]); w.y = cvt_pk_bf16(v[2], v[3]); w.z = cvt_pk_bf16(v[4], v[5]); w.w = cvt_pk_bf16(v[6], v[7]);
                        *(u32x4*)(Od + off) = w;
                    }
        }
    }
};

struct SchedOutProj {
    const bf16_t* WoutT; int G, c;
    __device__ __forceinline__ bool next(int i, pg::Unit& u) const {
        const int L = i * G + c; int pm, pn; if (!pg::static_order(64, 4, L, pm, pn)) return false;
        u.bptr = (const char*)(WoutT + (size_t)pn * 256 * D); u.arow = pm * 256; u.orow = pm * 256; u.pn = pn; u.e = 0; u.cnt = 0; u.pad = 0; return true;
    }
    __device__ __forceinline__ void aoff(const pg::Unit& u, const int (&R)[2], const int (&C)[2], unsigned (&v)[2][2]) const {
#pragma unroll
        for (int h = 0; h < 2; ++h)
#pragma unroll
            for (int i = 0; i < 2; ++i) v[h][i] = (unsigned)((u.arow + h * 128 + R[i]) * D + C[i]) * 2u;
    }
};
struct EpiOutProj {
    static constexpr bool PERM = false;
    const float* x; const float* mod; float* X1; float* SS;
    __device__ __forceinline__ void operator()(const Acc& acc, const pg::Unit& u, int wr, int wc, int fr, int fq) const {
        const int row0 = u.orow + wr * 64 + fr, col0 = u.pn * 256 + wc * 32 + 4 * fq;
        const float* g1 = mod + (size_t)(u.orow >> 11) * 6144 + 2048;
        f32x4 gv[2][2];
#pragma unroll
        for (int bj = 0; bj < 2; ++bj)
#pragma unroll
            for (int n = 0; n < 2; ++n) gv[bj][n] = *(const f32x4*)(g1 + col0 + bj * 128 + n * 16);
#pragma unroll
        for (int ai = 0; ai < 2; ++ai)
#pragma unroll
            for (int m = 0; m < 4; ++m) {
                const int row = row0 + ai * 128 + m * 16; const size_t off = (size_t)row * D + col0; float s = 0.f;
#pragma unroll
                for (int bj = 0; bj < 2; ++bj)
#pragma unroll
                    for (int n = 0; n < 2; ++n) {
                        const f32x4 xv = *(const f32x4*)(x + off + bj * 128 + n * 16);
                        const f32x4 o = xv + gv[bj][n] * acc[ai][bj][m][n] * (float)DBG_MIX;
                        *(f32x4*)(X1 + off + bj * 128 + n * 16) = o;
                        s += (o[0] * o[0] + o[1] * o[1]) + (o[2] * o[2] + o[3] * o[3]);
                    }
                s += __shfl_xor(s, 16); s += __shfl_xor(s, 32);
                if (fq == 0) SS[(size_t)row * 16 + u.pn * 4 + wc] = s;
            }
    }
};

struct MoeTab { LAS int* cnt; LAS int* tstart; LAS int* ent; };
__device__ __forceinline__ MoeTab moe_tab(LAS unsigned char* lds) { MoeTab t; t.cnt = (LAS int*)(lds + LDS_EXTRA_OFF); t.tstart = t.cnt + 32; t.ent = t.tstart + 64; return t; }
__device__ __forceinline__ void moe_tables(const Frame& F) {
    const MoeTab T = moe_tab(F.lds);
    if (threadIdx.x < 64) {
        const int lane = threadIdx.x;
        const int c = (lane < NE) ? (int)__hip_atomic_load(F.ctl + CW_CNT + 64 * lane, __ATOMIC_RELAXED, __HIP_MEMORY_SCOPE_AGENT) : 0;
        const int t = (c + 255) >> 8;
        int incl = t;
#pragma unroll
        for (int o = 1; o < 64; o <<= 1) { const int v = __shfl_up(incl, o); if (lane >= o) incl += v; }
        const int start = incl - t;
        if (lane < NE) { T.cnt[lane] = c; T.tstart[lane] = start; for (int k = 0; k < t; ++k) T.ent[start + k] = lane; }
        if (lane == NE) T.tstart[NE] = start;
    }
    __syncthreads();
}
struct SchedGateUp {
    const unsigned char* W1T; const int* LIST; MoeTab T; int G, c;
    __device__ __forceinline__ bool next(int i, pg::Unit& u) const {
        int idx, pn; const int total = __builtin_amdgcn_readfirstlane(T.tstart[32]);
        if ((G & 7) == 0) { pn = c & 7; idx = (c >> 3) + (G >> 3) * i; if (idx >= total) return false; }
        else { const int L = i * G + c; if (L >= total * 8) return false; idx = L >> 3; pn = L & 7; }
        const int e = __builtin_amdgcn_readfirstlane(T.ent[idx]); const int ts = __builtin_amdgcn_readfirstlane(T.tstart[e]); const int mt = idx - ts;
        u.bptr = (const char*)(W1T + ((size_t)e * 2048 + (size_t)pn * 256) * D);     u.arow = mt * 256; u.orow = ts * 256 + mt * 256; u.pn = pn; u.e = e;
        u.cnt = __builtin_amdgcn_readfirstlane(T.cnt[e]); u.pad = 0; return true;
    }
    __device__ __forceinline__ void aoff(const pg::Unit& u, const int (&R)[2], const int (&C)[2], unsigned (&v)[2][2]) const {
#pragma unroll
        for (int h = 0; h < 2; ++h)
#pragma unroll
            for (int i = 0; i < 2; ++i) {
                int s = u.arow + h * 128 + R[i]; s = s < u.cnt ? s : u.cnt - 1;
                const int tok = LIST[u.e * NTOK + s];
                v[h][i] = (unsigned)(tok * D + 2 * C[i]);
            }
    }
};
struct EpiGateUp {
    static constexpr bool PERM = true;
    const float* b1; unsigned char* ACT;
    __device__ __forceinline__ void operator()(const Acc& acc, const pg::Unit& u, int wr, int wc, int fr, int fq) const {
        const int col = u.pn * 128 + wc * 32 + 8 * fq;
        const float* bg = b1 + (size_t)u.e * 2048 + col; const float* bu = bg + 1024;
        float vg[8], vu[8];
#pragma unroll
        for (int j = 0; j < 8; ++j) { vg[j] = bg[j]; vu[j] = bu[j]; }
        const int row0 = u.orow + wr * 64 + fr;
#pragma unroll
        for (int ai = 0; ai < 2; ++ai)
#pragma unroll
            for (int m = 0; m < 4; ++m) {
                float a[8];
#pragma unroll
                for (int n = 0; n < 2; ++n)
#pragma unroll
                    for (int j = 0; j < 4; ++j) {
                        float g = acc[ai][0][m][n][j] + vg[4 * n + j], up = acc[ai][1][m][n][j] + vu[4 * n + j];
                        g = fminf(g, 7.0f); up = clampf(up, -7.0f, 7.0f);
                        a[4 * n + j] = g * fast_rcp(1.0f + __expf(-1.702f * g)) * (up + 1.0f);
                    }
                u32x2 w; w.x = pack_fp8x4(a[0], a[1], a[2], a[3]); w.y = pack_fp8x4(a[4], a[5], a[6], a[7]);
                *(u32x2*)(ACT + (size_t)(row0 + ai * 128 + m * 16) * DE + col) = w;
            }
    }
};
struct SchedDown {
    const unsigned char* W2T; MoeTab T; int G, c;
    __device__ __forceinline__ bool next(int i, pg::Unit& u) const {
        int idx, pn; const int total = __builtin_amdgcn_readfirstlane(T.tstart[32]);
        if ((G & 7) == 0) { const int x = c & 7; pn = x & 3; idx = 2 * ((c >> 3) + (G >> 3) * i) + (x >> 2); if (idx >= total) return false; }
        else { const int L = i * G + c; if (L >= total * 4) return false; idx = L >> 2; pn = L & 3; }
        const int e = __builtin_amdgcn_readfirstlane(T.ent[idx]); const int ts = __builtin_amdgcn_readfirstlane(T.tstart[e]); const int mt = idx - ts;
        u.bptr = (const char*)(W2T + ((size_t)e * 1024 + (size_t)pn * 256) * DE); u.arow = ts * 256 + mt * 256; u.orow = u.arow; u.pn = pn; u.e = e; u.cnt = 0; u.pad = 0; return true;
    }
    __device__ __forceinline__ void aoff(const pg::Unit& u, const int (&R)[2], const int (&C)[2], unsigned (&v)[2][2]) const {
#pragma unroll
        for (int h = 0; h < 2; ++h)
#pragma unroll
            for (int i = 0; i < 2; ++i) v[h][i] = (unsigned)((u.arow + h * 128 + R[i]) * DE + 2 * C[i]);
    }
};
struct EpiDown {
    static constexpr bool PERM = true;
    const float* b2; bf16_t* DOUT;
    __device__ __forceinline__ void operator()(const Acc& acc, const pg::Unit& u, int wr, int wc, int fr, int fq) const {
        const int col0 = u.pn * 256 + wc * 32 + 8 * fq; const int row0 = u.orow + wr * 64 + fr;
        float bv[2][8];
#pragma unroll
        for (int bj = 0; bj < 2; ++bj)
#pragma unroll
            for (int j = 0; j < 8; ++j) bv[bj][j] = b2[(size_t)u.e * D + col0 + bj * 128 + j];
#pragma unroll
        for (int ai = 0; ai < 2; ++ai)
#pragma unroll
            for (int m = 0; m < 4; ++m)
#pragma unroll
                for (int bj = 0; bj < 2; ++bj) {
                    const f32x4 v0 = acc[ai][bj][m][0], v1 = acc[ai][bj][m][1];
                    u32x4 w; w.x = cvt_pk_bf16(v0[0] + bv[bj][0], v0[1] + bv[bj][1]); w.y = cvt_pk_bf16(v0[2] + bv[bj][2], v0[3] + bv[bj][3]);
                    w.z = cvt_pk_bf16(v1[0] + bv[bj][4], v1[1] + bv[bj][5]); w.w = cvt_pk_bf16(v1[2] + bv[bj][6], v1[3] + bv[bj][7]);
                    *(u32x4*)(DOUT + (size_t)(row0 + ai * 128 + m * 16) * D + col0 + bj * 128) = w;
                }
    }
};

__device__ __forceinline__ void conv_tile(const float* src, int ld, int k0, int n0, bf16_t* dst, int drow0, LAS unsigned char* lds) {
    const int tid = threadIdx.x, p = tid >> 4, q = tid & 15;
    f32x4 v[4];
#pragma unroll
    for (int r = 0; r < 4; ++r) v[r] = *(const f32x4*)(src + (size_t)(k0 + 4 * p + r) * ld + n0 + 4 * q);
#pragma unroll
    for (int i = 0; i < 4; ++i) {
        u32x2 w; w.x = cvt_pk_bf16(v[0][i], v[1][i]); w.y = cvt_pk_bf16(v[2][i], v[3][i]);
        *(LAS u32x2*)(lds + (4 * q + i) * 256 + ((p ^ q) * 8)) = w;
    }
    __syncthreads();
#pragma unroll
    for (int jj = 0; jj < 2; ++jj) {
        const int n = (tid >> 4) + 32 * jj, c = tid & 15, qn = (n >> 2) & 15;
        u32x4 w = *(const LAS u32x4*)(lds + n * 256 + ((c ^ (qn >> 1)) * 16));
        if (qn & 1) { const unsigned t0 = w.x, t1 = w.y; w.x = w.z; w.y = w.w; w.z = t0; w.w = t1; }
        *(u32x4*)(dst + (size_t)(drow0 + n) * 1024 + k0 + 8 * c) = w;
    }
    __syncthreads();
}
constexpr int CONV_ITEMS = 32 * 128 + 32 * 64;
struct ConvDesc { const float* src; unsigned char* dst; int ld, k0, n0, drow0; };
__device__ __forceinline__ ConvDesc conv8_desc(const Frame& F, int it) {
    ConvDesc d;
    if (it < 4096) { const int e = it >> 7, r = it & 127, nt = r & 15, kt = r >> 4, n0 = nt * 128;
        d.src = F.w1 + (size_t)e * D * 2048; d.ld = 2048; d.k0 = kt * 128; d.n0 = n0; d.dst = F.W1T + (size_t)e * 2048 * D;
        d.drow0 = (n0 < 1024) ? ((n0 >> 7) * 256) : (((n0 - 1024) >> 7) * 256 + 128); }
    else { const int i2 = it - 4096, e = i2 >> 6, r = i2 & 63, nt = r & 7, kt = r >> 3;
        d.src = F.w2 + (size_t)e * DE * D; d.ld = 1024; d.k0 = kt * 128; d.n0 = nt * 128; d.dst = F.W2T + (size_t)e * D * DE; d.drow0 = nt * 128; }
    return d;
}
__device__ __forceinline__ void conv8_load(const ConvDesc& d, f32x4 (&v)[8]) {
    const int p = threadIdx.x >> 5, q = threadIdx.x & 31;
#pragma unroll
    for (int g = 0; g < 2; ++g)
#pragma unroll
        for (int r = 0; r < 4; ++r) v[4 * g + r] = *(const f32x4*)(d.src + (size_t)(d.k0 + 64 * g + 4 * p + r) * d.ld + d.n0 + 4 * q);
}
__device__ __forceinline__ void conv8_lds_write(const f32x4 (&v)[8], LAS unsigned char* buf) {
    const int p = threadIdx.x >> 5, q = threadIdx.x & 31;
#pragma unroll
    for (int g = 0; g < 2; ++g)
#pragma unroll
        for (int i = 0; i < 4; ++i)
            *(LAS unsigned*)(buf + (4 * q + i) * 128 + (((16 * g + p) ^ q) * 4)) = pack_fp8x4(32.f * v[4 * g][i], 32.f * v[4 * g + 1][i], 32.f * v[4 * g + 2][i], 32.f * v[4 * g + 3][i]);
}
__device__ __forceinline__ void conv8_store(const ConvDesc& d, const LAS unsigned char* buf) {
#pragma unroll
    for (int jj = 0; jj < 2; ++jj) {
        const int n = (threadIdx.x >> 3) + 64 * jj, c = threadIdx.x & 7, qn = (n >> 2) & 31;
        u32x4 w = *(const LAS u32x4*)(buf + n * 128 + ((c ^ (qn >> 2)) * 16));
        if (qn & 1) { unsigned t = w.x; w.x = w.y; w.y = t; t = w.z; w.z = w.w; w.w = t; }
        if (qn & 2) { unsigned t = w.x; w.x = w.z; w.z = t; t = w.y; w.y = w.w; w.w = t; }
        *(u32x4*)(d.dst + (size_t)(d.drow0 + n) * 1024 + d.k0 + 16 * c) = w;
    }
}
__device__ __forceinline__ void conv8_run(const Frame& F, int first, int stride, int n) {
    if (n <= 0) return;
    f32x4 vA[8], vB[8];
    const int last = first + (n - 1) * stride;
#define CV_IT(i) ((first + (i) * stride) < last ? (first + (i) * stride) : last)
    ConvDesc dA = conv8_desc(F, CV_IT(0)), dB = conv8_desc(F, CV_IT(1));
    conv8_load(dA, vA); conv8_load(dB, vB);
    for (int i = 0; i < n; i += 2) {
        conv8_lds_write(vA, F.lds);
        const ConvDesc dA2 = conv8_desc(F, CV_IT(i + 2)); conv8_load(dA2, vA);
        asm volatile("s_waitcnt lgkmcnt(0)" ::: "memory"); __builtin_amdgcn_s_barrier(); asm volatile("" ::: "memory");
        conv8_store(dA, F.lds);
        dA = dA2;
        conv8_lds_write(vB, F.lds + 16384);
        const ConvDesc dB2 = conv8_desc(F, CV_IT(i + 3)); conv8_load(dB2, vB);
        asm volatile("s_waitcnt lgkmcnt(0)" ::: "memory"); __builtin_amdgcn_s_barrier(); asm volatile("" ::: "memory");
        conv8_store(dB, F.lds + 16384);
        dB = dB2;
    }
#undef CV_IT
    __syncthreads();
}

__device__ __forceinline__ void mod_item(const Frame& F, int item) {
    LAS float* S = (LAS float*)F.lds;
    LAS float* RED = (LAS float*)(F.lds + 40960);
    const int tid = threadIdx.x, lane = tid & 63, wv = tid >> 6, c0 = item * 64;
    for (int idx = tid; idx < 9 * 1024; idx += NTHREADS) { const int r = idx >> 10, k = idx & 1023; const float v = (r < 8) ? F.c[r * 1024 + k] : F.c_ctx[k]; S[idx] = v * sigmoidf_(v); }
    __syncthreads();
    const int cq = tid & 15, kg = tid >> 4;
    f32x4 acc[9];
#pragma unroll
    for (int r = 0; r < 9; ++r) acc[r] = (f32x4){0.f, 0.f, 0.f, 0.f};
    for (int k = kg; k < 1024; k += 32) {
        const f32x4 wv4 = *(const f32x4*)(F.w_mod + (size_t)k * 6144 + c0 + 4 * cq);
#pragma unroll
        for (int r = 0; r < 9; ++r) acc[r] += S[r * 1024 + k] * wv4;
    }
#pragma unroll
    for (int r = 0; r < 9; ++r)
#pragma unroll
        for (int j = 0; j < 4; ++j) { float v = acc[r][j]; v += __shfl_xor(v, 16); v += __shfl_xor(v, 32); if (lane < 16) RED[(wv * 9 + r) * 64 + 4 * cq + j] = v; }
    __syncthreads();
    for (int idx = tid; idx < 9 * 64; idx += NTHREADS) {
        const int r = idx >> 6, cc = idx & 63; float s = F.b_mod[c0 + cc];
#pragma unroll
        for (int w8 = 0; w8 < 8; ++w8) s += RED[(w8 * 9 + r) * 64 + cc];
        F.mod[r * 6144 + c0 + cc] = s;
    }
    __syncthreads();
}
__device__ __forceinline__ void phase0(const Frame& F) {
    for (int item = blockIdx.x; item < 96 + 448 + 128; item += gridDim.x) {
        if (item < 96) mod_item(F, item);
        else if (item < 96 + 448) { const int it = item - 96, nt = it % 56, kt = it / 56;
            if (INPROJ_FP8) { if (nt & 1) continue;
                ConvDesc d; d.src = F.w_in; d.ld = DIN; d.k0 = kt * 128; d.n0 = nt * 64; d.dst = (unsigned char*)F.WinT; d.drow0 = nt * 64;
                f32x4 v[8]; conv8_load(d, v); conv8_lds_write(v, F.lds); __syncthreads(); conv8_store(d, F.lds); __syncthreads(); }
            else conv_tile(F.w_in, DIN, kt * 128, nt * 64, F.WinT, nt * 64, F.lds); }
        else { const int it = item - 544, nt = it & 15, kt = it >> 4; conv_tile(F.w_out, D, kt * 128, nt * 64, F.WoutT, nt * 64, F.lds); }
    }
}

__device__ __forceinline__ void phase1(const Frame& F) {
    const int lane = threadIdx.x & 63, wv = threadIdx.x >> 6;
    for (int r = blockIdx.x * 8 + wv; r < NROW; r += gridDim.x * 8) {
        const float* src; const float* md;
        if (r < NTOK) { src = F.x + (size_t)r * D; md = F.mod + (size_t)(r >> 11) * 6144; } else { src = F.ctx + (size_t)(r - NTOK) * D; md = F.mod + (size_t)8 * 6144; }
        f32x4 v[4]; float ss = 0.f;
#pragma unroll
        for (int j = 0; j < 4; ++j) { v[j] = *(const f32x4*)(src + 4 * lane + 256 * j); ss += (v[j][0] * v[j][0] + v[j][1] * v[j][1]) + (v[j][2] * v[j][2] + v[j][3] * v[j][3]); }
        ss = wave_sum(ss);
        const float rstd = __builtin_amdgcn_rsqf(ss * (1.0f / 1024.0f) + EPS);
#pragma unroll
        for (int j = 0; j < 4; ++j) {
            const int c = 4 * lane + 256 * j;
            const f32x4 nw = *(const f32x4*)(F.norm1 + c), sh = *(const f32x4*)(md + c), sc = *(const f32x4*)(md + 1024 + c);
            const f32x4 o = v[j] * rstd * nw * (1.0f + sc) + sh;
            if (INPROJ_FP8) *(unsigned*)((unsigned char*)F.H + (size_t)r * D + c) = pack_fp8x4(o[0], o[1], o[2], o[3]);
            else { u32x2 w; w.x = cvt_pk_bf16(o[0], o[1]); w.y = cvt_pk_bf16(o[2], o[3]); *(u32x2*)(F.H + (size_t)r * D + c) = w; }
        }
    }
}

__device__ __forceinline__ void phase4(const Frame& F) {
    const int lane = threadIdx.x & 63, wv = threadIdx.x >> 6;
    for (int t = blockIdx.x * 8 + wv; t < NTOK; t += gridDim.x * 8) {
        const size_t o = (size_t)t * GW + 8 * lane;
        const f32x4 a0 = *(const f32x4*)(F.OF + o), a1 = *(const f32x4*)(F.OF + o + 4), b0 = *(const f32x4*)(F.OB + o), b1 = *(const f32x4*)(F.OB + o + 4);
        const f32x4 s0 = a0 + b0, s1 = a1 + b1;
        float ss = (s0[0] * s0[0] + s0[1] * s0[1]) + (s0[2] * s0[2] + s0[3] * s0[3]) + (s1[0] * s1[0] + s1[1] * s1[1]) + (s1[2] * s1[2] + s1[3] * s1[3]);
        ss += __shfl_xor(ss, 1); ss += __shfl_xor(ss, 2); ss += __shfl_xor(ss, 4); ss += __shfl_xor(ss, 8);
        const float rstd = __builtin_amdgcn_rsqf(ss * (1.0f / 128.0f) + EPS);
        const f32x4 n0 = *(const f32x4*)(F.hgrn_norm + 8 * lane), n1 = *(const f32x4*)(F.hgrn_norm + 8 * lane + 4);
        const u32x4 g = *(const u32x4*)(F.GS + o);
        u32x4 w;
        w.x = cvt_pk_bf16(s0[0] * rstd * n0[0] * bflo(g.x), s0[1] * rstd * n0[1] * bfhi(g.x));
        w.y = cvt_pk_bf16(s0[2] * rstd * n0[2] * bflo(g.y), s0[3] * rstd * n0[3] * bfhi(g.y));
        w.z = cvt_pk_bf16(s1[0] * rstd * n1[0] * bflo(g.z), s1[1] * rstd * n1[1] * bfhi(g.z));
        w.w = cvt_pk_bf16(s1[2] * rstd * n1[2] * bflo(g.w), s1[3] * rstd * n1[3] * bfhi(g.w));
        *(u32x4*)(F.YCAT + (size_t)t * D + GW + 8 * lane) = w;
    }
}

constexpr int RT_STRIDE = 1028;
__device__ __forceinline__ void phase6(const Frame& F) {
    LAS float* RT = (LAS float*)F.lds;
    LAS int* lcnt = (LAS int*)(F.lds + 132096);
    LAS int* lbase = lcnt + 32;
    LAS int* sel = lbase + 32;
    LAS float* selw = (LAS float*)(sel + 256);
    const int tid = threadIdx.x, lane = tid & 63, wv = tid >> 6;
    for (int idx = tid; idx < D * NE; idx += NTHREADS) { const int c = idx >> 5, e = idx & 31; RT[e * RT_STRIDE + c] = F.router_w[idx]; }
    if (tid < 32) lcnt[tid] = 0;
    __syncthreads();
    for (int rep6 = 0; rep6 < (DBG_REP6 ? 2 : 1); ++rep6)
    for (int grp = blockIdx.x; grp < NTOK / 64; grp += gridDim.x) {
        for (int i = 0; i < 4; ++i) {
            const int tl0 = wv * 8 + 2 * i, t0 = grp * 64 + tl0;
            const float* md = F.mod + (size_t)(t0 >> 11) * 6144;
            f32x4 hv[2][4];
#pragma unroll
            for (int u = 0; u < 2; ++u) {
                const int t = t0 + u;
                float ss = (lane < 16) ? F.SS[(size_t)t * 16 + lane] : 0.f;
                ss = wave_sum(ss);
                const float rstd = __builtin_amdgcn_rsqf(ss * (1.0f / 1024.0f) + EPS);
#pragma unroll
                for (int j = 0; j < 4; ++j) {
                    const int c = 4 * lane + 256 * j;
                    const f32x4 xv = *(const f32x4*)(F.X1 + (size_t)t * D + c), nw = *(const f32x4*)(F.norm2 + c), sh = *(const f32x4*)(md + 3072 + c), sc = *(const f32x4*)(md + 4096 + c);
                    hv[u][j] = xv * rstd * nw * (1.0f + sc) + sh;
                    *(unsigned*)(F.H2 + (size_t)t * D + c) = pack_fp8x4(hv[u][j][0], hv[u][j][1], hv[u][j][2], hv[u][j][3]);
                }
            }
            float p[2][16];
            const bool hi32 = (lane & 32) != 0;
#pragma unroll
            for (int q = 0; q < 16; ++q) {
                float a[2][2] = {{0.f, 0.f}, {0.f, 0.f}};
#pragma unroll
                for (int hh = 0; hh < 2; ++hh)
#pragma unroll
                    for (int j = 0; j < 4; ++j) {
                        const f32x4 rw = *(const LAS f32x4*)(RT + (q + 16 * hh) * RT_STRIDE + 4 * lane + 256 * j);
                        a[0][hh] += (hv[0][j][0] * rw[0] + hv[0][j][1] * rw[1]) + (hv[0][j][2] * rw[2] + hv[0][j][3] * rw[3]);
                        a[1][hh] += (hv[1][j][0] * rw[0] + hv[1][j][1] * rw[1]) + (hv[1][j][2] * rw[2] + hv[1][j][3] * rw[3]);
                    }
#pragma unroll
                for (int u = 0; u < 2; ++u) { const float keep = hi32 ? a[u][1] : a[u][0], send = hi32 ? a[u][0] : a[u][1]; p[u][q] = keep + __shfl_xor(send, 32); }
                __builtin_amdgcn_sched_barrier(0);
            }
#pragma unroll
            for (int u = 0; u < 2; ++u) {
#pragma unroll
                for (int st = 1; st < 5; ++st) {
                    const int o = 32 >> st, n = 16 >> st; const bool hi = (lane & o) != 0;
#pragma unroll
                    for (int q = 0; q < n; ++q) { const float keep = hi ? p[u][n + q] : p[u][q], send = hi ? p[u][q] : p[u][n + q]; p[u][q] = keep + __shfl_xor(send, o); }
                }
                p[u][0] += __shfl_xor(p[u][0], 1);
            }
            const int myexp = (lane >> 1) & 31; const float rb = F.router_b[myexp];
#pragma unroll
            for (int u = 0; u < 2; ++u) {
                const float v = p[u][0] + rb;
                int rank = 0;
#pragma unroll
                for (int e = 0; e < NE; ++e) { const float o = __builtin_bit_cast(float, __builtin_amdgcn_readlane(__builtin_bit_cast(int, v), 2 * e)); rank += (o > v || (o == v && e < myexp)) ? 1 : 0; }
                const bool even = (lane & 1) == 0;
                float tv[4]; int te[4];
#pragma unroll
                for (int k = 0; k < 4; ++k) { const unsigned long long bal = __ballot(even && rank == k); const int src = (__ffsll((long long)bal) - 1) & 63; tv[k] = __shfl(v, src); te[k] = src >> 1; }
                const float e1 = __expf(tv[1] - tv[0]), e2 = __expf(tv[2] - tv[0]), e3 = __expf(tv[3] - tv[0]);
                const float inv = 1.0f / (1.0f + e1 + e2 + e3);
                if (lane < 4 && rep6 == 0) {
                    const int e = (lane == 0) ? te[0] : (lane == 1) ? te[1] : (lane == 2) ? te[2] : te[3];
                    const float wgt = ((lane == 0) ? 1.0f : (lane == 1) ? e1 : (lane == 2) ? e2 : e3) * inv;
                    const int rk = __hip_atomic_fetch_add(lcnt + e, 1, __ATOMIC_RELAXED, __HIP_MEMORY_SCOPE_WORKGROUP);
                    sel[(tl0 + u) * 4 + lane] = e | (rk << 8); selw[(tl0 + u) * 4 + lane] = wgt;
                }
            }
        }
        __syncthreads();
        if (tid < 32 && rep6 == 0) { const int n = lcnt[tid]; lbase[tid] = n ? (int)__hip_atomic_fetch_add(F.ctl + CW_CNT + 64 * tid, (unsigned)n, __ATOMIC_RELAXED, __HIP_MEMORY_SCOPE_AGENT) : 0; lcnt[tid] = 0; }
        __syncthreads();
        if (tid < 256 && rep6 == 0) {
            const int sv = sel[tid], e = sv & 255, idx = lbase[e] + (sv >> 8), t = grp * 64 + (tid >> 2);
            F.LIST[e * NTOK + idx] = t; F.TSLOT[t * 4 + (tid & 3)] = e * NTOK + idx; F.TW[t * 4 + (tid & 3)] = selw[tid];
        }
        __syncthreads();
    }
}

__device__ __forceinline__ void phase9(const Frame& F) {
    moe_tables(F);
    const MoeTab T = moe_tab(F.lds);
    const int lane = threadIdx.x & 63, wv = threadIdx.x >> 6;
    for (int t = blockIdx.x * 8 + wv; t < NTOK; t += gridDim.x * 8) {
        const float* g2 = F.mod + (size_t)(t >> 11) * 6144 + 5120;
        float y[2][8];
#pragma unroll
        for (int j = 0; j < 2; ++j)
#pragma unroll
            for (int i = 0; i < 8; ++i) y[j][i] = 0.f;
#pragma unroll
        for (int k = 0; k < (DBG_NO_MOE ? 0 : 4); ++k) {
            const int sl = F.TSLOT[t * 4 + k]; const float wk = F.TW[t * 4 + k];
            const int e = sl >> 14, idx = sl & (NTOK - 1);
            const size_t row = (size_t)(T.tstart[e] * 256 + idx);
#pragma unroll
            for (int j = 0; j < 2; ++j) {
                const u32x4 d = *(const u32x4*)(F.DOUT + row * D + 8 * lane + 512 * j);
                y[j][0] += wk * bflo(d.x); y[j][1] += wk * bfhi(d.x); y[j][2] += wk * bflo(d.y); y[j][3] += wk * bfhi(d.y);
                y[j][4] += wk * bflo(d.z); y[j][5] += wk * bfhi(d.z); y[j][6] += wk * bflo(d.w); y[j][7] += wk * bfhi(d.w);
            }
        }
        float xf[2][8]; float ss = 0.f;
#pragma unroll
        for (int j = 0; j < 2; ++j) {
            const int c = 8 * lane + 512 * j;
            const f32x4 x0 = *(const f32x4*)(F.X1 + (size_t)t * D + c), x1v = *(const f32x4*)(F.X1 + (size_t)t * D + c + 4);
            const f32x4 ga = *(const f32x4*)(g2 + c), gb = *(const f32x4*)(g2 + c + 4);
#pragma unroll
            for (int i = 0; i < 4; ++i) { xf[j][i] = x0[i] + ga[i] * y[j][i]; xf[j][4 + i] = x1v[i] + gb[i] * y[j][4 + i]; }
#pragma unroll
            for (int i = 0; i < 8; ++i) ss += xf[j][i] * xf[j][i];
        }
        ss = wave_sum(ss);
        const float rstd = __builtin_amdgcn_rsqf(ss * (1.0f / 1024.0f) + EPS);
#pragma unroll
        for (int j = 0; j < 2; ++j) {
            const int c = 8 * lane + 512 * j;
            const f32x4 fa = *(const f32x4*)(F.final_norm + c), fb = *(const f32x4*)(F.final_norm + c + 4);
            f32x4 o0, o1;
#pragma unroll
            for (int i = 0; i < 4; ++i) { o0[i] = xf[j][i] * rstd * fa[i]; o1[i] = xf[j][4 + i] * rstd * fb[i]; }
            *(f32x4*)(F.out + (size_t)t * D + c) = o0; *(f32x4*)(F.out + (size_t)t * D + c + 4) = o1;
        }
    }
}

__device__ __forceinline__ void sgu_item(const Frame& F, int item) {
    constexpr int RS = 272;
    LAS unsigned char* WL = F.lds;
    LAS unsigned char* VT = F.lds + 128 * RS;
    const int tid = threadIdx.x, lane = tid & 63, wv = __builtin_amdgcn_readfirstlane(tid >> 6), fr = lane & 15, fq = lane >> 4;
    const int h = item & 3, n = (item >> 2) & 15, b = item >> 6;
    const int row0 = b * SEQ + n * 128;
    {
        const int t = tid >> 2, s0 = (tid & 3) * 32;
        const float* wp = F.sgu_w + ((size_t)h * 128 + t) * 128 + s0;
#pragma unroll
        for (int j = 0; j < 4; ++j) {
            const f32x4 a = *(const f32x4*)(wp + 8 * j), c = *(const f32x4*)(wp + 8 * j + 4);
            u32x4 w; w.x = cvt_pk_bf16(a[0], a[1]); w.y = cvt_pk_bf16(a[2], a[3]); w.z = cvt_pk_bf16(c[0], c[1]); w.w = cvt_pk_bf16(c[2], c[3]);
            *(LAS u32x4*)(WL + t * RS + (s0 + 8 * j) * 2) = w;
        }
    }
    {
        const int s = tid >> 2, d0 = (tid & 3) * 32;
        const bf16_t* vp = F.VG + (size_t)(row0 + s) * GW + h * 128 + d0;
        float v[32];
#pragma unroll
        for (int j = 0; j < 4; ++j) { const u32x4 w = *(const u32x4*)(vp + 8 * j);
            v[8 * j + 0] = bflo(w.x); v[8 * j + 1] = bfhi(w.x); v[8 * j + 2] = bflo(w.y); v[8 * j + 3] = bfhi(w.y); v[8 * j + 4] = bflo(w.z); v[8 * j + 5] = bfhi(w.z); v[8 * j + 6] = bflo(w.w); v[8 * j + 7] = bfhi(w.w); }
        float sm = 0.f;
#pragma unroll
        for (int i = 0; i < 32; ++i) sm += v[i];
        sm += __shfl_xor(sm, 1); sm += __shfl_xor(sm, 2);
        const float mu = sm * (1.0f / 128.0f); float q = 0.f;
#pragma unroll
        for (int i = 0; i < 32; ++i) { const float dd = v[i] - mu; q += dd * dd; }
        q += __shfl_xor(q, 1); q += __shfl_xor(q, 2);
        const float rstd = __builtin_amdgcn_rsqf(q * (1.0f / 128.0f) + EPS);
        const float* lg = F.sgu_ln + h * 128 + d0;
#pragma unroll
        for (int i = 0; i < 32; i += 2) {
            const unsigned pk = cvt_pk_bf16((v[i] - mu) * rstd * lg[i], (v[i + 1] - mu) * rstd * lg[i + 1]);
            *(LAS unsigned short*)(VT + (d0 + i) * RS + s * 2) = (unsigned short)(pk & 0xffffu);
            *(LAS unsigned short*)(VT + (d0 + i + 1) * RS + s * 2) = (unsigned short)(pk >> 16);
        }
    }
    __syncthreads();
    f32x4 acc[8];
#pragma unroll
    for (int nt = 0; nt < 8; ++nt) acc[nt] = (f32x4){0.f, 0.f, 0.f, 0.f};
#pragma unroll
    for (int a = 0; a < 4; ++a) {
        const bf16x8 wf = *(const LAS bf16x8*)(WL + (16 * wv + fr) * RS + (32 * a + 8 * fq) * 2);
#pragma unroll
        for (int nt = 0; nt < 8; ++nt) {
            const bf16x8 vf = *(const LAS bf16x8*)(VT + (16 * nt + fr) * RS + (32 * a + 8 * fq) * 2);
            acc[nt] = __builtin_amdgcn_mfma_f32_16x16x32_bf16(vf, wf, acc[nt], 0, 0, 0);
        }
    }
    {
        const int t = 16 * wv + fr; const size_t row = (size_t)(row0 + t);
        const float bias = F.sgu_b[h * 128 + t];
#pragma unroll
        for (int nt = 0; nt < 8; ++nt) {
            const int d = h * 128 + 16 * nt + 4 * fq;
            const u32x2 uu = *(const u32x2*)(F.U + row * GW + d);
            u32x2 w; w.x = cvt_pk_bf16(bflo(uu.x) * (acc[nt][0] + bias), bfhi(uu.x) * (acc[nt][1] + bias)); w.y = cvt_pk_bf16(bflo(uu.y) * (acc[nt][2] + bias), bfhi(uu.y) * (acc[nt][3] + bias));
            *(u32x2*)(F.YCAT + row * D + d) = w;
        }
    }
    __syncthreads();
}

__device__ __forceinline__ float hexp(float x) { return fast_exp(clampf(x, -87.0f, 60.0f)); }
namespace hg {
constexpr int RS = 256, OFF_QP = 0, OFF_QA = 8192, OFF_QB = OFF_QA + 4096, OFF_QC = OFF_QB + 4096, OFF_KA = OFF_QC + 4096, OFF_KB = OFF_KA + 4096, OFF_KC = OFF_KB + 4096,
              KDS = 96, OFF_KDT = OFF_KC + 4096, OFF_D = OFF_KDT + 128 * KDS, BUF = OFF_D + 512;
constexpr int RRS = 272;
constexpr int RAW_OFF = 2 * BUF, RAWBUF = 2 * 32 * RRS;
__device__ __forceinline__ int swz(int row, int byteoff) { return row * RS + (byteoff ^ ((row & 15) << 4)); }
struct QK { u32x2 kk[2], q[2]; };
struct GV { u32x4 g, v; };
struct Ctx {
    LAS unsigned char* lds; const bf16_t *Gp, *Kp, *Ip, *Qp; float* Op;
    int b, dir, sgn, colw, h, w, fr, fq, tid, slot0, cend;
    bf16_t* qcum;
    bf16x8 tri0, tri1;
};
__device__ __forceinline__ int base_row(const Ctx& X, int c) {
    return c < 8 ? (NTOK + X.b * CTXL + (X.dir ? (CTXL - 1 - 32 * c) : 32 * c)) : (X.b * SEQ + (X.dir ? (SEQ - 1 - 32 * (c - 8)) : 32 * (c - 8)));
}
template <bool ALLLAT> __device__ __forceinline__ void load_qk(const Ctx& X, int c, QK& r) {
    const int base = base_row(X, c);
#pragma unroll
    for (int j = 0; j < 2; ++j) {
        const int row = base + X.sgn * (X.fr + 16 * j);
        const unsigned o = (unsigned)(row * GW + X.colw + 4 * X.fq) * 2u;
        r.kk[j] = *(const u32x2*)((const char*)X.Kp + o);
        if (ALLLAT) r.q[j] = *(const u32x2*)((const char*)X.Qp + o);
        else { const unsigned oq = (unsigned)((row < NTOK ? row : row - NTOK) * GW + X.colw + 4 * X.fq) * 2u; r.q[j] = *(const u32x2*)((const char*)X.Qp + oq); }
    }
}
__device__ __forceinline__ void load_gv(const Ctx& X, int c, GV& r) {
    const int base = base_row(X, c);
    const unsigned o = (unsigned)((base + X.sgn * (X.tid >> 4)) * GW + X.h * 128 + 8 * (X.tid & 15)) * 2u;
    r.g = *(const u32x4*)((const char*)X.Gp + o); r.v = *(const u32x4*)((const char*)X.Ip + o);
}
__device__ __forceinline__ void raw_write(const Ctx& X, int c, const GV& r) {
    LAS unsigned char* rb = X.lds + RAW_OFF + (c & 1) * RAWBUF + (X.tid >> 4) * RRS + (X.tid & 15) * 16;
    *(LAS u32x4*)(rb) = r.g; *(LAS u32x4*)(rb + 32 * RRS) = r.v;
}
template <bool LAT, bool CUM> __device__ __forceinline__ bf16x8 stage(const Ctx& X, int c, const QK& qk, f32x4& Bsum) {
    LAS unsigned char* buf = X.lds + (c & 1) * BUF;
    const LAS unsigned char* rg = X.lds + RAW_OFF + (c & 1) * RAWBUF + (16 * X.w + X.fr) * 2;
    const int fr = X.fr, fq = X.fq, w = X.w;
    constexpr bool lat = LAT;
    unsigned gs[8], vs[8];
#pragma unroll
    for (int jj = 0; jj < 8; ++jj) {
        const int p = (jj < 4) ? (4 * fq + jj) : (16 + 4 * fq + jj - 4);
        gs[jj] = *(const LAS unsigned short*)(rg + p * RRS); vs[jj] = *(const LAS unsigned short*)(rg + 32 * RRS + p * RRS);
    }
    bf16x8 gT, VTf;
    { u32x4 t; t.x = gs[0] | (gs[1] << 16); t.y = gs[2] | (gs[3] << 16); t.z = gs[4] | (gs[5] << 16); t.w = gs[6] | (gs[7] << 16); gT = __builtin_bit_cast(bf16x8, t);
      u32x4 u; u.x = vs[0] | (vs[1] << 16); u.y = vs[2] | (vs[3] << 16); u.z = vs[4] | (vs[5] << 16); u.w = vs[6] | (vs[7] << 16); VTf = __builtin_bit_cast(bf16x8, u); }
    const f32x4 z4 = (f32x4){0.f, 0.f, 0.f, 0.f};
    f32x4 bT[2];
    bT[0] = __builtin_amdgcn_mfma_f32_16x16x32_bf16(gT, X.tri0, z4, 0, 0, 0);
    bT[1] = __builtin_amdgcn_mfma_f32_16x16x32_bf16(gT, X.tri1, z4, 0, 0, 0);
    f32x4 b7, b15, b23, b31;
#pragma unroll
    for (int r = 0; r < 4; ++r) { b7[r] = __shfl(bT[0][r], 16 * fq + 7); b15[r] = __shfl(bT[0][r], 16 * fq + 15); b23[r] = __shfl(bT[1][r], 16 * fq + 7); b31[r] = __shfl(bT[1][r], 16 * fq + 15); }
#pragma unroll
    for (int j = 0; j < 2; ++j) {
        const float kv[4] = {bflo(qk.kk[j].x), bfhi(qk.kk[j].x), bflo(qk.kk[j].y), bfhi(qk.kk[j].y)};
        const float qv[4] = {bflo(qk.q[j].x), bfhi(qk.q[j].x), bflo(qk.q[j].y), bfhi(qk.q[j].y)};
        float kd[4], qp[4], qi[4], ki[4], x2[4];
#pragma unroll
        for (int r = 0; r < 4; ++r) {
            const float bt = bT[j][r], mref = (j == 0) ? b7[r] : b23[r];
            kd[r] = kv[r] * hexp(b31[r] - bt);
            qp[r] = qv[r] * hexp(bt);
            qi[r] = qv[r] * hexp(bt - mref);
            ki[r] = kv[r] * hexp(mref - bt);
            x2[r] = (j == 0) ? kv[r] * hexp(b15[r] - bt) : qv[r] * hexp(bt - b15[r]);
        }
        const int trow = fr + 16 * j;
        const unsigned kd01 = cvt_pk_bf16(kd[0], kd[1]), kd23 = cvt_pk_bf16(kd[2], kd[3]);
        LAS unsigned char* kdp = buf + OFF_KDT + (16 * w + 4 * fq) * KDS + (X.slot0 + 4 * j) * 2;
        *(LAS unsigned short*)(kdp) = (unsigned short)(kd01 & 0xffffu); *(LAS unsigned short*)(kdp + KDS) = (unsigned short)(kd01 >> 16);
        *(LAS unsigned short*)(kdp + 2 * KDS) = (unsigned short)(kd23 & 0xffffu); *(LAS unsigned short*)(kdp + 3 * KDS) = (unsigned short)(kd23 >> 16);
        if (lat) {
            { u32x2 wv; wv.x = cvt_pk_bf16(ki[0], ki[1]); wv.y = cvt_pk_bf16(ki[2], ki[3]); *(LAS u32x2*)(buf + (j == 0 ? OFF_KA : OFF_KB) + swz(fr, (16 * w + 4 * fq) * 2)) = wv; }
            { u32x2 wv; wv.x = cvt_pk_bf16(qp[0], qp[1]); wv.y = cvt_pk_bf16(qp[2], qp[3]); *(LAS u32x2*)(buf + OFF_QP + swz(trow, (32 * (w >> 1) + 8 * fq + 4 * (w & 1)) * 2)) = wv; }
            if (CUM) { u32x2 wv; wv.x = cvt_pk_bf16(qv[0] * hexp(bT[j][0] + Bsum[0]), qv[1] * hexp(bT[j][1] + Bsum[1])); wv.y = cvt_pk_bf16(qv[2] * hexp(bT[j][2] + Bsum[2]), qv[3] * hexp(bT[j][3] + Bsum[3]));
                *(u32x2*)((char*)X.qcum + (unsigned)((32 * (c - 36) + trow) * 128 + 32 * (w >> 1) + 8 * fq + 4 * (w & 1)) * 2u) = wv; }
            { u32x2 wv; wv.x = cvt_pk_bf16(qi[0], qi[1]); wv.y = cvt_pk_bf16(qi[2], qi[3]); *(LAS u32x2*)(buf + (j == 0 ? OFF_QA : OFF_QB) + swz(fr, (16 * w + 4 * fq) * 2)) = wv; }
            { u32x2 wv; wv.x = cvt_pk_bf16(x2[0], x2[1]); wv.y = cvt_pk_bf16(x2[2], x2[3]); *(LAS u32x2*)(buf + (j == 0 ? OFF_KC : OFF_QC) + swz(fr, (16 * w + 4 * fq) * 2)) = wv; }
        }
    }
    if (fr == 0) { f32x4 dv; dv[0] = hexp(b31[0]); dv[1] = hexp(b31[1]); dv[2] = hexp(b31[2]); dv[3] = hexp(b31[3]); *(LAS f32x4*)(buf + OFF_D + (16 * w + 4 * fq) * 4) = dv; }
    if (CUM) Bsum += b31;
    return VTf;
}
template <bool LAT> __device__ __forceinline__ void products(const Ctx& X, int c, const bf16x8 VTf, f32x4 (&S)[8]) {
    const LAS unsigned char* buf = X.lds + (c & 1) * BUF;
    const int fr = X.fr, fq = X.fq;
    const f32x4 z4 = (f32x4){0.f, 0.f, 0.f, 0.f};
    if (LAT) {
        f32x4 X00 = z4, X11 = z4, X01 = z4;
#pragma unroll
        for (int a = 0; a < 4; ++a) {
            const int co = swz(fr, (32 * a + 8 * fq) * 2);
            const bf16x8 ka = *(const LAS bf16x8*)(buf + OFF_KA + co), qa = *(const LAS bf16x8*)(buf + OFF_QA + co);
            const bf16x8 kb = *(const LAS bf16x8*)(buf + OFF_KB + co), qb = *(const LAS bf16x8*)(buf + OFF_QB + co);
            const bf16x8 kc = *(const LAS bf16x8*)(buf + OFF_KC + co), qc = *(const LAS bf16x8*)(buf + OFF_QC + co);
            X00 = __builtin_amdgcn_mfma_f32_16x16x32_bf16(ka, qa, X00, 0, 0, 0);
            X11 = __builtin_amdgcn_mfma_f32_16x16x32_bf16(kb, qb, X11, 0, 0, 0);
            X01 = __builtin_amdgcn_mfma_f32_16x16x32_bf16(kc, qc, X01, 0, 0, 0);
        }
#pragma unroll
        for (int r = 0; r < 4; ++r) { const bool keep = (4 * fq + r) <= fr; X00[r] = keep ? X00[r] : 0.f; X11[r] = keep ? X11[r] : 0.f; }
        bf16x8 P0, P1;
        { u32x4 t; t.x = cvt_pk_bf16(X00[0], X00[1]); t.y = cvt_pk_bf16(X00[2], X00[3]); t.z = 0u; t.w = 0u; P0 = __builtin_bit_cast(bf16x8, t);
          u32x4 u; u.x = cvt_pk_bf16(X01[0], X01[1]); u.y = cvt_pk_bf16(X01[2], X01[3]); u.z = cvt_pk_bf16(X11[0], X11[1]); u.w = cvt_pk_bf16(X11[2], X11[3]); P1 = __builtin_bit_cast(bf16x8, u); }
        f32x4 o0 = __builtin_amdgcn_mfma_f32_16x16x32_bf16(VTf, P0, z4, 0, 0, 0);
        f32x4 o1 = __builtin_amdgcn_mfma_f32_16x16x32_bf16(VTf, P1, z4, 0, 0, 0);
#pragma unroll
        for (int a = 0; a < 4; ++a) {
            u32x4 t; t.x = cvt_pk_bf16(S[2 * a][0], S[2 * a][1]); t.y = cvt_pk_bf16(S[2 * a][2], S[2 * a][3]); t.z = cvt_pk_bf16(S[2 * a + 1][0], S[2 * a + 1][1]); t.w = cvt_pk_bf16(S[2 * a + 1][2], S[2 * a + 1][3]);
            const bf16x8 Sb = __builtin_bit_cast(bf16x8, t);
            const bf16x8 qp0 = *(const LAS bf16x8*)(buf + OFF_QP + swz(fr, (32 * a + 8 * fq) * 2)), qp1 = *(const LAS bf16x8*)(buf + OFF_QP + swz(16 + fr, (32 * a + 8 * fq) * 2));
            o0 = __builtin_amdgcn_mfma_f32_16x16x32_bf16(Sb, qp0, o0, 0, 0, 0);
            o1 = __builtin_amdgcn_mfma_f32_16x16x32_bf16(Sb, qp1, o1, 0, 0, 0);
        }
        const int base = base_row(X, c);
        *(f32x4*)((char*)X.Op + (unsigned)((base + X.sgn * fr) * GW + X.colw + 4 * fq) * 4u) = o0;
        *(f32x4*)((char*)X.Op + (unsigned)((base + X.sgn * (fr + 16)) * GW + X.colw + 4 * fq) * 4u) = o1;
    }
#pragma unroll
    for (int kt = 0; kt < 8; ++kt) {
        const bf16x8 kdf = *(const LAS bf16x8*)(buf + OFF_KDT + (16 * kt + fr) * KDS + 16 * fq);
        const f32x4 dv = *(const LAS f32x4*)(buf + OFF_D + (16 * kt + 4 * fq) * 4);
        S[kt] = __builtin_amdgcn_mfma_f32_16x16x32_bf16(kdf, VTf, S[kt] * dv, 0, 0, 0);
    }
}
__device__ __forceinline__ void lds_barrier() {
    asm volatile("s_waitcnt lgkmcnt(0)" ::: "memory"); __builtin_amdgcn_s_barrier(); asm volatile("" ::: "memory");
}
template <bool PL, bool SL, bool CUM> __device__ __forceinline__ void iter(const Ctx& X, int c, QK& qk, GV& gv, bf16x8& VTcur, f32x4 (&S)[8], f32x4& Bsum) {
    lds_barrier();
    products<PL>(X, c, VTcur, S);
    VTcur = stage<SL, CUM>(X, c + 1, qk, Bsum);
    load_qk<CUM>(X, c + 3 < X.cend ? c + 3 : X.cend - 1, qk);
    if (c + 2 < X.cend) raw_write(X, c + 2, gv);
    load_gv(X, c + 4 < X.cend ? c + 4 : X.cend - 1, gv);
}
}
template <int half> __device__ __forceinline__ void hgrn_chain(const Frame& F, int chain) {
    using namespace hg;
    Ctx X;
    X.lds = F.lds; X.tid = threadIdx.x; const int lane = X.tid & 63; X.w = __builtin_amdgcn_readfirstlane(X.tid >> 6); X.fr = lane & 15; X.fq = lane >> 4;
    X.dir = chain & 1; X.h = (chain >> 1) & 3; X.b = chain >> 3; X.sgn = X.dir ? -1 : 1; X.colw = X.h * 128 + 16 * X.w;
    X.Gp = X.dir ? F.GB : F.GF; X.Kp = X.dir ? F.KB : F.KF; X.Ip = F.I; X.Qp = F.Q; X.Op = X.dir ? F.OB : F.OF;
    X.slot0 = 8 * (X.fr >> 2) + (X.fr & 3);
    X.qcum = nullptr;
    X.cend = half ? 72 : 36;
#pragma unroll
    for (int jj = 0; jj < 8; ++jj) {
        X.tri0[jj] = (jj < 4 && 4 * X.fq + jj <= X.fr) ? (short)0x3F80 : (short)0;
        X.tri1[jj] = (jj < 4) ? (short)0x3F80 : ((4 * X.fq + jj - 4 <= X.fr) ? (short)0x3F80 : (short)0);
    }
    f32x4 S[8];
#pragma unroll
    for (int kt = 0; kt < 8; ++kt) S[kt] = (f32x4){0.f, 0.f, 0.f, 0.f};
    f32x4 Bsum = (f32x4){0.f, 0.f, 0.f, 0.f};
    QK qkA, qkB; GV gvA, gvB;
    load_gv(X, 0, gvA); load_gv(X, 1, gvB); load_qk<false>(X, 0, qkA); load_qk<false>(X, 1, qkB);
    raw_write(X, 0, gvA); load_gv(X, 2, gvA);
    lds_barrier();
    bf16x8 VTcur = stage<false, false>(X, 0, qkA, Bsum); load_qk<false>(X, 2, qkA);
    raw_write(X, 1, gvB); load_gv(X, 3, gvB);
    if constexpr (half == 0) {
        for (int c = 0; c < 6; c += 2) { iter<false, false, false>(X, c, qkB, gvA, VTcur, S, Bsum); iter<false, false, false>(X, c + 1, qkA, gvB, VTcur, S, Bsum); }
        iter<false, false, false>(X, 6, qkB, gvA, VTcur, S, Bsum); iter<false, true, false>(X, 7, qkA, gvB, VTcur, S, Bsum);
        for (int c = 8; c < 34; c += 2) { iter<true, true, false>(X, c, qkB, gvA, VTcur, S, Bsum); iter<true, true, false>(X, c + 1, qkA, gvB, VTcur, S, Bsum); }
        iter<true, true, false>(X, 34, qkB, gvA, VTcur, S, Bsum);
        lds_barrier();
        products<true>(X, 35, VTcur, S);
    } else {
        for (int c = 0; c < 34; c += 2) { iter<false, false, false>(X, c, qkB, gvA, VTcur, S, Bsum); iter<false, false, false>(X, c + 1, qkA, gvB, VTcur, S, Bsum); }
        iter<false, false, false>(X, 34, qkB, gvA, VTcur, S, Bsum); iter<false, true, false>(X, 35, qkA, gvB, VTcur, S, Bsum);
        for (int c = 36; c < 70; c += 2) { iter<true, true, false>(X, c, qkB, gvA, VTcur, S, Bsum); iter<true, true, false>(X, c + 1, qkA, gvB, VTcur, S, Bsum); }
        iter<true, true, false>(X, 70, qkB, gvA, VTcur, S, Bsum);
        lds_barrier();
        products<true>(X, 71, VTcur, S);
    }
    __syncthreads();
}

constexpr int CONV_PER_WG = CONV_ITEMS / 128;
#ifndef CONV_CHAIN_SHARE
#define CONV_CHAIN_SHARE 2
#endif
__device__ __forceinline__ void phase3(const Frame& F) {
    const int G = gridDim.x, bid = blockIdx.x;
    if (bid < 128) {
        if (bid & 1) hgrn_chain<1>(F, bid >> 1); else hgrn_chain<0>(F, bid >> 1);
        conv8_run(F, bid + 128 * (CONV_PER_WG - CONV_CHAIN_SHARE), 128, CONV_CHAIN_SHARE);
    } else {
        const int j = bid - 128, nw = G - 128;
        for (int rep = 0; rep < ((DBG_REP3 & 2) ? 2 : 1); ++rep) for (int item = j; item < 512; item += nw) sgu_item(F, item);
        if (j < 128) conv8_run(F, j, 128, CONV_PER_WG - CONV_CHAIN_SHARE);
    }
}

constexpr int N_PHASES = 10;
#ifndef DBG_NO_MOE
#define DBG_NO_MOE 0
#endif
#ifndef DBG_MAX_PHASE
#define DBG_MAX_PHASE 9
#endif
__global__ void __launch_bounds__(NTHREADS, 2) fwd_kernel(Args a) {
    extern __shared__ __attribute__((aligned(16))) unsigned char lds_raw[];
    Frame F;
    F.x = a.in[0]; F.c = a.in[1]; F.ctx = a.in[2]; F.c_ctx = a.in[3]; F.w_mod = a.in[4]; F.b_mod = a.in[5]; F.norm1 = a.in[6]; F.w_in = a.in[7]; F.sgu_ln = a.in[8]; F.sgu_w = a.in[9];
    F.sgu_b = a.in[10]; F.lb_fwd = a.in[11]; F.lb_bwd = a.in[12]; F.hgrn_norm = a.in[13]; F.w_out = a.in[14]; F.norm2 = a.in[15]; F.router_w = a.in[16]; F.router_b = a.in[17];
    F.w1 = a.in[18]; F.b1 = a.in[19]; F.w2 = a.in[20]; F.b2 = a.in[21]; F.final_norm = a.in[22];
    F.out = a.out; F.ws = a.ws; unsigned char* ws = a.ws;
    F.ctl = (unsigned*)(ws + WS_CTL); F.mod = (float*)(ws + WS_MOD);
    F.WinT = (bf16_t*)(ws + WS_WIN); F.WoutT = (bf16_t*)(ws + WS_WOUT); F.W1T = ws + WS_W1; F.W2T = ws + WS_W2;
    F.H = (bf16_t*)(ws + WS_H); F.U = (bf16_t*)(ws + WS_U); F.VG = (bf16_t*)(ws + WS_VG); F.Q = (bf16_t*)(ws + WS_Q); F.GS = (bf16_t*)(ws + WS_GS); F.I = (bf16_t*)(ws + WS_I);
    F.GF = (bf16_t*)(ws + WS_GF); F.KF = (bf16_t*)(ws + WS_KF); F.GB = (bf16_t*)(ws + WS_GB); F.KB = (bf16_t*)(ws + WS_KB);
    F.YCAT = (bf16_t*)(ws + WS_YCAT); F.H2 = ws + WS_H2; F.ACT = ws + WS_ACT; F.DOUT = (bf16_t*)(ws + WS_DOUT);
    F.OF = (float*)(ws + WS_OF); F.OB = (float*)(ws + WS_OB); F.X1 = (float*)(ws + WS_X1); F.SS = (float*)(ws + WS_SS); F.TW = (float*)(ws + WS_TW);
    F.LIST = (int*)(ws + WS_LIST); F.TSLOT = (int*)(ws + WS_TSLOT); F.QCUM = (bf16_t*)(ws + WS_QCUM); F.SMID = ws + WS_SMID;
    F.lds = (LAS unsigned char*)lds_raw;
    if (threadIdx.x < 64) ((LAS unsigned*)(F.lds + LDS_MISC_OFF))[threadIdx.x] = 0u;
    __syncthreads();
    const int lo = a.ph_lo, hi = a.ph_hi, G = gridDim.x, cid = blockIdx.x;
    XcdBarrier bar; bar.bar = F.ctl + CW_BAR; bar.x = 0; bar.st = nullptr;
    if (hi - lo > 1) bar = xcd_barrier_post(F.ctl + CW_BAR, (volatile LAS unsigned*)(F.lds + LDS_MISC_OFF));
#define IN(k) (lo <= (k) && (k) < hi)
#define SEAM(k) do { if (IN(k) && IN((k) + 1)) xcd_barrier(bar); } while (0)
#define REP(k) for (int _r = 0; _r < (((DBG_REP >> (k)) & 1) ? 2 : 1); ++_r)
    if (IN(0)) REP(0) phase0(F);
    SEAM(0);
    if (IN(1)) REP(1) phase1(F);
    SEAM(1);
    for (int _b = 0; _b < DBG_BARX; ++_b) xcd_barrier(bar);
    if (IN(2)) REP(2) {
        SchedInProj S{(const unsigned char*)F.WinT, G, cid}; EpiInProj E{F.U, F.VG, F.Q, F.GS, F.I, F.GF, F.KF, F.GB, F.KB, F.lb_fwd, F.lb_bwd};
        pg::gemm_phase<EpiInProj, SchedInProj, INPROJ_FP8 != 0>(F.lds, (const char*)F.H, D, S, E);
    }
    SEAM(2);
    if (IN(3)) REP(3) phase3(F);
    SEAM(3);
    if (IN(4)) REP(4) phase4(F);
    SEAM(4);
    if (IN(5)) REP(5) {
        SchedOutProj S{F.WoutT, G, cid}; EpiOutProj E{F.x, F.mod, F.X1, F.SS};
        pg::gemm_phase<EpiOutProj, SchedOutProj, false>(F.lds, (const char*)F.YCAT, D, S, E);
    }
    SEAM(5);
    if (IN(6)) phase6(F);
    SEAM(6);
    if (IN(7)) REP(7) {
        moe_tables(F);
        SchedGateUp S{F.W1T, F.LIST, moe_tab(F.lds), G, cid}; EpiGateUp E{F.b1, F.ACT};
        pg::gemm_phase<EpiGateUp, SchedGateUp, true>(F.lds, (const char*)F.H2, D, S, E);
    }
    SEAM(7);
    if (IN(8)) REP(8) {
        moe_tables(F);
        SchedDown S{F.W2T, moe_tab(F.lds), G, cid}; EpiDown E{F.b2, F.DOUT};
        pg::gemm_phase<EpiDown, SchedDown, true>(F.lds, (const char*)F.ACT, DE, S, E);
    }
    SEAM(8);
    if (IN(9)) REP(9) phase9(F);
#undef IN
#undef SEAM
}

extern "C" void kernel_launch(void* const* d_in, const int* in_sizes, int n_in, void* d_out, int out_size, void* d_ws, size_t ws_size, hipStream_t stream) {
    static int grid = 0;
    if (grid == 0) {
        if (n_in != 23 || in_sizes[0] != NTOK * D || out_size != NTOK * D || ws_size < WS_END) {
            fprintf(stderr, "kernel_launch: unexpected shapes / workspace (n_in %d, in0 %d, out %d, ws %zu, need %zu); nothing launched\n", n_in, n_in > 0 ? in_sizes[0] : -1, out_size, ws_size, (size_t)WS_END);
            grid = -1; return;
        }
        int dev = 0, cus = 0;
        if (hipGetDevice(&dev) != hipSuccess || hipDeviceGetAttribute(&cus, hipDeviceAttributeMultiprocessorCount, dev) != hipSuccess) { grid = -1; return; }
        if (hipFuncSetAttribute((const void*)fwd_kernel, hipFuncAttributeMaxDynamicSharedMemorySize, LDS_BYTES) != hipSuccess) { fprintf(stderr, "kernel_launch: hipFuncSetAttribute failed\n"); grid = -1; return; }
        (void)hipGetLastError();
        grid = cus;
        if (grid < 256) { fprintf(stderr, "kernel_launch: needs >= 256 CUs\n"); grid = -1; return; }
    }
    if (grid < 0) return;
    (void)hipMemsetAsync((char*)d_ws + WS_CTL, 0, CTL_BYTES, stream);
    Args a{};
    for (int i = 0; i < 23; ++i) a.in[i] = (const float*)d_in[i];
    a.out = (float*)d_out; a.ws = (unsigned char*)d_ws;
#if N_LAUNCH_MODE == 1
    a.ph_lo = 0; a.ph_hi = N_PHASES;
    hipLaunchKernelGGL(fwd_kernel, dim3(grid), dim3(NTHREADS), LDS_BYTES, stream, a);
#else
    for (int p = 0; p < N_PHASES; ++p) { if (DBG_NO_MOE && p >= 6 && p <= 8) continue; a.ph_lo = p; a.ph_hi = p + 1; hipLaunchKernelGGL(fwd_kernel, dim3(grid), dim3(NTHREADS), LDS_BYTES, stream, a); }
#endif
}
```

```cpp
#include <hip/hip_runtime.h>
#include <cstdio>
#include <cstdint>

#ifndef N_LAUNCH_MODE
#define N_LAUNCH_MODE 1
#endif

#ifndef DBG_NO_MOE
#define DBG_NO_MOE 0
#endif
#ifndef DBG_REP
#define DBG_REP 0
#endif
#ifndef DBG_REP3
#define DBG_REP3 0
#endif
#ifndef DBG_REP6
#define DBG_REP6 0
#endif
#ifndef DBG_BARX
#define DBG_BARX 0
#endif
#ifndef INPROJ_FP8
#define INPROJ_FP8 0
#endif
#ifndef DBG_MIX
#define DBG_MIX 1
#endif
#define LAS __attribute__((address_space(3)))
typedef unsigned short bf16_t;
typedef short bf16x8 __attribute__((ext_vector_type(8)));
typedef float f32x4 __attribute__((ext_vector_type(4)));
typedef float f32x2 __attribute__((ext_vector_type(2)));
typedef unsigned u32x4 __attribute__((ext_vector_type(4)));
typedef unsigned u32x2 __attribute__((ext_vector_type(2)));

constexpr int D = 1024, NB = 8, SEQ = 2048, CTXL = 256;
constexpr int NTOK = NB * SEQ;
constexpr int NCTX = NB * CTXL;
constexpr int NROW = NTOK + NCTX;
constexpr int DIN = 3584, GW = 512, NE = 32, DE = 1024, TOPK = 4;
constexpr int ACT_ROWS = NTOK * TOPK + NE * 256;
constexpr float EPS = 1e-6f;
constexpr int NTHREADS = 512;

constexpr int LDS_STAGE = 131072;
constexpr int LDS_EXTRA_OFF = LDS_STAGE;
constexpr int LDS_MISC_OFF = 155648;
constexpr int LDS_BYTES = LDS_MISC_OFF + 256;

constexpr size_t al256(size_t x) { return (x + 255) & ~(size_t)255; }
constexpr size_t WS_CTL = 0;
constexpr size_t CTL_BYTES = 65536;
constexpr int CW_BAR = 0;
constexpr int CW_HFLAG = 8192;
constexpr int CW_CNT = 4096;
constexpr size_t WS_MOD = WS_CTL + CTL_BYTES;
constexpr size_t WS_WIN = WS_MOD + al256((size_t)9 * 6144 * 4);
constexpr size_t WS_WOUT = WS_WIN + (size_t)DIN * D * 2;
constexpr size_t WS_W1 = WS_WOUT + (size_t)D * D * 2;
constexpr size_t WS_W2 = WS_W1 + (size_t)NE * 2 * DE * D * 2;
constexpr size_t WS_YCAT = WS_W2 + (size_t)NE * D * DE * 2;
constexpr size_t WS_OF = WS_YCAT + (size_t)NTOK * D * 2;
constexpr size_t WS_OB = WS_OF + (size_t)NTOK * GW * 4;
constexpr size_t WS_X1 = WS_OB + (size_t)NTOK * GW * 4;
constexpr size_t WS_SS = WS_X1 + (size_t)NTOK * D * 4;
constexpr size_t WS_H2 = WS_SS + (size_t)NTOK * 16 * 4;
constexpr size_t WS_LIST = WS_H2 + (size_t)NTOK * D * 2;
constexpr size_t WS_TSLOT = WS_LIST + (size_t)NE * NTOK * 4;
constexpr size_t WS_TW = WS_TSLOT + (size_t)NTOK * 4 * 4;
constexpr size_t WS_QCUM = WS_TW + (size_t)NTOK * 4 * 4;
constexpr size_t WS_SMID = WS_QCUM + (size_t)64 * 1152 * 128 * 2;
constexpr size_t WS_ACT = WS_SMID + (size_t)64 * 8 * 4 * 64 * 16;
constexpr size_t WS_REGA = WS_ACT + (size_t)ACT_ROWS * DE * 2;
constexpr size_t WS_H = WS_REGA;
constexpr size_t WS_U = WS_H + (size_t)NROW * D * 2;
constexpr size_t WS_VG = WS_U + (size_t)NTOK * GW * 2;
constexpr size_t WS_Q = WS_VG + (size_t)NTOK * GW * 2;
constexpr size_t WS_GS = WS_Q + (size_t)NTOK * GW * 2;
constexpr size_t WS_I = WS_GS + (size_t)NTOK * GW * 2;
constexpr size_t WS_GF = WS_I + (size_t)NROW * GW * 2;
constexpr size_t WS_KF = WS_GF + (size_t)NROW * GW * 2;
constexpr size_t WS_GB = WS_KF + (size_t)NROW * GW * 2;
constexpr size_t WS_KB = WS_GB + (size_t)NROW * GW * 2;
constexpr size_t WS_REGA_END = WS_KB + (size_t)NROW * GW * 2;
constexpr size_t WS_DOUT = WS_REGA;
constexpr size_t WS_END0 = WS_DOUT + (size_t)ACT_ROWS * D * 2;
constexpr size_t WS_END = WS_END0 > WS_REGA_END ? WS_END0 : WS_REGA_END;

typedef __bf16 bf16x2_t __attribute__((ext_vector_type(2)));
__device__ __forceinline__ unsigned cvt_pk_bf16(float lo, float hi) { bf16x2_t v; v[0] = (__bf16)lo; v[1] = (__bf16)hi; return __builtin_bit_cast(unsigned, v); }
__device__ __forceinline__ float bf2f(unsigned b) { return __uint_as_float(b << 16); }
__device__ __forceinline__ float bflo(unsigned w) { return __uint_as_float(w << 16); }
__device__ __forceinline__ float bfhi(unsigned w) { return __uint_as_float(w & 0xffff0000u); }
__device__ __forceinline__ float fast_exp(float x) { return __builtin_amdgcn_exp2f(x * 1.44269504089f); }
__device__ __forceinline__ float fast_rcp(float x) { return __builtin_amdgcn_rcpf(x); }
__device__ __forceinline__ float sigmoidf_(float x) { return fast_rcp(1.0f + fast_exp(-x)); }
__device__ __forceinline__ float gelu_tanh(float x) { const float u = 1.5957691216f * (x + 0.044715f * x * x * x); return x * fast_rcp(1.0f + fast_exp(-u)); }
__device__ __forceinline__ float clampf(float x, float lo, float hi) { return fminf(fmaxf(x, lo), hi); }
__device__ __forceinline__ float wave_sum(float v) {
#pragma unroll
    for (int o = 32; o >= 1; o >>= 1) v += __shfl_xor(v, o);
    return v;
}
__device__ __forceinline__ unsigned pack_fp8x4(float a, float b, float c, float d) {
    a = __builtin_amdgcn_fmed3f(a, -448.f, 448.f); b = __builtin_amdgcn_fmed3f(b, -448.f, 448.f); c = __builtin_amdgcn_fmed3f(c, -448.f, 448.f); d = __builtin_amdgcn_fmed3f(d, -448.f, 448.f);
    int p = __builtin_amdgcn_cvt_pk_fp8_f32(a, b, 0, false); p = __builtin_amdgcn_cvt_pk_fp8_f32(c, d, p, true); return (unsigned)p;
}
#define VM_WAIT() asm volatile("s_waitcnt vmcnt(0)" ::: "memory")
#define LDS_WAIT() asm volatile("s_waitcnt lgkmcnt(0)" ::: "memory")

#define XB_TMO      128
#define XB_XCNT(j)  (256  + 64 * (j))
#define XB_XSUB(j)  (1280 + 64 * (j))
#define XB_XGEN(j)  (2304 + 64 * (j))
#define XB_TOP      3328
#define XB_TOPGEN   3392
#define XCD_BAR_WORDS 3456
#define XB_SPIN_CAP (1u << 18)
__device__ __forceinline__ unsigned xb_ld(unsigned* p)              { return __hip_atomic_load(p, __ATOMIC_RELAXED, __HIP_MEMORY_SCOPE_AGENT); }
__device__ __forceinline__ unsigned xb_add(unsigned* p, unsigned v) { return __hip_atomic_fetch_add(p, v, __ATOMIC_RELAXED, __HIP_MEMORY_SCOPE_AGENT); }
__device__ __forceinline__ unsigned xb_xcc_id() { return (unsigned)__builtin_amdgcn_s_getreg((3 << 11) | 20) & 0xFu; }
#define XB_SPIN(cond, bar) do { unsigned _sp = 0; while (cond) { __builtin_amdgcn_s_sleep(1); \
    if ((++_sp & 255u) == 0u) { if (xb_ld(&(bar)[XB_TMO])) break; if (_sp > XB_SPIN_CAP) { atomicAdd(&(bar)[XB_TMO], 1u); break; } } } } while (0)
struct XcdBarrier { unsigned* bar; unsigned x; volatile LAS unsigned* st; };
__device__ __forceinline__ XcdBarrier xcd_barrier_post(unsigned* bar, volatile LAS unsigned* st) {
    XcdBarrier b; b.bar = bar; b.x = xb_xcc_id(); b.st = st;
    if (threadIdx.x == 0) (void)xb_add(&bar[XB_XCNT(b.x)], 1u);
    return b;
}
__device__ __forceinline__ void xcd_barrier_complete(unsigned* bar, unsigned x, unsigned& nloc, unsigned& nx) {
    const unsigned G = gridDim.x * gridDim.y * gridDim.z;
    unsigned sum, cnt, mine, sp = 0u;
    for (;;) {
        sum = 0u; cnt = 0u; mine = 0u;
#pragma unroll
        for (unsigned j = 0; j < 16; ++j) { const unsigned c = xb_ld(&bar[XB_XCNT(j)]); sum += c; cnt += (c > 0u) ? 1u : 0u; mine = (j == x) ? c : mine; }
        if (sum == G) break;
        __builtin_amdgcn_s_sleep(1);
        if ((++sp & 255u) == 0u) { if (xb_ld(&bar[XB_TMO])) break; if (sp > XB_SPIN_CAP) { atomicAdd(&bar[XB_TMO], 1u); break; } }
    }
    nloc = mine > 0u ? mine : 1u; nx = cnt > 0u ? cnt : 1u;
}
__device__ __forceinline__ void xcd_barrier(const XcdBarrier& b) {
    asm volatile("s_waitcnt vmcnt(0)" ::: "memory");
    __syncthreads();
    if (threadIdx.x == 0) {
        unsigned* bar = b.bar;
        __builtin_amdgcn_s_waitcnt(0);
        unsigned nloc = b.st[0], nx = b.st[1];
        if (nloc == 0u) { xcd_barrier_complete(bar, b.x, nloc, nx); b.st[0] = nloc; b.st[1] = nx; }
        const unsigned old = xb_add(&bar[XB_XSUB(b.x)], 1u);
        const unsigned gen = old / nloc;
        if (old + 1u == (gen + 1u) * nloc) {
            __builtin_amdgcn_fence(__ATOMIC_RELEASE, "agent");
            asm volatile("s_waitcnt vmcnt(0)" ::: "memory");
            const unsigned og = xb_add(&bar[XB_TOP], 1u);
            const unsigned tg = og / nx;
            if (og + 1u == (tg + 1u) * nx) xb_add(&bar[XB_TOPGEN], 1u);
            else XB_SPIN(xb_ld(&bar[XB_TOPGEN]) == tg, bar);
            __builtin_amdgcn_fence(__ATOMIC_ACQUIRE, "agent");
            xb_add(&bar[XB_XGEN(b.x)], 1u);
            asm volatile("s_waitcnt vmcnt(0)" ::: "memory");
        } else {
            XB_SPIN(xb_ld(&bar[XB_XGEN(b.x)]) == gen, bar);
            __builtin_amdgcn_fence(__ATOMIC_ACQUIRE, "agent");
            asm volatile("s_waitcnt vmcnt(0)" ::: "memory");
        }
    }
    __syncthreads();
}

struct Args { const float* in[23]; float* out; unsigned char* ws; int ph_lo, ph_hi; };
struct Frame {
    const float *x, *c, *ctx, *c_ctx, *w_mod, *b_mod, *norm1, *w_in, *sgu_ln, *sgu_w, *sgu_b, *lb_fwd, *lb_bwd, *hgrn_norm, *w_out, *norm2,
                *router_w, *router_b, *w1, *b1, *w2, *b2, *final_norm;
    float* out; unsigned char* ws;
    unsigned* ctl; float* mod;
    bf16_t *WinT, *WoutT, *H, *U, *VG, *Q, *GS, *I, *GF, *KF, *GB, *KB, *YCAT, *DOUT;
    unsigned char *W1T, *W2T, *H2, *ACT;
    float *SS, *TW; bf16_t *OF, *OB, *X1;
    bf16_t* QCUM; unsigned char* SMID;
    int *LIST, *TSLOT;
    LAS unsigned char* lds;
};

namespace pg {
constexpr int BM = 256, BK = 64, HALF = 128, HTB = HALF * BK * 2, NXCD = 8, WGM = 8;
__device__ __forceinline__ int lds_byte(int r, int c) { const int st = (r >> 4) * 2 + (c >> 5), rr = r & 15, cc = c & 31, ob = rr * 64 + cc * 2; return st * 1024 + (ob ^ (((ob >> 9) & 1) << 5)); }
__device__ __forceinline__ void stage_rc(int b, int& R, int& C) { const int st = b / 1024, sb = b % 1024, swz = sb ^ (((sb >> 9) & 1) << 5); R = (st >> 1) * 16 + swz / 64; C = (st & 1) * 32 + (swz % 64) / 2; }
__device__ __forceinline__ int perm32(int rho) { const int n = rho >> 4, i = rho & 15; return 8 * (i >> 2) + 4 * n + (i & 3); }

struct Unit { const char* bptr; int arow, orow, pn, e, cnt, pad; };

__device__ __forceinline__ bool static_order(int nM, int nN, int L, int& pm, int& pn) {
    const int nwg = nM * nN; if (L >= nwg) return false;
    int wgid = L; { const int q = nwg / NXCD, r = nwg % NXCD, xcd = wgid % NXCD, off = wgid / NXCD; wgid = (xcd < r ? xcd * (q + 1) : r * (q + 1) + (xcd - r) * q) + off; }
    const int nig = WGM * nN, gid = wgid / nig, fm = gid * WGM, gsz = (nM - fm) < WGM ? (nM - fm) : WGM;
    pm = fm + ((wgid % nig) % gsz); pn = (wgid % nig) / gsz; return true;
}

typedef int v8i __attribute__((ext_vector_type(8)));
typedef int v4i __attribute__((ext_vector_type(4)));
template <class Epi, class Sched, bool FP8>
__device__ __forceinline__ void gemm_phase(LAS unsigned char* lds, const char* Abase, const int K, const Sched& S, const Epi& E) {
    const int tid = threadIdx.x, wid = __builtin_amdgcn_readfirstlane(tid >> 6), lane = tid & 63, wr = wid >> 2, wc = wid & 3, fr = lane & 15, fq = lane >> 4;
    const int pitch = FP8 ? K : 2 * K;
    const int nt = pitch / 128;
    int sR[2], sC[2]; unsigned voffB[2];
#pragma unroll
    for (int i = 0; i < 2; ++i) { stage_rc(tid * 16 + i * 8192, sR[i], sC[i]); const int Rb = Epi::PERM ? ((sR[i] & ~31) + perm32(sR[i] & 31)) : sR[i]; voffB[i] = (unsigned)(Rb * pitch + 2 * sC[i]); }
    const size_t kstep = (size_t)(BK * 2);
    const size_t hstep = (size_t)HALF * pitch;
    const unsigned ldsw = (unsigned)wid * 1024u;
    const int aoff = lds_byte(wr * 64 + fr, fq * 8), boff = lds_byte(wc * 32 + fr, fq * 8);
#define PG_SA(b, h) (((b) * 2 + (h)) * HTB)
#define PG_SB(b, h) ((4 + (b) * 2 + (h)) * HTB)
#define PG_STAGE(bufoff, gbase, voff) do { _Pragma("unroll") for (int _i = 0; _i < 2; ++_i) \
        __builtin_amdgcn_global_load_lds((const unsigned*)((const char*)(gbase) + (voff)[_i]), (LAS unsigned*)(lds + (bufoff) + ldsw + _i * 8192), 16, 0, 0); } while (0)
#define PG_LDA(dst, b, h) do { _Pragma("unroll") for (int m = 0; m < 4; ++m) { dst[m].lo = *(const LAS v4i*)(lds + PG_SA(b, h) + aoff + m * 2048); dst[m].hi = *(const LAS v4i*)(lds + PG_SA(b, h) + aoff + m * 2048 + 1024); } } while (0)
#define PG_LDB(dst, b, h) do { _Pragma("unroll") for (int n = 0; n < 2; ++n) { dst[n].lo = *(const LAS v4i*)(lds + PG_SB(b, h) + boff + n * 2048); dst[n].hi = *(const LAS v4i*)(lds + PG_SB(b, h) + boff + n * 2048 + 1024); } } while (0)
#define PG_MMA(ai, bj, At, Bt) do { __builtin_amdgcn_s_setprio(1); _Pragma("unroll") for (int m = 0; m < 4; ++m) _Pragma("unroll") for (int n = 0; n < 2; ++n) { \
        if constexpr (FP8) acc[ai][bj][m][n] = __builtin_amdgcn_mfma_scale_f32_16x16x128_f8f6f4(Bt[n], At[m], acc[ai][bj][m][n], 0, 0, 0, 0x7a7a7a7a, 0, 0x7f7f7f7f); \
        else { const v4i _bl = Bt[n].lo, _bh = Bt[n].hi, _al = At[m].lo, _ah = At[m].hi;     \
               acc[ai][bj][m][n] = __builtin_amdgcn_mfma_f32_16x16x32_bf16(__builtin_bit_cast(bf16x8, _bl), __builtin_bit_cast(bf16x8, _al), acc[ai][bj][m][n], 0, 0, 0); \
               acc[ai][bj][m][n] = __builtin_amdgcn_mfma_f32_16x16x32_bf16(__builtin_bit_cast(bf16x8, _bh), __builtin_bit_cast(bf16x8, _ah), acc[ai][bj][m][n], 0, 0, 0); } } \
        __builtin_amdgcn_s_setprio(0); } while (0)
#define PG_WAIT_V(n) asm volatile("s_waitcnt vmcnt(" #n ")" ::: "memory")
#define PG_WAIT_L(n) asm volatile("s_waitcnt lgkmcnt(" #n ")" ::: "memory")
#define PG_BAR __builtin_amdgcn_s_barrier()
#define PG_SCHED __builtin_amdgcn_sched_barrier(0)
    Unit cur, nxt, nn; int ui = 0;
    if (!S.next(0, cur)) return;
    bool has_next = S.next(1, nxt);
    unsigned vA[2][2], vN[2][2];
    S.aoff(cur, sR, sC, vA);
    if (has_next) S.aoff(nxt, sR, sC, vN); else { vN[0][0] = vA[0][0]; vN[0][1] = vA[0][1]; vN[1][0] = vA[1][0]; vN[1][1] = vA[1][1]; }
    f32x4 acc[2][2][4][2];
#pragma unroll
    for (int a = 0; a < 2; ++a)
#pragma unroll
        for (int b = 0; b < 2; ++b)
#pragma unroll
            for (int m = 0; m < 4; ++m)
#pragma unroll
                for (int n = 0; n < 2; ++n) acc[a][b][m][n] = (f32x4){0.f, 0.f, 0.f, 0.f};
    v8i At[4], B0[2], B1[2];
    const char* cB = cur.bptr;
    PG_STAGE(PG_SB(0, 0), cB, voffB); PG_STAGE(PG_SA(0, 0), Abase, vA[0]); PG_STAGE(PG_SB(0, 1), cB + hstep, voffB); PG_STAGE(PG_SA(0, 1), Abase, vA[1]);
    if (wr == 1) PG_BAR;
    PG_WAIT_V(4); PG_BAR;
    PG_STAGE(PG_SB(1, 0), cB + kstep, voffB); PG_STAGE(PG_SA(1, 0), Abase + kstep, vA[0]); PG_STAGE(PG_SB(1, 1), cB + hstep + kstep, voffB);
    PG_WAIT_V(6); PG_BAR;
    for (;;) {
        const char* nB = has_next ? nxt.bptr : cB;
#pragma unroll 1
        for (int t = 0; t < nt; t += 2) {
            const bool last = (t == nt - 2);
            const char* a1 = Abase + (size_t)(t + 1) * kstep;
            const char* a2 = last ? Abase : Abase + (size_t)(t + 2) * kstep; const char* b2 = last ? nB : cB + (size_t)(t + 2) * kstep;
            const char* a3 = a2 + kstep; const char* b3 = b2 + kstep;
            PG_LDB(B0, 0, 0); PG_SCHED; PG_LDA(At, 0, 0); PG_STAGE(PG_SA(1, 1), a1, vA[1]);
            if (last) { vA[0][0] = vN[0][0]; vA[0][1] = vN[0][1]; vA[1][0] = vN[1][0]; vA[1][1] = vN[1][1]; }
            PG_WAIT_L(8); PG_BAR; PG_WAIT_L(0); PG_MMA(0, 0, At, B0); PG_BAR; PG_SCHED;
            PG_LDB(B1, 0, 1); PG_STAGE(PG_SB(0, 0), b2, voffB);
            PG_BAR; PG_WAIT_L(0); PG_MMA(0, 1, At, B1); PG_BAR;
            PG_LDA(At, 0, 1); PG_STAGE(PG_SA(0, 0), a2, vA[0]);
            PG_BAR; PG_WAIT_L(0); PG_MMA(1, 0, At, B0); PG_BAR; PG_SCHED;
            PG_STAGE(PG_SB(0, 1), b2 + hstep, voffB);
            PG_WAIT_V(6); PG_BAR; PG_MMA(1, 1, At, B1); PG_BAR;
            PG_LDB(B0, 1, 0); PG_SCHED; PG_LDA(At, 1, 0); PG_STAGE(PG_SA(0, 1), a2, vA[1]);
            PG_WAIT_L(8); PG_BAR; PG_WAIT_L(0); PG_MMA(0, 0, At, B0); PG_BAR; PG_SCHED;
            PG_LDB(B1, 1, 1); PG_STAGE(PG_SB(1, 0), b3, voffB);
            PG_BAR; PG_WAIT_L(0); PG_MMA(0, 1, At, B1); PG_BAR;
            PG_LDA(At, 1, 1); PG_STAGE(PG_SA(1, 0), a3, vA[0]);
            PG_BAR; PG_WAIT_L(0); PG_MMA(1, 0, At, B0); PG_BAR; PG_SCHED;
            PG_STAGE(PG_SB(1, 1), b3 + hstep, voffB);
            PG_WAIT_V(6); PG_BAR; PG_MMA(1, 1, At, B1); PG_BAR;
        }
        E(acc, cur, wr, wc, fr, fq);
        if (!has_next) break;
#pragma unroll
        for (int a = 0; a < 2; ++a)
#pragma unroll
            for (int b = 0; b < 2; ++b)
#pragma unroll
                for (int m = 0; m < 4; ++m)
#pragma unroll
                    for (int n = 0; n < 2; ++n) acc[a][b][m][n] = (f32x4){0.f, 0.f, 0.f, 0.f};
        cur = nxt; cB = nB; ++ui;
        has_next = S.next(ui + 1, nn);
        if (has_next) { nxt = nn; S.aoff(nxt, sR, sC, vN); }
    }
    PG_WAIT_V(0);
    if (wr == 0) PG_BAR;
    PG_BAR;
#undef PG_SA
#undef PG_SB
#undef PG_STAGE
#undef PG_LDA
#undef PG_LDB
#undef PG_MMA
#undef PG_WAIT_V
#undef PG_WAIT_L
#undef PG_BAR
#undef PG_SCHED
}
}

typedef f32x4 Acc[2][2][4][2];

struct SchedInProj {
    const unsigned char* WinT; int G, c;
    static constexpr int ESZ = INPROJ_FP8 ? 1 : 2;
    __device__ __forceinline__ bool next(int i, pg::Unit& u) const {
        const int L = i * G + c; int pm, pn;
        if (L < 64 * 14) { pg::static_order(64, 14, L, pm, pn); }
        else { const int x = L - 64 * 14; if (x >= 48) return false; pm = 64 + (x & 7); pn = 6 + (x >> 3); }
        u.bptr = (const char*)(WinT + (size_t)pn * 256 * D * ESZ); u.arow = pm * 256; u.orow = pm * 256; u.pn = pn; u.e = 0; u.cnt = 0; u.pad = 0; return true;
    }
    __device__ __forceinline__ void aoff(const pg::Unit& u, const int (&R)[2], const int (&C)[2], unsigned (&v)[2][2]) const {
#pragma unroll
        for (int h = 0; h < 2; ++h)
#pragma unroll
            for (int i = 0; i < 2; ++i) v[h][i] = (unsigned)((u.arow + h * 128 + R[i]) * D * ESZ + 2 * C[i]);
    }
};
struct EpiInProj {
    static constexpr bool PERM = true;
    bf16_t *U, *VG, *Q, *GS, *I, *GF, *KF, *GB, *KB; const float *lb_fwd, *lb_bwd;
    __device__ __forceinline__ void operator()(const Acc& acc, const pg::Unit& u, int wr, int wc, int fr, int fq) const {
        const int cg = u.pn >> 1;
        const int cbase = (u.pn & 1) * 256 + wc * 32 + 8 * fq;
        const int row0 = u.orow + wr * 64 + fr;
        if (cg == 3 || cg == 4) {
            const float* tab = (cg == 3) ? lb_fwd : lb_bwd; bf16_t* Gd = (cg == 3) ? GF : GB; bf16_t* Kd = (cg == 3) ? KF : KB;
#pragma unroll
            for (int bj = 0; bj < 2; ++bj) {
                const int col = cbase + bj * 128;
                float lb[8], omlb[8];
#pragma unroll
                for (int j = 0; j < 8; ++j) { const float t0 = tab[col + j], t1 = tab[GW + col + j]; lb[j] = fast_rcp(1.0f + __expf(t1 - t0)); omlb[j] = 1.0f - lb[j]; }
#pragma unroll
                for (int ai = 0; ai < 2; ++ai)
#pragma unroll
                    for (int m = 0; m < 4; ++m) {
                        const size_t off = (size_t)(row0 + ai * 128 + m * 16) * GW + col;
                        float gv[8], kv[8];
#pragma unroll
                        for (int n = 0; n < 2; ++n)
#pragma unroll
                            for (int j = 0; j < 4; ++j) {
                                const float z = clampf(acc[ai][bj][m][n][j], -30.f, 30.f);
                                const float e = __expf(-z), s = fast_rcp(1.0f + e), oms = e * s;
                                const float f = lb[4 * n + j] + omlb[4 * n + j] * s;
                                gv[4 * n + j] = __logf(f); kv[4 * n + j] = omlb[4 * n + j] * oms;
                            }
                        u32x4 wg, wk;
                        wg.x = cvt_pk_bf16(gv[0], gv[1]); wg.y = cvt_pk_bf16(gv[2], gv[3]); wg.z = cvt_pk_bf16(gv[4], gv[5]); wg.w = cvt_pk_bf16(gv[6], gv[7]);
                        wk.x = cvt_pk_bf16(kv[0], kv[1]); wk.y = cvt_pk_bf16(kv[2], kv[3]); wk.z = cvt_pk_bf16(kv[4], kv[5]); wk.w = cvt_pk_bf16(kv[6], kv[7]);
                        *(u32x4*)(Gd + off) = wg; *(u32x4*)(Kd + off) = wk;
                    }
            }
        } else {
            bf16_t* Od = (cg == 0) ? U : (cg == 1) ? VG : (cg == 2) ? Q : (cg == 5) ? I : GS;
            const int act = (cg <= 1) ? 1 : (cg == 6) ? 2 : 0;
#pragma unroll
            for (int ai = 0; ai < 2; ++ai)
#pragma unroll
                for (int m = 0; m < 4; ++m)
#pragma unroll
                    for (int bj = 0; bj < 2; ++bj) {
                        const size_t off = (size_t)(row0 + ai * 128 + m * 16) * GW + cbase + bj * 128;
                        float v[8];
#pragma unroll
                        for (int n = 0; n < 2; ++n)
#pragma unroll
                            for (int j = 0; j < 4; ++j) { float z = acc[ai][bj][m][n][j]; if (act == 1) z = gelu_tanh(z); else if (act == 2) z = z * sigmoidf_(z); v[4 * n + j] = z; }
                        u32x4 w; w.x = cvt_pk_bf16(v[0], v[1]); w.y = cvt_pk_bf16(v[2], v[3]); w.z = cvt_pk_bf16(v[4], v[5]); w.w = cvt_pk_bf16(v[6], v[7]);
                        *(u32x4*)(Od + off) = w;
                    }
        }
    }
};

struct SchedOutProj {
    const bf16_t* WoutT; int G, c;
    __device__ __forceinline__ bool next(int i, pg::Unit& u) const {
        const int L = i * G + c; int pm, pn; if (!pg::static_order(64, 4, L, pm, pn)) return false;
        u.bptr = (const char*)(WoutT + (size_t)pn * 256 * D); u.arow = pm * 256; u.orow = pm * 256; u.pn = pn; u.e = 0; u.cnt = 0; u.pad = 0; return true;
    }
    __device__ __forceinline__ void aoff(const pg::Unit& u, const int (&R)[2], const int (&C)[2], unsigned (&v)[2][2]) const {
#pragma unroll
        for (int h = 0; h < 2; ++h)
#pragma unroll
            for (int i = 0; i < 2; ++i) v[h][i] = (unsigned)((u.arow + h * 128 + R[i]) * D + C[i]) * 2u;
    }
};
struct EpiOutProj {
    static constexpr bool PERM = false;
    const float* x; const float* mod; bf16_t* X1; float* SS;
    __device__ __forceinline__ void operator()(const Acc& acc, const pg::Unit& u, int wr, int wc, int fr, int fq) const {
        const int row0 = u.orow + wr * 64 + fr, col0 = u.pn * 256 + wc * 32 + 4 * fq;
        const float* g1 = mod + (size_t)(u.orow >> 11) * 6144 + 2048;
        f32x4 gv[2][2];
#pragma unroll
        for (int bj = 0; bj < 2; ++bj)
#pragma unroll
            for (int n = 0; n < 2; ++n) gv[bj][n] = *(const f32x4*)(g1 + col0 + bj * 128 + n * 16);
#pragma unroll
        for (int ai = 0; ai < 2; ++ai)
#pragma unroll
            for (int m = 0; m < 4; ++m) {
                const int row = row0 + ai * 128 + m * 16; const size_t off = (size_t)row * D + col0; float s = 0.f;
#pragma unroll
                for (int bj = 0; bj < 2; ++bj)
#pragma unroll
                    for (int n = 0; n < 2; ++n) {
                        const f32x4 xv = *(const f32x4*)(x + off + bj * 128 + n * 16);
                        const f32x4 o = xv + gv[bj][n] * acc[ai][bj][m][n] * (float)DBG_MIX;
                        { u32x2 w; w.x = cvt_pk_bf16(o[0], o[1]); w.y = cvt_pk_bf16(o[2], o[3]); *(u32x2*)(X1 + off + bj * 128 + n * 16) = w; }
                        s += (o[0] * o[0] + o[1] * o[1]) + (o[2] * o[2] + o[3] * o[3]);
                    }
                s += __shfl_xor(s, 16); s += __shfl_xor(s, 32);
                if (fq == 0) SS[(size_t)row * 16 + u.pn * 4 + wc] = s;
            }
    }
};

struct MoeTab { LAS int* cnt; LAS int* tstart; LAS int* ent; };
__device__ __forceinline__ MoeTab moe_tab(LAS unsigned char* lds) { MoeTab t; t.cnt = (LAS int*)(lds + LDS_EXTRA_OFF); t.tstart = t.cnt + 32; t.ent = t.tstart + 64; return t; }
__device__ __forceinline__ void moe_tables(const Frame& F) {
    const MoeTab T = moe_tab(F.lds);
    if (threadIdx.x < 64) {
        const int lane = threadIdx.x;
        const int c = (lane < NE) ? (int)__hip_atomic_load(F.ctl + CW_CNT + 64 * lane, __ATOMIC_RELAXED, __HIP_MEMORY_SCOPE_AGENT) : 0;
        const int t = (c + 255) >> 8;
        int incl = t;
#pragma unroll
        for (int o = 1; o < 64; o <<= 1) { const int v = __shfl_up(incl, o); if (lane >= o) incl += v; }
        const int start = incl - t;
        if (lane < NE) { T.cnt[lane] = c; T.tstart[lane] = start; for (int k = 0; k < t; ++k) T.ent[start + k] = lane; }
        if (lane == NE) T.tstart[NE] = start;
    }
    __syncthreads();
}
constexpr int META_OFF = LDS_EXTRA_OFF + 2048, META_MAXU = 11;
__device__ __forceinline__ LAS float* meta_bias(LAS unsigned char* lds, int i, int stride) { return (LAS float*)(lds + META_OFF + i * stride); }
struct SchedGateUp {
    const unsigned char* W1T; const int* LIST; MoeTab T; int G, c; LAS unsigned char* lds;
    __device__ __forceinline__ bool next(int i, pg::Unit& u) const {
        int idx, pn; const int total = __builtin_amdgcn_readfirstlane(T.tstart[32]);
        if ((G & 7) == 0) { pn = c & 7; idx = (c >> 3) + (G >> 3) * i; if (idx >= total) return false; }
        else { const int L = i * G + c; if (L >= total * 8) return false; idx = L >> 3; pn = L & 7; }
        const int e = __builtin_amdgcn_readfirstlane(T.ent[idx]); const int ts = __builtin_amdgcn_readfirstlane(T.tstart[e]); const int mt = idx - ts;
        u.bptr = (const char*)(W1T + ((size_t)e * 2048 + (size_t)pn * 256) * D); u.arow = mt * 256; u.orow = ts * 256 + mt * 256; u.pn = pn; u.e = e;
        u.cnt = __builtin_amdgcn_readfirstlane(T.cnt[e]); u.pad = i; return true;
    }
    __device__ __forceinline__ void aoff(const pg::Unit& u, const int (&R)[2], const int (&C)[2], unsigned (&v)[2][2]) const {
        if (u.pad < META_MAXU) {
            const LAS int* L = (const LAS int*)(lds + META_OFF + u.pad * 2048 + 1024);
#pragma unroll
            for (int h = 0; h < 2; ++h)
#pragma unroll
                for (int i = 0; i < 2; ++i) v[h][i] = (unsigned)(L[h * 128 + R[i]] * D + 2 * C[i]);
        } else {
#pragma unroll
            for (int h = 0; h < 2; ++h)
#pragma unroll
                for (int i = 0; i < 2; ++i) {
                    int sl = u.arow + h * 128 + R[i]; sl = sl < u.cnt ? sl : u.cnt - 1;
                    const int tok = LIST[u.e * NTOK + sl];
                    v[h][i] = (unsigned)(tok * D + 2 * C[i]);
                }
        }
    }
    __device__ __forceinline__ void preload(const float* b1) const {
        pg::Unit u; const int t = threadIdx.x;
        for (int i = 0; i < META_MAXU; ++i) {
            if (!next(i, u)) break;
            LAS float* B = meta_bias(lds, i, 2048); LAS int* L = (LAS int*)(B + 256);
            if (t < 256) B[t] = b1[(size_t)u.e * 2048 + (t < 128 ? u.pn * 128 + t : 1024 + u.pn * 128 + (t - 128))];
            else { int sl = u.arow + (t - 256); sl = sl < u.cnt ? sl : u.cnt - 1; L[t - 256] = LIST[u.e * NTOK + sl]; }
        }
        __syncthreads();
    }
};
struct EpiGateUp {
    static constexpr bool PERM = true;
    const float* b1; unsigned char* ACT; LAS unsigned char* lds;
    __device__ __forceinline__ void operator()(const Acc& acc, const pg::Unit& u, int wr, int wc, int fr, int fq) const {
        const int col = u.pn * 128 + wc * 32 + 8 * fq;
        float vg[8], vu[8];
        if (u.pad < META_MAXU) { const LAS float* B = meta_bias(lds, u.pad, 2048) + wc * 32 + 8 * fq;
            const f32x4 g0 = *(const LAS f32x4*)B, g1 = *(const LAS f32x4*)(B + 4), u0 = *(const LAS f32x4*)(B + 128), u1 = *(const LAS f32x4*)(B + 132);
#pragma unroll
            for (int j = 0; j < 4; ++j) { vg[j] = g0[j]; vg[4 + j] = g1[j]; vu[j] = u0[j]; vu[4 + j] = u1[j]; } }
        else { const float* bg = b1 + (size_t)u.e * 2048 + col; const float* bu = bg + 1024;
#pragma unroll
            for (int j = 0; j < 8; ++j) { vg[j] = bg[j]; vu[j] = bu[j]; } }
        const int row0 = u.orow + wr * 64 + fr;
#pragma unroll
        for (int ai = 0; ai < 2; ++ai)
#pragma unroll
            for (int m = 0; m < 4; ++m) {
                float a[8];
#pragma unroll
                for (int n = 0; n < 2; ++n)
#pragma unroll
                    for (int j = 0; j < 4; ++j) {
                        float g = acc[ai][0][m][n][j] + vg[4 * n + j], up = acc[ai][1][m][n][j] + vu[4 * n + j];
                        g = fminf(g, 7.0f); up = clampf(up, -7.0f, 7.0f);
                        a[4 * n + j] = g * fast_rcp(1.0f + __expf(-1.702f * g)) * (up + 1.0f);
                    }
                u32x2 w; w.x = pack_fp8x4(a[0], a[1], a[2], a[3]); w.y = pack_fp8x4(a[4], a[5], a[6], a[7]);
                *(u32x2*)(ACT + (size_t)(row0 + ai * 128 + m * 16) * DE + col) = w;
            }
    }
};
struct SchedDown {
    const unsigned char* W2T; MoeTab T; int G, c; LAS unsigned char* lds;
    __device__ __forceinline__ void preload(const float* b2) const {
        pg::Unit u; const int t = threadIdx.x;
        for (int i = 0; i < 2 * META_MAXU; ++i) { if (!next(i, u)) break; if (t < 256) meta_bias(lds, i, 1024)[t] = b2[(size_t)u.e * D + u.pn * 256 + t]; }
        __syncthreads();
    }
    __device__ __forceinline__ bool next(int i, pg::Unit& u) const {
        int idx, pn; const int total = __builtin_amdgcn_readfirstlane(T.tstart[32]);
        if ((G & 7) == 0) { const int x = c & 7; pn = x & 3; idx = 2 * ((c >> 3) + (G >> 3) * i) + (x >> 2); if (idx >= total) return false; }
        else { const int L = i * G + c; if (L >= total * 4) return false; idx = L >> 2; pn = L & 3; }
        const int e = __builtin_amdgcn_readfirstlane(T.ent[idx]); const int ts = __builtin_amdgcn_readfirstlane(T.tstart[e]); const int mt = idx - ts;
        u.bptr = (const char*)(W2T + ((size_t)e * 1024 + (size_t)pn * 256) * DE); u.arow = ts * 256 + mt * 256; u.orow = u.arow; u.pn = pn; u.e = e; u.cnt = 0; u.pad = i; return true;
    }
    __device__ __forceinline__ void aoff(const pg::Unit& u, const int (&R)[2], const int (&C)[2], unsigned (&v)[2][2]) const {
#pragma unroll
        for (int h = 0; h < 2; ++h)
#pragma unroll
            for (int i = 0; i < 2; ++i) v[h][i] = (unsigned)((u.arow + h * 128 + R[i]) * DE + 2 * C[i]);
    }
};
struct EpiDown {
    static constexpr bool PERM = true;
    const float* b2; bf16_t* DOUT; LAS unsigned char* lds;
    __device__ __forceinline__ void operator()(const Acc& acc, const pg::Unit& u, int wr, int wc, int fr, int fq) const {
        const int col0 = u.pn * 256 + wc * 32 + 8 * fq; const int row0 = u.orow + wr * 64 + fr;
        float bv[2][8];
        if (u.pad < 2 * META_MAXU) { const LAS float* B = meta_bias(lds, u.pad, 1024) + wc * 32 + 8 * fq;
#pragma unroll
            for (int bj = 0; bj < 2; ++bj) { const f32x4 a = *(const LAS f32x4*)(B + bj * 128), b = *(const LAS f32x4*)(B + bj * 128 + 4);
#pragma unroll
                for (int j = 0; j < 4; ++j) { bv[bj][j] = a[j]; bv[bj][4 + j] = b[j]; } } }
        else
#pragma unroll
        for (int bj = 0; bj < 2; ++bj)
#pragma unroll
            for (int j = 0; j < 8; ++j) bv[bj][j] = b2[(size_t)u.e * D + col0 + bj * 128 + j];
#pragma unroll
        for (int ai = 0; ai < 2; ++ai)
#pragma unroll
            for (int m = 0; m < 4; ++m)
#pragma unroll
                for (int bj = 0; bj < 2; ++bj) {
                    const f32x4 v0 = acc[ai][bj][m][0], v1 = acc[ai][bj][m][1];
                    u32x4 w; w.x = cvt_pk_bf16(v0[0] + bv[bj][0], v0[1] + bv[bj][1]); w.y = cvt_pk_bf16(v0[2] + bv[bj][2], v0[3] + bv[bj][3]);
                    w.z = cvt_pk_bf16(v1[0] + bv[bj][4], v1[1] + bv[bj][5]); w.w = cvt_pk_bf16(v1[2] + bv[bj][6], v1[3] + bv[bj][7]);
                    *(u32x4*)(DOUT + (size_t)(row0 + ai * 128 + m * 16) * D + col0 + bj * 128) = w;
                }
    }
};

__device__ __forceinline__ void conv_tile(const float* src, int ld, int k0, int n0, bf16_t* dst, int drow0, LAS unsigned char* lds) {
    const int tid = threadIdx.x, p = tid >> 4, q = tid & 15;
    f32x4 v[4];
#pragma unroll
    for (int r = 0; r < 4; ++r) v[r] = *(const f32x4*)(src + (size_t)(k0 + 4 * p + r) * ld + n0 + 4 * q);
#pragma unroll
    for (int i = 0; i < 4; ++i) {
        u32x2 w; w.x = cvt_pk_bf16(v[0][i], v[1][i]); w.y = cvt_pk_bf16(v[2][i], v[3][i]);
        *(LAS u32x2*)(lds + (4 * q + i) * 256 + ((p ^ q) * 8)) = w;
    }
    __syncthreads();
#pragma unroll
    for (int jj = 0; jj < 2; ++jj) {
        const int n = (tid >> 4) + 32 * jj, c = tid & 15, qn = (n >> 2) & 15;
        u32x4 w = *(const LAS u32x4*)(lds + n * 256 + ((c ^ (qn >> 1)) * 16));
        if (qn & 1) { const unsigned t0 = w.x, t1 = w.y; w.x = w.z; w.y = w.w; w.z = t0; w.w = t1; }
        *(u32x4*)(dst + (size_t)(drow0 + n) * 1024 + k0 + 8 * c) = w;
    }
    __syncthreads();
}
constexpr int CONV_ITEMS = 32 * 128 + 32 * 64;
struct ConvDesc { const float* src; unsigned char* dst; int ld, k0, n0, drow0; };
__device__ __forceinline__ ConvDesc conv8_desc(const Frame& F, int it) {
    ConvDesc d;
    if (it < 4096) { const int e = it >> 7, r = it & 127, nt = r & 15, kt = r >> 4, n0 = nt * 128;
        d.src = F.w1 + (size_t)e * D * 2048; d.ld = 2048; d.k0 = kt * 128; d.n0 = n0; d.dst = F.W1T + (size_t)e * 2048 * D;
        d.drow0 = (n0 < 1024) ? ((n0 >> 7) * 256) : (((n0 - 1024) >> 7) * 256 + 128); }
    else { const int i2 = it - 4096, e = i2 >> 6, r = i2 & 63, nt = r & 7, kt = r >> 3;
        d.src = F.w2 + (size_t)e * DE * D; d.ld = 1024; d.k0 = kt * 128; d.n0 = nt * 128; d.dst = F.W2T + (size_t)e * D * DE; d.drow0 = nt * 128; }
    return d;
}
__device__ __forceinline__ void conv8_load(const ConvDesc& d, f32x4 (&v)[8]) {
    const int p = threadIdx.x >> 5, q = threadIdx.x & 31;
#pragma unroll
    for (int g = 0; g < 2; ++g)
#pragma unroll
        for (int r = 0; r < 4; ++r) v[4 * g + r] = *(const f32x4*)(d.src + (size_t)(d.k0 + 64 * g + 4 * p + r) * d.ld + d.n0 + 4 * q);
}
__device__ __forceinline__ void conv8_lds_write(const f32x4 (&v)[8], LAS unsigned char* buf) {
    const int p = threadIdx.x >> 5, q = threadIdx.x & 31;
#pragma unroll
    for (int g = 0; g < 2; ++g)
#pragma unroll
        for (int i = 0; i < 4; ++i)
            *(LAS unsigned*)(buf + (4 * q + i) * 128 + (((16 * g + p) ^ q) * 4)) = pack_fp8x4(32.f * v[4 * g][i], 32.f * v[4 * g + 1][i], 32.f * v[4 * g + 2][i], 32.f * v[4 * g + 3][i]);
}
__device__ __forceinline__ void conv8_store(const ConvDesc& d, const LAS unsigned char* buf) {
#pragma unroll
    for (int jj = 0; jj < 2; ++jj) {
        const int n = (threadIdx.x >> 3) + 64 * jj, c = threadIdx.x & 7, qn = (n >> 2) & 31;
        u32x4 w = *(const LAS u32x4*)(buf + n * 128 + ((c ^ (qn >> 2)) * 16));
        if (qn & 1) { unsigned t = w.x; w.x = w.y; w.y = t; t = w.z; w.z = w.w; w.w = t; }
        if (qn & 2) { unsigned t = w.x; w.x = w.z; w.z = t; t = w.y; w.y = w.w; w.w = t; }
        *(u32x4*)(d.dst + (size_t)(d.drow0 + n) * 1024 + d.k0 + 16 * c) = w;
    }
}
__device__ __forceinline__ void conv8_run(const Frame& F, int first, int stride, int n) {
    if (n <= 0) return;
    f32x4 vA[8], vB[8];
    const int last = first + (n - 1) * stride;
#define CV_IT(i) ((first + (i) * stride) < last ? (first + (i) * stride) : last)
    ConvDesc dA = conv8_desc(F, CV_IT(0)), dB = conv8_desc(F, CV_IT(1));
    conv8_load(dA, vA); conv8_load(dB, vB);
    for (int i = 0; i < n; i += 2) {
        conv8_lds_write(vA, F.lds);
        const ConvDesc dA2 = conv8_desc(F, CV_IT(i + 2)); conv8_load(dA2, vA);
        asm volatile("s_waitcnt lgkmcnt(0)" ::: "memory"); __builtin_amdgcn_s_barrier(); asm volatile("" ::: "memory");
        conv8_store(dA, F.lds);
        dA = dA2;
        conv8_lds_write(vB, F.lds + 16384);
        const ConvDesc dB2 = conv8_desc(F, CV_IT(i + 3)); conv8_load(dB2, vB);
        asm volatile("s_waitcnt lgkmcnt(0)" ::: "memory"); __builtin_amdgcn_s_barrier(); asm volatile("" ::: "memory");
        conv8_store(dB, F.lds + 16384);
        dB = dB2;
    }
#undef CV_IT
    __syncthreads();
}

__device__ __forceinline__ void mod_item(const Frame& F, int item) {
    LAS float* S = (LAS float*)F.lds;
    LAS float* RED = (LAS float*)(F.lds + 40960);
    const int tid = threadIdx.x, lane = tid & 63, wv = tid >> 6, c0 = item * 64;
    for (int idx = tid; idx < 9 * 1024; idx += NTHREADS) { const int r = idx >> 10, k = idx & 1023; const float v = (r < 8) ? F.c[r * 1024 + k] : F.c_ctx[k]; S[idx] = v * sigmoidf_(v); }
    __syncthreads();
    const int cq = tid & 15, kg = tid >> 4;
    f32x4 acc[9];
#pragma unroll
    for (int r = 0; r < 9; ++r) acc[r] = (f32x4){0.f, 0.f, 0.f, 0.f};
    for (int k = kg; k < 1024; k += 32) {
        const f32x4 wv4 = *(const f32x4*)(F.w_mod + (size_t)k * 6144 + c0 + 4 * cq);
#pragma unroll
        for (int r = 0; r < 9; ++r) acc[r] += S[r * 1024 + k] * wv4;
    }
#pragma unroll
    for (int r = 0; r < 9; ++r)
#pragma unroll
        for (int j = 0; j < 4; ++j) { float v = acc[r][j]; v += __shfl_xor(v, 16); v += __shfl_xor(v, 32); if (lane < 16) RED[(wv * 9 + r) * 64 + 4 * cq + j] = v; }
    __syncthreads();
    for (int idx = tid; idx < 9 * 64; idx += NTHREADS) {
        const int r = idx >> 6, cc = idx & 63; float s = F.b_mod[c0 + cc];
#pragma unroll
        for (int w8 = 0; w8 < 8; ++w8) s += RED[(w8 * 9 + r) * 64 + cc];
        F.mod[r * 6144 + c0 + cc] = s;
    }
    __syncthreads();
}
__device__ __forceinline__ void phase0(const Frame& F) {
    for (int item = blockIdx.x; item < 96 + 448 + 128; item += gridDim.x) {
        if (item < 96) mod_item(F, item);
        else if (item < 96 + 448) { const int it = item - 96, nt = it % 56, kt = it / 56;
            if (INPROJ_FP8) { if (nt & 1) continue;
                ConvDesc d; d.src = F.w_in; d.ld = DIN; d.k0 = kt * 128; d.n0 = nt * 64; d.dst = (unsigned char*)F.WinT; d.drow0 = nt * 64;
                f32x4 v[8]; conv8_load(d, v); conv8_lds_write(v, F.lds); __syncthreads(); conv8_store(d, F.lds); __syncthreads(); }
            else conv_tile(F.w_in, DIN, kt * 128, nt * 64, F.WinT, nt * 64, F.lds); }
        else { const int it = item - 544, nt = it & 15, kt = it >> 4; conv_tile(F.w_out, D, kt * 128, nt * 64, F.WoutT, nt * 64, F.lds); }
    }
}

__device__ __forceinline__ void phase1(const Frame& F) {
    const int lane = threadIdx.x & 63, wv = threadIdx.x >> 6;
    for (int r = blockIdx.x * 8 + wv; r < NROW; r += gridDim.x * 8) {
        const float* src; const float* md;
        if (r < NTOK) { src = F.x + (size_t)r * D; md = F.mod + (size_t)(r >> 11) * 6144; } else { src = F.ctx + (size_t)(r - NTOK) * D; md = F.mod + (size_t)8 * 6144; }
        f32x4 v[4]; float ss = 0.f;
#pragma unroll
        for (int j = 0; j < 4; ++j) { v[j] = *(const f32x4*)(src + 4 * lane + 256 * j); ss += (v[j][0] * v[j][0] + v[j][1] * v[j][1]) + (v[j][2] * v[j][2] + v[j][3] * v[j][3]); }
        ss = wave_sum(ss);
        const float rstd = __builtin_amdgcn_rsqf(ss * (1.0f / 1024.0f) + EPS);
#pragma unroll
        for (int j = 0; j < 4; ++j) {
            const int c = 4 * lane + 256 * j;
            const f32x4 nw = *(const f32x4*)(F.norm1 + c), sh = *(const f32x4*)(md + c), sc = *(const f32x4*)(md + 1024 + c);
            const f32x4 o = v[j] * rstd * nw * (1.0f + sc) + sh;
            if (INPROJ_FP8) *(unsigned*)((unsigned char*)F.H + (size_t)r * D + c) = pack_fp8x4(o[0], o[1], o[2], o[3]);
            else { u32x2 w; w.x = cvt_pk_bf16(o[0], o[1]); w.y = cvt_pk_bf16(o[2], o[3]); *(u32x2*)(F.H + (size_t)r * D + c) = w; }
        }
    }
}

__device__ __forceinline__ void phase4(const Frame& F) {
    const int lane = threadIdx.x & 63, wv = threadIdx.x >> 6;
    for (int t = blockIdx.x * 8 + wv; t < NTOK; t += gridDim.x * 8) {
        const size_t o = (size_t)t * GW + 8 * lane;
        const u32x4 fa = *(const u32x4*)(F.OF + o), fb = *(const u32x4*)(F.OB + o);
        const f32x4 s0 = (f32x4){bflo(fa.x) + bflo(fb.x), bfhi(fa.x) + bfhi(fb.x), bflo(fa.y) + bflo(fb.y), bfhi(fa.y) + bfhi(fb.y)};
        const f32x4 s1 = (f32x4){bflo(fa.z) + bflo(fb.z), bfhi(fa.z) + bfhi(fb.z), bflo(fa.w) + bflo(fb.w), bfhi(fa.w) + bfhi(fb.w)};
        float ss = (s0[0] * s0[0] + s0[1] * s0[1]) + (s0[2] * s0[2] + s0[3] * s0[3]) + (s1[0] * s1[0] + s1[1] * s1[1]) + (s1[2] * s1[2] + s1[3] * s1[3]);
        ss += __shfl_xor(ss, 1); ss += __shfl_xor(ss, 2); ss += __shfl_xor(ss, 4); ss += __shfl_xor(ss, 8);
        const float rstd = __builtin_amdgcn_rsqf(ss * (1.0f / 128.0f) + EPS);
        const f32x4 n0 = *(const f32x4*)(F.hgrn_norm + 8 * lane), n1 = *(const f32x4*)(F.hgrn_norm + 8 * lane + 4);
        const u32x4 g = *(const u32x4*)(F.GS + o);
        u32x4 w;
        w.x = cvt_pk_bf16(s0[0] * rstd * n0[0] * bflo(g.x), s0[1] * rstd * n0[1] * bfhi(g.x));
        w.y = cvt_pk_bf16(s0[2] * rstd * n0[2] * bflo(g.y), s0[3] * rstd * n0[3] * bfhi(g.y));
        w.z = cvt_pk_bf16(s1[0] * rstd * n1[0] * bflo(g.z), s1[1] * rstd * n1[1] * bfhi(g.z));
        w.w = cvt_pk_bf16(s1[2] * rstd * n1[2] * bflo(g.w), s1[3] * rstd * n1[3] * bfhi(g.w));
        *(u32x4*)(F.YCAT + (size_t)t * D + GW + 8 * lane) = w;
    }
}

__device__ __forceinline__ void phase6(const Frame& F) {
    LAS unsigned char* WH = F.lds;
    LAS unsigned char* WL = F.lds + 65536;
    LAS float* LG = (LAS float*)(F.lds + 131072);
    LAS float* RSTD = LG + 64 * 32;
    LAS float* B2 = RSTD + 64;
    LAS float* B2P = B2 + 32;
    LAS int* lcnt = (LAS int*)(B2P + 512);
    LAS int* lbase = lcnt + 32;
    LAS int* sel = lbase + 32;
    LAS float* selw = (LAS float*)(sel + 256);
    const int tid = threadIdx.x, lane = tid & 63, wv = __builtin_amdgcn_readfirstlane(tid >> 6), fr = lane & 15, fq = lane >> 4;
    if (tid < 32) lcnt[tid] = 0;
    int cur_b = -1;
    for (int rep6 = 0; rep6 < (DBG_REP6 ? 2 : 1); ++rep6)
    for (int grp = blockIdx.x; grp < NTOK / 64; grp += gridDim.x) {
        const int b = (grp * 64) >> 11;
        const float* md = F.mod + (size_t)b * 6144;
        if (b != cur_b) {
            cur_b = b;
            __syncthreads();
            const int e = tid & 31;
            float bp = 0.f;
            for (int it = 0; it < 8; ++it) {
                const int c0 = ((tid >> 5) + 16 * it) * 8;
                const f32x4 n0 = *(const f32x4*)(F.norm2 + c0), n1 = *(const f32x4*)(F.norm2 + c0 + 4), s0 = *(const f32x4*)(md + 4096 + c0), s1 = *(const f32x4*)(md + 4096 + c0 + 4);
                const f32x4 h0 = *(const f32x4*)(md + 3072 + c0), h1 = *(const f32x4*)(md + 3072 + c0 + 4);
                float wa[8], lo[8];
#pragma unroll
                for (int j = 0; j < 8; ++j) { const float rw = F.router_w[(size_t)(c0 + j) * NE + e]; const float a = (j < 4 ? n0[j] * (1.0f + s0[j]) : n1[j - 4] * (1.0f + s1[j - 4])); wa[j] = rw * a; bp += rw * (j < 4 ? h0[j] : h1[j - 4]); }
                u32x4 hw; hw.x = cvt_pk_bf16(wa[0], wa[1]); hw.y = cvt_pk_bf16(wa[2], wa[3]); hw.z = cvt_pk_bf16(wa[4], wa[5]); hw.w = cvt_pk_bf16(wa[6], wa[7]);
                lo[0] = wa[0] - bflo(hw.x); lo[1] = wa[1] - bfhi(hw.x); lo[2] = wa[2] - bflo(hw.y); lo[3] = wa[3] - bfhi(hw.y); lo[4] = wa[4] - bflo(hw.z); lo[5] = wa[5] - bfhi(hw.z); lo[6] = wa[6] - bflo(hw.w); lo[7] = wa[7] - bfhi(hw.w);
                u32x4 lw; lw.x = cvt_pk_bf16(lo[0], lo[1]); lw.y = cvt_pk_bf16(lo[2], lo[3]); lw.z = cvt_pk_bf16(lo[4], lo[5]); lw.w = cvt_pk_bf16(lo[6], lo[7]);
                const int off = e * 2048 + (((c0 >> 3) ^ (e & 15)) << 4);
                *(LAS u32x4*)(WH + off) = hw; *(LAS u32x4*)(WL + off) = lw;
            }
            B2P[(tid >> 5) * 32 + e] = bp;
            __syncthreads();
            if (tid < 32) { float sb = F.router_b[tid];
#pragma unroll
                for (int k = 0; k < 16; ++k) sb += B2P[k * 32 + tid];
                B2[tid] = sb; }
        }
        f32x4 ca[4], cs[4];
#pragma unroll
        for (int j = 0; j < 4; ++j) { const int c = 4 * lane + 256 * j; const f32x4 nw = *(const f32x4*)(F.norm2 + c), sc = *(const f32x4*)(md + 4096 + c); ca[j] = nw * (1.0f + sc); cs[j] = *(const f32x4*)(md + 3072 + c); }
#pragma unroll 2
        for (int i = 0; i < 8; ++i) {
            const int tl = wv * 8 + i, t = grp * 64 + tl;
            float ss = (lane < 16) ? F.SS[(size_t)t * 16 + lane] : 0.f;
            u32x2 xw[4];
#pragma unroll
            for (int j = 0; j < 4; ++j) xw[j] = *(const u32x2*)(F.X1 + (size_t)t * D + 4 * lane + 256 * j);
            ss = wave_sum(ss);
            const float rstd = __builtin_amdgcn_rsqf(ss * (1.0f / 1024.0f) + EPS);
            if (lane == 0) RSTD[tl] = rstd;
#pragma unroll
            for (int j = 0; j < 4; ++j) {
                const f32x4 xv = (f32x4){bflo(xw[j].x), bfhi(xw[j].x), bflo(xw[j].y), bfhi(xw[j].y)};
                const f32x4 hv = xv * rstd * ca[j] + cs[j];
                *(unsigned*)(F.H2 + (size_t)t * D + 4 * lane + 256 * j) = pack_fp8x4(hv[0], hv[1], hv[2], hv[3]);
            }
        }
        {
            const int mt = wv & 3, nt = wv >> 2;
            const bf16_t* xa = F.X1 + (size_t)(grp * 64 + 16 * mt + fr) * D + 8 * fq;
            const int erow = 16 * nt + fr;
            f32x4 acc = (f32x4){0.f, 0.f, 0.f, 0.f};
            u32x4 af[8], an[8];
#pragma unroll
            for (int k = 0; k < 8; ++k) af[k] = *(const u32x4*)(xa + 32 * k);
#pragma unroll
            for (int kb = 0; kb < 4; ++kb) {
                if (kb < 3) {
#pragma unroll
                    for (int k = 0; k < 8; ++k) an[k] = *(const u32x4*)(xa + 32 * (8 * (kb + 1) + k));
                }
#pragma unroll
                for (int k = 0; k < 8; ++k) {
                    const int ks = 8 * kb + k;
                    const int off = erow * 2048 + ((((32 * ks) >> 3) + fq) ^ (erow & 15)) * 16;
                    const bf16x8 bh = *(const LAS bf16x8*)(WH + off), bl = *(const LAS bf16x8*)(WL + off);
                    acc = __builtin_amdgcn_mfma_f32_16x16x32_bf16(__builtin_bit_cast(bf16x8, af[k]), bh, acc, 0, 0, 0);
                    acc = __builtin_amdgcn_mfma_f32_16x16x32_bf16(__builtin_bit_cast(bf16x8, af[k]), bl, acc, 0, 0, 0);
                }
                if (kb < 3) {
#pragma unroll
                    for (int k = 0; k < 8; ++k) af[k] = an[k];
                }
            }
            __syncthreads();
            const float b2 = B2[erow];
#pragma unroll
            for (int r = 0; r < 4; ++r) { const int tl = 16 * mt + 4 * fq + r; LG[tl * 32 + erow] = RSTD[tl] * acc[r] + b2; }
        }
        __syncthreads();
        for (int i = 0; i < 8; ++i) {
            const int tl = wv * 8 + i;
            const int myexp = (lane >> 1) & 31;
            const float v = LG[tl * 32 + myexp];
            int rank = 0;
#pragma unroll
            for (int e = 0; e < NE; ++e) { const float o = __builtin_bit_cast(float, __builtin_amdgcn_readlane(__builtin_bit_cast(int, v), 2 * e)); rank += (o > v || (o == v && e < myexp)) ? 1 : 0; }
            const bool even = (lane & 1) == 0;
            float tv[4]; int te[4];
#pragma unroll
            for (int k = 0; k < 4; ++k) { const unsigned long long bal = __ballot(even && rank == k); const int src = (__ffsll((long long)bal) - 1) & 63; tv[k] = __shfl(v, src); te[k] = src >> 1; }
            const float e1 = __expf(tv[1] - tv[0]), e2 = __expf(tv[2] - tv[0]), e3 = __expf(tv[3] - tv[0]);
            const float inv = 1.0f / (1.0f + e1 + e2 + e3);
            if (lane < 4 && rep6 == 0) {
                const int e = (lane == 0) ? te[0] : (lane == 1) ? te[1] : (lane == 2) ? te[2] : te[3];
                const float wgt = ((lane == 0) ? 1.0f : (lane == 1) ? e1 : (lane == 2) ? e2 : e3) * inv;
                const int rk = __hip_atomic_fetch_add(lcnt + e, 1, __ATOMIC_RELAXED, __HIP_MEMORY_SCOPE_WORKGROUP);
                sel[tl * 4 + lane] = e | (rk << 8); selw[tl * 4 + lane] = wgt;
            }
        }
        __syncthreads();
        if (tid < 32 && rep6 == 0) { const int n = lcnt[tid]; lbase[tid] = n ? (int)__hip_atomic_fetch_add(F.ctl + CW_CNT + 64 * tid, (unsigned)n, __ATOMIC_RELAXED, __HIP_MEMORY_SCOPE_AGENT) : 0; lcnt[tid] = 0; }
        __syncthreads();
        if (tid < 256 && rep6 == 0) {
            const int sv = sel[tid], e = sv & 255, idx = lbase[e] + (sv >> 8), t = grp * 64 + (tid >> 2);
            F.LIST[e * NTOK + idx] = t; F.TSLOT[t * 4 + (tid & 3)] = e * NTOK + idx; F.TW[t * 4 + (tid & 3)] = selw[tid];
        }
        __syncthreads();
    }
}

__device__ __forceinline__ void phase9(const Frame& F) {
    moe_tables(F);
    const MoeTab T = moe_tab(F.lds);
    const int lane = threadIdx.x & 63, wv = threadIdx.x >> 6;
    for (int t = blockIdx.x * 8 + wv; t < NTOK; t += gridDim.x * 8) {
        const float* g2 = F.mod + (size_t)(t >> 11) * 6144 + 5120;
        float y[2][8];
#pragma unroll
        for (int j = 0; j < 2; ++j)
#pragma unroll
            for (int i = 0; i < 8; ++i) y[j][i] = 0.f;
#pragma unroll
        for (int k = 0; k < (DBG_NO_MOE ? 0 : 4); ++k) {
            const int sl = F.TSLOT[t * 4 + k]; const float wk = F.TW[t * 4 + k];
            const int e = sl >> 14, idx = sl & (NTOK - 1);
            const size_t row = (size_t)(T.tstart[e] * 256 + idx);
#pragma unroll
            for (int j = 0; j < 2; ++j) {
                const u32x4 d = *(const u32x4*)(F.DOUT + row * D + 8 * lane + 512 * j);
                y[j][0] += wk * bflo(d.x); y[j][1] += wk * bfhi(d.x); y[j][2] += wk * bflo(d.y); y[j][3] += wk * bfhi(d.y);
                y[j][4] += wk * bflo(d.z); y[j][5] += wk * bfhi(d.z); y[j][6] += wk * bflo(d.w); y[j][7] += wk * bfhi(d.w);
            }
        }
        float xf[2][8]; float ss = 0.f;
#pragma unroll
        for (int j = 0; j < 2; ++j) {
            const int c = 8 * lane + 512 * j;
            const u32x4 xw = *(const u32x4*)(F.X1 + (size_t)t * D + c); const f32x4 x0 = (f32x4){bflo(xw.x), bfhi(xw.x), bflo(xw.y), bfhi(xw.y)}, x1v = (f32x4){bflo(xw.z), bfhi(xw.z), bflo(xw.w), bfhi(xw.w)};
            const f32x4 ga = *(const f32x4*)(g2 + c), gb = *(const f32x4*)(g2 + c + 4);
#pragma unroll
            for (int i = 0; i < 4; ++i) { xf[j][i] = x0[i] + ga[i] * y[j][i]; xf[j][4 + i] = x1v[i] + gb[i] * y[j][4 + i]; }
#pragma unroll
            for (int i = 0; i < 8; ++i) ss += xf[j][i] * xf[j][i];
        }
        ss = wave_sum(ss);
        const float rstd = __builtin_amdgcn_rsqf(ss * (1.0f / 1024.0f) + EPS);
#pragma unroll
        for (int j = 0; j < 2; ++j) {
            const int c = 8 * lane + 512 * j;
            const f32x4 fa = *(const f32x4*)(F.final_norm + c), fb = *(const f32x4*)(F.final_norm + c + 4);
            f32x4 o0, o1;
#pragma unroll
            for (int i = 0; i < 4; ++i) { o0[i] = xf[j][i] * rstd * fa[i]; o1[i] = xf[j][4 + i] * rstd * fb[i]; }
            *(f32x4*)(F.out + (size_t)t * D + c) = o0; *(f32x4*)(F.out + (size_t)t * D + c + 4) = o1;
        }
    }
}

__device__ __forceinline__ void sgu_item(const Frame& F, int item) {
    constexpr int RS = 272;
    LAS unsigned char* WL = F.lds;
    LAS unsigned char* VT = F.lds + 128 * RS;
    const int tid = threadIdx.x, lane = tid & 63, wv = __builtin_amdgcn_readfirstlane(tid >> 6), fr = lane & 15, fq = lane >> 4;
    const int h = item & 3, n = (item >> 2) & 15, b = item >> 6;
    const int row0 = b * SEQ + n * 128;
    {
        const int t = tid >> 2, s0 = (tid & 3) * 32;
        const float* wp = F.sgu_w + ((size_t)h * 128 + t) * 128 + s0;
#pragma unroll
        for (int j = 0; j < 4; ++j) {
            const f32x4 a = *(const f32x4*)(wp + 8 * j), c = *(const f32x4*)(wp + 8 * j + 4);
            u32x4 w; w.x = cvt_pk_bf16(a[0], a[1]); w.y = cvt_pk_bf16(a[2], a[3]); w.z = cvt_pk_bf16(c[0], c[1]); w.w = cvt_pk_bf16(c[2], c[3]);
            *(LAS u32x4*)(WL + t * RS + (s0 + 8 * j) * 2) = w;
        }
    }
    {
        const int s = tid >> 2, d0 = (tid & 3) * 32;
        const bf16_t* vp = F.VG + (size_t)(row0 + s) * GW + h * 128 + d0;
        float v[32];
#pragma unroll
        for (int j = 0; j < 4; ++j) { const u32x4 w = *(const u32x4*)(vp + 8 * j);
            v[8 * j + 0] = bflo(w.x); v[8 * j + 1] = bfhi(w.x); v[8 * j + 2] = bflo(w.y); v[8 * j + 3] = bfhi(w.y); v[8 * j + 4] = bflo(w.z); v[8 * j + 5] = bfhi(w.z); v[8 * j + 6] = bflo(w.w); v[8 * j + 7] = bfhi(w.w); }
        float sm = 0.f;
#pragma unroll
        for (int i = 0; i < 32; ++i) sm += v[i];
        sm += __shfl_xor(sm, 1); sm += __shfl_xor(sm, 2);
        const float mu = sm * (1.0f / 128.0f); float q = 0.f;
#pragma unroll
        for (int i = 0; i < 32; ++i) { const float dd = v[i] - mu; q += dd * dd; }
        q += __shfl_xor(q, 1); q += __shfl_xor(q, 2);
        const float rstd = __builtin_amdgcn_rsqf(q * (1.0f / 128.0f) + EPS);
        const float* lg = F.sgu_ln + h * 128 + d0;
#pragma unroll
        for (int i = 0; i < 32; i += 2) {
            const unsigned pk = cvt_pk_bf16((v[i] - mu) * rstd * lg[i], (v[i + 1] - mu) * rstd * lg[i + 1]);
            *(LAS unsigned short*)(VT + (d0 + i) * RS + s * 2) = (unsigned short)(pk & 0xffffu);
            *(LAS unsigned short*)(VT + (d0 + i + 1) * RS + s * 2) = (unsigned short)(pk >> 16);
        }
    }
    __syncthreads();
    f32x4 acc[8];
#pragma unroll
    for (int nt = 0; nt < 8; ++nt) acc[nt] = (f32x4){0.f, 0.f, 0.f, 0.f};
#pragma unroll
    for (int a = 0; a < 4; ++a) {
        const bf16x8 wf = *(const LAS bf16x8*)(WL + (16 * wv + fr) * RS + (32 * a + 8 * fq) * 2);
#pragma unroll
        for (int nt = 0; nt < 8; ++nt) {
            const bf16x8 vf = *(const LAS bf16x8*)(VT + (16 * nt + fr) * RS + (32 * a + 8 * fq) * 2);
            acc[nt] = __builtin_amdgcn_mfma_f32_16x16x32_bf16(vf, wf, acc[nt], 0, 0, 0);
        }
    }
    {
        const int t = 16 * wv + fr; const size_t row = (size_t)(row0 + t);
        const float bias = F.sgu_b[h * 128 + t];
#pragma unroll
        for (int nt = 0; nt < 8; ++nt) {
            const int d = h * 128 + 16 * nt + 4 * fq;
            const u32x2 uu = *(const u32x2*)(F.U + row * GW + d);
            u32x2 w; w.x = cvt_pk_bf16(bflo(uu.x) * (acc[nt][0] + bias), bfhi(uu.x) * (acc[nt][1] + bias)); w.y = cvt_pk_bf16(bflo(uu.y) * (acc[nt][2] + bias), bfhi(uu.y) * (acc[nt][3] + bias));
            *(u32x2*)(F.YCAT + row * D + d) = w;
        }
    }
    __syncthreads();
}

__device__ __forceinline__ float hexp(float x) { return fast_exp(clampf(x, -87.0f, 60.0f)); }
namespace hg {
constexpr int RS = 256, OFF_QP = 0, OFF_QA = 8192, OFF_QB = OFF_QA + 4096, OFF_QC = OFF_QB + 4096, OFF_KA = OFF_QC + 4096, OFF_KB = OFF_KA + 4096, OFF_KC = OFF_KB + 4096,
              KDS = 96, OFF_KDT = OFF_KC + 4096, OFF_D = OFF_KDT + 128 * KDS, BUF = OFF_D + 512;
constexpr int RRS = 272;
constexpr int RAW_OFF = 2 * BUF, RAWBUF = 2 * 32 * RRS;
__device__ __forceinline__ int swz(int row, int byteoff) { return row * RS + (byteoff ^ ((row & 15) << 4)); }
struct QK { u32x2 kk[2], q[2]; };
struct GV { u32x4 g, v; };
struct Ctx {
    LAS unsigned char* lds; const bf16_t *Gp, *Kp, *Ip, *Qp; bf16_t* Op;
    int b, dir, sgn, colw, h, w, fr, fq, tid, slot0, cend;
    bf16_t* qcum;
    bf16x8 tri0, tri1;
};
__device__ __forceinline__ int base_row(const Ctx& X, int c) {
    return c < 8 ? (NTOK + X.b * CTXL + (X.dir ? (CTXL - 1 - 32 * c) : 32 * c)) : (X.b * SEQ + (X.dir ? (SEQ - 1 - 32 * (c - 8)) : 32 * (c - 8)));
}
template <bool ALLLAT> __device__ __forceinline__ void load_qk(const Ctx& X, int c, QK& r) {
    const int base = base_row(X, c);
#pragma unroll
    for (int j = 0; j < 2; ++j) {
        const int row = base + X.sgn * (X.fr + 16 * j);
        const unsigned o = (unsigned)(row * GW + X.colw + 4 * X.fq) * 2u;
        r.kk[j] = *(const u32x2*)((const char*)X.Kp + o);
        if (ALLLAT) r.q[j] = *(const u32x2*)((const char*)X.Qp + o);
        else { const unsigned oq = (unsigned)((row < NTOK ? row : row - NTOK) * GW + X.colw + 4 * X.fq) * 2u; r.q[j] = *(const u32x2*)((const char*)X.Qp + oq); }
    }
}
__device__ __forceinline__ void load_gv(const Ctx& X, int c, GV& r) {
    const int base = base_row(X, c);
    const unsigned o = (unsigned)((base + X.sgn * (X.tid >> 4)) * GW + X.h * 128 + 8 * (X.tid & 15)) * 2u;
    r.g = *(const u32x4*)((const char*)X.Gp + o); r.v = *(const u32x4*)((const char*)X.Ip + o);
}
__device__ __forceinline__ void raw_write(const Ctx& X, int c, const GV& r) {
    LAS unsigned char* rb = X.lds + RAW_OFF + (c & 1) * RAWBUF + (X.tid >> 4) * RRS + (X.tid & 15) * 16;
    *(LAS u32x4*)(rb) = r.g; *(LAS u32x4*)(rb + 32 * RRS) = r.v;
}
template <bool LAT, bool CUM> __device__ __forceinline__ bf16x8 stage(const Ctx& X, int c, const QK& qk, f32x4& Bsum) {
    LAS unsigned char* buf = X.lds + (c & 1) * BUF;
    const LAS unsigned char* rg = X.lds + RAW_OFF + (c & 1) * RAWBUF + (16 * X.w + X.fr) * 2;
    const int fr = X.fr, fq = X.fq, w = X.w;
    constexpr bool lat = LAT;
    unsigned gs[8], vs[8];
#pragma unroll
    for (int jj = 0; jj < 8; ++jj) {
        const int p = (jj < 4) ? (4 * fq + jj) : (16 + 4 * fq + jj - 4);
        gs[jj] = *(const LAS unsigned short*)(rg + p * RRS); vs[jj] = *(const LAS unsigned short*)(rg + 32 * RRS + p * RRS);
    }
    bf16x8 gT, VTf;
    { u32x4 t; t.x = gs[0] | (gs[1] << 16); t.y = gs[2] | (gs[3] << 16); t.z = gs[4] | (gs[5] << 16); t.w = gs[6] | (gs[7] << 16); gT = __builtin_bit_cast(bf16x8, t);
      u32x4 u; u.x = vs[0] | (vs[1] << 16); u.y = vs[2] | (vs[3] << 16); u.z = vs[4] | (vs[5] << 16); u.w = vs[6] | (vs[7] << 16); VTf = __builtin_bit_cast(bf16x8, u); }
    const f32x4 z4 = (f32x4){0.f, 0.f, 0.f, 0.f};
    f32x4 bT[2];
    bT[0] = __builtin_amdgcn_mfma_f32_16x16x32_bf16(gT, X.tri0, z4, 0, 0, 0);
    bT[1] = __builtin_amdgcn_mfma_f32_16x16x32_bf16(gT, X.tri1, z4, 0, 0, 0);
    f32x4 b7, b15, b23, b31;
#pragma unroll
    for (int r = 0; r < 4; ++r) { b7[r] = __shfl(bT[0][r], 16 * fq + 7); b15[r] = __shfl(bT[0][r], 16 * fq + 15); b23[r] = __shfl(bT[1][r], 16 * fq + 7); b31[r] = __shfl(bT[1][r], 16 * fq + 15); }
#pragma unroll
    for (int j = 0; j < 2; ++j) {
        const float kv[4] = {bflo(qk.kk[j].x), bfhi(qk.kk[j].x), bflo(qk.kk[j].y), bfhi(qk.kk[j].y)};
        const float qv[4] = {bflo(qk.q[j].x), bfhi(qk.q[j].x), bflo(qk.q[j].y), bfhi(qk.q[j].y)};
        float kd[4], qp[4], qi[4], ki[4], x2[4];
#pragma unroll
        for (int r = 0; r < 4; ++r) {
            const float bt = bT[j][r], mref = (j == 0) ? b7[r] : b23[r];
            kd[r] = kv[r] * hexp(b31[r] - bt);
            qp[r] = qv[r] * hexp(bt);
            qi[r] = qv[r] * hexp(bt - mref);
            ki[r] = kv[r] * hexp(mref - bt);
            x2[r] = (j == 0) ? kv[r] * hexp(b15[r] - bt) : qv[r] * hexp(bt - b15[r]);
        }
        const int trow = fr + 16 * j;
        const unsigned kd01 = cvt_pk_bf16(kd[0], kd[1]), kd23 = cvt_pk_bf16(kd[2], kd[3]);
        LAS unsigned char* kdp = buf + OFF_KDT + (16 * w + 4 * fq) * KDS + (X.slot0 + 4 * j) * 2;
        *(LAS unsigned short*)(kdp) = (unsigned short)(kd01 & 0xffffu); *(LAS unsigned short*)(kdp + KDS) = (unsigned short)(kd01 >> 16);
        *(LAS unsigned short*)(kdp + 2 * KDS) = (unsigned short)(kd23 & 0xffffu); *(LAS unsigned short*)(kdp + 3 * KDS) = (unsigned short)(kd23 >> 16);
        if (lat) {
            { u32x2 wv; wv.x = cvt_pk_bf16(ki[0], ki[1]); wv.y = cvt_pk_bf16(ki[2], ki[3]); *(LAS u32x2*)(buf + (j == 0 ? OFF_KA : OFF_KB) + swz(fr, (16 * w + 4 * fq) * 2)) = wv; }
            { u32x2 wv; wv.x = cvt_pk_bf16(qp[0], qp[1]); wv.y = cvt_pk_bf16(qp[2], qp[3]); *(LAS u32x2*)(buf + OFF_QP + swz(trow, (32 * (w >> 1) + 8 * fq + 4 * (w & 1)) * 2)) = wv; }
            if (CUM) { u32x2 wv; wv.x = cvt_pk_bf16(qv[0] * hexp(bT[j][0] + Bsum[0]), qv[1] * hexp(bT[j][1] + Bsum[1])); wv.y = cvt_pk_bf16(qv[2] * hexp(bT[j][2] + Bsum[2]), qv[3] * hexp(bT[j][3] + Bsum[3]));
                *(u32x2*)((char*)X.qcum + (unsigned)((32 * (c - 36) + trow) * 128 + 32 * (w >> 1) + 8 * fq + 4 * (w & 1)) * 2u) = wv; }
            { u32x2 wv; wv.x = cvt_pk_bf16(qi[0], qi[1]); wv.y = cvt_pk_bf16(qi[2], qi[3]); *(LAS u32x2*)(buf + (j == 0 ? OFF_QA : OFF_QB) + swz(fr, (16 * w + 4 * fq) * 2)) = wv; }
            { u32x2 wv; wv.x = cvt_pk_bf16(x2[0], x2[1]); wv.y = cvt_pk_bf16(x2[2], x2[3]); *(LAS u32x2*)(buf + (j == 0 ? OFF_KC : OFF_QC) + swz(fr, (16 * w + 4 * fq) * 2)) = wv; }
        }
    }
    if (fr == 0) { f32x4 dv; dv[0] = hexp(b31[0]); dv[1] = hexp(b31[1]); dv[2] = hexp(b31[2]); dv[3] = hexp(b31[3]); *(LAS f32x4*)(buf + OFF_D + (16 * w + 4 * fq) * 4) = dv; }
    if (CUM) Bsum += b31;
    return VTf;
}
template <bool LAT> __device__ __forceinline__ void products(const Ctx& X, int c, const bf16x8 VTf, f32x4 (&S)[8]) {
    const LAS unsigned char* buf = X.lds + (c & 1) * BUF;
    const int fr = X.fr, fq = X.fq;
    const f32x4 z4 = (f32x4){0.f, 0.f, 0.f, 0.f};
    if (LAT) {
        f32x4 X00 = z4, X11 = z4, X01 = z4;
#pragma unroll
        for (int a = 0; a < 4; ++a) {
            const int co = swz(fr, (32 * a + 8 * fq) * 2);
            const bf16x8 ka = *(const LAS bf16x8*)(buf + OFF_KA + co), qa = *(const LAS bf16x8*)(buf + OFF_QA + co);
            const bf16x8 kb = *(const LAS bf16x8*)(buf + OFF_KB + co), qb = *(const LAS bf16x8*)(buf + OFF_QB + co);
            const bf16x8 kc = *(const LAS bf16x8*)(buf + OFF_KC + co), qc = *(const LAS bf16x8*)(buf + OFF_QC + co);
            X00 = __builtin_amdgcn_mfma_f32_16x16x32_bf16(ka, qa, X00, 0, 0, 0);
            X11 = __builtin_amdgcn_mfma_f32_16x16x32_bf16(kb, qb, X11, 0, 0, 0);
            X01 = __builtin_amdgcn_mfma_f32_16x16x32_bf16(kc, qc, X01, 0, 0, 0);
        }
#pragma unroll
        for (int r = 0; r < 4; ++r) { const bool keep = (4 * fq + r) <= fr; X00[r] = keep ? X00[r] : 0.f; X11[r] = keep ? X11[r] : 0.f; }
        bf16x8 P0, P1;
        { u32x4 t; t.x = cvt_pk_bf16(X00[0], X00[1]); t.y = cvt_pk_bf16(X00[2], X00[3]); t.z = 0u; t.w = 0u; P0 = __builtin_bit_cast(bf16x8, t);
          u32x4 u; u.x = cvt_pk_bf16(X01[0], X01[1]); u.y = cvt_pk_bf16(X01[2], X01[3]); u.z = cvt_pk_bf16(X11[0], X11[1]); u.w = cvt_pk_bf16(X11[2], X11[3]); P1 = __builtin_bit_cast(bf16x8, u); }
        f32x4 o0 = __builtin_amdgcn_mfma_f32_16x16x32_bf16(VTf, P0, z4, 0, 0, 0);
        f32x4 o1 = __builtin_amdgcn_mfma_f32_16x16x32_bf16(VTf, P1, z4, 0, 0, 0);
#pragma unroll
        for (int a = 0; a < 4; ++a) {
            u32x4 t; t.x = cvt_pk_bf16(S[2 * a][0], S[2 * a][1]); t.y = cvt_pk_bf16(S[2 * a][2], S[2 * a][3]); t.z = cvt_pk_bf16(S[2 * a + 1][0], S[2 * a + 1][1]); t.w = cvt_pk_bf16(S[2 * a + 1][2], S[2 * a + 1][3]);
            const bf16x8 Sb = __builtin_bit_cast(bf16x8, t);
            const bf16x8 qp0 = *(const LAS bf16x8*)(buf + OFF_QP + swz(fr, (32 * a + 8 * fq) * 2)), qp1 = *(const LAS bf16x8*)(buf + OFF_QP + swz(16 + fr, (32 * a + 8 * fq) * 2));
            o0 = __builtin_amdgcn_mfma_f32_16x16x32_bf16(Sb, qp0, o0, 0, 0, 0);
            o1 = __builtin_amdgcn_mfma_f32_16x16x32_bf16(Sb, qp1, o1, 0, 0, 0);
        }
        const int base = base_row(X, c);
        { u32x2 w0, w1; w0.x = cvt_pk_bf16(o0[0], o0[1]); w0.y = cvt_pk_bf16(o0[2], o0[3]); w1.x = cvt_pk_bf16(o1[0], o1[1]); w1.y = cvt_pk_bf16(o1[2], o1[3]);
          *(u32x2*)((char*)X.Op + (unsigned)((base + X.sgn * fr) * GW + X.colw + 4 * fq) * 2u) = w0;
          *(u32x2*)((char*)X.Op + (unsigned)((base + X.sgn * (fr + 16)) * GW + X.colw + 4 * fq) * 2u) = w1; }
    }
#pragma unroll
    for (int kt = 0; kt < 8; ++kt) {
        const bf16x8 kdf = *(const LAS bf16x8*)(buf + OFF_KDT + (16 * kt + fr) * KDS + 16 * fq);
        const f32x4 dv = *(const LAS f32x4*)(buf + OFF_D + (16 * kt + 4 * fq) * 4);
        S[kt] = __builtin_amdgcn_mfma_f32_16x16x32_bf16(kdf, VTf, S[kt] * dv, 0, 0, 0);
    }
}
__device__ __forceinline__ void lds_barrier() {
    asm volatile("s_waitcnt lgkmcnt(0)" ::: "memory"); __builtin_amdgcn_s_barrier(); asm volatile("" ::: "memory");
}
template <bool PL, bool SL, bool CUM> __device__ __forceinline__ void iter(const Ctx& X, int c, QK& qk, GV& gv, bf16x8& VTcur, f32x4 (&S)[8], f32x4& Bsum) {
    lds_barrier();
    products<PL>(X, c, VTcur, S);
    VTcur = stage<SL, CUM>(X, c + 1, qk, Bsum);
    load_qk<CUM>(X, c + 3 < X.cend ? c + 3 : X.cend - 1, qk);
    if (c + 2 < X.cend) raw_write(X, c + 2, gv);
    load_gv(X, c + 4 < X.cend ? c + 4 : X.cend - 1, gv);
}
}
template <int half> __device__ __forceinline__ void hgrn_chain(const Frame& F, int chain) {
    using namespace hg;
    Ctx X;
    X.lds = F.lds; X.tid = threadIdx.x; const int lane = X.tid & 63; X.w = __builtin_amdgcn_readfirstlane(X.tid >> 6); X.fr = lane & 15; X.fq = lane >> 4;
    X.dir = chain & 1; X.h = (chain >> 1) & 3; X.b = chain >> 3; X.sgn = X.dir ? -1 : 1; X.colw = X.h * 128 + 16 * X.w;
    X.Gp = X.dir ? F.GB : F.GF; X.Kp = X.dir ? F.KB : F.KF; X.Ip = F.I; X.Qp = F.Q; X.Op = X.dir ? F.OB : F.OF;
    X.slot0 = 8 * (X.fr >> 2) + (X.fr & 3);
    X.qcum = nullptr;
    X.cend = half ? 72 : 36;
#pragma unroll
    for (int jj = 0; jj < 8; ++jj) {
        X.tri0[jj] = (jj < 4 && 4 * X.fq + jj <= X.fr) ? (short)0x3F80 : (short)0;
        X.tri1[jj] = (jj < 4) ? (short)0x3F80 : ((4 * X.fq + jj - 4 <= X.fr) ? (short)0x3F80 : (short)0);
    }
    f32x4 S[8];
#pragma unroll
    for (int kt = 0; kt < 8; ++kt) S[kt] = (f32x4){0.f, 0.f, 0.f, 0.f};
    f32x4 Bsum = (f32x4){0.f, 0.f, 0.f, 0.f};
    QK qkA, qkB; GV gvA, gvB;
    load_gv(X, 0, gvA); load_gv(X, 1, gvB); load_qk<false>(X, 0, qkA); load_qk<false>(X, 1, qkB);
    raw_write(X, 0, gvA); load_gv(X, 2, gvA);
    lds_barrier();
    bf16x8 VTcur = stage<false, false>(X, 0, qkA, Bsum); load_qk<false>(X, 2, qkA);
    raw_write(X, 1, gvB); load_gv(X, 3, gvB);
    if constexpr (half == 0) {
        for (int c = 0; c < 6; c += 2) { iter<false, false, false>(X, c, qkB, gvA, VTcur, S, Bsum); iter<false, false, false>(X, c + 1, qkA, gvB, VTcur, S, Bsum); }
        iter<false, false, false>(X, 6, qkB, gvA, VTcur, S, Bsum); iter<false, true, false>(X, 7, qkA, gvB, VTcur, S, Bsum);
        for (int c = 8; c < 34; c += 2) { iter<true, true, false>(X, c, qkB, gvA, VTcur, S, Bsum); iter<true, true, false>(X, c + 1, qkA, gvB, VTcur, S, Bsum); }
        iter<true, true, false>(X, 34, qkB, gvA, VTcur, S, Bsum);
        lds_barrier();
        products<true>(X, 35, VTcur, S);
    } else {
        for (int c = 0; c < 34; c += 2) { iter<false, false, false>(X, c, qkB, gvA, VTcur, S, Bsum); iter<false, false, false>(X, c + 1, qkA, gvB, VTcur, S, Bsum); }
        iter<false, false, false>(X, 34, qkB, gvA, VTcur, S, Bsum); iter<false, true, false>(X, 35, qkA, gvB, VTcur, S, Bsum);
        for (int c = 36; c < 70; c += 2) { iter<true, true, false>(X, c, qkB, gvA, VTcur, S, Bsum); iter<true, true, false>(X, c + 1, qkA, gvB, VTcur, S, Bsum); }
        iter<true, true, false>(X, 70, qkB, gvA, VTcur, S, Bsum);
        lds_barrier();
        products<true>(X, 71, VTcur, S);
    }
    __syncthreads();
}

constexpr int CONV_PER_WG = CONV_ITEMS / 128;
#ifndef CONV_CHAIN_SHARE
#define CONV_CHAIN_SHARE 2
#endif
__device__ __forceinline__ void phase3(const Frame& F) {
    const int G = gridDim.x, bid = blockIdx.x;
    if (bid < 128) {
        if (bid & 1) hgrn_chain<1>(F, bid >> 1); else hgrn_chain<0>(F, bid >> 1);
        conv8_run(F, bid + 128 * (CONV_PER_WG - CONV_CHAIN_SHARE), 128, CONV_CHAIN_SHARE);
    } else {
        const int j = bid - 128, nw = G - 128;
        for (int rep = 0; rep < ((DBG_REP3 & 2) ? 2 : 1); ++rep) for (int item = j; item < 512; item += nw) sgu_item(F, item);
        if (j < 128) conv8_run(F, j, 128, CONV_PER_WG - CONV_CHAIN_SHARE);
    }
}

constexpr int N_PHASES = 10;
#ifndef DBG_NO_MOE
#define DBG_NO_MOE 0
#endif
#ifndef DBG_MAX_PHASE
#define DBG_MAX_PHASE 9
#endif
__global__ void __launch_bounds__(NTHREADS, 2) fwd_kernel(Args a) {
    extern __shared__ __attribute__((aligned(16))) unsigned char lds_raw[];
    Frame F;
    F.x = a.in[0]; F.c = a.in[1]; F.ctx = a.in[2]; F.c_ctx = a.in[3]; F.w_mod = a.in[4]; F.b_mod = a.in[5]; F.norm1 = a.in[6]; F.w_in = a.in[7]; F.sgu_ln = a.in[8]; F.sgu_w = a.in[9];
    F.sgu_b = a.in[10]; F.lb_fwd = a.in[11]; F.lb_bwd = a.in[12]; F.hgrn_norm = a.in[13]; F.w_out = a.in[14]; F.norm2 = a.in[15]; F.router_w = a.in[16]; F.router_b = a.in[17];
    F.w1 = a.in[18]; F.b1 = a.in[19]; F.w2 = a.in[20]; F.b2 = a.in[21]; F.final_norm = a.in[22];
    F.out = a.out; F.ws = a.ws; unsigned char* ws = a.ws;
    F.ctl = (unsigned*)(ws + WS_CTL); F.mod = (float*)(ws + WS_MOD);
    F.WinT = (bf16_t*)(ws + WS_WIN); F.WoutT = (bf16_t*)(ws + WS_WOUT); F.W1T = ws + WS_W1; F.W2T = ws + WS_W2;
    F.H = (bf16_t*)(ws + WS_H); F.U = (bf16_t*)(ws + WS_U); F.VG = (bf16_t*)(ws + WS_VG); F.Q = (bf16_t*)(ws + WS_Q); F.GS = (bf16_t*)(ws + WS_GS); F.I = (bf16_t*)(ws + WS_I);
    F.GF = (bf16_t*)(ws + WS_GF); F.KF = (bf16_t*)(ws + WS_KF); F.GB = (bf16_t*)(ws + WS_GB); F.KB = (bf16_t*)(ws + WS_KB);
    F.YCAT = (bf16_t*)(ws + WS_YCAT); F.H2 = ws + WS_H2; F.ACT = ws + WS_ACT; F.DOUT = (bf16_t*)(ws + WS_DOUT);
    F.OF = (bf16_t*)(ws + WS_OF); F.OB = (bf16_t*)(ws + WS_OB); F.X1 = (bf16_t*)(ws + WS_X1); F.SS = (float*)(ws + WS_SS); F.TW = (float*)(ws + WS_TW);
    F.LIST = (int*)(ws + WS_LIST); F.TSLOT = (int*)(ws + WS_TSLOT); F.QCUM = (bf16_t*)(ws + WS_QCUM); F.SMID = ws + WS_SMID;
    F.lds = (LAS unsigned char*)lds_raw;
    if (threadIdx.x < 64) ((LAS unsigned*)(F.lds + LDS_MISC_OFF))[threadIdx.x] = 0u;
    __syncthreads();
    const int lo = a.ph_lo, hi = a.ph_hi, G = gridDim.x, cid = blockIdx.x;
    XcdBarrier bar; bar.bar = F.ctl + CW_BAR; bar.x = 0; bar.st = nullptr;
    if (hi - lo > 1) bar = xcd_barrier_post(F.ctl + CW_BAR, (volatile LAS unsigned*)(F.lds + LDS_MISC_OFF));
#define IN(k) (lo <= (k) && (k) < hi)
#define SEAM(k) do { if (IN(k) && IN((k) + 1)) xcd_barrier(bar); } while (0)
#define REP(k) for (int _r = 0; _r < (((DBG_REP >> (k)) & 1) ? 2 : 1); ++_r)
    if (IN(0)) REP(0) phase0(F);
    SEAM(0);
    if (IN(1)) REP(1) phase1(F);
    SEAM(1);
    for (int _b = 0; _b < DBG_BARX; ++_b) xcd_barrier(bar);
    if (IN(2)) REP(2) {
        SchedInProj S{(const unsigned char*)F.WinT, G, cid}; EpiInProj E{F.U, F.VG, F.Q, F.GS, F.I, F.GF, F.KF, F.GB, F.KB, F.lb_fwd, F.lb_bwd};
        pg::gemm_phase<EpiInProj, SchedInProj, INPROJ_FP8 != 0>(F.lds, (const char*)F.H, D, S, E);
    }
    SEAM(2);
    if (IN(3)) REP(3) phase3(F);
    SEAM(3);
    if (IN(4)) REP(4) phase4(F);
    SEAM(4);
    if (IN(5)) REP(5) {
        SchedOutProj S{F.WoutT, G, cid}; EpiOutProj E{F.x, F.mod, F.X1, F.SS};
        pg::gemm_phase<EpiOutProj, SchedOutProj, false>(F.lds, (const char*)F.YCAT, D, S, E);
    }
    SEAM(5);
    if (IN(6)) phase6(F);
    SEAM(6);
    if (IN(7)) REP(7) {
        moe_tables(F);
        SchedGateUp S{F.W1T, F.LIST, moe_tab(F.lds), G, cid, F.lds}; EpiGateUp E{F.b1, F.ACT, F.lds};
        S.preload(F.b1);
        pg::gemm_phase<EpiGateUp, SchedGateUp, true>(F.lds, (const char*)F.H2, D, S, E);
    }
    SEAM(7);
    if (IN(8)) REP(8) {
        moe_tables(F);
        SchedDown S{F.W2T, moe_tab(F.lds), G, cid, F.lds}; EpiDown E{F.b2, F.DOUT, F.lds};
        S.preload(F.b2);
        pg::gemm_phase<EpiDown, SchedDown, true>(F.lds, (const char*)F.ACT, DE, S, E);
    }
    SEAM(8);
    if (IN(9)) REP(9) phase9(F);
#undef IN
#undef SEAM
}

extern "C" void kernel_launch(void* const* d_in, const int* in_sizes, int n_in, void* d_out, int out_size, void* d_ws, size_t ws_size, hipStream_t stream) {
    static int grid = 0;
    if (grid == 0) {
        if (n_in != 23 || in_sizes[0] != NTOK * D || out_size != NTOK * D || ws_size < WS_END) {
            fprintf(stderr, "kernel_launch: unexpected shapes / workspace (n_in %d, in0 %d, out %d, ws %zu, need %zu); nothing launched\n", n_in, n_in > 0 ? in_sizes[0] : -1, out_size, ws_size, (size_t)WS_END);
            grid = -1; return;
        }
        int dev = 0, cus = 0;
        if (hipGetDevice(&dev) != hipSuccess || hipDeviceGetAttribute(&cus, hipDeviceAttributeMultiprocessorCount, dev) != hipSuccess) { grid = -1; return; }
        if (hipFuncSetAttribute((const void*)fwd_kernel, hipFuncAttributeMaxDynamicSharedMemorySize, LDS_BYTES) != hipSuccess) { fprintf(stderr, "kernel_launch: hipFuncSetAttribute failed\n"); grid = -1; return; }
        (void)hipGetLastError();
        grid = cus;
        if (grid < 256) { fprintf(stderr, "kernel_launch: needs >= 256 CUs\n"); grid = -1; return; }
    }
    if (grid < 0) return;
    (void)hipMemsetAsync((char*)d_ws + WS_CTL, 0, CTL_BYTES, stream);
    Args a{};
    for (int i = 0; i < 23; ++i) a.in[i] = (const float*)d_in[i];
    a.out = (float*)d_out; a.ws = (unsigned char*)d_ws;
#if N_LAUNCH_MODE == 1
    a.ph_lo = 0; a.ph_hi = N_PHASES;
    hipLaunchKernelGGL(fwd_kernel, dim3(grid), dim3(NTHREADS), LDS_BYTES, stream, a);
#else
    for (int p = 0; p < N_PHASES; ++p) { if (DBG_NO_MOE && p >= 6 && p <= 8) continue; a.ph_lo = p; a.ph_hi = p + 1; hipLaunchKernelGGL(fwd_kernel, dim3(grid), dim3(NTHREADS), LDS_BYTES, stream, a); }
#endif
}
```

```cpp
#include <hip/hip_runtime.h>
#include <cstdio>
#include <cstdint>

#ifndef N_LAUNCH_MODE
#define N_LAUNCH_MODE 1
#endif

#ifndef DBG_NO_MOE
#define DBG_NO_MOE 0
#endif
#ifndef DBG_REP
#define DBG_REP 0
#endif
#ifndef DBG_REP3
#define DBG_REP3 0
#endif
#ifndef DBG_REP6
#define DBG_REP6 0
#endif
#ifndef DBG_BARX
#define DBG_BARX 0
#endif
#ifndef INPROJ_FP8
#define INPROJ_FP8 0
#endif
#ifndef DBG_MIX
#define DBG_MIX 1
#endif
#define LAS __attribute__((address_space(3)))
typedef unsigned short bf16_t;
typedef short bf16x8 __attribute__((ext_vector_type(8)));
typedef float f32x4 __attribute__((ext_vector_type(4)));
typedef float f32x2 __attribute__((ext_vector_type(2)));
typedef unsigned u32x4 __attribute__((ext_vector_type(4)));
typedef unsigned u32x2 __attribute__((ext_vector_type(2)));

constexpr int D = 1024, NB = 8, SEQ = 2048, CTXL = 256;
constexpr int NTOK = NB * SEQ;
constexpr int NCTX = NB * CTXL;
constexpr int NROW = NTOK + NCTX;
constexpr int DIN = 3584, GW = 512, NE = 32, DE = 1024, TOPK = 4;
constexpr int ACT_ROWS = NTOK * TOPK + NE * 256;
constexpr float EPS = 1e-6f;
constexpr int NTHREADS = 512;

constexpr int LDS_STAGE = 131072;
constexpr int LDS_EXTRA_OFF = LDS_STAGE;
constexpr int LDS_MISC_OFF = 155648;
constexpr int LDS_BYTES = LDS_MISC_OFF + 256;

constexpr size_t al256(size_t x) { return (x + 255) & ~(size_t)255; }
constexpr size_t WS_CTL = 0;
constexpr size_t CTL_BYTES = 65536;
constexpr int CW_BAR = 0;
constexpr int CW_CNT = 4096;
constexpr size_t WS_MOD = WS_CTL + CTL_BYTES;
constexpr size_t WS_WIN = WS_MOD + al256((size_t)9 * 6144 * 4);
constexpr size_t WS_WOUT = WS_WIN + (size_t)DIN * D * 2;
constexpr size_t WS_W1 = WS_WOUT + (size_t)D * D * 2;
constexpr size_t WS_W2 = WS_W1 + (size_t)NE * 2 * DE * D * 2;
constexpr size_t WS_YCAT = WS_W2 + (size_t)NE * D * DE * 2;
constexpr size_t WS_OF = WS_YCAT + (size_t)NTOK * D * 2;
constexpr size_t WS_OB = WS_OF + (size_t)NTOK * GW * 4;
constexpr size_t WS_X1 = WS_OB + (size_t)NTOK * GW * 4;
constexpr size_t WS_SS = WS_X1 + (size_t)NTOK * D * 4;
constexpr size_t WS_H2 = WS_SS + (size_t)NTOK * 16 * 4;
constexpr size_t WS_LIST = WS_H2 + (size_t)NTOK * D * 2;
constexpr size_t WS_TSLOT = WS_LIST + (size_t)NE * NTOK * 4;
constexpr size_t WS_TW = WS_TSLOT + (size_t)NTOK * 4 * 4;
constexpr size_t WS_QCUM = WS_TW + (size_t)NTOK * 4 * 4;
constexpr size_t WS_SMID = WS_QCUM + (size_t)64 * 1152 * 128 * 2;
constexpr size_t WS_ACT = WS_SMID + (size_t)64 * 8 * 4 * 64 * 16;
constexpr size_t WS_REGA = WS_ACT + (size_t)ACT_ROWS * DE * 2;
constexpr size_t WS_H = WS_REGA;
constexpr size_t WS_U = WS_H + (size_t)NROW * D * 2;
constexpr size_t WS_VG = WS_U + (size_t)NTOK * GW * 2;
constexpr size_t WS_Q = WS_VG + (size_t)NTOK * GW * 2;
constexpr size_t WS_GS = WS_Q + (size_t)NTOK * GW * 2;
constexpr size_t WS_I = WS_GS + (size_t)NTOK * GW * 2;
constexpr size_t WS_GF = WS_I + (size_t)NROW * GW * 2;
constexpr size_t WS_KF = WS_GF + (size_t)NROW * GW * 2;
constexpr size_t WS_GB = WS_KF + (size_t)NROW * GW * 2;
constexpr size_t WS_KB = WS_GB + (size_t)NROW * GW * 2;
constexpr size_t WS_REGA_END = WS_KB + (size_t)NROW * GW * 2;
constexpr size_t WS_DOUT = WS_REGA;
constexpr size_t WS_END0 = WS_DOUT + (size_t)ACT_ROWS * D * 2;
constexpr size_t WS_END = WS_END0 > WS_REGA_END ? WS_END0 : WS_REGA_END;

typedef __bf16 bf16x2_t __attribute__((ext_vector_type(2)));
__device__ __forceinline__ unsigned cvt_pk_bf16(float lo, float hi) { bf16x2_t v; v[0] = (__bf16)lo; v[1] = (__bf16)hi; return __builtin_bit_cast(unsigned, v); }
__device__ __forceinline__ float bf2f(unsigned b) { return __uint_as_float(b << 16); }
__device__ __forceinline__ float bflo(unsigned w) { return __uint_as_float(w << 16); }
__device__ __forceinline__ float bfhi(unsigned w) { return __uint_as_float(w & 0xffff0000u); }
__device__ __forceinline__ float fast_exp(float x) { return __builtin_amdgcn_exp2f(x * 1.44269504089f); }
__device__ __forceinline__ float fast_rcp(float x) { return __builtin_amdgcn_rcpf(x); }
__device__ __forceinline__ float sigmoidf_(float x) { return fast_rcp(1.0f + fast_exp(-x)); }
__device__ __forceinline__ float gelu_tanh(float x) { const float u = 1.5957691216f * (x + 0.044715f * x * x * x); return x * fast_rcp(1.0f + fast_exp(-u)); }
__device__ __forceinline__ float clampf(float x, float lo, float hi) { return fminf(fmaxf(x, lo), hi); }
__device__ __forceinline__ float wave_sum(float v) {
#pragma unroll
    for (int o = 32; o >= 1; o >>= 1) v += __shfl_xor(v, o);
    return v;
}
__device__ __forceinline__ unsigned pack_fp8x4(float a, float b, float c, float d) {
    a = __builtin_amdgcn_fmed3f(a, -448.f, 448.f); b = __builtin_amdgcn_fmed3f(b, -448.f, 448.f); c = __builtin_amdgcn_fmed3f(c, -448.f, 448.f); d = __builtin_amdgcn_fmed3f(d, -448.f, 448.f);
    int p = __builtin_amdgcn_cvt_pk_fp8_f32(a, b, 0, false); p = __builtin_amdgcn_cvt_pk_fp8_f32(c, d, p, true); return (unsigned)p;
}
#define VM_WAIT() asm volatile("s_waitcnt vmcnt(0)" ::: "memory")
#define LDS_WAIT() asm volatile("s_waitcnt lgkmcnt(0)" ::: "memory")

#define XB_TMO      128
#define XB_XCNT(j)  (256  + 64 * (j))
#define XB_XSUB(j)  (1280 + 64 * (j))
#define XB_XGEN(j)  (2304 + 64 * (j))
#define XB_TOP      3328
#define XB_TOPGEN   3392
#define XCD_BAR_WORDS 3456
#define XB_SPIN_CAP (1u << 18)
__device__ __forceinline__ unsigned xb_ld(unsigned* p)              { return __hip_atomic_load(p, __ATOMIC_RELAXED, __HIP_MEMORY_SCOPE_AGENT); }
__device__ __forceinline__ unsigned xb_add(unsigned* p, unsigned v) { return __hip_atomic_fetch_add(p, v, __ATOMIC_RELAXED, __HIP_MEMORY_SCOPE_AGENT); }
__device__ __forceinline__ unsigned xb_xcc_id() { return (unsigned)__builtin_amdgcn_s_getreg((3 << 11) | 20) & 0xFu; }
#define XB_SPIN(cond, bar) do { unsigned _sp = 0; while (cond) { __builtin_amdgcn_s_sleep(1); \
    if ((++_sp & 255u) == 0u) { if (xb_ld(&(bar)[XB_TMO])) break; if (_sp > XB_SPIN_CAP) { atomicAdd(&(bar)[XB_TMO], 1u); break; } } } } while (0)
struct XcdBarrier { unsigned* bar; unsigned x; volatile LAS unsigned* st; };
__device__ __forceinline__ XcdBarrier xcd_barrier_post(unsigned* bar, volatile LAS unsigned* st) {
    XcdBarrier b; b.bar = bar; b.x = xb_xcc_id(); b.st = st;
    if (threadIdx.x == 0) (void)xb_add(&bar[XB_XCNT(b.x)], 1u);
    return b;
}
__device__ __forceinline__ void xcd_barrier_complete(unsigned* bar, unsigned x, unsigned& nloc, unsigned& nx) {
    const unsigned G = gridDim.x * gridDim.y * gridDim.z;
    unsigned sum, cnt, mine, sp = 0u;
    for (;;) {
        sum = 0u; cnt = 0u; mine = 0u;
#pragma unroll
        for (unsigned j = 0; j < 16; ++j) { const unsigned c = xb_ld(&bar[XB_XCNT(j)]); sum += c; cnt += (c > 0u) ? 1u : 0u; mine = (j == x) ? c : mine; }
        if (sum == G) break;
        __builtin_amdgcn_s_sleep(1);
        if ((++sp & 255u) == 0u) { if (xb_ld(&bar[XB_TMO])) break; if (sp > XB_SPIN_CAP) { atomicAdd(&bar[XB_TMO], 1u); break; } }
    }
    nloc = mine > 0u ? mine : 1u; nx = cnt > 0u ? cnt : 1u;
}
__device__ __forceinline__ void xcd_barrier(const XcdBarrier& b) {
    asm volatile("s_waitcnt vmcnt(0)" ::: "memory");
    __syncthreads();
    if (threadIdx.x == 0) {
        unsigned* bar = b.bar;
        __builtin_amdgcn_s_waitcnt(0);
        unsigned nloc = b.st[0], nx = b.st[1];
        if (nloc == 0u) { xcd_barrier_complete(bar, b.x, nloc, nx); b.st[0] = nloc; b.st[1] = nx; }
        const unsigned old = xb_add(&bar[XB_XSUB(b.x)], 1u);
        const unsigned gen = old / nloc;
        if (old + 1u == (gen + 1u) * nloc) {
            __builtin_amdgcn_fence(__ATOMIC_RELEASE, "agent");
            asm volatile("s_waitcnt vmcnt(0)" ::: "memory");
            const unsigned og = xb_add(&bar[XB_TOP], 1u);
            const unsigned tg = og / nx;
            if (og + 1u == (tg + 1u) * nx) xb_add(&bar[XB_TOPGEN], 1u);
            else XB_SPIN(xb_ld(&bar[XB_TOPGEN]) == tg, bar);
            __builtin_amdgcn_fence(__ATOMIC_ACQUIRE, "agent");
            xb_add(&bar[XB_XGEN(b.x)], 1u);
            asm volatile("s_waitcnt vmcnt(0)" ::: "memory");
        } else {
            XB_SPIN(xb_ld(&bar[XB_XGEN(b.x)]) == gen, bar);
            __builtin_amdgcn_fence(__ATOMIC_ACQUIRE, "agent");
            asm volatile("s_waitcnt vmcnt(0)" ::: "memory");
        }
    }
    __syncthreads();
}

struct Args { const float* in[23]; float* out; unsigned char* ws; int ph_lo, ph_hi; };
struct Frame {
    const float *x, *c, *ctx, *c_ctx, *w_mod, *b_mod, *norm1, *w_in, *sgu_ln, *sgu_w, *sgu_b, *lb_fwd, *lb_bwd, *hgrn_norm, *w_out, *norm2,
                *router_w, *router_b, *w1, *b1, *w2, *b2, *final_norm;
    float* out; unsigned char* ws;
    unsigned* ctl; float* mod;
    bf16_t *WinT, *WoutT, *H, *U, *VG, *Q, *GS, *I, *GF, *KF, *GB, *KB, *YCAT, *DOUT;
    unsigned char *W1T, *W2T, *H2, *ACT;
    float *SS, *TW; bf16_t *OF, *OB, *X1;
    bf16_t* QCUM; unsigned char* SMID;
    int *LIST, *TSLOT;
    LAS unsigned char* lds;
};

namespace pg {
constexpr int BM = 256, BK = 64, HALF = 128, HTB = HALF * BK * 2, NXCD = 8, WGM = 8;
__device__ __forceinline__ int lds_byte(int r, int c) { const int st = (r >> 4) * 2 + (c >> 5), rr = r & 15, cc = c & 31, ob = rr * 64 + cc * 2; return st * 1024 + (ob ^ (((ob >> 9) & 1) << 5)); }
__device__ __forceinline__ void stage_rc(int b, int& R, int& C) { const int st = b / 1024, sb = b % 1024, swz = sb ^ (((sb >> 9) & 1) << 5); R = (st >> 1) * 16 + swz / 64; C = (st & 1) * 32 + (swz % 64) / 2; }
__device__ __forceinline__ int perm32(int rho) { const int n = rho >> 4, i = rho & 15; return 8 * (i >> 2) + 4 * n + (i & 3); }

struct Unit { const char* bptr; int arow, orow, pn, e, cnt, pad, kind, idx; };

__device__ __forceinline__ bool static_order(int nM, int nN, int L, int& pm, int& pn) {
    const int nwg = nM * nN; if (L >= nwg) return false;
    int wgid = L; { const int q = nwg / NXCD, r = nwg % NXCD, xcd = wgid % NXCD, off = wgid / NXCD; wgid = (xcd < r ? xcd * (q + 1) : r * (q + 1) + (xcd - r) * q) + off; }
    const int nig = WGM * nN, gid = wgid / nig, fm = gid * WGM, gsz = (nM - fm) < WGM ? (nM - fm) : WGM;
    pm = fm + ((wgid % nig) % gsz); pn = (wgid % nig) / gsz; return true;
}

typedef int v8i __attribute__((ext_vector_type(8)));
typedef int v4i __attribute__((ext_vector_type(4)));
template <class Epi, class Sched, bool FP8>
__device__ __forceinline__ void gemm_phase(LAS unsigned char* lds, const char* Abase, const int K, const Sched& S, const Epi& E) {
    const int tid = threadIdx.x, wid = __builtin_amdgcn_readfirstlane(tid >> 6), lane = tid & 63, wr = wid >> 2, wc = wid & 3, fr = lane & 15, fq = lane >> 4;
    const int pitch = FP8 ? K : 2 * K;
    const int nt = pitch / 128;
    int sR[2], sC[2]; unsigned voffB[2];
#pragma unroll
    for (int i = 0; i < 2; ++i) { stage_rc(tid * 16 + i * 8192, sR[i], sC[i]); const int Rb = Epi::PERM ? ((sR[i] & ~31) + perm32(sR[i] & 31)) : sR[i]; voffB[i] = (unsigned)(Rb * pitch + 2 * sC[i]); }
    const size_t kstep = (size_t)(BK * 2);
    const size_t hstep = (size_t)HALF * pitch;
    const unsigned ldsw = (unsigned)wid * 1024u;
    const int aoff = lds_byte(wr * 64 + fr, fq * 8), boff = lds_byte(wc * 32 + fr, fq * 8);
#define PG_SA(b, h) (((b) * 2 + (h)) * HTB)
#define PG_SB(b, h) ((4 + (b) * 2 + (h)) * HTB)
#define PG_STAGE(bufoff, gbase, voff) do { _Pragma("unroll") for (int _i = 0; _i < 2; ++_i) \
        __builtin_amdgcn_global_load_lds((const unsigned*)((const char*)(gbase) + (voff)[_i]), (LAS unsigned*)(lds + (bufoff) + ldsw + _i * 8192), 16, 0, 0); } while (0)
#define PG_LDA(dst, b, h) do { _Pragma("unroll") for (int m = 0; m < 4; ++m) { dst[m].lo = *(const LAS v4i*)(lds + PG_SA(b, h) + aoff + m * 2048); dst[m].hi = *(const LAS v4i*)(lds + PG_SA(b, h) + aoff + m * 2048 + 1024); } } while (0)
#define PG_LDB(dst, b, h) do { _Pragma("unroll") for (int n = 0; n < 2; ++n) { dst[n].lo = *(const LAS v4i*)(lds + PG_SB(b, h) + boff + n * 2048); dst[n].hi = *(const LAS v4i*)(lds + PG_SB(b, h) + boff + n * 2048 + 1024); } } while (0)
#define PG_MMA(ai, bj, At, Bt) do { __builtin_amdgcn_s_setprio(1); _Pragma("unroll") for (int m = 0; m < 4; ++m) _Pragma("unroll") for (int n = 0; n < 2; ++n) { \
        if constexpr (FP8) acc[ai][bj][m][n] = __builtin_amdgcn_mfma_scale_f32_16x16x128_f8f6f4(Bt[n], At[m], acc[ai][bj][m][n], 0, 0, 0, 0x7a7a7a7a, 0, 0x7f7f7f7f); \
        else { const v4i _bl = Bt[n].lo, _bh = Bt[n].hi, _al = At[m].lo, _ah = At[m].hi;     \
               acc[ai][bj][m][n] = __builtin_amdgcn_mfma_f32_16x16x32_bf16(__builtin_bit_cast(bf16x8, _bl), __builtin_bit_cast(bf16x8, _al), acc[ai][bj][m][n], 0, 0, 0); \
               acc[ai][bj][m][n] = __builtin_amdgcn_mfma_f32_16x16x32_bf16(__builtin_bit_cast(bf16x8, _bh), __builtin_bit_cast(bf16x8, _ah), acc[ai][bj][m][n], 0, 0, 0); } } \
        __builtin_amdgcn_s_setprio(0); } while (0)
#define PG_WAIT_V(n) asm volatile("s_waitcnt vmcnt(" #n ")" ::: "memory")
#define PG_WAIT_L(n) asm volatile("s_waitcnt lgkmcnt(" #n ")" ::: "memory")
#define PG_BAR __builtin_amdgcn_s_barrier()
#define PG_SCHED __builtin_amdgcn_sched_barrier(0)
    Unit cur, nxt, nn; int ui = 0;
    if (!S.next(0, cur)) return;
    bool has_next = S.next(1, nxt);
    unsigned vA[2][2], vN[2][2];
    S.a_ready(cur);
    S.aoff(cur, sR, sC, vA);
    if (has_next) S.aoff(nxt, sR, sC, vN); else { vN[0][0] = vA[0][0]; vN[0][1] = vA[0][1]; vN[1][0] = vA[1][0]; vN[1][1] = vA[1][1]; }
    f32x4 acc[2][2][4][2];
#pragma unroll
    for (int a = 0; a < 2; ++a)
#pragma unroll
        for (int b = 0; b < 2; ++b)
#pragma unroll
            for (int m = 0; m < 4; ++m)
#pragma unroll
                for (int n = 0; n < 2; ++n) acc[a][b][m][n] = (f32x4){0.f, 0.f, 0.f, 0.f};
    v8i At[4], B0[2], B1[2];
    const char* cB = cur.bptr;
    PG_STAGE(PG_SB(0, 0), cB, voffB); PG_STAGE(PG_SA(0, 0), Abase, vA[0]); PG_STAGE(PG_SB(0, 1), cB + hstep, voffB); PG_STAGE(PG_SA(0, 1), Abase, vA[1]);
    if (wr == 1) PG_BAR;
    PG_WAIT_V(4); PG_BAR;
    PG_STAGE(PG_SB(1, 0), cB + kstep, voffB); PG_STAGE(PG_SA(1, 0), Abase + kstep, vA[0]); PG_STAGE(PG_SB(1, 1), cB + hstep + kstep, voffB);
    PG_WAIT_V(6); PG_BAR;
    for (;;) {
        const char* nB = has_next ? nxt.bptr : cB;
#pragma unroll 1
        for (int t = 0; t < nt; t += 2) {
            const bool last = (t == nt - 2);
            if (last && has_next) S.a_ready(nxt);
            const char* a1 = Abase + (size_t)(t + 1) * kstep;
            const char* a2 = last ? Abase : Abase + (size_t)(t + 2) * kstep; const char* b2 = last ? nB : cB + (size_t)(t + 2) * kstep;
            const char* a3 = a2 + kstep; const char* b3 = b2 + kstep;
            PG_LDB(B0, 0, 0); PG_SCHED; PG_LDA(At, 0, 0); PG_STAGE(PG_SA(1, 1), a1, vA[1]);
            if (last) { vA[0][0] = vN[0][0]; vA[0][1] = vN[0][1]; vA[1][0] = vN[1][0]; vA[1][1] = vN[1][1]; }
            PG_WAIT_L(8); PG_BAR; PG_WAIT_L(0); PG_MMA(0, 0, At, B0); PG_BAR; PG_SCHED;
            PG_LDB(B1, 0, 1); PG_STAGE(PG_SB(0, 0), b2, voffB);
            PG_BAR; PG_WAIT_L(0); PG_MMA(0, 1, At, B1); PG_BAR;
            PG_LDA(At, 0, 1); PG_STAGE(PG_SA(0, 0), a2, vA[0]);
            PG_BAR; PG_WAIT_L(0); PG_MMA(1, 0, At, B0); PG_BAR; PG_SCHED;
            PG_STAGE(PG_SB(0, 1), b2 + hstep, voffB);
            PG_WAIT_V(6); PG_BAR; PG_MMA(1, 1, At, B1); PG_BAR;
            PG_LDB(B0, 1, 0); PG_SCHED; PG_LDA(At, 1, 0); PG_STAGE(PG_SA(0, 1), a2, vA[1]);
            PG_WAIT_L(8); PG_BAR; PG_WAIT_L(0); PG_MMA(0, 0, At, B0); PG_BAR; PG_SCHED;
            PG_LDB(B1, 1, 1); PG_STAGE(PG_SB(1, 0), b3, voffB);
            PG_BAR; PG_WAIT_L(0); PG_MMA(0, 1, At, B1); PG_BAR;
            PG_LDA(At, 1, 1); PG_STAGE(PG_SA(1, 0), a3, vA[0]);
            PG_BAR; PG_WAIT_L(0); PG_MMA(1, 0, At, B0); PG_BAR; PG_SCHED;
            PG_STAGE(PG_SB(1, 1), b3 + hstep, voffB);
            PG_WAIT_V(6); PG_BAR; PG_MMA(1, 1, At, B1); PG_BAR;
        }
        E(acc, cur, wr, wc, fr, fq);
        S.done(cur);
        if (!has_next) break;
#pragma unroll
        for (int a = 0; a < 2; ++a)
#pragma unroll
            for (int b = 0; b < 2; ++b)
#pragma unroll
                for (int m = 0; m < 4; ++m)
#pragma unroll
                    for (int n = 0; n < 2; ++n) acc[a][b][m][n] = (f32x4){0.f, 0.f, 0.f, 0.f};
        cur = nxt; cB = nB; ++ui;
        has_next = S.next(ui + 1, nn);
        if (has_next) { nxt = nn; S.aoff(nxt, sR, sC, vN); }
    }
    PG_WAIT_V(0);
    if (wr == 0) PG_BAR;
    PG_BAR;
#undef PG_SA
#undef PG_SB
#undef PG_STAGE
#undef PG_LDA
#undef PG_LDB
#undef PG_MMA
#undef PG_WAIT_V
#undef PG_WAIT_L
#undef PG_BAR
#undef PG_SCHED
}
}

typedef f32x4 Acc[2][2][4][2];

struct SchedInProj {
    __device__ __forceinline__ void a_ready(const pg::Unit&) const {}
    __device__ __forceinline__ void done(const pg::Unit&) const {}
    const unsigned char* WinT; int G, c;
    static constexpr int ESZ = INPROJ_FP8 ? 1 : 2;
    __device__ __forceinline__ bool next(int i, pg::Unit& u) const {
        const int L = i * G + c; int pm, pn;
        if (L < 64 * 14) { pg::static_order(64, 14, L, pm, pn); }
        else { const int x = L - 64 * 14; if (x >= 48) return false; pm = 64 + (x & 7); pn = 6 + (x >> 3); }
        u.bptr = (const char*)(WinT + (size_t)pn * 256 * D * ESZ); u.arow = pm * 256; u.orow = pm * 256; u.pn = pn; u.e = 0; u.cnt = 0; u.pad = 0; return true;
    }
    __device__ __forceinline__ void aoff(const pg::Unit& u, const int (&R)[2], const int (&C)[2], unsigned (&v)[2][2]) const {
#pragma unroll
        for (int h = 0; h < 2; ++h)
#pragma unroll
            for (int i = 0; i < 2; ++i) v[h][i] = (unsigned)((u.arow + h * 128 + R[i]) * D * ESZ + 2 * C[i]);
    }
};
struct EpiInProj {
    static constexpr bool PERM = true;
    bf16_t *U, *VG, *Q, *GS, *I, *GF, *KF, *GB, *KB; const float *lb_fwd, *lb_bwd;
    __device__ __forceinline__ void operator()(const Acc& acc, const pg::Unit& u, int wr, int wc, int fr, int fq) const {
        const int cg = u.pn >> 1;
        const int cbase = (u.pn & 1) * 256 + wc * 32 + 8 * fq;
        const int row0 = u.orow + wr * 64 + fr;
        if (cg == 3 || cg == 4) {
            const float* tab = (cg == 3) ? lb_fwd : lb_bwd; bf16_t* Gd = (cg == 3) ? GF : GB; bf16_t* Kd = (cg == 3) ? KF : KB;
#pragma unroll
            for (int bj = 0; bj < 2; ++bj) {
                const int col = cbase + bj * 128;
                float lb[8], omlb[8];
#pragma unroll
                for (int j = 0; j < 8; ++j) { const float t0 = tab[col + j], t1 = tab[GW + col + j]; lb[j] = fast_rcp(1.0f + __expf(t1 - t0)); omlb[j] = 1.0f - lb[j]; }
#pragma unroll
                for (int ai = 0; ai < 2; ++ai)
#pragma unroll
                    for (int m = 0; m < 4; ++m) {
                        const size_t off = (size_t)(row0 + ai * 128 + m * 16) * GW + col;
                        float gv[8], kv[8];
#pragma unroll
                        for (int n = 0; n < 2; ++n)
#pragma unroll
                            for (int j = 0; j < 4; ++j) {
                                const float z = clampf(acc[ai][bj][m][n][j], -30.f, 30.f);
                                const float e = __expf(-z), s = fast_rcp(1.0f + e), oms = e * s;
                                const float f = lb[4 * n + j] + omlb[4 * n + j] * s;
                                gv[4 * n + j] = __logf(f); kv[4 * n + j] = omlb[4 * n + j] * oms;
                            }
                        u32x4 wg, wk;
                        wg.x = cvt_pk_bf16(gv[0], gv[1]); wg.y = cvt_pk_bf16(gv[2], gv[3]); wg.z = cvt_pk_bf16(gv[4], gv[5]); wg.w = cvt_pk_bf16(gv[6], gv[7]);
                        wk.x = cvt_pk_bf16(kv[0], kv[1]); wk.y = cvt_pk_bf16(kv[2], kv[3]); wk.z = cvt_pk_bf16(kv[4], kv[5]); wk.w = cvt_pk_bf16(kv[6], kv[7]);
                        *(u32x4*)(Gd + off) = wg; *(u32x4*)(Kd + off) = wk;
                    }
            }
        } else {
            bf16_t* Od = (cg == 0) ? U : (cg == 1) ? VG : (cg == 2) ? Q : (cg == 5) ? I : GS;
            const int act = (cg <= 1) ? 1 : (cg == 6) ? 2 : 0;
#pragma unroll
            for (int ai = 0; ai < 2; ++ai)
#pragma unroll
                for (int m = 0; m < 4; ++m)
#pragma unroll
                    for (int bj = 0; bj < 2; ++bj) {
                        const size_t off = (size_t)(row0 + ai * 128 + m * 16) * GW + cbase + bj * 128;
                        float v[8];
#pragma unroll
                        for (int n = 0; n < 2; ++n)
#pragma unroll
                            for (int j = 0; j < 4; ++j) { float z = acc[ai][bj][m][n][j]; if (act == 1) z = gelu_tanh(z); else if (act == 2) z = z * sigmoidf_(z); v[4 * n + j] = z; }
                        u32x4 w; w.x = cvt_pk_bf16(v[0], v[1]); w.y = cvt_pk_bf16(v[2], v[3]); w.z = cvt_pk_bf16(v[4], v[5]); w.w = cvt_pk_bf16(v[6], v[7]);
                        *(u32x4*)(Od + off) = w;
                    }
        }
    }
};

struct SchedOutProj {
    __device__ __forceinline__ void a_ready(const pg::Unit&) const {}
    __device__ __forceinline__ void done(const pg::Unit&) const {}
    const bf16_t* WoutT; int G, c;
    __device__ __forceinline__ bool next(int i, pg::Unit& u) const {
        const int L = i * G + c; int pm, pn; if (!pg::static_order(64, 4, L, pm, pn)) return false;
        u.bptr = (const char*)(WoutT + (size_t)pn * 256 * D); u.arow = pm * 256; u.orow = pm * 256; u.pn = pn; u.e = 0; u.cnt = 0; u.pad = 0; return true;
    }
    __device__ __forceinline__ void aoff(const pg::Unit& u, const int (&R)[2], const int (&C)[2], unsigned (&v)[2][2]) const {
#pragma unroll
        for (int h = 0; h < 2; ++h)
#pragma unroll
            for (int i = 0; i < 2; ++i) v[h][i] = (unsigned)((u.arow + h * 128 + R[i]) * D + C[i]) * 2u;
    }
};
struct EpiOutProj {
    static constexpr bool PERM = false;
    const float* x; const float* mod; bf16_t* X1; float* SS;
    __device__ __forceinline__ void operator()(const Acc& acc, const pg::Unit& u, int wr, int wc, int fr, int fq) const {
        const int row0 = u.orow + wr * 64 + fr, col0 = u.pn * 256 + wc * 32 + 4 * fq;
        const float* g1 = mod + (size_t)(u.orow >> 11) * 6144 + 2048;
        f32x4 gv[2][2];
#pragma unroll
        for (int bj = 0; bj < 2; ++bj)
#pragma unroll
            for (int n = 0; n < 2; ++n) gv[bj][n] = *(const f32x4*)(g1 + col0 + bj * 128 + n * 16);
#pragma unroll
        for (int ai = 0; ai < 2; ++ai)
#pragma unroll
            for (int m = 0; m < 4; ++m) {
                const int row = row0 + ai * 128 + m * 16; const size_t off = (size_t)row * D + col0; float s = 0.f;
#pragma unroll
                for (int bj = 0; bj < 2; ++bj)
#pragma unroll
                    for (int n = 0; n < 2; ++n) {
                        const f32x4 xv = *(const f32x4*)(x + off + bj * 128 + n * 16);
                        const f32x4 o = xv + gv[bj][n] * acc[ai][bj][m][n] * (float)DBG_MIX;
                        { u32x2 w; w.x = cvt_pk_bf16(o[0], o[1]); w.y = cvt_pk_bf16(o[2], o[3]); *(u32x2*)(X1 + off + bj * 128 + n * 16) = w; }
                        s += (o[0] * o[0] + o[1] * o[1]) + (o[2] * o[2] + o[3] * o[3]);
                    }
                s += __shfl_xor(s, 16); s += __shfl_xor(s, 32);
                if (fq == 0) SS[(size_t)row * 16 + u.pn * 4 + wc] = s;
            }
    }
};

struct MoeTab { LAS int* cnt; LAS int* tstart; LAS int* ent; };
__device__ __forceinline__ MoeTab moe_tab(LAS unsigned char* lds) { MoeTab t; t.cnt = (LAS int*)(lds + LDS_EXTRA_OFF); t.tstart = t.cnt + 32; t.ent = t.tstart + 64; return t; }
__device__ __forceinline__ void moe_tables(const Frame& F) {
    const MoeTab T = moe_tab(F.lds);
    if (threadIdx.x < 64) {
        const int lane = threadIdx.x;
        const int c = (lane < NE) ? (int)__hip_atomic_load(F.ctl + CW_CNT + 64 * lane, __ATOMIC_RELAXED, __HIP_MEMORY_SCOPE_AGENT) : 0;
        const int t = (c + 255) >> 8;
        int incl = t;
#pragma unroll
        for (int o = 1; o < 64; o <<= 1) { const int v = __shfl_up(incl, o); if (lane >= o) incl += v; }
        const int start = incl - t;
        if (lane < NE) { T.cnt[lane] = c; T.tstart[lane] = start; for (int k = 0; k < t; ++k) T.ent[start + k] = lane; }
        if (lane == NE) T.tstart[NE] = start;
    }
    __syncthreads();
}
constexpr int META_OFF = LDS_EXTRA_OFF + 2048, META_MAXU = 11;
__device__ __forceinline__ LAS float* meta_bias(LAS unsigned char* lds, int i, int stride) { return (LAS float*)(lds + META_OFF + i * stride); }
constexpr int CW_RDY = 8192;
constexpr int MOE_MAXGU = 10, MOE_MAXD = 6;
struct SchedMoe {
    const unsigned char *W1T, *W2T; const int* LIST; MoeTab T; int G, c; LAS unsigned char* lds; unsigned* ctl; unsigned aH2, aACT; int nGU;
    __device__ __forceinline__ int total() const { return __builtin_amdgcn_readfirstlane(T.tstart[32]); }
    __device__ __forceinline__ void init() { const int tot = total(), j = c >> 3, per = G >> 3; nGU = (j < tot) ? (tot - j + per - 1) / per : 0; }
    __device__ __forceinline__ bool next(int i, pg::Unit& u) const {
        const int tot = total(), per = G >> 3, x = c & 7, j = c >> 3;
        int idx, pn, kind;
        if (i < nGU) { kind = 0; pn = x; idx = j + per * i; }
        else { kind = 1; pn = x & 3; idx = 2 * ((per - 1 - j) + per * (i - nGU)) + (x >> 2); if (idx >= tot) return false; }
        const int e = __builtin_amdgcn_readfirstlane(T.ent[idx]); const int ts = __builtin_amdgcn_readfirstlane(T.tstart[e]); const int mt = idx - ts;
        u.kind = kind; u.idx = idx; u.pn = pn; u.e = e; u.orow = ts * 256 + mt * 256; u.pad = i;
        if (kind == 0) { u.bptr = (const char*)(W1T + ((size_t)e * 2048 + (size_t)pn * 256) * D); u.arow = mt * 256; u.cnt = __builtin_amdgcn_readfirstlane(T.cnt[e]); }
        else { u.bptr = (const char*)(W2T + ((size_t)e * 1024 + (size_t)pn * 256) * DE); u.arow = u.orow; u.cnt = 0; }
        return true;
    }
    __device__ __forceinline__ int meta_off(const pg::Unit& u) const {
        if (u.kind == 0) return (u.pad < MOE_MAXGU) ? META_OFF + u.pad * 1536 : -1;
        const int k = u.pad - nGU, ng = nGU < MOE_MAXGU ? nGU : MOE_MAXGU; return (k < MOE_MAXD) ? META_OFF + ng * 1536 + k * 1024 : -1;
    }
    __device__ __forceinline__ void aoff(const pg::Unit& u, const int (&R)[2], const int (&C)[2], unsigned (&v)[2][2]) const {
        if (u.kind == 1) {
#pragma unroll
            for (int h = 0; h < 2; ++h)
#pragma unroll
                for (int i = 0; i < 2; ++i) v[h][i] = aACT + (unsigned)((u.arow + h * 128 + R[i]) * DE + 2 * C[i]);
            return;
        }
        const int mo = meta_off(u);
        if (mo >= 0) {
            const LAS unsigned short* L = (const LAS unsigned short*)(lds + mo + 1024);
#pragma unroll
            for (int h = 0; h < 2; ++h)
#pragma unroll
                for (int i = 0; i < 2; ++i) v[h][i] = aH2 + (unsigned)((int)L[h * 128 + R[i]] * D + 2 * C[i]);
        } else {
#pragma unroll
            for (int h = 0; h < 2; ++h)
#pragma unroll
                for (int i = 0; i < 2; ++i) { int sl = u.arow + h * 128 + R[i]; sl = sl < u.cnt ? sl : u.cnt - 1; v[h][i] = aH2 + (unsigned)(LIST[u.e * NTOK + sl] * D + 2 * C[i]); }
        }
    }
    __device__ __forceinline__ void preload(const float* b1, const float* b2) const {
        pg::Unit u; const int t = threadIdx.x;
        for (int i = 0; i < MOE_MAXGU + MOE_MAXD + 8; ++i) {
            if (!next(i, u)) break;
            const int mo = meta_off(u); if (mo < 0) continue;
            LAS float* B = (LAS float*)(lds + mo);
            if (u.kind == 0) {
                if (t < 256) B[t] = b1[(size_t)u.e * 2048 + (t < 128 ? u.pn * 128 + t : 1024 + u.pn * 128 + (t - 128))];
                else { int sl = u.arow + (t - 256); sl = sl < u.cnt ? sl : u.cnt - 1; ((LAS unsigned short*)(B + 256))[t - 256] = (unsigned short)LIST[u.e * NTOK + sl]; }
            } else if (t < 256) B[t] = b2[(size_t)u.e * D + u.pn * 256 + t];
        }
        __syncthreads();
    }
    __device__ __forceinline__ void a_ready(const pg::Unit& u) const {
        if (u.kind != 1) return;
        if (threadIdx.x < 64) {
            unsigned* w = ctl + CW_RDY + 16 * u.idx; unsigned sp = 0;
            while ((unsigned)__builtin_amdgcn_readfirstlane(__hip_atomic_load(w, __ATOMIC_RELAXED, __HIP_MEMORY_SCOPE_AGENT)) < 64u) { __builtin_amdgcn_s_sleep(2); if (++sp > (1u << 22)) break; }
            __builtin_amdgcn_fence(__ATOMIC_ACQUIRE, "agent");
            asm volatile("s_waitcnt vmcnt(0)" ::: "memory");
        }
        asm volatile("" ::: "memory"); __builtin_amdgcn_s_barrier(); asm volatile("" ::: "memory");
    }
    __device__ __forceinline__ void done(const pg::Unit& u) const {
        if (u.kind != 0) return;
        asm volatile("s_waitcnt vmcnt(0)" ::: "memory");
        if ((threadIdx.x & 63) == 0) __hip_atomic_fetch_add(ctl + CW_RDY + 16 * u.idx, 1u, __ATOMIC_RELAXED, __HIP_MEMORY_SCOPE_AGENT);
    }
};
struct EpiMoe {
    static constexpr bool PERM = true;
    const float *b1, *b2; unsigned char* ACT; bf16_t* DOUT; LAS unsigned char* lds; const SchedMoe* S;
    __device__ __forceinline__ void operator()(const Acc& acc, const pg::Unit& u, int wr, int wc, int fr, int fq) const {
        const int mo = S->meta_off(u);
        const int row0 = u.orow + wr * 64 + fr;
        if (u.kind == 0) {
            const int col = u.pn * 128 + wc * 32 + 8 * fq;
            float vg[8], vu[8];
            if (mo >= 0) { const LAS float* B = (const LAS float*)(lds + mo) + wc * 32 + 8 * fq;
                const f32x4 g0 = *(const LAS f32x4*)B, g1 = *(const LAS f32x4*)(B + 4), u0 = *(const LAS f32x4*)(B + 128), u1 = *(const LAS f32x4*)(B + 132);
#pragma unroll
                for (int j = 0; j < 4; ++j) { vg[j] = g0[j]; vg[4 + j] = g1[j]; vu[j] = u0[j]; vu[4 + j] = u1[j]; } }
            else { const float* bg = b1 + (size_t)u.e * 2048 + col; const float* bu = bg + 1024;
#pragma unroll
                for (int j = 0; j < 8; ++j) { vg[j] = bg[j]; vu[j] = bu[j]; } }
#pragma unroll
            for (int ai = 0; ai < 2; ++ai)
#pragma unroll
                for (int m = 0; m < 4; ++m) {
                    float a[8];
#pragma unroll
                    for (int n = 0; n < 2; ++n)
#pragma unroll
                        for (int j = 0; j < 4; ++j) {
                            float g = acc[ai][0][m][n][j] + vg[4 * n + j], up = acc[ai][1][m][n][j] + vu[4 * n + j];
                            g = fminf(g, 7.0f); up = clampf(up, -7.0f, 7.0f);
                            a[4 * n + j] = g * fast_rcp(1.0f + __expf(-1.702f * g)) * (up + 1.0f);
                        }
                    const unsigned long long w = (unsigned long long)pack_fp8x4(a[0], a[1], a[2], a[3]) | ((unsigned long long)pack_fp8x4(a[4], a[5], a[6], a[7]) << 32);
                    __hip_atomic_store((unsigned long long*)(ACT + (size_t)(row0 + ai * 128 + m * 16) * DE + col), w, __ATOMIC_RELAXED, __HIP_MEMORY_SCOPE_AGENT);
                }
        } else {
            const int col0 = u.pn * 256 + wc * 32 + 8 * fq;
            float bv[2][8];
            if (mo >= 0) { const LAS float* B = (const LAS float*)(lds + mo) + wc * 32 + 8 * fq;
#pragma unroll
                for (int bj = 0; bj < 2; ++bj) { const f32x4 a = *(const LAS f32x4*)(B + bj * 128), b = *(const LAS f32x4*)(B + bj * 128 + 4);
#pragma unroll
                    for (int j = 0; j < 4; ++j) { bv[bj][j] = a[j]; bv[bj][4 + j] = b[j]; } } }
            else {
#pragma unroll
                for (int bj = 0; bj < 2; ++bj)
#pragma unroll
                    for (int j = 0; j < 8; ++j) bv[bj][j] = b2[(size_t)u.e * D + col0 + bj * 128 + j]; }
#pragma unroll
            for (int ai = 0; ai < 2; ++ai)
#pragma unroll
                for (int m = 0; m < 4; ++m)
#pragma unroll
                    for (int bj = 0; bj < 2; ++bj) {
                        const f32x4 v0 = acc[ai][bj][m][0], v1 = acc[ai][bj][m][1];
                        u32x4 w; w.x = cvt_pk_bf16(v0[0] + bv[bj][0], v0[1] + bv[bj][1]); w.y = cvt_pk_bf16(v0[2] + bv[bj][2], v0[3] + bv[bj][3]);
                        w.z = cvt_pk_bf16(v1[0] + bv[bj][4], v1[1] + bv[bj][5]); w.w = cvt_pk_bf16(v1[2] + bv[bj][6], v1[3] + bv[bj][7]);
                        *(u32x4*)(DOUT + (size_t)(row0 + ai * 128 + m * 16) * D + col0 + bj * 128) = w;
                    }
        }
    }
};

__device__ __forceinline__ void conv_tile(const float* src, int ld, int k0, int n0, bf16_t* dst, int drow0, LAS unsigned char* lds) {
    const int tid = threadIdx.x, p = tid >> 4, q = tid & 15;
    f32x4 v[4];
#pragma unroll
    for (int r = 0; r < 4; ++r) v[r] = *(const f32x4*)(src + (size_t)(k0 + 4 * p + r) * ld + n0 + 4 * q);
#pragma unroll
    for (int i = 0; i < 4; ++i) {
        u32x2 w; w.x = cvt_pk_bf16(v[0][i], v[1][i]); w.y = cvt_pk_bf16(v[2][i], v[3][i]);
        *(LAS u32x2*)(lds + (4 * q + i) * 256 + ((p ^ q) * 8)) = w;
    }
    __syncthreads();
#pragma unroll
    for (int jj = 0; jj < 2; ++jj) {
        const int n = (tid >> 4) + 32 * jj, c = tid & 15, qn = (n >> 2) & 15;
        u32x4 w = *(const LAS u32x4*)(lds + n * 256 + ((c ^ (qn >> 1)) * 16));
        if (qn & 1) { const unsigned t0 = w.x, t1 = w.y; w.x = w.z; w.y = w.w; w.z = t0; w.w = t1; }
        *(u32x4*)(dst + (size_t)(drow0 + n) * 1024 + k0 + 8 * c) = w;
    }
    __syncthreads();
}
constexpr int CONV_ITEMS = 32 * 128 + 32 * 64;
struct ConvDesc { const float* src; unsigned char* dst; int ld, k0, n0, drow0; };
__device__ __forceinline__ ConvDesc conv8_desc(const Frame& F, int it) {
    ConvDesc d;
    if (it < 4096) { const int e = it >> 7, r = it & 127, nt = r & 15, kt = r >> 4, n0 = nt * 128;
        d.src = F.w1 + (size_t)e * D * 2048; d.ld = 2048; d.k0 = kt * 128; d.n0 = n0; d.dst = F.W1T + (size_t)e * 2048 * D;
        d.drow0 = (n0 < 1024) ? ((n0 >> 7) * 256) : (((n0 - 1024) >> 7) * 256 + 128); }
    else { const int i2 = it - 4096, e = i2 >> 6, r = i2 & 63, nt = r & 7, kt = r >> 3;
        d.src = F.w2 + (size_t)e * DE * D; d.ld = 1024; d.k0 = kt * 128; d.n0 = nt * 128; d.dst = F.W2T + (size_t)e * D * DE; d.drow0 = nt * 128; }
    return d;
}
__device__ __forceinline__ void conv8_load(const ConvDesc& d, f32x4 (&v)[8]) {
    const int p = threadIdx.x >> 5, q = threadIdx.x & 31;
#pragma unroll
    for (int g = 0; g < 2; ++g)
#pragma unroll
        for (int r = 0; r < 4; ++r) v[4 * g + r] = *(const f32x4*)(d.src + (size_t)(d.k0 + 64 * g + 4 * p + r) * d.ld + d.n0 + 4 * q);
}
__device__ __forceinline__ void conv8_lds_write(const f32x4 (&v)[8], LAS unsigned char* buf) {
    const int p = threadIdx.x >> 5, q = threadIdx.x & 31;
#pragma unroll
    for (int g = 0; g < 2; ++g)
#pragma unroll
        for (int i = 0; i < 4; ++i)
            *(LAS unsigned*)(buf + (4 * q + i) * 128 + (((16 * g + p) ^ q) * 4)) = pack_fp8x4(32.f * v[4 * g][i], 32.f * v[4 * g + 1][i], 32.f * v[4 * g + 2][i], 32.f * v[4 * g + 3][i]);
}
__device__ __forceinline__ void conv8_store(const ConvDesc& d, const LAS unsigned char* buf) {
#pragma unroll
    for (int jj = 0; jj < 2; ++jj) {
        const int n = (threadIdx.x >> 3) + 64 * jj, c = threadIdx.x & 7, qn = (n >> 2) & 31;
        u32x4 w = *(const LAS u32x4*)(buf + n * 128 + ((c ^ (qn >> 2)) * 16));
        if (qn & 1) { unsigned t = w.x; w.x = w.y; w.y = t; t = w.z; w.z = w.w; w.w = t; }
        if (qn & 2) { unsigned t = w.x; w.x = w.z; w.z = t; t = w.y; w.y = w.w; w.w = t; }
        *(u32x4*)(d.dst + (size_t)(d.drow0 + n) * 1024 + d.k0 + 16 * c) = w;
    }
}
__device__ __forceinline__ void conv8_run(const Frame& F, int first, int stride, int n) {
    if (n <= 0) return;
    f32x4 vA[8], vB[8];
    const int last = first + (n - 1) * stride;
#define CV_IT(i) ((first + (i) * stride) < last ? (first + (i) * stride) : last)
    ConvDesc dA = conv8_desc(F, CV_IT(0)), dB = conv8_desc(F, CV_IT(1));
    conv8_load(dA, vA); conv8_load(dB, vB);
    for (int i = 0; i < n; i += 2) {
        conv8_lds_write(vA, F.lds);
        const ConvDesc dA2 = conv8_desc(F, CV_IT(i + 2)); conv8_load(dA2, vA);
        asm volatile("s_waitcnt lgkmcnt(0)" ::: "memory"); __builtin_amdgcn_s_barrier(); asm volatile("" ::: "memory");
        conv8_store(dA, F.lds);
        dA = dA2;
        conv8_lds_write(vB, F.lds + 16384);
        const ConvDesc dB2 = conv8_desc(F, CV_IT(i + 3)); conv8_load(dB2, vB);
        asm volatile("s_waitcnt lgkmcnt(0)" ::: "memory"); __builtin_amdgcn_s_barrier(); asm volatile("" ::: "memory");
        conv8_store(dB, F.lds + 16384);
        dB = dB2;
    }
#undef CV_IT
    __syncthreads();
}

__device__ __forceinline__ void mod_item(const Frame& F, int item) {
    LAS float* S = (LAS float*)F.lds;
    LAS float* RED = (LAS float*)(F.lds + 40960);
    const int tid = threadIdx.x, lane = tid & 63, wv = tid >> 6, c0 = item * 64;
    for (int idx = tid; idx < 9 * 1024; idx += NTHREADS) { const int r = idx >> 10, k = idx & 1023; const float v = (r < 8) ? F.c[r * 1024 + k] : F.c_ctx[k]; S[idx] = v * sigmoidf_(v); }
    __syncthreads();
    const int cq = tid & 15, kg = tid >> 4;
    f32x4 acc[9];
#pragma unroll
    for (int r = 0; r < 9; ++r) acc[r] = (f32x4){0.f, 0.f, 0.f, 0.f};
    for (int k = kg; k < 1024; k += 32) {
        const f32x4 wv4 = *(const f32x4*)(F.w_mod + (size_t)k * 6144 + c0 + 4 * cq);
#pragma unroll
        for (int r = 0; r < 9; ++r) acc[r] += S[r * 1024 + k] * wv4;
    }
#pragma unroll
    for (int r = 0; r < 9; ++r)
#pragma unroll
        for (int j = 0; j < 4; ++j) { float v = acc[r][j]; v += __shfl_xor(v, 16); v += __shfl_xor(v, 32); if (lane < 16) RED[(wv * 9 + r) * 64 + 4 * cq + j] = v; }
    __syncthreads();
    for (int idx = tid; idx < 9 * 64; idx += NTHREADS) {
        const int r = idx >> 6, cc = idx & 63; float s = F.b_mod[c0 + cc];
#pragma unroll
        for (int w8 = 0; w8 < 8; ++w8) s += RED[(w8 * 9 + r) * 64 + cc];
        F.mod[r * 6144 + c0 + cc] = s;
    }
    __syncthreads();
}
__device__ __forceinline__ void phase0(const Frame& F) {
    for (int item = blockIdx.x; item < 96 + 448 + 128; item += gridDim.x) {
        if (item < 96) mod_item(F, item);
        else if (item < 96 + 448) { const int it = item - 96, nt = it % 56, kt = it / 56;
            if (INPROJ_FP8) { if (nt & 1) continue;
                ConvDesc d; d.src = F.w_in; d.ld = DIN; d.k0 = kt * 128; d.n0 = nt * 64; d.dst = (unsigned char*)F.WinT; d.drow0 = nt * 64;
                f32x4 v[8]; conv8_load(d, v); conv8_lds_write(v, F.lds); __syncthreads(); conv8_store(d, F.lds); __syncthreads(); }
            else conv_tile(F.w_in, DIN, kt * 128, nt * 64, F.WinT, nt * 64, F.lds); }
        else { const int it = item - 544, nt = it & 15, kt = it >> 4; conv_tile(F.w_out, D, kt * 128, nt * 64, F.WoutT, nt * 64, F.lds); }
    }
}

__device__ __forceinline__ void phase1(const Frame& F) {
    const int lane = threadIdx.x & 63, wv = threadIdx.x >> 6;
    for (int r = blockIdx.x * 8 + wv; r < NROW; r += gridDim.x * 8) {
        const float* src; const float* md;
        if (r < NTOK) { src = F.x + (size_t)r * D; md = F.mod + (size_t)(r >> 11) * 6144; } else { src = F.ctx + (size_t)(r - NTOK) * D; md = F.mod + (size_t)8 * 6144; }
        f32x4 v[4]; float ss = 0.f;
#pragma unroll
        for (int j = 0; j < 4; ++j) { v[j] = *(const f32x4*)(src + 4 * lane + 256 * j); ss += (v[j][0] * v[j][0] + v[j][1] * v[j][1]) + (v[j][2] * v[j][2] + v[j][3] * v[j][3]); }
        ss = wave_sum(ss);
        const float rstd = __builtin_amdgcn_rsqf(ss * (1.0f / 1024.0f) + EPS);
#pragma unroll
        for (int j = 0; j < 4; ++j) {
            const int c = 4 * lane + 256 * j;
            const f32x4 nw = *(const f32x4*)(F.norm1 + c), sh = *(const f32x4*)(md + c), sc = *(const f32x4*)(md + 1024 + c);
            const f32x4 o = v[j] * rstd * nw * (1.0f + sc) + sh;
            if (INPROJ_FP8) *(unsigned*)((unsigned char*)F.H + (size_t)r * D + c) = pack_fp8x4(o[0], o[1], o[2], o[3]);
            else { u32x2 w; w.x = cvt_pk_bf16(o[0], o[1]); w.y = cvt_pk_bf16(o[2], o[3]); *(u32x2*)(F.H + (size_t)r * D + c) = w; }
        }
    }
}

__device__ __forceinline__ void phase4(const Frame& F) {
    const int lane = threadIdx.x & 63, wv = threadIdx.x >> 6;
    for (int t = blockIdx.x * 8 + wv; t < NTOK; t += gridDim.x * 8) {
        const size_t o = (size_t)t * GW + 8 * lane;
        const u32x4 fa = *(const u32x4*)(F.OF + o), fb = *(const u32x4*)(F.OB + o);
        const f32x4 s0 = (f32x4){bflo(fa.x) + bflo(fb.x), bfhi(fa.x) + bfhi(fb.x), bflo(fa.y) + bflo(fb.y), bfhi(fa.y) + bfhi(fb.y)};
        const f32x4 s1 = (f32x4){bflo(fa.z) + bflo(fb.z), bfhi(fa.z) + bfhi(fb.z), bflo(fa.w) + bflo(fb.w), bfhi(fa.w) + bfhi(fb.w)};
        float ss = (s0[0] * s0[0] + s0[1] * s0[1]) + (s0[2] * s0[2] + s0[3] * s0[3]) + (s1[0] * s1[0] + s1[1] * s1[1]) + (s1[2] * s1[2] + s1[3] * s1[3]);
        ss += __shfl_xor(ss, 1); ss += __shfl_xor(ss, 2); ss += __shfl_xor(ss, 4); ss += __shfl_xor(ss, 8);
        const float rstd = __builtin_amdgcn_rsqf(ss * (1.0f / 128.0f) + EPS);
        const f32x4 n0 = *(const f32x4*)(F.hgrn_norm + 8 * lane), n1 = *(const f32x4*)(F.hgrn_norm + 8 * lane + 4);
        const u32x4 g = *(const u32x4*)(F.GS + o);
        u32x4 w;
        w.x = cvt_pk_bf16(s0[0] * rstd * n0[0] * bflo(g.x), s0[1] * rstd * n0[1] * bfhi(g.x));
        w.y = cvt_pk_bf16(s0[2] * rstd * n0[2] * bflo(g.y), s0[3] * rstd * n0[3] * bfhi(g.y));
        w.z = cvt_pk_bf16(s1[0] * rstd * n1[0] * bflo(g.z), s1[1] * rstd * n1[1] * bfhi(g.z));
        w.w = cvt_pk_bf16(s1[2] * rstd * n1[2] * bflo(g.w), s1[3] * rstd * n1[3] * bfhi(g.w));
        *(u32x4*)(F.YCAT + (size_t)t * D + GW + 8 * lane) = w;
    }
}

__device__ __forceinline__ void phase6(const Frame& F) {
    LAS unsigned char* WH = F.lds;
    LAS unsigned char* WL = F.lds + 65536;
    LAS float* LG = (LAS float*)(F.lds + 131072);
    LAS float* RSTD = LG + 64 * 32;
    LAS float* B2 = RSTD + 64;
    LAS float* B2P = B2 + 32;
    LAS int* lcnt = (LAS int*)(B2P + 512);
    LAS int* lbase = lcnt + 32;
    LAS int* sel = lbase + 32;
    LAS float* selw = (LAS float*)(sel + 256);
    const int tid = threadIdx.x, lane = tid & 63, wv = __builtin_amdgcn_readfirstlane(tid >> 6), fr = lane & 15, fq = lane >> 4;
    if (tid < 32) lcnt[tid] = 0;
    int cur_b = -1;
    for (int rep6 = 0; rep6 < (DBG_REP6 ? 2 : 1); ++rep6)
    for (int grp = blockIdx.x; grp < NTOK / 64; grp += gridDim.x) {
        const int b = (grp * 64) >> 11;
        const float* md = F.mod + (size_t)b * 6144;
        if (b != cur_b) {
            cur_b = b;
            __syncthreads();
            const int e = tid & 31;
            float bp = 0.f;
            for (int it = 0; it < 8; ++it) {
                const int c0 = ((tid >> 5) + 16 * it) * 8;
                const f32x4 n0 = *(const f32x4*)(F.norm2 + c0), n1 = *(const f32x4*)(F.norm2 + c0 + 4), s0 = *(const f32x4*)(md + 4096 + c0), s1 = *(const f32x4*)(md + 4096 + c0 + 4);
                const f32x4 h0 = *(const f32x4*)(md + 3072 + c0), h1 = *(const f32x4*)(md + 3072 + c0 + 4);
                float wa[8], lo[8];
#pragma unroll
                for (int j = 0; j < 8; ++j) { const float rw = F.router_w[(size_t)(c0 + j) * NE + e]; const float a = (j < 4 ? n0[j] * (1.0f + s0[j]) : n1[j - 4] * (1.0f + s1[j - 4])); wa[j] = rw * a; bp += rw * (j < 4 ? h0[j] : h1[j - 4]); }
                u32x4 hw; hw.x = cvt_pk_bf16(wa[0], wa[1]); hw.y = cvt_pk_bf16(wa[2], wa[3]); hw.z = cvt_pk_bf16(wa[4], wa[5]); hw.w = cvt_pk_bf16(wa[6], wa[7]);
                lo[0] = wa[0] - bflo(hw.x); lo[1] = wa[1] - bfhi(hw.x); lo[2] = wa[2] - bflo(hw.y); lo[3] = wa[3] - bfhi(hw.y); lo[4] = wa[4] - bflo(hw.z); lo[5] = wa[5] - bfhi(hw.z); lo[6] = wa[6] - bflo(hw.w); lo[7] = wa[7] - bfhi(hw.w);
                u32x4 lw; lw.x = cvt_pk_bf16(lo[0], lo[1]); lw.y = cvt_pk_bf16(lo[2], lo[3]); lw.z = cvt_pk_bf16(lo[4], lo[5]); lw.w = cvt_pk_bf16(lo[6], lo[7]);
                const int off = e * 2048 + (((c0 >> 3) ^ (e & 15)) << 4);
                *(LAS u32x4*)(WH + off) = hw; *(LAS u32x4*)(WL + off) = lw;
            }
            B2P[(tid >> 5) * 32 + e] = bp;
            __syncthreads();
            if (tid < 32) { float sb = F.router_b[tid];
#pragma unroll
                for (int k = 0; k < 16; ++k) sb += B2P[k * 32 + tid];
                B2[tid] = sb; }
        }
        f32x4 ca[4], cs[4];
#pragma unroll
        for (int j = 0; j < 4; ++j) { const int c = 4 * lane + 256 * j; const f32x4 nw = *(const f32x4*)(F.norm2 + c), sc = *(const f32x4*)(md + 4096 + c); ca[j] = nw * (1.0f + sc); cs[j] = *(const f32x4*)(md + 3072 + c); }
#pragma unroll 2
        for (int i = 0; i < 8; ++i) {
            const int tl = wv * 8 + i, t = grp * 64 + tl;
            float ss = (lane < 16) ? F.SS[(size_t)t * 16 + lane] : 0.f;
            u32x2 xw[4];
#pragma unroll
            for (int j = 0; j < 4; ++j) xw[j] = *(const u32x2*)(F.X1 + (size_t)t * D + 4 * lane + 256 * j);
            ss = wave_sum(ss);
            const float rstd = __builtin_amdgcn_rsqf(ss * (1.0f / 1024.0f) + EPS);
            if (lane == 0) RSTD[tl] = rstd;
#pragma unroll
            for (int j = 0; j < 4; ++j) {
                const f32x4 xv = (f32x4){bflo(xw[j].x), bfhi(xw[j].x), bflo(xw[j].y), bfhi(xw[j].y)};
                const f32x4 hv = xv * rstd * ca[j] + cs[j];
                *(unsigned*)(F.H2 + (size_t)t * D + 4 * lane + 256 * j) = pack_fp8x4(hv[0], hv[1], hv[2], hv[3]);
            }
        }
        {
            const int mt = wv & 3, nt = wv >> 2;
            const bf16_t* xa = F.X1 + (size_t)(grp * 64 + 16 * mt + fr) * D + 8 * fq;
            const int erow = 16 * nt + fr;
            f32x4 acc = (f32x4){0.f, 0.f, 0.f, 0.f};
            u32x4 af[8], an[8];
#pragma unroll
            for (int k = 0; k < 8; ++k) af[k] = *(const u32x4*)(xa + 32 * k);
#pragma unroll
            for (int kb = 0; kb < 4; ++kb) {
                if (kb < 3) {
#pragma unroll
                    for (int k = 0; k < 8; ++k) an[k] = *(const u32x4*)(xa + 32 * (8 * (kb + 1) + k));
                }
#pragma unroll
                for (int k = 0; k < 8; ++k) {
                    const int ks = 8 * kb + k;
                    const int off = erow * 2048 + ((((32 * ks) >> 3) + fq) ^ (erow & 15)) * 16;
                    const bf16x8 bh = *(const LAS bf16x8*)(WH + off), bl = *(const LAS bf16x8*)(WL + off);
                    acc = __builtin_amdgcn_mfma_f32_16x16x32_bf16(__builtin_bit_cast(bf16x8, af[k]), bh, acc, 0, 0, 0);
                    acc = __builtin_amdgcn_mfma_f32_16x16x32_bf16(__builtin_bit_cast(bf16x8, af[k]), bl, acc, 0, 0, 0);
                }
                if (kb < 3) {
#pragma unroll
                    for (int k = 0; k < 8; ++k) af[k] = an[k];
                }
            }
            __syncthreads();
            const float b2 = B2[erow];
#pragma unroll
            for (int r = 0; r < 4; ++r) { const int tl = 16 * mt + 4 * fq + r; LG[tl * 32 + erow] = RSTD[tl] * acc[r] + b2; }
        }
        __syncthreads();
        for (int i = 0; i < 8; ++i) {
            const int tl = wv * 8 + i;
            const int myexp = (lane >> 1) & 31;
            const float v = LG[tl * 32 + myexp];
            int rank = 0;
#pragma unroll
            for (int e = 0; e < NE; ++e) { const float o = __builtin_bit_cast(float, __builtin_amdgcn_readlane(__builtin_bit_cast(int, v), 2 * e)); rank += (o > v || (o == v && e < myexp)) ? 1 : 0; }
            const bool even = (lane & 1) == 0;
            float tv[4]; int te[4];
#pragma unroll
            for (int k = 0; k < 4; ++k) { const unsigned long long bal = __ballot(even && rank == k); const int src = (__ffsll((long long)bal) - 1) & 63; tv[k] = __shfl(v, src); te[k] = src >> 1; }
            const float e1 = __expf(tv[1] - tv[0]), e2 = __expf(tv[2] - tv[0]), e3 = __expf(tv[3] - tv[0]);
            const float inv = 1.0f / (1.0f + e1 + e2 + e3);
            if (lane < 4 && rep6 == 0) {
                const int e = (lane == 0) ? te[0] : (lane == 1) ? te[1] : (lane == 2) ? te[2] : te[3];
                const float wgt = ((lane == 0) ? 1.0f : (lane == 1) ? e1 : (lane == 2) ? e2 : e3) * inv;
                const int rk = __hip_atomic_fetch_add(lcnt + e, 1, __ATOMIC_RELAXED, __HIP_MEMORY_SCOPE_WORKGROUP);
                sel[tl * 4 + lane] = e | (rk << 8); selw[tl * 4 + lane] = wgt;
            }
        }
        __syncthreads();
        if (tid < 32 && rep6 == 0) { const int n = lcnt[tid]; lbase[tid] = n ? (int)__hip_atomic_fetch_add(F.ctl + CW_CNT + 64 * tid, (unsigned)n, __ATOMIC_RELAXED, __HIP_MEMORY_SCOPE_AGENT) : 0; lcnt[tid] = 0; }
        __syncthreads();
        if (tid < 256 && rep6 == 0) {
            const int sv = sel[tid], e = sv & 255, idx = lbase[e] + (sv >> 8), t = grp * 64 + (tid >> 2);
            F.LIST[e * NTOK + idx] = t; F.TSLOT[t * 4 + (tid & 3)] = e * NTOK + idx; F.TW[t * 4 + (tid & 3)] = selw[tid];
        }
        __syncthreads();
    }
}

__device__ __forceinline__ void phase9(const Frame& F) {
    moe_tables(F);
    const MoeTab T = moe_tab(F.lds);
    const int lane = threadIdx.x & 63, wv = threadIdx.x >> 6;
    for (int t = blockIdx.x * 8 + wv; t < NTOK; t += gridDim.x * 8) {
        const float* g2 = F.mod + (size_t)(t >> 11) * 6144 + 5120;
        float y[2][8];
#pragma unroll
        for (int j = 0; j < 2; ++j)
#pragma unroll
            for (int i = 0; i < 8; ++i) y[j][i] = 0.f;
#pragma unroll
        for (int k = 0; k < (DBG_NO_MOE ? 0 : 4); ++k) {
            const int sl = F.TSLOT[t * 4 + k]; const float wk = F.TW[t * 4 + k];
            const int e = sl >> 14, idx = sl & (NTOK - 1);
            const size_t row = (size_t)(T.tstart[e] * 256 + idx);
#pragma unroll
            for (int j = 0; j < 2; ++j) {
                const u32x4 d = *(const u32x4*)(F.DOUT + row * D + 8 * lane + 512 * j);
                y[j][0] += wk * bflo(d.x); y[j][1] += wk * bfhi(d.x); y[j][2] += wk * bflo(d.y); y[j][3] += wk * bfhi(d.y);
                y[j][4] += wk * bflo(d.z); y[j][5] += wk * bfhi(d.z); y[j][6] += wk * bflo(d.w); y[j][7] += wk * bfhi(d.w);
            }
        }
        float xf[2][8]; float ss = 0.f;
#pragma unroll
        for (int j = 0; j < 2; ++j) {
            const int c = 8 * lane + 512 * j;
            const u32x4 xw = *(const u32x4*)(F.X1 + (size_t)t * D + c); const f32x4 x0 = (f32x4){bflo(xw.x), bfhi(xw.x), bflo(xw.y), bfhi(xw.y)}, x1v = (f32x4){bflo(xw.z), bfhi(xw.z), bflo(xw.w), bfhi(xw.w)};
            const f32x4 ga = *(const f32x4*)(g2 + c), gb = *(const f32x4*)(g2 + c + 4);
#pragma unroll
            for (int i = 0; i < 4; ++i) { xf[j][i] = x0[i] + ga[i] * y[j][i]; xf[j][4 + i] = x1v[i] + gb[i] * y[j][4 + i]; }
#pragma unroll
            for (int i = 0; i < 8; ++i) ss += xf[j][i] * xf[j][i];
        }
        ss = wave_sum(ss);
        const float rstd = __builtin_amdgcn_rsqf(ss * (1.0f / 1024.0f) + EPS);
#pragma unroll
        for (int j = 0; j < 2; ++j) {
            const int c = 8 * lane + 512 * j;
            const f32x4 fa = *(const f32x4*)(F.final_norm + c), fb = *(const f32x4*)(F.final_norm + c + 4);
            f32x4 o0, o1;
#pragma unroll
            for (int i = 0; i < 4; ++i) { o0[i] = xf[j][i] * rstd * fa[i]; o1[i] = xf[j][4 + i] * rstd * fb[i]; }
            *(f32x4*)(F.out + (size_t)t * D + c) = o0; *(f32x4*)(F.out + (size_t)t * D + c + 4) = o1;
        }
    }
}

__device__ __forceinline__ void sgu_item(const Frame& F, int item) {
    constexpr int RS = 272;
    LAS unsigned char* WL = F.lds;
    LAS unsigned char* VT = F.lds + 128 * RS;
    const int tid = threadIdx.x, lane = tid & 63, wv = __builtin_amdgcn_readfirstlane(tid >> 6), fr = lane & 15, fq = lane >> 4;
    const int h = item & 3, n = (item >> 2) & 15, b = item >> 6;
    const int row0 = b * SEQ + n * 128;
    {
        const int t = tid >> 2, s0 = (tid & 3) * 32;
        const float* wp = F.sgu_w + ((size_t)h * 128 + t) * 128 + s0;
#pragma unroll
        for (int j = 0; j < 4; ++j) {
            const f32x4 a = *(const f32x4*)(wp + 8 * j), c = *(const f32x4*)(wp + 8 * j + 4);
            u32x4 w; w.x = cvt_pk_bf16(a[0], a[1]); w.y = cvt_pk_bf16(a[2], a[3]); w.z = cvt_pk_bf16(c[0], c[1]); w.w = cvt_pk_bf16(c[2], c[3]);
            *(LAS u32x4*)(WL + t * RS + (s0 + 8 * j) * 2) = w;
        }
    }
    {
        const int s = tid >> 2, d0 = (tid & 3) * 32;
        const bf16_t* vp = F.VG + (size_t)(row0 + s) * GW + h * 128 + d0;
        float v[32];
#pragma unroll
        for (int j = 0; j < 4; ++j) { const u32x4 w = *(const u32x4*)(vp + 8 * j);
            v[8 * j + 0] = bflo(w.x); v[8 * j + 1] = bfhi(w.x); v[8 * j + 2] = bflo(w.y); v[8 * j + 3] = bfhi(w.y); v[8 * j + 4] = bflo(w.z); v[8 * j + 5] = bfhi(w.z); v[8 * j + 6] = bflo(w.w); v[8 * j + 7] = bfhi(w.w); }
        float sm = 0.f;
#pragma unroll
        for (int i = 0; i < 32; ++i) sm += v[i];
        sm += __shfl_xor(sm, 1); sm += __shfl_xor(sm, 2);
        const float mu = sm * (1.0f / 128.0f); float q = 0.f;
#pragma unroll
        for (int i = 0; i < 32; ++i) { const float dd = v[i] - mu; q += dd * dd; }
        q += __shfl_xor(q, 1); q += __shfl_xor(q, 2);
        const float rstd = __builtin_amdgcn_rsqf(q * (1.0f / 128.0f) + EPS);
        const float* lg = F.sgu_ln + h * 128 + d0;
#pragma unroll
        for (int i = 0; i < 32; i += 2) {
            const unsigned pk = cvt_pk_bf16((v[i] - mu) * rstd * lg[i], (v[i + 1] - mu) * rstd * lg[i + 1]);
            *(LAS unsigned short*)(VT + (d0 + i) * RS + s * 2) = (unsigned short)(pk & 0xffffu);
            *(LAS unsigned short*)(VT + (d0 + i + 1) * RS + s * 2) = (unsigned short)(pk >> 16);
        }
    }
    __syncthreads();
    f32x4 acc[8];
#pragma unroll
    for (int nt = 0; nt < 8; ++nt) acc[nt] = (f32x4){0.f, 0.f, 0.f, 0.f};
#pragma unroll
    for (int a = 0; a < 4; ++a) {
        const bf16x8 wf = *(const LAS bf16x8*)(WL + (16 * wv + fr) * RS + (32 * a + 8 * fq) * 2);
#pragma unroll
        for (int nt = 0; nt < 8; ++nt) {
            const bf16x8 vf = *(const LAS bf16x8*)(VT + (16 * nt + fr) * RS + (32 * a + 8 * fq) * 2);
            acc[nt] = __builtin_amdgcn_mfma_f32_16x16x32_bf16(vf, wf, acc[nt], 0, 0, 0);
        }
    }
    {
        const int t = 16 * wv + fr; const size_t row = (size_t)(row0 + t);
        const float bias = F.sgu_b[h * 128 + t];
#pragma unroll
        for (int nt = 0; nt < 8; ++nt) {
            const int d = h * 128 + 16 * nt + 4 * fq;
            const u32x2 uu = *(const u32x2*)(F.U + row * GW + d);
            u32x2 w; w.x = cvt_pk_bf16(bflo(uu.x) * (acc[nt][0] + bias), bfhi(uu.x) * (acc[nt][1] + bias)); w.y = cvt_pk_bf16(bflo(uu.y) * (acc[nt][2] + bias), bfhi(uu.y) * (acc[nt][3] + bias));
            *(u32x2*)(F.YCAT + row * D + d) = w;
        }
    }
    __syncthreads();
}

__device__ __forceinline__ float hexp(float x) { return fast_exp(clampf(x, -87.0f, 60.0f)); }
namespace hg {
constexpr int RS = 256, OFF_QP = 0, OFF_QA = 8192, OFF_QB = OFF_QA + 4096, OFF_QC = OFF_QB + 4096, OFF_KA = OFF_QC + 4096, OFF_KB = OFF_KA + 4096, OFF_KC = OFF_KB + 4096,
              KDS = 96, OFF_KDT = OFF_KC + 4096, OFF_D = OFF_KDT + 128 * KDS, BUF = OFF_D + 512;
constexpr int RRS = 272;
constexpr int RAW_OFF = 2 * BUF, RAWBUF = 2 * 32 * RRS;
__device__ __forceinline__ int swz(int row, int byteoff) { return row * RS + (byteoff ^ ((row & 15) << 4)); }
struct QK { u32x2 kk[2], q[2]; };
struct GV { u32x4 g, v; };
struct Ctx {
    LAS unsigned char* lds; const bf16_t *Gp, *Kp, *Ip, *Qp; bf16_t* Op;
    int b, dir, sgn, colw, h, w, fr, fq, tid, slot0, cend;
    bf16_t* qcum;
    bf16x8 tri0, tri1;
};
__device__ __forceinline__ int base_row(const Ctx& X, int c) {
    return c < 8 ? (NTOK + X.b * CTXL + (X.dir ? (CTXL - 1 - 32 * c) : 32 * c)) : (X.b * SEQ + (X.dir ? (SEQ - 1 - 32 * (c - 8)) : 32 * (c - 8)));
}
template <bool ALLLAT> __device__ __forceinline__ void load_qk(const Ctx& X, int c, QK& r) {
    const int base = base_row(X, c);
#pragma unroll
    for (int j = 0; j < 2; ++j) {
        const int row = base + X.sgn * (X.fr + 16 * j);
        const unsigned o = (unsigned)(row * GW + X.colw + 4 * X.fq) * 2u;
        r.kk[j] = *(const u32x2*)((const char*)X.Kp + o);
        if (ALLLAT) r.q[j] = *(const u32x2*)((const char*)X.Qp + o);
        else { const unsigned oq = (unsigned)((row < NTOK ? row : row - NTOK) * GW + X.colw + 4 * X.fq) * 2u; r.q[j] = *(const u32x2*)((const char*)X.Qp + oq); }
    }
}
__device__ __forceinline__ void load_gv(const Ctx& X, int c, GV& r) {
    const int base = base_row(X, c);
    const unsigned o = (unsigned)((base + X.sgn * (X.tid >> 4)) * GW + X.h * 128 + 8 * (X.tid & 15)) * 2u;
    r.g = *(const u32x4*)((const char*)X.Gp + o); r.v = *(const u32x4*)((const char*)X.Ip + o);
}
__device__ __forceinline__ void raw_write(const Ctx& X, int c, const GV& r) {
    LAS unsigned char* rb = X.lds + RAW_OFF + (c & 1) * RAWBUF + (X.tid >> 4) * RRS + (X.tid & 15) * 16;
    *(LAS u32x4*)(rb) = r.g; *(LAS u32x4*)(rb + 32 * RRS) = r.v;
}
template <bool LAT, bool CUM> __device__ __forceinline__ bf16x8 stage(const Ctx& X, int c, const QK& qk, f32x4& Bsum) {
    LAS unsigned char* buf = X.lds + (c & 1) * BUF;
    const LAS unsigned char* rg = X.lds + RAW_OFF + (c & 1) * RAWBUF + (16 * X.w + X.fr) * 2;
    const int fr = X.fr, fq = X.fq, w = X.w;
    constexpr bool lat = LAT;
    unsigned gs[8], vs[8];
#pragma unroll
    for (int jj = 0; jj < 8; ++jj) {
        const int p = (jj < 4) ? (4 * fq + jj) : (16 + 4 * fq + jj - 4);
        gs[jj] = *(const LAS unsigned short*)(rg + p * RRS); vs[jj] = *(const LAS unsigned short*)(rg + 32 * RRS + p * RRS);
    }
    bf16x8 gT, VTf;
    { u32x4 t; t.x = gs[0] | (gs[1] << 16); t.y = gs[2] | (gs[3] << 16); t.z = gs[4] | (gs[5] << 16); t.w = gs[6] | (gs[7] << 16); gT = __builtin_bit_cast(bf16x8, t);
      u32x4 u; u.x = vs[0] | (vs[1] << 16); u.y = vs[2] | (vs[3] << 16); u.z = vs[4] | (vs[5] << 16); u.w = vs[6] | (vs[7] << 16); VTf = __builtin_bit_cast(bf16x8, u); }
    const f32x4 z4 = (f32x4){0.f, 0.f, 0.f, 0.f};
    f32x4 bT[2];
    bT[0] = __builtin_amdgcn_mfma_f32_16x16x32_bf16(gT, X.tri0, z4, 0, 0, 0);
    bT[1] = __builtin_amdgcn_mfma_f32_16x16x32_bf16(gT, X.tri1, z4, 0, 0, 0);
    f32x4 b7, b15, b23, b31;
#pragma unroll
    for (int r = 0; r < 4; ++r) { b7[r] = __shfl(bT[0][r], 16 * fq + 7); b15[r] = __shfl(bT[0][r], 16 * fq + 15); b23[r] = __shfl(bT[1][r], 16 * fq + 7); b31[r] = __shfl(bT[1][r], 16 * fq + 15); }
#pragma unroll
    for (int j = 0; j < 2; ++j) {
        const float kv[4] = {bflo(qk.kk[j].x), bfhi(qk.kk[j].x), bflo(qk.kk[j].y), bfhi(qk.kk[j].y)};
        const float qv[4] = {bflo(qk.q[j].x), bfhi(qk.q[j].x), bflo(qk.q[j].y), bfhi(qk.q[j].y)};
        float kd[4], qp[4], qi[4], ki[4], x2[4];
#pragma unroll
        for (int r = 0; r < 4; ++r) {
            const float bt = bT[j][r], mref = (j == 0) ? b7[r] : b23[r];
            kd[r] = kv[r] * hexp(b31[r] - bt);
            qp[r] = qv[r] * hexp(bt);
            qi[r] = qv[r] * hexp(bt - mref);
            ki[r] = kv[r] * hexp(mref - bt);
            x2[r] = (j == 0) ? kv[r] * hexp(b15[r] - bt) : qv[r] * hexp(bt - b15[r]);
        }
        const int trow = fr + 16 * j;
        const unsigned kd01 = cvt_pk_bf16(kd[0], kd[1]), kd23 = cvt_pk_bf16(kd[2], kd[3]);
        LAS unsigned char* kdp = buf + OFF_KDT + (16 * w + 4 * fq) * KDS + (X.slot0 + 4 * j) * 2;
        *(LAS unsigned short*)(kdp) = (unsigned short)(kd01 & 0xffffu); *(LAS unsigned short*)(kdp + KDS) = (unsigned short)(kd01 >> 16);
        *(LAS unsigned short*)(kdp + 2 * KDS) = (unsigned short)(kd23 & 0xffffu); *(LAS unsigned short*)(kdp + 3 * KDS) = (unsigned short)(kd23 >> 16);
        if (lat) {
            { u32x2 wv; wv.x = cvt_pk_bf16(ki[0], ki[1]); wv.y = cvt_pk_bf16(ki[2], ki[3]); *(LAS u32x2*)(buf + (j == 0 ? OFF_KA : OFF_KB) + swz(fr, (16 * w + 4 * fq) * 2)) = wv; }
            { u32x2 wv; wv.x = cvt_pk_bf16(qp[0], qp[1]); wv.y = cvt_pk_bf16(qp[2], qp[3]); *(LAS u32x2*)(buf + OFF_QP + swz(trow, (32 * (w >> 1) + 8 * fq + 4 * (w & 1)) * 2)) = wv; }
            if (CUM) { u32x2 wv; wv.x = cvt_pk_bf16(qv[0] * hexp(bT[j][0] + Bsum[0]), qv[1] * hexp(bT[j][1] + Bsum[1])); wv.y = cvt_pk_bf16(qv[2] * hexp(bT[j][2] + Bsum[2]), qv[3] * hexp(bT[j][3] + Bsum[3]));
                *(u32x2*)((char*)X.qcum + (unsigned)((32 * (c - 36) + trow) * 128 + 32 * (w >> 1) + 8 * fq + 4 * (w & 1)) * 2u) = wv; }
            { u32x2 wv; wv.x = cvt_pk_bf16(qi[0], qi[1]); wv.y = cvt_pk_bf16(qi[2], qi[3]); *(LAS u32x2*)(buf + (j == 0 ? OFF_QA : OFF_QB) + swz(fr, (16 * w + 4 * fq) * 2)) = wv; }
            { u32x2 wv; wv.x = cvt_pk_bf16(x2[0], x2[1]); wv.y = cvt_pk_bf16(x2[2], x2[3]); *(LAS u32x2*)(buf + (j == 0 ? OFF_KC : OFF_QC) + swz(fr, (16 * w + 4 * fq) * 2)) = wv; }
        }
    }
    if (fr == 0) { f32x4 dv; dv[0] = hexp(b31[0]); dv[1] = hexp(b31[1]); dv[2] = hexp(b31[2]); dv[3] = hexp(b31[3]); *(LAS f32x4*)(buf + OFF_D + (16 * w + 4 * fq) * 4) = dv; }
    if (CUM) Bsum += b31;
    return VTf;
}
template <bool LAT> __device__ __forceinline__ void products(const Ctx& X, int c, const bf16x8 VTf, f32x4 (&S)[8]) {
    const LAS unsigned char* buf = X.lds + (c & 1) * BUF;
    const int fr = X.fr, fq = X.fq;
    const f32x4 z4 = (f32x4){0.f, 0.f, 0.f, 0.f};
    if (LAT) {
        f32x4 X00 = z4, X11 = z4, X01 = z4;
#pragma unroll
        for (int a = 0; a < 4; ++a) {
            const int co = swz(fr, (32 * a + 8 * fq) * 2);
            const bf16x8 ka = *(const LAS bf16x8*)(buf + OFF_KA + co), qa = *(const LAS bf16x8*)(buf + OFF_QA + co);
            const bf16x8 kb = *(const LAS bf16x8*)(buf + OFF_KB + co), qb = *(const LAS bf16x8*)(buf + OFF_QB + co);
            const bf16x8 kc = *(const LAS bf16x8*)(buf + OFF_KC + co), qc = *(const LAS bf16x8*)(buf + OFF_QC + co);
            X00 = __builtin_amdgcn_mfma_f32_16x16x32_bf16(ka, qa, X00, 0, 0, 0);
            X11 = __builtin_amdgcn_mfma_f32_16x16x32_bf16(kb, qb, X11, 0, 0, 0);
            X01 = __builtin_amdgcn_mfma_f32_16x16x32_bf16(kc, qc, X01, 0, 0, 0);
        }
#pragma unroll
        for (int r = 0; r < 4; ++r) { const bool keep = (4 * fq + r) <= fr; X00[r] = keep ? X00[r] : 0.f; X11[r] = keep ? X11[r] : 0.f; }
        bf16x8 P0, P1;
        { u32x4 t; t.x = cvt_pk_bf16(X00[0], X00[1]); t.y = cvt_pk_bf16(X00[2], X00[3]); t.z = 0u; t.w = 0u; P0 = __builtin_bit_cast(bf16x8, t);
          u32x4 u; u.x = cvt_pk_bf16(X01[0], X01[1]); u.y = cvt_pk_bf16(X01[2], X01[3]); u.z = cvt_pk_bf16(X11[0], X11[1]); u.w = cvt_pk_bf16(X11[2], X11[3]); P1 = __builtin_bit_cast(bf16x8, u); }
        f32x4 o0 = __builtin_amdgcn_mfma_f32_16x16x32_bf16(VTf, P0, z4, 0, 0, 0);
        f32x4 o1 = __builtin_amdgcn_mfma_f32_16x16x32_bf16(VTf, P1, z4, 0, 0, 0);
#pragma unroll
        for (int a = 0; a < 4; ++a) {
            u32x4 t; t.x = cvt_pk_bf16(S[2 * a][0], S[2 * a][1]); t.y = cvt_pk_bf16(S[2 * a][2], S[2 * a][3]); t.z = cvt_pk_bf16(S[2 * a + 1][0], S[2 * a + 1][1]); t.w = cvt_pk_bf16(S[2 * a + 1][2], S[2 * a + 1][3]);
            const bf16x8 Sb = __builtin_bit_cast(bf16x8, t);
            const bf16x8 qp0 = *(const LAS bf16x8*)(buf + OFF_QP + swz(fr, (32 * a + 8 * fq) * 2)), qp1 = *(const LAS bf16x8*)(buf + OFF_QP + swz(16 + fr, (32 * a + 8 * fq) * 2));
            o0 = __builtin_amdgcn_mfma_f32_16x16x32_bf16(Sb, qp0, o0, 0, 0, 0);
            o1 = __builtin_amdgcn_mfma_f32_16x16x32_bf16(Sb, qp1, o1, 0, 0, 0);
        }
        const int base = base_row(X, c);
        { u32x2 w0, w1; w0.x = cvt_pk_bf16(o0[0], o0[1]); w0.y = cvt_pk_bf16(o0[2], o0[3]); w1.x = cvt_pk_bf16(o1[0], o1[1]); w1.y = cvt_pk_bf16(o1[2], o1[3]);
          *(u32x2*)((char*)X.Op + (unsigned)((base + X.sgn * fr) * GW + X.colw + 4 * fq) * 2u) = w0;
          *(u32x2*)((char*)X.Op + (unsigned)((base + X.sgn * (fr + 16)) * GW + X.colw + 4 * fq) * 2u) = w1; }
    }
#pragma unroll
    for (int kt = 0; kt < 8; ++kt) {
        const bf16x8 kdf = *(const LAS bf16x8*)(buf + OFF_KDT + (16 * kt + fr) * KDS + 16 * fq);
        const f32x4 dv = *(const LAS f32x4*)(buf + OFF_D + (16 * kt + 4 * fq) * 4);
        S[kt] = __builtin_amdgcn_mfma_f32_16x16x32_bf16(kdf, VTf, S[kt] * dv, 0, 0, 0);
    }
}
__device__ __forceinline__ void lds_barrier() {
    asm volatile("s_waitcnt lgkmcnt(0)" ::: "memory"); __builtin_amdgcn_s_barrier(); asm volatile("" ::: "memory");
}
template <bool PL, bool SL, bool CUM> __device__ __forceinline__ void iter(const Ctx& X, int c, QK& qk, GV& gv, bf16x8& VTcur, f32x4 (&S)[8], f32x4& Bsum) {
    lds_barrier();
    products<PL>(X, c, VTcur, S);
    VTcur = stage<SL, CUM>(X, c + 1, qk, Bsum);
    load_qk<CUM>(X, c + 3 < X.cend ? c + 3 : X.cend - 1, qk);
    if (c + 2 < X.cend) raw_write(X, c + 2, gv);
    load_gv(X, c + 4 < X.cend ? c + 4 : X.cend - 1, gv);
}
}
#ifndef HG_SPLIT
#define HG_SPLIT 52
#endif
template <int half> __device__ __forceinline__ void hgrn_chain(const Frame& F, int chain) {
    using namespace hg;
    Ctx X;
    X.lds = F.lds; X.tid = threadIdx.x; const int lane = X.tid & 63; X.w = __builtin_amdgcn_readfirstlane(X.tid >> 6); X.fr = lane & 15; X.fq = lane >> 4;
    X.dir = chain & 1; X.h = (chain >> 1) & 3; X.b = chain >> 3; X.sgn = X.dir ? -1 : 1; X.colw = X.h * 128 + 16 * X.w;
    X.Gp = X.dir ? F.GB : F.GF; X.Kp = X.dir ? F.KB : F.KF; X.Ip = F.I; X.Qp = F.Q; X.Op = X.dir ? F.OB : F.OF;
    X.slot0 = 8 * (X.fr >> 2) + (X.fr & 3);
    X.qcum = nullptr;
    X.cend = half ? 72 : HG_SPLIT;
#pragma unroll
    for (int jj = 0; jj < 8; ++jj) {
        X.tri0[jj] = (jj < 4 && 4 * X.fq + jj <= X.fr) ? (short)0x3F80 : (short)0;
        X.tri1[jj] = (jj < 4) ? (short)0x3F80 : ((4 * X.fq + jj - 4 <= X.fr) ? (short)0x3F80 : (short)0);
    }
    f32x4 S[8];
#pragma unroll
    for (int kt = 0; kt < 8; ++kt) S[kt] = (f32x4){0.f, 0.f, 0.f, 0.f};
    f32x4 Bsum = (f32x4){0.f, 0.f, 0.f, 0.f};
    QK qkA, qkB; GV gvA, gvB;
    load_gv(X, 0, gvA); load_gv(X, 1, gvB); load_qk<false>(X, 0, qkA); load_qk<false>(X, 1, qkB);
    raw_write(X, 0, gvA); load_gv(X, 2, gvA);
    lds_barrier();
    bf16x8 VTcur = stage<false, false>(X, 0, qkA, Bsum); load_qk<false>(X, 2, qkA);
    raw_write(X, 1, gvB); load_gv(X, 3, gvB);
    if constexpr (half == 0) {
        for (int c = 0; c < 6; c += 2) { iter<false, false, false>(X, c, qkB, gvA, VTcur, S, Bsum); iter<false, false, false>(X, c + 1, qkA, gvB, VTcur, S, Bsum); }
        iter<false, false, false>(X, 6, qkB, gvA, VTcur, S, Bsum); iter<false, true, false>(X, 7, qkA, gvB, VTcur, S, Bsum);
        for (int c = 8; c < HG_SPLIT - 2; c += 2) { iter<true, true, false>(X, c, qkB, gvA, VTcur, S, Bsum); iter<true, true, false>(X, c + 1, qkA, gvB, VTcur, S, Bsum); }
        iter<true, true, false>(X, HG_SPLIT - 2, qkB, gvA, VTcur, S, Bsum);
        lds_barrier();
        products<true>(X, HG_SPLIT - 1, VTcur, S);
    } else {
        for (int c = 0; c < HG_SPLIT - 2; c += 2) { iter<false, false, false>(X, c, qkB, gvA, VTcur, S, Bsum); iter<false, false, false>(X, c + 1, qkA, gvB, VTcur, S, Bsum); }
        iter<false, false, false>(X, HG_SPLIT - 2, qkB, gvA, VTcur, S, Bsum); iter<false, true, false>(X, HG_SPLIT - 1, qkA, gvB, VTcur, S, Bsum);
        for (int c = HG_SPLIT; c < 70; c += 2) { iter<true, true, false>(X, c, qkB, gvA, VTcur, S, Bsum); iter<true, true, false>(X, c + 1, qkA, gvB, VTcur, S, Bsum); }
        iter<true, true, false>(X, 70, qkB, gvA, VTcur, S, Bsum);
        lds_barrier();
        products<true>(X, 71, VTcur, S);
    }
    __syncthreads();
}

constexpr int CONV_P2_PER_WG = 38, CONV_P2_ITEMS = 20 * CONV_P2_PER_WG + 8;
constexpr int CONV_PER_WG = (CONV_ITEMS - CONV_P2_ITEMS) / 128;
#ifndef CONV_CHAIN_SHARE
#define CONV_CHAIN_SHARE 0
#endif
__device__ __forceinline__ void phase3(const Frame& F) {
    const int G = gridDim.x, bid = blockIdx.x;
    if (bid < 128) {
        if (bid & 1) hgrn_chain<1>(F, bid >> 1); else hgrn_chain<0>(F, bid >> 1);
        conv8_run(F, CONV_P2_ITEMS + bid + 128 * (CONV_PER_WG - CONV_CHAIN_SHARE), 128, CONV_CHAIN_SHARE);
    } else {
        const int j = bid - 128, nw = G - 128;
        for (int rep = 0; rep < ((DBG_REP3 & 2) ? 2 : 1); ++rep) for (int item = j; item < 512; item += nw) sgu_item(F, item);
        if (j < 128) conv8_run(F, CONV_P2_ITEMS + j, 128, CONV_PER_WG - CONV_CHAIN_SHARE);
    }
}

constexpr int N_PHASES = 10;
#ifndef DBG_NO_MOE
#define DBG_NO_MOE 0
#endif
#ifndef DBG_MAX_PHASE
#define DBG_MAX_PHASE 9
#endif
__global__ void __launch_bounds__(NTHREADS, 2) fwd_kernel(Args a) {
    extern __shared__ __attribute__((aligned(16))) unsigned char lds_raw[];
    Frame F;
    F.x = a.in[0]; F.c = a.in[1]; F.ctx = a.in[2]; F.c_ctx = a.in[3]; F.w_mod = a.in[4]; F.b_mod = a.in[5]; F.norm1 = a.in[6]; F.w_in = a.in[7]; F.sgu_ln = a.in[8]; F.sgu_w = a.in[9];
    F.sgu_b = a.in[10]; F.lb_fwd = a.in[11]; F.lb_bwd = a.in[12]; F.hgrn_norm = a.in[13]; F.w_out = a.in[14]; F.norm2 = a.in[15]; F.router_w = a.in[16]; F.router_b = a.in[17];
    F.w1 = a.in[18]; F.b1 = a.in[19]; F.w2 = a.in[20]; F.b2 = a.in[21]; F.final_norm = a.in[22];
    F.out = a.out; F.ws = a.ws; unsigned char* ws = a.ws;
    F.ctl = (unsigned*)(ws + WS_CTL); F.mod = (float*)(ws + WS_MOD);
    F.WinT = (bf16_t*)(ws + WS_WIN); F.WoutT = (bf16_t*)(ws + WS_WOUT); F.W1T = ws + WS_W1; F.W2T = ws + WS_W2;
    F.H = (bf16_t*)(ws + WS_H); F.U = (bf16_t*)(ws + WS_U); F.VG = (bf16_t*)(ws + WS_VG); F.Q = (bf16_t*)(ws + WS_Q); F.GS = (bf16_t*)(ws + WS_GS); F.I = (bf16_t*)(ws + WS_I);
    F.GF = (bf16_t*)(ws + WS_GF); F.KF = (bf16_t*)(ws + WS_KF); F.GB = (bf16_t*)(ws + WS_GB); F.KB = (bf16_t*)(ws + WS_KB);
    F.YCAT = (bf16_t*)(ws + WS_YCAT); F.H2 = ws + WS_H2; F.ACT = ws + WS_ACT; F.DOUT = (bf16_t*)(ws + WS_DOUT);
    F.OF = (bf16_t*)(ws + WS_OF); F.OB = (bf16_t*)(ws + WS_OB); F.X1 = (bf16_t*)(ws + WS_X1); F.SS = (float*)(ws + WS_SS); F.TW = (float*)(ws + WS_TW);
    F.LIST = (int*)(ws + WS_LIST); F.TSLOT = (int*)(ws + WS_TSLOT); F.QCUM = (bf16_t*)(ws + WS_QCUM); F.SMID = ws + WS_SMID;
    F.lds = (LAS unsigned char*)lds_raw;
    if (threadIdx.x < 64) ((LAS unsigned*)(F.lds + LDS_MISC_OFF))[threadIdx.x] = 0u;
    __syncthreads();
    const int lo = a.ph_lo, hi = a.ph_hi, G = gridDim.x, cid = blockIdx.x;
    XcdBarrier bar; bar.bar = F.ctl + CW_BAR; bar.x = 0; bar.st = nullptr;
    if (hi - lo > 1) bar = xcd_barrier_post(F.ctl + CW_BAR, (volatile LAS unsigned*)(F.lds + LDS_MISC_OFF));
#define IN(k) (lo <= (k) && (k) < hi)
#define SEAM(k) do { if (IN(k) && IN((k) + 1)) xcd_barrier(bar); } while (0)
#define REP(k) for (int _r = 0; _r < (((DBG_REP >> (k)) & 1) ? 2 : 1); ++_r)
    if (IN(0)) REP(0) phase0(F);
    SEAM(0);
    if (IN(1)) REP(1) phase1(F);
    SEAM(1);
    for (int _b = 0; _b < DBG_BARX; ++_b) xcd_barrier(bar);
    if (IN(2)) REP(2) {
        const int GG = (G >= 256) ? 236 : G;
        if (cid < GG) { SchedInProj S{(const unsigned char*)F.WinT, GG, cid}; EpiInProj E{F.U, F.VG, F.Q, F.GS, F.I, F.GF, F.KF, F.GB, F.KB, F.lb_fwd, F.lb_bwd};
            pg::gemm_phase<EpiInProj, SchedInProj, INPROJ_FP8 != 0>(F.lds, (const char*)F.H, D, S, E); }
        else if (cid < 256) { const int k = cid - 236; conv8_run(F, k, 20, CONV_P2_PER_WG); if (k < 8) conv8_run(F, 20 * CONV_P2_PER_WG + k, 20, 1); }
    }
    SEAM(2);
    if (IN(3)) REP(3) phase3(F);
    SEAM(3);
    if (IN(4)) REP(4) phase4(F);
    SEAM(4);
    if (IN(5)) REP(5) {
        SchedOutProj S{F.WoutT, G, cid}; EpiOutProj E{F.x, F.mod, F.X1, F.SS};
        pg::gemm_phase<EpiOutProj, SchedOutProj, false>(F.lds, (const char*)F.YCAT, D, S, E);
    }
    SEAM(5);
    if (IN(6)) phase6(F);
    SEAM(6);
    if (IN(7)) {
        moe_tables(F);
        SchedMoe S{F.W1T, F.W2T, F.LIST, moe_tab(F.lds), G, cid, F.lds, F.ctl, (unsigned)WS_H2, (unsigned)WS_ACT, 0}; S.init();
        EpiMoe E{F.b1, F.b2, F.ACT, F.DOUT, F.lds, &S};
        S.preload(F.b1, F.b2);
        pg::gemm_phase<EpiMoe, SchedMoe, true>(F.lds, (const char*)F.ws, D, S, E);
    }
    SEAM(7);
    if (IN(9)) REP(9) phase9(F);
#undef IN
#undef SEAM
}

extern "C" void kernel_launch(void* const* d_in, const int* in_sizes, int n_in, void* d_out, int out_size, void* d_ws, size_t ws_size, hipStream_t stream) {
    static int grid = 0;
    if (grid == 0) {
        if (n_in != 23 || in_sizes[0] != NTOK * D || out_size != NTOK * D || ws_size < WS_END) {
            fprintf(stderr, "kernel_launch: unexpected shapes / workspace (n_in %d, in0 %d, out %d, ws %zu, need %zu); nothing launched\n", n_in, n_in > 0 ? in_sizes[0] : -1, out_size, ws_size, (size_t)WS_END);
            grid = -1; return;
        }
        int dev = 0, cus = 0;
        if (hipGetDevice(&dev) != hipSuccess || hipDeviceGetAttribute(&cus, hipDeviceAttributeMultiprocessorCount, dev) != hipSuccess) { grid = -1; return; }
        if (hipFuncSetAttribute((const void*)fwd_kernel, hipFuncAttributeMaxDynamicSharedMemorySize, LDS_BYTES) != hipSuccess) { fprintf(stderr, "kernel_launch: hipFuncSetAttribute failed\n"); grid = -1; return; }
        (void)hipGetLastError();
        grid = cus;
        if (grid < 256) { fprintf(stderr, "kernel_launch: needs >= 256 CUs\n"); grid = -1; return; }
    }
    if (grid < 0) return;
    (void)hipMemsetAsync((char*)d_ws + WS_CTL, 0, CTL_BYTES, stream);
    Args a{};
    for (int i = 0; i < 23; ++i) a.in[i] = (const float*)d_in[i];
    a.out = (float*)d_out; a.ws = (unsigned char*)d_ws;
#if N_LAUNCH_MODE == 1
    a.ph_lo = 0; a.ph_hi = N_PHASES;
    hipLaunchKernelGGL(fwd_kernel, dim3(grid), dim3(NTHREADS), LDS_BYTES, stream, a);
#else
    for (int p = 0; p < N_PHASES; ++p) { if (DBG_NO_MOE && p >= 6 && p <= 8) continue; a.ph_lo = p; a.ph_hi = p + 1; hipLaunchKernelGGL(fwd_kernel, dim3(grid), dim3(NTHREADS), LDS_BYTES, stream, a); }
#endif
}
```

```cpp
#include <hip/hip_runtime.h>
#include <cstdio>
#include <cstdint>

#ifndef N_LAUNCH_MODE
#define N_LAUNCH_MODE 1
#endif

#ifndef DBG_NO_MOE
#define DBG_NO_MOE 0
#endif
#ifndef DBG_REP
#define DBG_REP 0
#endif
#ifndef DBG_REP3
#define DBG_REP3 0
#endif
#ifndef DBG_REP6
#define DBG_REP6 0
#endif
#ifndef DBG_BARX
#define DBG_BARX 0
#endif
#ifndef OUTPROJ_FP8
#define OUTPROJ_FP8 0
#endif
#ifndef INPROJ_FP8
#define INPROJ_FP8 0
#endif
#ifndef DBG_MIX
#define DBG_MIX 1
#endif
#define LAS __attribute__((address_space(3)))
typedef unsigned short bf16_t;
typedef short bf16x8 __attribute__((ext_vector_type(8)));
typedef float f32x4 __attribute__((ext_vector_type(4)));
typedef float f32x2 __attribute__((ext_vector_type(2)));
typedef unsigned u32x4 __attribute__((ext_vector_type(4)));
typedef unsigned u32x2 __attribute__((ext_vector_type(2)));

constexpr int D = 1024, NB = 8, SEQ = 2048, CTXL = 256;
constexpr int NTOK = NB * SEQ;
constexpr int NCTX = NB * CTXL;
constexpr int NROW = NTOK + NCTX;
constexpr int DIN = 3584, GW = 512, NE = 32, DE = 1024, TOPK = 4;
constexpr int ACT_ROWS = NTOK * TOPK + NE * 256;
constexpr float EPS = 1e-6f;
constexpr int NTHREADS = 512;

constexpr int LDS_STAGE = 131072;
constexpr int LDS_EXTRA_OFF = LDS_STAGE;
constexpr int LDS_MISC_OFF = 155648;
constexpr int LDS_BYTES = LDS_MISC_OFF + 256;

constexpr size_t al256(size_t x) { return (x + 255) & ~(size_t)255; }
constexpr size_t WS_CTL = 0;
constexpr size_t CTL_BYTES = 65536;
constexpr int CW_BAR = 0;
constexpr int CW_CNT = 4096;
constexpr size_t WS_MOD = WS_CTL + CTL_BYTES;
constexpr size_t WS_WIN = WS_MOD + al256((size_t)9 * 6144 * 4);
constexpr size_t WS_WOUT = WS_WIN + (size_t)DIN * D * 2;
constexpr size_t WS_W1 = WS_WOUT + (size_t)D * D * 2;
constexpr size_t WS_W2 = WS_W1 + (size_t)NE * 2 * DE * D * 2;
constexpr size_t WS_YCAT = WS_W2 + (size_t)NE * D * DE * 2;
constexpr size_t WS_OF = WS_YCAT + (size_t)NTOK * D * 2;
constexpr size_t WS_OB = WS_OF + (size_t)NTOK * GW * 4;
constexpr size_t WS_X1 = WS_OB + (size_t)NTOK * GW * 4;
constexpr size_t WS_SS = WS_X1 + (size_t)NTOK * D * 4;
constexpr size_t WS_H2 = WS_SS + (size_t)NTOK * 16 * 4;
constexpr size_t WS_LIST = WS_H2 + (size_t)NTOK * D * 2;
constexpr size_t WS_TSLOT = WS_LIST + (size_t)NE * NTOK * 4;
constexpr size_t WS_TW = WS_TSLOT + (size_t)NTOK * 4 * 4;
constexpr size_t WS_QCUM = WS_TW + (size_t)NTOK * 4 * 4;
constexpr size_t WS_SMID = WS_QCUM + (size_t)64 * 1152 * 128 * 2;
constexpr size_t WS_ACT = WS_SMID + (size_t)64 * 8 * 4 * 64 * 16;
constexpr size_t WS_REGA = WS_ACT + (size_t)ACT_ROWS * DE * 2;
constexpr size_t WS_H = WS_REGA;
constexpr size_t WS_U = WS_H + (size_t)NROW * D * 2;
constexpr size_t WS_VG = WS_U + (size_t)NTOK * GW * 2;
constexpr size_t WS_Q = WS_VG + (size_t)NTOK * GW * 2;
constexpr size_t WS_GS = WS_Q + (size_t)NTOK * GW * 2;
constexpr size_t WS_I = WS_GS + (size_t)NTOK * GW * 2;
constexpr size_t WS_GF = WS_I + (size_t)NROW * GW * 2;
constexpr size_t WS_KF = WS_GF + (size_t)NROW * GW * 2;
constexpr size_t WS_GB = WS_KF + (size_t)NROW * GW * 2;
constexpr size_t WS_KB = WS_GB + (size_t)NROW * GW * 2;
constexpr size_t WS_REGA_END = WS_KB + (size_t)NROW * GW * 2;
constexpr size_t WS_DOUT = WS_REGA;
constexpr size_t WS_END0 = WS_DOUT + (size_t)ACT_ROWS * D * 2;
constexpr size_t WS_END = WS_END0 > WS_REGA_END ? WS_END0 : WS_REGA_END;

typedef __bf16 bf16x2_t __attribute__((ext_vector_type(2)));
__device__ __forceinline__ unsigned cvt_pk_bf16(float lo, float hi) { bf16x2_t v; v[0] = (__bf16)lo; v[1] = (__bf16)hi; return __builtin_bit_cast(unsigned, v); }
__device__ __forceinline__ float bf2f(unsigned b) { return __uint_as_float(b << 16); }
__device__ __forceinline__ float bflo(unsigned w) { return __uint_as_float(w << 16); }
__device__ __forceinline__ float bfhi(unsigned w) { return __uint_as_float(w & 0xffff0000u); }
__device__ __forceinline__ float fast_exp(float x) { return __builtin_amdgcn_exp2f(x * 1.44269504089f); }
__device__ __forceinline__ float fast_rcp(float x) { return __builtin_amdgcn_rcpf(x); }
__device__ __forceinline__ float sigmoidf_(float x) { return fast_rcp(1.0f + fast_exp(-x)); }
__device__ __forceinline__ float gelu_tanh(float x) { const float u = 1.5957691216f * (x + 0.044715f * x * x * x); return x * fast_rcp(1.0f + fast_exp(-u)); }
__device__ __forceinline__ float clampf(float x, float lo, float hi) { return fminf(fmaxf(x, lo), hi); }
__device__ __forceinline__ float wave_sum(float v) {
#pragma unroll
    for (int o = 32; o >= 1; o >>= 1) v += __shfl_xor(v, o);
    return v;
}
__device__ __forceinline__ unsigned pack_fp8x4(float a, float b, float c, float d) {
    a = __builtin_amdgcn_fmed3f(a, -448.f, 448.f); b = __builtin_amdgcn_fmed3f(b, -448.f, 448.f); c = __builtin_amdgcn_fmed3f(c, -448.f, 448.f); d = __builtin_amdgcn_fmed3f(d, -448.f, 448.f);
    int p = __builtin_amdgcn_cvt_pk_fp8_f32(a, b, 0, false); p = __builtin_amdgcn_cvt_pk_fp8_f32(c, d, p, true); return (unsigned)p;
}
#define VM_WAIT() asm volatile("s_waitcnt vmcnt(0)" ::: "memory")
#define LDS_WAIT() asm volatile("s_waitcnt lgkmcnt(0)" ::: "memory")

#define XB_TMO      128
#define XB_XCNT(j)  (256  + 64 * (j))
#define XB_XSUB(j)  (1280 + 64 * (j))
#define XB_XGEN(j)  (2304 + 64 * (j))
#define XB_TOP      3328
#define XB_TOPGEN   3392
#define XCD_BAR_WORDS 3456
#define XB_SPIN_CAP (1u << 18)
__device__ __forceinline__ unsigned xb_ld(unsigned* p)              { return __hip_atomic_load(p, __ATOMIC_RELAXED, __HIP_MEMORY_SCOPE_AGENT); }
__device__ __forceinline__ unsigned xb_add(unsigned* p, unsigned v) { return __hip_atomic_fetch_add(p, v, __ATOMIC_RELAXED, __HIP_MEMORY_SCOPE_AGENT); }
__device__ __forceinline__ unsigned xb_xcc_id() { return (unsigned)__builtin_amdgcn_s_getreg((3 << 11) | 20) & 0xFu; }
#define XB_SPIN(cond, bar) do { unsigned _sp = 0; while (cond) { __builtin_amdgcn_s_sleep(1); \
    if ((++_sp & 255u) == 0u) { if (xb_ld(&(bar)[XB_TMO])) break; if (_sp > XB_SPIN_CAP) { atomicAdd(&(bar)[XB_TMO], 1u); break; } } } } while (0)
struct XcdBarrier { unsigned* bar; unsigned x; volatile LAS unsigned* st; };
__device__ __forceinline__ XcdBarrier xcd_barrier_post(unsigned* bar, volatile LAS unsigned* st) {
    XcdBarrier b; b.bar = bar; b.x = xb_xcc_id(); b.st = st;
    if (threadIdx.x == 0) (void)xb_add(&bar[XB_XCNT(b.x)], 1u);
    return b;
}
__device__ __forceinline__ void xcd_barrier_complete(unsigned* bar, unsigned x, unsigned& nloc, unsigned& nx) {
    const unsigned G = gridDim.x * gridDim.y * gridDim.z;
    unsigned sum, cnt, mine, sp = 0u;
    for (;;) {
        sum = 0u; cnt = 0u; mine = 0u;
#pragma unroll
        for (unsigned j = 0; j < 16; ++j) { const unsigned c = xb_ld(&bar[XB_XCNT(j)]); sum += c; cnt += (c > 0u) ? 1u : 0u; mine = (j == x) ? c : mine; }
        if (sum == G) break;
        __builtin_amdgcn_s_sleep(1);
        if ((++sp & 255u) == 0u) { if (xb_ld(&bar[XB_TMO])) break; if (sp > XB_SPIN_CAP) { atomicAdd(&bar[XB_TMO], 1u); break; } }
    }
    nloc = mine > 0u ? mine : 1u; nx = cnt > 0u ? cnt : 1u;
}
__device__ __forceinline__ void xcd_barrier(const XcdBarrier& b) {
    asm volatile("s_waitcnt vmcnt(0)" ::: "memory");
    __syncthreads();
    if (threadIdx.x == 0) {
        unsigned* bar = b.bar;
        __builtin_amdgcn_s_waitcnt(0);
        unsigned nloc = b.st[0], nx = b.st[1];
        if (nloc == 0u) { xcd_barrier_complete(bar, b.x, nloc, nx); b.st[0] = nloc; b.st[1] = nx; }
        const unsigned old = xb_add(&bar[XB_XSUB(b.x)], 1u);
        const unsigned gen = old / nloc;
        if (old + 1u == (gen + 1u) * nloc) {
            __builtin_amdgcn_fence(__ATOMIC_RELEASE, "agent");
            asm volatile("s_waitcnt vmcnt(0)" ::: "memory");
            const unsigned og = xb_add(&bar[XB_TOP], 1u);
            const unsigned tg = og / nx;
            if (og + 1u == (tg + 1u) * nx) xb_add(&bar[XB_TOPGEN], 1u);
            else XB_SPIN(xb_ld(&bar[XB_TOPGEN]) == tg, bar);
            __builtin_amdgcn_fence(__ATOMIC_ACQUIRE, "agent");
            xb_add(&bar[XB_XGEN(b.x)], 1u);
            asm volatile("s_waitcnt vmcnt(0)" ::: "memory");
        } else {
            XB_SPIN(xb_ld(&bar[XB_XGEN(b.x)]) == gen, bar);
            __builtin_amdgcn_fence(__ATOMIC_ACQUIRE, "agent");
            asm volatile("s_waitcnt vmcnt(0)" ::: "memory");
        }
    }
    __syncthreads();
}

struct Args { const float* in[23]; float* out; unsigned char* ws; int ph_lo, ph_hi; };
struct Frame {
    const float *x, *c, *ctx, *c_ctx, *w_mod, *b_mod, *norm1, *w_in, *sgu_ln, *sgu_w, *sgu_b, *lb_fwd, *lb_bwd, *hgrn_norm, *w_out, *norm2,
                *router_w, *router_b, *w1, *b1, *w2, *b2, *final_norm;
    float* out; unsigned char* ws;
    unsigned* ctl; float* mod;
    bf16_t *WinT, *WoutT, *H, *U, *VG, *Q, *GS, *I, *GF, *KF, *GB, *KB, *YCAT; unsigned char* DOUT;
    unsigned char *W1T, *W2T, *H2, *ACT;
    float *SS, *TW; bf16_t *OF, *OB, *X1;
    bf16_t* QCUM; unsigned char* SMID;
    int *LIST, *TSLOT;
    LAS unsigned char* lds;
};

namespace pg {
constexpr int BM = 256, BK = 64, HALF = 128, HTB = HALF * BK * 2, NXCD = 8, WGM = 8;
__device__ __forceinline__ int lds_byte(int r, int c) { const int st = (r >> 4) * 2 + (c >> 5), rr = r & 15, cc = c & 31, ob = rr * 64 + cc * 2; return st * 1024 + (ob ^ (((ob >> 9) & 1) << 5)); }
__device__ __forceinline__ void stage_rc(int b, int& R, int& C) { const int st = b / 1024, sb = b % 1024, swz = sb ^ (((sb >> 9) & 1) << 5); R = (st >> 1) * 16 + swz / 64; C = (st & 1) * 32 + (swz % 64) / 2; }
__device__ __forceinline__ int perm32(int rho) { const int n = rho >> 4, i = rho & 15; return 8 * (i >> 2) + 4 * n + (i & 3); }

struct Unit { const char* bptr; int arow, orow, pn, e, cnt, pad, kind, idx; };

__device__ __forceinline__ bool static_order(int nM, int nN, int L, int& pm, int& pn) {
    const int nwg = nM * nN; if (L >= nwg) return false;
    int wgid = L; { const int q = nwg / NXCD, r = nwg % NXCD, xcd = wgid % NXCD, off = wgid / NXCD; wgid = (xcd < r ? xcd * (q + 1) : r * (q + 1) + (xcd - r) * q) + off; }
    const int nig = WGM * nN, gid = wgid / nig, fm = gid * WGM, gsz = (nM - fm) < WGM ? (nM - fm) : WGM;
    pm = fm + ((wgid % nig) % gsz); pn = (wgid % nig) / gsz; return true;
}

typedef int v8i __attribute__((ext_vector_type(8)));
typedef int v4i __attribute__((ext_vector_type(4)));
template <class Epi, class Sched, bool FP8>
__device__ __forceinline__ void gemm_phase(LAS unsigned char* lds, const char* Abase, const int K, const Sched& S, const Epi& E) {
    const int tid = threadIdx.x, wid = __builtin_amdgcn_readfirstlane(tid >> 6), lane = tid & 63, wr = wid >> 2, wc = wid & 3, fr = lane & 15, fq = lane >> 4;
    const int pitch = FP8 ? K : 2 * K;
    const int nt = pitch / 128;
    int sR[2], sC[2]; unsigned voffB[2];
#pragma unroll
    for (int i = 0; i < 2; ++i) { stage_rc(tid * 16 + i * 8192, sR[i], sC[i]); const int Rb = Epi::PERM ? ((sR[i] & ~31) + perm32(sR[i] & 31)) : sR[i]; voffB[i] = (unsigned)(Rb * pitch + 2 * sC[i]); }
    const size_t kstep = (size_t)(BK * 2);
    const size_t hstep = (size_t)HALF * pitch;
    const unsigned ldsw = (unsigned)wid * 1024u;
    const int aoff = lds_byte(wr * 64 + fr, fq * 8), boff = lds_byte(wc * 32 + fr, fq * 8);
#define PG_SA(b, h) (((b) * 2 + (h)) * HTB)
#define PG_SB(b, h) ((4 + (b) * 2 + (h)) * HTB)
#define PG_STAGE(bufoff, gbase, voff) do { _Pragma("unroll") for (int _i = 0; _i < 2; ++_i) \
        __builtin_amdgcn_global_load_lds((const unsigned*)((const char*)(gbase) + (voff)[_i]), (LAS unsigned*)(lds + (bufoff) + ldsw + _i * 8192), 16, 0, 0); } while (0)
#define PG_LDA(dst, b, h) do { _Pragma("unroll") for (int m = 0; m < 4; ++m) { dst[m].lo = *(const LAS v4i*)(lds + PG_SA(b, h) + aoff + m * 2048); dst[m].hi = *(const LAS v4i*)(lds + PG_SA(b, h) + aoff + m * 2048 + 1024); } } while (0)
#define PG_LDB(dst, b, h) do { _Pragma("unroll") for (int n = 0; n < 2; ++n) { dst[n].lo = *(const LAS v4i*)(lds + PG_SB(b, h) + boff + n * 2048); dst[n].hi = *(const LAS v4i*)(lds + PG_SB(b, h) + boff + n * 2048 + 1024); } } while (0)
#define PG_MMA(ai, bj, At, Bt) do { __builtin_amdgcn_s_setprio(1); _Pragma("unroll") for (int m = 0; m < 4; ++m) _Pragma("unroll") for (int n = 0; n < 2; ++n) { \
        if constexpr (FP8) acc[ai][bj][m][n] = __builtin_amdgcn_mfma_scale_f32_16x16x128_f8f6f4(Bt[n], At[m], acc[ai][bj][m][n], 0, 0, 0, 0x7a7a7a7a, 0, 0x7f7f7f7f); \
        else { const v4i _bl = Bt[n].lo, _bh = Bt[n].hi, _al = At[m].lo, _ah = At[m].hi;     \
               acc[ai][bj][m][n] = __builtin_amdgcn_mfma_f32_16x16x32_bf16(__builtin_bit_cast(bf16x8, _bl), __builtin_bit_cast(bf16x8, _al), acc[ai][bj][m][n], 0, 0, 0); \
               acc[ai][bj][m][n] = __builtin_amdgcn_mfma_f32_16x16x32_bf16(__builtin_bit_cast(bf16x8, _bh), __builtin_bit_cast(bf16x8, _ah), acc[ai][bj][m][n], 0, 0, 0); } } \
        __builtin_amdgcn_s_setprio(0); } while (0)
#define PG_WAIT_V(n) asm volatile("s_waitcnt vmcnt(" #n ")" ::: "memory")
#define PG_WAIT_L(n) asm volatile("s_waitcnt lgkmcnt(" #n ")" ::: "memory")
#define PG_BAR __builtin_amdgcn_s_barrier()
#define PG_SCHED __builtin_amdgcn_sched_barrier(0)
    Unit cur, nxt, nn; int ui = 0;
    if (!S.next(0, cur)) return;
    bool has_next = S.next(1, nxt);
    unsigned vA[2][2], vN[2][2];
    S.a_ready(cur);
    S.aoff(cur, sR, sC, vA);
    if (has_next) S.aoff(nxt, sR, sC, vN); else { vN[0][0] = vA[0][0]; vN[0][1] = vA[0][1]; vN[1][0] = vA[1][0]; vN[1][1] = vA[1][1]; }
    f32x4 acc[2][2][4][2];
#pragma unroll
    for (int a = 0; a < 2; ++a)
#pragma unroll
        for (int b = 0; b < 2; ++b)
#pragma unroll
            for (int m = 0; m < 4; ++m)
#pragma unroll
                for (int n = 0; n < 2; ++n) acc[a][b][m][n] = (f32x4){0.f, 0.f, 0.f, 0.f};
    v8i At[4], B0[2], B1[2];
    const char* cB = cur.bptr;
    PG_STAGE(PG_SB(0, 0), cB, voffB); PG_STAGE(PG_SA(0, 0), Abase, vA[0]); PG_STAGE(PG_SB(0, 1), cB + hstep, voffB); PG_STAGE(PG_SA(0, 1), Abase, vA[1]);
    if (wr == 1) PG_BAR;
    PG_WAIT_V(4); PG_BAR;
    PG_STAGE(PG_SB(1, 0), cB + kstep, voffB); PG_STAGE(PG_SA(1, 0), Abase + kstep, vA[0]); PG_STAGE(PG_SB(1, 1), cB + hstep + kstep, voffB);
    PG_WAIT_V(6); PG_BAR;
    for (;;) {
        const char* nB = has_next ? nxt.bptr : cB;
#pragma unroll 1
        for (int t = 0; t < nt; t += 2) {
            const bool last = (t == nt - 2);
            if (last && has_next) S.a_ready(nxt);
            const char* a1 = Abase + (size_t)(t + 1) * kstep;
            const char* a2 = last ? Abase : Abase + (size_t)(t + 2) * kstep; const char* b2 = last ? nB : cB + (size_t)(t + 2) * kstep;
            const char* a3 = a2 + kstep; const char* b3 = b2 + kstep;
            PG_LDB(B0, 0, 0); PG_SCHED; PG_LDA(At, 0, 0); PG_STAGE(PG_SA(1, 1), a1, vA[1]);
            if (last) { vA[0][0] = vN[0][0]; vA[0][1] = vN[0][1]; vA[1][0] = vN[1][0]; vA[1][1] = vN[1][1]; }
            PG_WAIT_L(8); PG_BAR; PG_WAIT_L(0); PG_MMA(0, 0, At, B0); PG_BAR; PG_SCHED;
            PG_LDB(B1, 0, 1); PG_STAGE(PG_SB(0, 0), b2, voffB);
            PG_BAR; PG_WAIT_L(0); PG_MMA(0, 1, At, B1); PG_BAR;
            PG_LDA(At, 0, 1); PG_STAGE(PG_SA(0, 0), a2, vA[0]);
            PG_BAR; PG_WAIT_L(0); PG_MMA(1, 0, At, B0); PG_BAR; PG_SCHED;
            PG_STAGE(PG_SB(0, 1), b2 + hstep, voffB);
            PG_WAIT_V(6); PG_BAR; PG_MMA(1, 1, At, B1); PG_BAR;
            PG_LDB(B0, 1, 0); PG_SCHED; PG_LDA(At, 1, 0); PG_STAGE(PG_SA(0, 1), a2, vA[1]);
            PG_WAIT_L(8); PG_BAR; PG_WAIT_L(0); PG_MMA(0, 0, At, B0); PG_BAR; PG_SCHED;
            PG_LDB(B1, 1, 1); PG_STAGE(PG_SB(1, 0), b3, voffB);
            PG_BAR; PG_WAIT_L(0); PG_MMA(0, 1, At, B1); PG_BAR;
            PG_LDA(At, 1, 1); PG_STAGE(PG_SA(1, 0), a3, vA[0]);
            PG_BAR; PG_WAIT_L(0); PG_MMA(1, 0, At, B0); PG_BAR; PG_SCHED;
            PG_STAGE(PG_SB(1, 1), b3 + hstep, voffB);
            PG_WAIT_V(6); PG_BAR; PG_MMA(1, 1, At, B1); PG_BAR;
        }
        E(acc, cur, wr, wc, fr, fq);
        S.done(cur);
        if (!has_next) break;
#pragma unroll
        for (int a = 0; a < 2; ++a)
#pragma unroll
            for (int b = 0; b < 2; ++b)
#pragma unroll
                for (int m = 0; m < 4; ++m)
#pragma unroll
                    for (int n = 0; n < 2; ++n) acc[a][b][m][n] = (f32x4){0.f, 0.f, 0.f, 0.f};
        cur = nxt; cB = nB; ++ui;
        has_next = S.next(ui + 1, nn);
        if (has_next) { nxt = nn; S.aoff(nxt, sR, sC, vN); }
    }
    PG_WAIT_V(0);
    if (wr == 0) PG_BAR;
    PG_BAR;
#undef PG_SA
#undef PG_SB
#undef PG_STAGE
#undef PG_LDA
#undef PG_LDB
#undef PG_MMA
#undef PG_WAIT_V
#undef PG_WAIT_L
#undef PG_BAR
#undef PG_SCHED
}
}

typedef f32x4 Acc[2][2][4][2];

struct SchedInProj {
    __device__ __forceinline__ void a_ready(const pg::Unit&) const {}
    __device__ __forceinline__ void done(const pg::Unit&) const {}
    const unsigned char* WinT; int G, c;
    static constexpr int ESZ = INPROJ_FP8 ? 1 : 2;
    __device__ __forceinline__ bool next(int i, pg::Unit& u) const {
        const int L = i * G + c; int pm, pn;
        if (L < 64 * 14) { pg::static_order(64, 14, L, pm, pn); }
        else { const int x = L - 64 * 14; if (x >= 48) return false; pm = 64 + (x & 7); pn = 6 + (x >> 3); }
        u.bptr = (const char*)(WinT + (size_t)pn * 256 * D * ESZ); u.arow = pm * 256; u.orow = pm * 256; u.pn = pn; u.e = 0; u.cnt = 0; u.pad = 0; return true;
    }
    __device__ __forceinline__ void aoff(const pg::Unit& u, const int (&R)[2], const int (&C)[2], unsigned (&v)[2][2]) const {
#pragma unroll
        for (int h = 0; h < 2; ++h)
#pragma unroll
            for (int i = 0; i < 2; ++i) v[h][i] = (unsigned)((u.arow + h * 128 + R[i]) * D * ESZ + 2 * C[i]);
    }
};
struct EpiInProj {
    static constexpr bool PERM = true;
    bf16_t *U, *VG, *Q, *GS, *I, *GF, *KF, *GB, *KB; const float *lb_fwd, *lb_bwd;
    __device__ __forceinline__ void operator()(const Acc& acc, const pg::Unit& u, int wr, int wc, int fr, int fq) const {
        const int cg = u.pn >> 1;
        const int cbase = (u.pn & 1) * 256 + wc * 32 + 8 * fq;
        const int row0 = u.orow + wr * 64 + fr;
        if (cg == 3 || cg == 4) {
            const float* tab = (cg == 3) ? lb_fwd : lb_bwd; bf16_t* Gd = (cg == 3) ? GF : GB; bf16_t* Kd = (cg == 3) ? KF : KB;
#pragma unroll
            for (int bj = 0; bj < 2; ++bj) {
                const int col = cbase + bj * 128;
                float lb[8], omlb[8];
#pragma unroll
                for (int j = 0; j < 8; ++j) { const float t0 = tab[col + j], t1 = tab[GW + col + j]; lb[j] = fast_rcp(1.0f + __expf(t1 - t0)); omlb[j] = 1.0f - lb[j]; }
#pragma unroll
                for (int ai = 0; ai < 2; ++ai)
#pragma unroll
                    for (int m = 0; m < 4; ++m) {
                        const size_t off = (size_t)(row0 + ai * 128 + m * 16) * GW + col;
                        float gv[8], kv[8];
#pragma unroll
                        for (int n = 0; n < 2; ++n)
#pragma unroll
                            for (int j = 0; j < 4; ++j) {
                                const float z = clampf(acc[ai][bj][m][n][j], -30.f, 30.f);
                                const float e = __expf(-z), s = fast_rcp(1.0f + e), oms = e * s;
                                const float f = lb[4 * n + j] + omlb[4 * n + j] * s;
                                gv[4 * n + j] = __logf(f); kv[4 * n + j] = omlb[4 * n + j] * oms;
                            }
                        u32x4 wg, wk;
                        wg.x = cvt_pk_bf16(gv[0], gv[1]); wg.y = cvt_pk_bf16(gv[2], gv[3]); wg.z = cvt_pk_bf16(gv[4], gv[5]); wg.w = cvt_pk_bf16(gv[6], gv[7]);
                        wk.x = cvt_pk_bf16(kv[0], kv[1]); wk.y = cvt_pk_bf16(kv[2], kv[3]); wk.z = cvt_pk_bf16(kv[4], kv[5]); wk.w = cvt_pk_bf16(kv[6], kv[7]);
                        *(u32x4*)(Gd + off) = wg; *(u32x4*)(Kd + off) = wk;
                    }
            }
        } else {
            bf16_t* Od = (cg == 0) ? U : (cg == 1) ? VG : (cg == 2) ? Q : (cg == 5) ? I : GS;
            const int act = (cg <= 1) ? 1 : (cg == 6) ? 2 : 0;
#pragma unroll
            for (int ai = 0; ai < 2; ++ai)
#pragma unroll
                for (int m = 0; m < 4; ++m)
#pragma unroll
                    for (int bj = 0; bj < 2; ++bj) {
                        const size_t off = (size_t)(row0 + ai * 128 + m * 16) * GW + cbase + bj * 128;
                        float v[8];
#pragma unroll
                        for (int n = 0; n < 2; ++n)
#pragma unroll
                            for (int j = 0; j < 4; ++j) { float z = acc[ai][bj][m][n][j]; if (act == 1) z = gelu_tanh(z); else if (act == 2) z = z * sigmoidf_(z); v[4 * n + j] = z; }
                        u32x4 w; w.x = cvt_pk_bf16(v[0], v[1]); w.y = cvt_pk_bf16(v[2], v[3]); w.z = cvt_pk_bf16(v[4], v[5]); w.w = cvt_pk_bf16(v[6], v[7]);
                        *(u32x4*)(Od + off) = w;
                    }
        }
    }
};

struct SchedOutProj {
    __device__ __forceinline__ void a_ready(const pg::Unit&) const {}
    __device__ __forceinline__ void done(const pg::Unit&) const {}
    const bf16_t* WoutT; int G, c;
    __device__ __forceinline__ bool next(int i, pg::Unit& u) const {
        const int L = i * G + c; int pm, pn; if (!pg::static_order(64, 4, L, pm, pn)) return false;
        u.bptr = (const char*)WoutT + (size_t)pn * 256 * D * (OUTPROJ_FP8 ? 1 : 2); u.arow = pm * 256; u.orow = pm * 256; u.pn = pn; u.e = 0; u.cnt = 0; u.pad = 0; return true;
    }
    __device__ __forceinline__ void aoff(const pg::Unit& u, const int (&R)[2], const int (&C)[2], unsigned (&v)[2][2]) const {
#pragma unroll
        for (int h = 0; h < 2; ++h)
#pragma unroll
            for (int i = 0; i < 2; ++i) v[h][i] = (unsigned)((u.arow + h * 128 + R[i]) * D * (OUTPROJ_FP8 ? 1 : 2) + 2 * C[i]);
    }
};
struct EpiOutProj {
    static constexpr bool PERM = false;
    const float* x; const float* mod; bf16_t* X1; float* SS;
    __device__ __forceinline__ void operator()(const Acc& acc, const pg::Unit& u, int wr, int wc, int fr, int fq) const {
        const int row0 = u.orow + wr * 64 + fr, col0 = u.pn * 256 + wc * 32 + 4 * fq;
        const float* g1 = mod + (size_t)(u.orow >> 11) * 6144 + 2048;
        f32x4 gv[2][2];
#pragma unroll
        for (int bj = 0; bj < 2; ++bj)
#pragma unroll
            for (int n = 0; n < 2; ++n) gv[bj][n] = *(const f32x4*)(g1 + col0 + bj * 128 + n * 16);
#pragma unroll
        for (int ai = 0; ai < 2; ++ai)
#pragma unroll
            for (int m = 0; m < 4; ++m) {
                const int row = row0 + ai * 128 + m * 16; const size_t off = (size_t)row * D + col0; float s = 0.f;
#pragma unroll
                for (int bj = 0; bj < 2; ++bj)
#pragma unroll
                    for (int n = 0; n < 2; ++n) {
                        const f32x4 xv = *(const f32x4*)(x + off + bj * 128 + n * 16);
                        const f32x4 o = xv + gv[bj][n] * acc[ai][bj][m][n] * (float)DBG_MIX;
                        { u32x2 w; w.x = cvt_pk_bf16(o[0], o[1]); w.y = cvt_pk_bf16(o[2], o[3]); *(u32x2*)(X1 + off + bj * 128 + n * 16) = w; }
                        s += (o[0] * o[0] + o[1] * o[1]) + (o[2] * o[2] + o[3] * o[3]);
                    }
                s += __shfl_xor(s, 16); s += __shfl_xor(s, 32);
                if (fq == 0) SS[(size_t)row * 16 + u.pn * 4 + wc] = s;
            }
    }
};

struct MoeTab { LAS int* cnt; LAS int* tstart; LAS int* ent; };
__device__ __forceinline__ MoeTab moe_tab(LAS unsigned char* lds) { MoeTab t; t.cnt = (LAS int*)(lds + LDS_EXTRA_OFF); t.tstart = t.cnt + 32; t.ent = t.tstart + 64; return t; }
__device__ __forceinline__ void moe_tables(const Frame& F) {
    const MoeTab T = moe_tab(F.lds);
    if (threadIdx.x < 64) {
        const int lane = threadIdx.x;
        const int c = (lane < NE) ? (int)__hip_atomic_load(F.ctl + CW_CNT + 64 * lane, __ATOMIC_RELAXED, __HIP_MEMORY_SCOPE_AGENT) : 0;
        const int t = (c + 255) >> 8;
        int incl = t;
#pragma unroll
        for (int o = 1; o < 64; o <<= 1) { const int v = __shfl_up(incl, o); if (lane >= o) incl += v; }
        const int start = incl - t;
        if (lane < NE) { T.cnt[lane] = c; T.tstart[lane] = start; for (int k = 0; k < t; ++k) T.ent[start + k] = lane; }
        if (lane == NE) T.tstart[NE] = start;
    }
    __syncthreads();
}
constexpr int META_OFF = LDS_EXTRA_OFF + 2048, META_MAXU = 11;
__device__ __forceinline__ LAS float* meta_bias(LAS unsigned char* lds, int i, int stride) { return (LAS float*)(lds + META_OFF + i * stride); }
constexpr int CW_MODRDY = 14336;
constexpr int CW_RDY = 8192;
constexpr int MOE_MAXGU = 10, MOE_MAXD = 6;
struct SchedMoe {
    const unsigned char *W1T, *W2T; const int* LIST; MoeTab T; int G, c; LAS unsigned char* lds; unsigned* ctl; unsigned aH2, aACT; int nGU;
    __device__ __forceinline__ int total() const { return __builtin_amdgcn_readfirstlane(T.tstart[32]); }
    __device__ __forceinline__ void init() { const int tot = total(), j = c >> 3, per = G >> 3; nGU = (j < tot) ? (tot - j + per - 1) / per : 0; }
    __device__ __forceinline__ bool next(int i, pg::Unit& u) const {
        const int tot = total(), per = G >> 3, x = c & 7, j = c >> 3;
        int idx, pn, kind;
        if (i < nGU) { kind = 0; pn = x; idx = j + per * i; }
        else { kind = 1; pn = x & 3; idx = 2 * ((per - 1 - j) + per * (i - nGU)) + (x >> 2); if (idx >= tot) return false; }
        const int e = __builtin_amdgcn_readfirstlane(T.ent[idx]); const int ts = __builtin_amdgcn_readfirstlane(T.tstart[e]); const int mt = idx - ts;
        u.kind = kind; u.idx = idx; u.pn = pn; u.e = e; u.orow = ts * 256 + mt * 256; u.pad = i;
        if (kind == 0) { u.bptr = (const char*)(W1T + ((size_t)e * 2048 + (size_t)pn * 256) * D); u.arow = mt * 256; u.cnt = __builtin_amdgcn_readfirstlane(T.cnt[e]); }
        else { u.bptr = (const char*)(W2T + ((size_t)e * 1024 + (size_t)pn * 256) * DE); u.arow = u.orow; u.cnt = 0; }
        return true;
    }
    __device__ __forceinline__ int meta_off(const pg::Unit& u) const {
        if (u.kind == 0) return (u.pad < MOE_MAXGU) ? META_OFF + u.pad * 1536 : -1;
        const int k = u.pad - nGU, ng = nGU < MOE_MAXGU ? nGU : MOE_MAXGU; return (k < MOE_MAXD) ? META_OFF + ng * 1536 + k * 1024 : -1;
    }
    __device__ __forceinline__ void aoff(const pg::Unit& u, const int (&R)[2], const int (&C)[2], unsigned (&v)[2][2]) const {
        if (u.kind == 1) {
#pragma unroll
            for (int h = 0; h < 2; ++h)
#pragma unroll
                for (int i = 0; i < 2; ++i) v[h][i] = aACT + (unsigned)((u.arow + h * 128 + R[i]) * DE + 2 * C[i]);
            return;
        }
        const int mo = meta_off(u);
        if (mo >= 0) {
            const LAS unsigned short* L = (const LAS unsigned short*)(lds + mo + 1024);
#pragma unroll
            for (int h = 0; h < 2; ++h)
#pragma unroll
                for (int i = 0; i < 2; ++i) v[h][i] = aH2 + (unsigned)((int)L[h * 128 + R[i]] * D + 2 * C[i]);
        } else {
#pragma unroll
            for (int h = 0; h < 2; ++h)
#pragma unroll
                for (int i = 0; i < 2; ++i) { int sl = u.arow + h * 128 + R[i]; sl = sl < u.cnt ? sl : u.cnt - 1; v[h][i] = aH2 + (unsigned)(LIST[u.e * NTOK + sl] * D + 2 * C[i]); }
        }
    }
    __device__ __forceinline__ void preload(const float* b1, const float* b2) const {
        pg::Unit u; const int t = threadIdx.x;
        for (int i = 0; i < MOE_MAXGU + MOE_MAXD + 8; ++i) {
            if (!next(i, u)) break;
            const int mo = meta_off(u); if (mo < 0) continue;
            LAS float* B = (LAS float*)(lds + mo);
            if (u.kind == 0) {
                if (t < 256) B[t] = b1[(size_t)u.e * 2048 + (t < 128 ? u.pn * 128 + t : 1024 + u.pn * 128 + (t - 128))];
                else { int sl = u.arow + (t - 256); sl = sl < u.cnt ? sl : u.cnt - 1; ((LAS unsigned short*)(B + 256))[t - 256] = (unsigned short)LIST[u.e * NTOK + sl]; }
            } else if (t < 256) B[t] = b2[(size_t)u.e * D + u.pn * 256 + t];
        }
        __syncthreads();
    }
    __device__ __forceinline__ void a_ready(const pg::Unit& u) const {
        if (u.kind != 1) return;
        if (threadIdx.x < 64) {
            unsigned* w = ctl + CW_RDY + 16 * u.idx; unsigned sp = 0;
            while ((unsigned)__builtin_amdgcn_readfirstlane(__hip_atomic_load(w, __ATOMIC_RELAXED, __HIP_MEMORY_SCOPE_AGENT)) < 64u) { __builtin_amdgcn_s_sleep(2); if (++sp > (1u << 22)) break; }
            __builtin_amdgcn_fence(__ATOMIC_ACQUIRE, "agent");
            asm volatile("s_waitcnt vmcnt(0)" ::: "memory");
        }
        asm volatile("" ::: "memory"); __builtin_amdgcn_s_barrier(); asm volatile("" ::: "memory");
    }
    __device__ __forceinline__ void done(const pg::Unit& u) const {
        if (u.kind != 0) return;
        asm volatile("s_waitcnt vmcnt(0)" ::: "memory");
        if ((threadIdx.x & 63) == 0) __hip_atomic_fetch_add(ctl + CW_RDY + 16 * u.idx, 1u, __ATOMIC_RELAXED, __HIP_MEMORY_SCOPE_AGENT);
    }
};
struct EpiMoe {
    static constexpr bool PERM = true;
    const float *b1, *b2; unsigned char* ACT; unsigned char* DOUT; LAS unsigned char* lds; const SchedMoe* S;
    __device__ __forceinline__ void operator()(const Acc& acc, const pg::Unit& u, int wr, int wc, int fr, int fq) const {
        const int mo = S->meta_off(u);
        const int row0 = u.orow + wr * 64 + fr;
        if (u.kind == 0) {
            const int col = u.pn * 128 + wc * 32 + 8 * fq;
            float vg[8], vu[8];
            if (mo >= 0) { const LAS float* B = (const LAS float*)(lds + mo) + wc * 32 + 8 * fq;
                const f32x4 g0 = *(const LAS f32x4*)B, g1 = *(const LAS f32x4*)(B + 4), u0 = *(const LAS f32x4*)(B + 128), u1 = *(const LAS f32x4*)(B + 132);
#pragma unroll
                for (int j = 0; j < 4; ++j) { vg[j] = g0[j]; vg[4 + j] = g1[j]; vu[j] = u0[j]; vu[4 + j] = u1[j]; } }
            else { const float* bg = b1 + (size_t)u.e * 2048 + col; const float* bu = bg + 1024;
#pragma unroll
                for (int j = 0; j < 8; ++j) { vg[j] = bg[j]; vu[j] = bu[j]; } }
#pragma unroll
            for (int ai = 0; ai < 2; ++ai)
#pragma unroll
                for (int m = 0; m < 4; ++m) {
                    float a[8];
#pragma unroll
                    for (int n = 0; n < 2; ++n)
#pragma unroll
                        for (int j = 0; j < 4; ++j) {
                            float g = acc[ai][0][m][n][j] + vg[4 * n + j], up = acc[ai][1][m][n][j] + vu[4 * n + j];
                            g = fminf(g, 7.0f); up = clampf(up, -7.0f, 7.0f);
                            a[4 * n + j] = g * fast_rcp(1.0f + __expf(-1.702f * g)) * (up + 1.0f);
                        }
                    const unsigned long long w = (unsigned long long)pack_fp8x4(a[0], a[1], a[2], a[3]) | ((unsigned long long)pack_fp8x4(a[4], a[5], a[6], a[7]) << 32);
                    __hip_atomic_store((unsigned long long*)(ACT + (size_t)(row0 + ai * 128 + m * 16) * DE + col), w, __ATOMIC_RELAXED, __HIP_MEMORY_SCOPE_AGENT);
                }
        } else {
            const int col0 = u.pn * 256 + wc * 32 + 8 * fq;
            float bv[2][8];
            if (mo >= 0) { const LAS float* B = (const LAS float*)(lds + mo) + wc * 32 + 8 * fq;
#pragma unroll
                for (int bj = 0; bj < 2; ++bj) { const f32x4 a = *(const LAS f32x4*)(B + bj * 128), b = *(const LAS f32x4*)(B + bj * 128 + 4);
#pragma unroll
                    for (int j = 0; j < 4; ++j) { bv[bj][j] = a[j]; bv[bj][4 + j] = b[j]; } } }
            else {
#pragma unroll
                for (int bj = 0; bj < 2; ++bj)
#pragma unroll
                    for (int j = 0; j < 8; ++j) bv[bj][j] = b2[(size_t)u.e * D + col0 + bj * 128 + j]; }
#pragma unroll
            for (int ai = 0; ai < 2; ++ai)
#pragma unroll
                for (int m = 0; m < 4; ++m)
#pragma unroll
                    for (int bj = 0; bj < 2; ++bj) {
                        const f32x4 v0 = acc[ai][bj][m][0], v1 = acc[ai][bj][m][1];
                        u32x2 w; w.x = pack_fp8x4(4.f * (v0[0] + bv[bj][0]), 4.f * (v0[1] + bv[bj][1]), 4.f * (v0[2] + bv[bj][2]), 4.f * (v0[3] + bv[bj][3]));
                        w.y = pack_fp8x4(4.f * (v1[0] + bv[bj][4]), 4.f * (v1[1] + bv[bj][5]), 4.f * (v1[2] + bv[bj][6]), 4.f * (v1[3] + bv[bj][7]));
                        *(u32x2*)(DOUT + (size_t)(row0 + ai * 128 + m * 16) * D + col0 + bj * 128) = w;
                    }
        }
    }
};

__device__ __forceinline__ void conv_tile(const float* src, int ld, int k0, int n0, bf16_t* dst, int drow0, LAS unsigned char* lds) {
    const int tid = threadIdx.x, p = tid >> 4, q = tid & 15;
    f32x4 v[4];
#pragma unroll
    for (int r = 0; r < 4; ++r) v[r] = *(const f32x4*)(src + (size_t)(k0 + 4 * p + r) * ld + n0 + 4 * q);
#pragma unroll
    for (int i = 0; i < 4; ++i) {
        u32x2 w; w.x = cvt_pk_bf16(v[0][i], v[1][i]); w.y = cvt_pk_bf16(v[2][i], v[3][i]);
        *(LAS u32x2*)(lds + (4 * q + i) * 256 + ((p ^ q) * 8)) = w;
    }
    __syncthreads();
#pragma unroll
    for (int jj = 0; jj < 2; ++jj) {
        const int n = (tid >> 4) + 32 * jj, c = tid & 15, qn = (n >> 2) & 15;
        u32x4 w = *(const LAS u32x4*)(lds + n * 256 + ((c ^ (qn >> 1)) * 16));
        if (qn & 1) { const unsigned t0 = w.x, t1 = w.y; w.x = w.z; w.y = w.w; w.z = t0; w.w = t1; }
        *(u32x4*)(dst + (size_t)(drow0 + n) * 1024 + k0 + 8 * c) = w;
    }
    __syncthreads();
}
constexpr int CONV_ITEMS = 32 * 128 + 32 * 64;
struct ConvDesc { const float* src; unsigned char* dst; int ld, k0, n0, drow0; };
__device__ __forceinline__ ConvDesc conv8_desc(const Frame& F, int it) {
    ConvDesc d;
    if (it < 4096) { const int e = it >> 7, r = it & 127, nt = r & 15, kt = r >> 4, n0 = nt * 128;
        d.src = F.w1 + (size_t)e * D * 2048; d.ld = 2048; d.k0 = kt * 128; d.n0 = n0; d.dst = F.W1T + (size_t)e * 2048 * D;
        d.drow0 = (n0 < 1024) ? ((n0 >> 7) * 256) : (((n0 - 1024) >> 7) * 256 + 128); }
    else { const int i2 = it - 4096, e = i2 >> 6, r = i2 & 63, nt = r & 7, kt = r >> 3;
        d.src = F.w2 + (size_t)e * DE * D; d.ld = 1024; d.k0 = kt * 128; d.n0 = nt * 128; d.dst = F.W2T + (size_t)e * D * DE; d.drow0 = nt * 128; }
    return d;
}
__device__ __forceinline__ void conv8_load(const ConvDesc& d, f32x4 (&v)[8]) {
    const int p = threadIdx.x >> 5, q = threadIdx.x & 31;
#pragma unroll
    for (int g = 0; g < 2; ++g)
#pragma unroll
        for (int r = 0; r < 4; ++r) v[4 * g + r] = *(const f32x4*)(d.src + (size_t)(d.k0 + 64 * g + 4 * p + r) * d.ld + d.n0 + 4 * q);
}
__device__ __forceinline__ void conv8_lds_write(const f32x4 (&v)[8], LAS unsigned char* buf) {
    const int p = threadIdx.x >> 5, q = threadIdx.x & 31;
#pragma unroll
    for (int g = 0; g < 2; ++g)
#pragma unroll
        for (int i = 0; i < 4; ++i)
            *(LAS unsigned*)(buf + (4 * q + i) * 128 + (((16 * g + p) ^ q) * 4)) = pack_fp8x4(32.f * v[4 * g][i], 32.f * v[4 * g + 1][i], 32.f * v[4 * g + 2][i], 32.f * v[4 * g + 3][i]);
}
__device__ __forceinline__ void conv8_store(const ConvDesc& d, const LAS unsigned char* buf) {
#pragma unroll
    for (int jj = 0; jj < 2; ++jj) {
        const int n = (threadIdx.x >> 3) + 64 * jj, c = threadIdx.x & 7, qn = (n >> 2) & 31;
        u32x4 w = *(const LAS u32x4*)(buf + n * 128 + ((c ^ (qn >> 2)) * 16));
        if (qn & 1) { unsigned t = w.x; w.x = w.y; w.y = t; t = w.z; w.z = w.w; w.w = t; }
        if (qn & 2) { unsigned t = w.x; w.x = w.z; w.z = t; t = w.y; w.y = w.w; w.w = t; }
        *(u32x4*)(d.dst + (size_t)(d.drow0 + n) * 1024 + d.k0 + 16 * c) = w;
    }
}
__device__ __forceinline__ void conv8_run(const Frame& F, int first, int stride, int n) {
    if (n <= 0) return;
    f32x4 vA[8], vB[8];
    const int last = first + (n - 1) * stride;
#define CV_IT(i) ((first + (i) * stride) < last ? (first + (i) * stride) : last)
    ConvDesc dA = conv8_desc(F, CV_IT(0)), dB = conv8_desc(F, CV_IT(1));
    conv8_load(dA, vA); conv8_load(dB, vB);
    for (int i = 0; i < n; i += 2) {
        conv8_lds_write(vA, F.lds);
        const ConvDesc dA2 = conv8_desc(F, CV_IT(i + 2)); conv8_load(dA2, vA);
        asm volatile("s_waitcnt lgkmcnt(0)" ::: "memory"); __builtin_amdgcn_s_barrier(); asm volatile("" ::: "memory");
        conv8_store(dA, F.lds);
        dA = dA2;
        conv8_lds_write(vB, F.lds + 16384);
        const ConvDesc dB2 = conv8_desc(F, CV_IT(i + 3)); conv8_load(dB2, vB);
        asm volatile("s_waitcnt lgkmcnt(0)" ::: "memory"); __builtin_amdgcn_s_barrier(); asm volatile("" ::: "memory");
        conv8_store(dB, F.lds + 16384);
        dB = dB2;
    }
#undef CV_IT
    __syncthreads();
}

__device__ __forceinline__ void mod_item(const Frame& F, int item) {
    LAS float* S = (LAS float*)F.lds;
    LAS float* RED = (LAS float*)(F.lds + 40960);
    const int tid = threadIdx.x, lane = tid & 63, wv = tid >> 6, c0 = item * 64;
    for (int idx = tid; idx < 9 * 1024; idx += NTHREADS) { const int r = idx >> 10, k = idx & 1023; const float v = (r < 8) ? F.c[r * 1024 + k] : F.c_ctx[k]; S[idx] = v * sigmoidf_(v); }
    __syncthreads();
    const int cq = tid & 15, kg = tid >> 4;
    f32x4 acc[9];
#pragma unroll
    for (int r = 0; r < 9; ++r) acc[r] = (f32x4){0.f, 0.f, 0.f, 0.f};
    for (int k = kg; k < 1024; k += 32) {
        const f32x4 wv4 = *(const f32x4*)(F.w_mod + (size_t)k * 6144 + c0 + 4 * cq);
#pragma unroll
        for (int r = 0; r < 9; ++r) acc[r] += S[r * 1024 + k] * wv4;
    }
#pragma unroll
    for (int r = 0; r < 9; ++r)
#pragma unroll
        for (int j = 0; j < 4; ++j) { float v = acc[r][j]; v += __shfl_xor(v, 16); v += __shfl_xor(v, 32); if (lane < 16) RED[(wv * 9 + r) * 64 + 4 * cq + j] = v; }
    __syncthreads();
    for (int idx = tid; idx < 9 * 64; idx += NTHREADS) {
        const int r = idx >> 6, cc = idx & 63; float s = F.b_mod[c0 + cc];
#pragma unroll
        for (int w8 = 0; w8 < 8; ++w8) s += RED[(w8 * 9 + r) * 64 + cc];
        F.mod[r * 6144 + c0 + cc] = s;
    }
    asm volatile("s_waitcnt vmcnt(0)" ::: "memory");
    __syncthreads();
    if (threadIdx.x == 0) { __builtin_amdgcn_fence(__ATOMIC_RELEASE, "agent"); asm volatile("s_waitcnt vmcnt(0)" ::: "memory"); __hip_atomic_fetch_add(F.ctl + CW_MODRDY, 1u, __ATOMIC_RELAXED, __HIP_MEMORY_SCOPE_AGENT); }
}
__device__ __forceinline__ void phase0(const Frame& F) {
    for (int item = blockIdx.x; item < 96 + 448 + 128; item += gridDim.x) {
        if (item < 96) mod_item(F, item);
        else if (item < 96 + 448) { const int it = item - 96, nt = it % 56, kt = it / 56;
            if (INPROJ_FP8) { if (nt & 1) continue;
                ConvDesc d; d.src = F.w_in; d.ld = DIN; d.k0 = kt * 128; d.n0 = nt * 64; d.dst = (unsigned char*)F.WinT; d.drow0 = nt * 64;
                f32x4 v[8]; conv8_load(d, v); conv8_lds_write(v, F.lds); __syncthreads(); conv8_store(d, F.lds); __syncthreads(); }
            else conv_tile(F.w_in, DIN, kt * 128, nt * 64, F.WinT, nt * 64, F.lds); }
        else { const int it = item - 544, nt = it & 15, kt = it >> 4;
            if (OUTPROJ_FP8) { if (nt & 1) continue;
                ConvDesc d; d.src = F.w_out; d.ld = D; d.k0 = kt * 128; d.n0 = nt * 64; d.dst = (unsigned char*)F.WoutT; d.drow0 = nt * 64;
                f32x4 v[8]; conv8_load(d, v); conv8_lds_write(v, F.lds); __syncthreads(); conv8_store(d, F.lds); __syncthreads(); }
            else conv_tile(F.w_out, D, kt * 128, nt * 64, F.WoutT, nt * 64, F.lds); }
    }
}

__device__ __forceinline__ void phase1(const Frame& F, bool wait_mod) {
    if (wait_mod) {
        if (threadIdx.x == 0) { unsigned sp = 0; while (__hip_atomic_load(F.ctl + CW_MODRDY, __ATOMIC_RELAXED, __HIP_MEMORY_SCOPE_AGENT) < 96u) { __builtin_amdgcn_s_sleep(2); if (++sp > (1u << 22)) break; }
            __builtin_amdgcn_fence(__ATOMIC_ACQUIRE, "agent"); asm volatile("s_waitcnt vmcnt(0)" ::: "memory"); }
        __syncthreads();
    }
    const int lane = threadIdx.x & 63, wv = threadIdx.x >> 6;
    for (int r = blockIdx.x * 8 + wv; r < NROW; r += gridDim.x * 8) {
        const float* src; const float* md;
        if (r < NTOK) { src = F.x + (size_t)r * D; md = F.mod + (size_t)(r >> 11) * 6144; } else { src = F.ctx + (size_t)(r - NTOK) * D; md = F.mod + (size_t)8 * 6144; }
        f32x4 v[4]; float ss = 0.f;
#pragma unroll
        for (int j = 0; j < 4; ++j) { v[j] = *(const f32x4*)(src + 4 * lane + 256 * j); ss += (v[j][0] * v[j][0] + v[j][1] * v[j][1]) + (v[j][2] * v[j][2] + v[j][3] * v[j][3]); }
        ss = wave_sum(ss);
        const float rstd = __builtin_amdgcn_rsqf(ss * (1.0f / 1024.0f) + EPS);
#pragma unroll
        for (int j = 0; j < 4; ++j) {
            const int c = 4 * lane + 256 * j;
            const f32x4 nw = *(const f32x4*)(F.norm1 + c), sh = *(const f32x4*)(md + c), sc = *(const f32x4*)(md + 1024 + c);
            const f32x4 o = v[j] * rstd * nw * (1.0f + sc) + sh;
            if (INPROJ_FP8) *(unsigned*)((unsigned char*)F.H + (size_t)r * D + c) = pack_fp8x4(o[0], o[1], o[2], o[3]);
            else { u32x2 w; w.x = cvt_pk_bf16(o[0], o[1]); w.y = cvt_pk_bf16(o[2], o[3]); *(u32x2*)(F.H + (size_t)r * D + c) = w; }
        }
    }
}

__device__ __forceinline__ void phase4(const Frame& F) {
    const int lane = threadIdx.x & 63, wv = threadIdx.x >> 6;
    for (int t = blockIdx.x * 8 + wv; t < NTOK; t += gridDim.x * 8) {
        const size_t o = (size_t)t * GW + 8 * lane;
        const u32x4 fa = *(const u32x4*)(F.OF + o), fb = *(const u32x4*)(F.OB + o);
        const f32x4 s0 = (f32x4){bflo(fa.x) + bflo(fb.x), bfhi(fa.x) + bfhi(fb.x), bflo(fa.y) + bflo(fb.y), bfhi(fa.y) + bfhi(fb.y)};
        const f32x4 s1 = (f32x4){bflo(fa.z) + bflo(fb.z), bfhi(fa.z) + bfhi(fb.z), bflo(fa.w) + bflo(fb.w), bfhi(fa.w) + bfhi(fb.w)};
        float ss = (s0[0] * s0[0] + s0[1] * s0[1]) + (s0[2] * s0[2] + s0[3] * s0[3]) + (s1[0] * s1[0] + s1[1] * s1[1]) + (s1[2] * s1[2] + s1[3] * s1[3]);
        ss += __shfl_xor(ss, 1); ss += __shfl_xor(ss, 2); ss += __shfl_xor(ss, 4); ss += __shfl_xor(ss, 8);
        const float rstd = __builtin_amdgcn_rsqf(ss * (1.0f / 128.0f) + EPS);
        const f32x4 n0 = *(const f32x4*)(F.hgrn_norm + 8 * lane), n1 = *(const f32x4*)(F.hgrn_norm + 8 * lane + 4);
        const u32x4 g = *(const u32x4*)(F.GS + o);
        u32x4 w;
        w.x = cvt_pk_bf16(s0[0] * rstd * n0[0] * bflo(g.x), s0[1] * rstd * n0[1] * bfhi(g.x));
        w.y = cvt_pk_bf16(s0[2] * rstd * n0[2] * bflo(g.y), s0[3] * rstd * n0[3] * bfhi(g.y));
        w.z = cvt_pk_bf16(s1[0] * rstd * n1[0] * bflo(g.z), s1[1] * rstd * n1[1] * bfhi(g.z));
        w.w = cvt_pk_bf16(s1[2] * rstd * n1[2] * bflo(g.w), s1[3] * rstd * n1[3] * bfhi(g.w));
        if (OUTPROJ_FP8) { u32x2 w8; w8.x = pack_fp8x4(bflo(w.x), bfhi(w.x), bflo(w.y), bfhi(w.y)); w8.y = pack_fp8x4(bflo(w.z), bfhi(w.z), bflo(w.w), bfhi(w.w)); *(u32x2*)((unsigned char*)F.YCAT + (size_t)t * D + GW + 8 * lane) = w8; }
        else *(u32x4*)(F.YCAT + (size_t)t * D + GW + 8 * lane) = w;
    }
}

__device__ __forceinline__ void phase6(const Frame& F) {
    LAS unsigned char* WH = F.lds;
    LAS unsigned char* WL = F.lds + 65536;
    LAS float* LG = (LAS float*)(F.lds + 131072);
    LAS float* RSTD = LG + 64 * 32;
    LAS float* B2 = RSTD + 64;
    LAS float* B2P = B2 + 32;
    LAS int* lcnt = (LAS int*)(B2P + 512);
    LAS int* lbase = lcnt + 32;
    LAS int* sel = lbase + 32;
    LAS float* selw = (LAS float*)(sel + 256);
    const int tid = threadIdx.x, lane = tid & 63, wv = __builtin_amdgcn_readfirstlane(tid >> 6), fr = lane & 15, fq = lane >> 4;
    if (tid < 32) lcnt[tid] = 0;
    int cur_b = -1;
    for (int rep6 = 0; rep6 < (DBG_REP6 ? 2 : 1); ++rep6)
    for (int grp = blockIdx.x; grp < NTOK / 64; grp += gridDim.x) {
        const int b = (grp * 64) >> 11;
        const float* md = F.mod + (size_t)b * 6144;
        if (b != cur_b) {
            cur_b = b;
            __syncthreads();
            const int e = tid & 31;
            float bp = 0.f;
            for (int it = 0; it < 8; ++it) {
                const int c0 = ((tid >> 5) + 16 * it) * 8;
                const f32x4 n0 = *(const f32x4*)(F.norm2 + c0), n1 = *(const f32x4*)(F.norm2 + c0 + 4), s0 = *(const f32x4*)(md + 4096 + c0), s1 = *(const f32x4*)(md + 4096 + c0 + 4);
                const f32x4 h0 = *(const f32x4*)(md + 3072 + c0), h1 = *(const f32x4*)(md + 3072 + c0 + 4);
                float wa[8], lo[8];
#pragma unroll
                for (int j = 0; j < 8; ++j) { const float rw = F.router_w[(size_t)(c0 + j) * NE + e]; const float a = (j < 4 ? n0[j] * (1.0f + s0[j]) : n1[j - 4] * (1.0f + s1[j - 4])); wa[j] = rw * a; bp += rw * (j < 4 ? h0[j] : h1[j - 4]); }
                u32x4 hw; hw.x = cvt_pk_bf16(wa[0], wa[1]); hw.y = cvt_pk_bf16(wa[2], wa[3]); hw.z = cvt_pk_bf16(wa[4], wa[5]); hw.w = cvt_pk_bf16(wa[6], wa[7]);
                lo[0] = wa[0] - bflo(hw.x); lo[1] = wa[1] - bfhi(hw.x); lo[2] = wa[2] - bflo(hw.y); lo[3] = wa[3] - bfhi(hw.y); lo[4] = wa[4] - bflo(hw.z); lo[5] = wa[5] - bfhi(hw.z); lo[6] = wa[6] - bflo(hw.w); lo[7] = wa[7] - bfhi(hw.w);
                u32x4 lw; lw.x = cvt_pk_bf16(lo[0], lo[1]); lw.y = cvt_pk_bf16(lo[2], lo[3]); lw.z = cvt_pk_bf16(lo[4], lo[5]); lw.w = cvt_pk_bf16(lo[6], lo[7]);
                const int off = e * 2048 + (((c0 >> 3) ^ (e & 15)) << 4);
                *(LAS u32x4*)(WH + off) = hw; *(LAS u32x4*)(WL + off) = lw;
            }
            B2P[(tid >> 5) * 32 + e] = bp;
            __syncthreads();
            if (tid < 32) { float sb = F.router_b[tid];
#pragma unroll
                for (int k = 0; k < 16; ++k) sb += B2P[k * 32 + tid];
                B2[tid] = sb; }
        }
        f32x4 ca[4], cs[4];
#pragma unroll
        for (int j = 0; j < 4; ++j) { const int c = 4 * lane + 256 * j; const f32x4 nw = *(const f32x4*)(F.norm2 + c), sc = *(const f32x4*)(md + 4096 + c); ca[j] = nw * (1.0f + sc); cs[j] = *(const f32x4*)(md + 3072 + c); }
#pragma unroll 2
        for (int i = 0; i < 8; ++i) {
            const int tl = wv * 8 + i, t = grp * 64 + tl;
            float ss = (lane < 16) ? F.SS[(size_t)t * 16 + lane] : 0.f;
            u32x2 xw[4];
#pragma unroll
            for (int j = 0; j < 4; ++j) xw[j] = *(const u32x2*)(F.X1 + (size_t)t * D + 4 * lane + 256 * j);
            ss = wave_sum(ss);
            const float rstd = __builtin_amdgcn_rsqf(ss * (1.0f / 1024.0f) + EPS);
            if (lane == 0) RSTD[tl] = rstd;
#pragma unroll
            for (int j = 0; j < 4; ++j) {
                const f32x4 xv = (f32x4){bflo(xw[j].x), bfhi(xw[j].x), bflo(xw[j].y), bfhi(xw[j].y)};
                const f32x4 hv = xv * rstd * ca[j] + cs[j];
                *(unsigned*)(F.H2 + (size_t)t * D + 4 * lane + 256 * j) = pack_fp8x4(hv[0], hv[1], hv[2], hv[3]);
            }
        }
        {
            const int mt = wv & 3, nt = wv >> 2;
            const bf16_t* xa = F.X1 + (size_t)(grp * 64 + 16 * mt + fr) * D + 8 * fq;
            const int erow = 16 * nt + fr;
            f32x4 acc = (f32x4){0.f, 0.f, 0.f, 0.f};
            u32x4 af[8], an[8];
#pragma unroll
            for (int k = 0; k < 8; ++k) af[k] = *(const u32x4*)(xa + 32 * k);
#pragma unroll
            for (int kb = 0; kb < 4; ++kb) {
                if (kb < 3) {
#pragma unroll
                    for (int k = 0; k < 8; ++k) an[k] = *(const u32x4*)(xa + 32 * (8 * (kb + 1) + k));
                }
#pragma unroll
                for (int k = 0; k < 8; ++k) {
                    const int ks = 8 * kb + k;
                    const int off = erow * 2048 + ((((32 * ks) >> 3) + fq) ^ (erow & 15)) * 16;
                    const bf16x8 bh = *(const LAS bf16x8*)(WH + off), bl = *(const LAS bf16x8*)(WL + off);
                    acc = __builtin_amdgcn_mfma_f32_16x16x32_bf16(__builtin_bit_cast(bf16x8, af[k]), bh, acc, 0, 0, 0);
                    acc = __builtin_amdgcn_mfma_f32_16x16x32_bf16(__builtin_bit_cast(bf16x8, af[k]), bl, acc, 0, 0, 0);
                }
                if (kb < 3) {
#pragma unroll
                    for (int k = 0; k < 8; ++k) af[k] = an[k];
                }
            }
            __syncthreads();
            const float b2 = B2[erow];
#pragma unroll
            for (int r = 0; r < 4; ++r) { const int tl = 16 * mt + 4 * fq + r; LG[tl * 32 + erow] = RSTD[tl] * acc[r] + b2; }
        }
        __syncthreads();
        for (int i = 0; i < 8; ++i) {
            const int tl = wv * 8 + i;
            const int myexp = (lane >> 1) & 31;
            const float v = LG[tl * 32 + myexp];
            int rank = 0;
#pragma unroll
            for (int e = 0; e < NE; ++e) { const float o = __builtin_bit_cast(float, __builtin_amdgcn_readlane(__builtin_bit_cast(int, v), 2 * e)); rank += (o > v || (o == v && e < myexp)) ? 1 : 0; }
            const bool even = (lane & 1) == 0;
            float tv[4]; int te[4];
#pragma unroll
            for (int k = 0; k < 4; ++k) { const unsigned long long bal = __ballot(even && rank == k); const int src = (__ffsll((long long)bal) - 1) & 63; tv[k] = __shfl(v, src); te[k] = src >> 1; }
            const float e1 = __expf(tv[1] - tv[0]), e2 = __expf(tv[2] - tv[0]), e3 = __expf(tv[3] - tv[0]);
            const float inv = 1.0f / (1.0f + e1 + e2 + e3);
            if (lane < 4 && rep6 == 0) {
                const int e = (lane == 0) ? te[0] : (lane == 1) ? te[1] : (lane == 2) ? te[2] : te[3];
                const float wgt = ((lane == 0) ? 1.0f : (lane == 1) ? e1 : (lane == 2) ? e2 : e3) * inv;
                const int rk = __hip_atomic_fetch_add(lcnt + e, 1, __ATOMIC_RELAXED, __HIP_MEMORY_SCOPE_WORKGROUP);
                sel[tl * 4 + lane] = e | (rk << 8); selw[tl * 4 + lane] = wgt;
            }
        }
        __syncthreads();
        if (tid < 32 && rep6 == 0) { const int n = lcnt[tid]; lbase[tid] = n ? (int)__hip_atomic_fetch_add(F.ctl + CW_CNT + 64 * tid, (unsigned)n, __ATOMIC_RELAXED, __HIP_MEMORY_SCOPE_AGENT) : 0; lcnt[tid] = 0; }
        __syncthreads();
        if (tid < 256 && rep6 == 0) {
            const int sv = sel[tid], e = sv & 255, idx = lbase[e] + (sv >> 8), t = grp * 64 + (tid >> 2);
            F.LIST[e * NTOK + idx] = t; F.TSLOT[t * 4 + (tid & 3)] = e * NTOK + idx; F.TW[t * 4 + (tid & 3)] = selw[tid];
        }
        __syncthreads();
    }
}

__device__ __forceinline__ void phase9(const Frame& F) {
    moe_tables(F);
    const MoeTab T = moe_tab(F.lds);
    const int lane = threadIdx.x & 63, wv = threadIdx.x >> 6;
    for (int t = blockIdx.x * 8 + wv; t < NTOK; t += gridDim.x * 8) {
        const float* g2 = F.mod + (size_t)(t >> 11) * 6144 + 5120;
        float y[2][8];
#pragma unroll
        for (int j = 0; j < 2; ++j)
#pragma unroll
            for (int i = 0; i < 8; ++i) y[j][i] = 0.f;
#pragma unroll
        for (int k = 0; k < (DBG_NO_MOE ? 0 : 4); ++k) {
            const int sl = F.TSLOT[t * 4 + k]; const float wk = F.TW[t * 4 + k];
            const int e = sl >> 14, idx = sl & (NTOK - 1);
            const size_t row = (size_t)(T.tstart[e] * 256 + idx);
#pragma unroll
            for (int j = 0; j < 2; ++j) {
                const u32x2 d = *(const u32x2*)(F.DOUT + row * D + 8 * lane + 512 * j);
                const f32x2 p0 = __builtin_amdgcn_cvt_pk_f32_fp8((int)d.x, false), p1 = __builtin_amdgcn_cvt_pk_f32_fp8((int)d.x, true), p2 = __builtin_amdgcn_cvt_pk_f32_fp8((int)d.y, false), p3 = __builtin_amdgcn_cvt_pk_f32_fp8((int)d.y, true);
                const float wq = 0.25f * wk;
                y[j][0] += wq * p0[0]; y[j][1] += wq * p0[1]; y[j][2] += wq * p1[0]; y[j][3] += wq * p1[1];
                y[j][4] += wq * p2[0]; y[j][5] += wq * p2[1]; y[j][6] += wq * p3[0]; y[j][7] += wq * p3[1];
            }
        }
        float xf[2][8]; float ss = 0.f;
#pragma unroll
        for (int j = 0; j < 2; ++j) {
            const int c = 8 * lane + 512 * j;
            const u32x4 xw = *(const u32x4*)(F.X1 + (size_t)t * D + c); const f32x4 x0 = (f32x4){bflo(xw.x), bfhi(xw.x), bflo(xw.y), bfhi(xw.y)}, x1v = (f32x4){bflo(xw.z), bfhi(xw.z), bflo(xw.w), bfhi(xw.w)};
            const f32x4 ga = *(const f32x4*)(g2 + c), gb = *(const f32x4*)(g2 + c + 4);
#pragma unroll
            for (int i = 0; i < 4; ++i) { xf[j][i] = x0[i] + ga[i] * y[j][i]; xf[j][4 + i] = x1v[i] + gb[i] * y[j][4 + i]; }
#pragma unroll
            for (int i = 0; i < 8; ++i) ss += xf[j][i] * xf[j][i];
        }
        ss = wave_sum(ss);
        const float rstd = __builtin_amdgcn_rsqf(ss * (1.0f / 1024.0f) + EPS);
#pragma unroll
        for (int j = 0; j < 2; ++j) {
            const int c = 8 * lane + 512 * j;
            const f32x4 fa = *(const f32x4*)(F.final_norm + c), fb = *(const f32x4*)(F.final_norm + c + 4);
            f32x4 o0, o1;
#pragma unroll
            for (int i = 0; i < 4; ++i) { o0[i] = xf[j][i] * rstd * fa[i]; o1[i] = xf[j][4 + i] * rstd * fb[i]; }
            *(f32x4*)(F.out + (size_t)t * D + c) = o0; *(f32x4*)(F.out + (size_t)t * D + c + 4) = o1;
        }
    }
}

__device__ __forceinline__ void sgu_item(const Frame& F, int item) {
    constexpr int RS = 272;
    LAS unsigned char* WL = F.lds;
    LAS unsigned char* VT = F.lds + 128 * RS;
    const int tid = threadIdx.x, lane = tid & 63, wv = __builtin_amdgcn_readfirstlane(tid >> 6), fr = lane & 15, fq = lane >> 4;
    const int h = item & 3, n = (item >> 2) & 15, b = item >> 6;
    const int row0 = b * SEQ + n * 128;
    {
        const int t = tid >> 2, s0 = (tid & 3) * 32;
        const float* wp = F.sgu_w + ((size_t)h * 128 + t) * 128 + s0;
#pragma unroll
        for (int j = 0; j < 4; ++j) {
            const f32x4 a = *(const f32x4*)(wp + 8 * j), c = *(const f32x4*)(wp + 8 * j + 4);
            u32x4 w; w.x = cvt_pk_bf16(a[0], a[1]); w.y = cvt_pk_bf16(a[2], a[3]); w.z = cvt_pk_bf16(c[0], c[1]); w.w = cvt_pk_bf16(c[2], c[3]);
            *(LAS u32x4*)(WL + t * RS + (s0 + 8 * j) * 2) = w;
        }
    }
    {
        const int s = tid >> 2, d0 = (tid & 3) * 32;
        const bf16_t* vp = F.VG + (size_t)(row0 + s) * GW + h * 128 + d0;
        float v[32];
#pragma unroll
        for (int j = 0; j < 4; ++j) { const u32x4 w = *(const u32x4*)(vp + 8 * j);
            v[8 * j + 0] = bflo(w.x); v[8 * j + 1] = bfhi(w.x); v[8 * j + 2] = bflo(w.y); v[8 * j + 3] = bfhi(w.y); v[8 * j + 4] = bflo(w.z); v[8 * j + 5] = bfhi(w.z); v[8 * j + 6] = bflo(w.w); v[8 * j + 7] = bfhi(w.w); }
        float sm = 0.f;
#pragma unroll
        for (int i = 0; i < 32; ++i) sm += v[i];
        sm += __shfl_xor(sm, 1); sm += __shfl_xor(sm, 2);
        const float mu = sm * (1.0f / 128.0f); float q = 0.f;
#pragma unroll
        for (int i = 0; i < 32; ++i) { const float dd = v[i] - mu; q += dd * dd; }
        q += __shfl_xor(q, 1); q += __shfl_xor(q, 2);
        const float rstd = __builtin_amdgcn_rsqf(q * (1.0f / 128.0f) + EPS);
        const float* lg = F.sgu_ln + h * 128 + d0;
#pragma unroll
        for (int i = 0; i < 32; i += 2) {
            const unsigned pk = cvt_pk_bf16((v[i] - mu) * rstd * lg[i], (v[i + 1] - mu) * rstd * lg[i + 1]);
            *(LAS unsigned short*)(VT + (d0 + i) * RS + s * 2) = (unsigned short)(pk & 0xffffu);
            *(LAS unsigned short*)(VT + (d0 + i + 1) * RS + s * 2) = (unsigned short)(pk >> 16);
        }
    }
    __syncthreads();
    f32x4 acc[8];
#pragma unroll
    for (int nt = 0; nt < 8; ++nt) acc[nt] = (f32x4){0.f, 0.f, 0.f, 0.f};
#pragma unroll
    for (int a = 0; a < 4; ++a) {
        const bf16x8 wf = *(const LAS bf16x8*)(WL + (16 * wv + fr) * RS + (32 * a + 8 * fq) * 2);
#pragma unroll
        for (int nt = 0; nt < 8; ++nt) {
            const bf16x8 vf = *(const LAS bf16x8*)(VT + (16 * nt + fr) * RS + (32 * a + 8 * fq) * 2);
            acc[nt] = __builtin_amdgcn_mfma_f32_16x16x32_bf16(vf, wf, acc[nt], 0, 0, 0);
        }
    }
    {
        const int t = 16 * wv + fr; const size_t row = (size_t)(row0 + t);
        const float bias = F.sgu_b[h * 128 + t];
#pragma unroll
        for (int nt = 0; nt < 8; ++nt) {
            const int d = h * 128 + 16 * nt + 4 * fq;
            const u32x2 uu = *(const u32x2*)(F.U + row * GW + d);
            u32x2 w; w.x = cvt_pk_bf16(bflo(uu.x) * (acc[nt][0] + bias), bfhi(uu.x) * (acc[nt][1] + bias)); w.y = cvt_pk_bf16(bflo(uu.y) * (acc[nt][2] + bias), bfhi(uu.y) * (acc[nt][3] + bias));
            if (OUTPROJ_FP8) *(unsigned*)((unsigned char*)F.YCAT + row * D + d) = pack_fp8x4(bflo(w.x), bfhi(w.x), bflo(w.y), bfhi(w.y));
            else *(u32x2*)(F.YCAT + row * D + d) = w;
        }
    }
    __syncthreads();
}

__device__ __forceinline__ float hexp(float x) { return fast_exp(clampf(x, -87.0f, 60.0f)); }
namespace hg {
constexpr int RS = 256, OFF_QP = 0, OFF_QA = 8192, OFF_QB = OFF_QA + 4096, OFF_QC = OFF_QB + 4096, OFF_KA = OFF_QC + 4096, OFF_KB = OFF_KA + 4096, OFF_KC = OFF_KB + 4096,
              KDS = 96, OFF_KDT = OFF_KC + 4096, OFF_D = OFF_KDT + 128 * KDS, BUF = OFF_D + 512;
constexpr int RRS = 272;
constexpr int RAW_OFF = 2 * BUF, RAWBUF = 2 * 32 * RRS;
__device__ __forceinline__ int swz(int row, int byteoff) { return row * RS + (byteoff ^ ((row & 15) << 4)); }
struct QK { u32x2 kk[2], q[2]; };
struct GV { u32x4 g, v; };
struct Ctx {
    LAS unsigned char* lds; const bf16_t *Gp, *Kp, *Ip, *Qp; bf16_t* Op;
    int b, dir, sgn, colw, h, w, fr, fq, tid, slot0, cend;
    bf16_t* qcum;
    bf16x8 tri0, tri1;
};
__device__ __forceinline__ int base_row(const Ctx& X, int c) {
    return c < 8 ? (NTOK + X.b * CTXL + (X.dir ? (CTXL - 1 - 32 * c) : 32 * c)) : (X.b * SEQ + (X.dir ? (SEQ - 1 - 32 * (c - 8)) : 32 * (c - 8)));
}
template <bool ALLLAT> __device__ __forceinline__ void load_qk(const Ctx& X, int c, QK& r) {
    const int base = base_row(X, c);
#pragma unroll
    for (int j = 0; j < 2; ++j) {
        const int row = base + X.sgn * (X.fr + 16 * j);
        const unsigned o = (unsigned)(row * GW + X.colw + 4 * X.fq) * 2u;
        r.kk[j] = *(const u32x2*)((const char*)X.Kp + o);
        if (ALLLAT) r.q[j] = *(const u32x2*)((const char*)X.Qp + o);
        else { const unsigned oq = (unsigned)((row < NTOK ? row : row - NTOK) * GW + X.colw + 4 * X.fq) * 2u; r.q[j] = *(const u32x2*)((const char*)X.Qp + oq); }
    }
}
__device__ __forceinline__ void load_gv(const Ctx& X, int c, GV& r) {
    const int base = base_row(X, c);
    const unsigned o = (unsigned)((base + X.sgn * (X.tid >> 4)) * GW + X.h * 128 + 8 * (X.tid & 15)) * 2u;
    r.g = *(const u32x4*)((const char*)X.Gp + o); r.v = *(const u32x4*)((const char*)X.Ip + o);
}
__device__ __forceinline__ void raw_write(const Ctx& X, int c, const GV& r) {
    LAS unsigned char* rb = X.lds + RAW_OFF + (c & 1) * RAWBUF + (X.tid >> 4) * RRS + (X.tid & 15) * 16;
    *(LAS u32x4*)(rb) = r.g; *(LAS u32x4*)(rb + 32 * RRS) = r.v;
}
template <bool LAT, bool CUM> __device__ __forceinline__ bf16x8 stage(const Ctx& X, int c, const QK& qk, f32x4& Bsum) {
    LAS unsigned char* buf = X.lds + (c & 1) * BUF;
    const LAS unsigned char* rg = X.lds + RAW_OFF + (c & 1) * RAWBUF + (16 * X.w + X.fr) * 2;
    const int fr = X.fr, fq = X.fq, w = X.w;
    constexpr bool lat = LAT;
    unsigned gs[8], vs[8];
#pragma unroll
    for (int jj = 0; jj < 8; ++jj) {
        const int p = (jj < 4) ? (4 * fq + jj) : (16 + 4 * fq + jj - 4);
        gs[jj] = *(const LAS unsigned short*)(rg + p * RRS); vs[jj] = *(const LAS unsigned short*)(rg + 32 * RRS + p * RRS);
    }
    bf16x8 gT, VTf;
    { u32x4 t; t.x = gs[0] | (gs[1] << 16); t.y = gs[2] | (gs[3] << 16); t.z = gs[4] | (gs[5] << 16); t.w = gs[6] | (gs[7] << 16); gT = __builtin_bit_cast(bf16x8, t);
      u32x4 u; u.x = vs[0] | (vs[1] << 16); u.y = vs[2] | (vs[3] << 16); u.z = vs[4] | (vs[5] << 16); u.w = vs[6] | (vs[7] << 16); VTf = __builtin_bit_cast(bf16x8, u); }
    const f32x4 z4 = (f32x4){0.f, 0.f, 0.f, 0.f};
    f32x4 bT[2];
    bT[0] = __builtin_amdgcn_mfma_f32_16x16x32_bf16(gT, X.tri0, z4, 0, 0, 0);
    bT[1] = __builtin_amdgcn_mfma_f32_16x16x32_bf16(gT, X.tri1, z4, 0, 0, 0);
    f32x4 b7, b15, b23, b31;
#pragma unroll
    for (int r = 0; r < 4; ++r) { b7[r] = __shfl(bT[0][r], 16 * fq + 7); b15[r] = __shfl(bT[0][r], 16 * fq + 15); b23[r] = __shfl(bT[1][r], 16 * fq + 7); b31[r] = __shfl(bT[1][r], 16 * fq + 15); }
#pragma unroll
    for (int j = 0; j < 2; ++j) {
        const float kv[4] = {bflo(qk.kk[j].x), bfhi(qk.kk[j].x), bflo(qk.kk[j].y), bfhi(qk.kk[j].y)};
        const float qv[4] = {bflo(qk.q[j].x), bfhi(qk.q[j].x), bflo(qk.q[j].y), bfhi(qk.q[j].y)};
        float kd[4], qp[4], qi[4], ki[4], x2[4];
#pragma unroll
        for (int r = 0; r < 4; ++r) {
            const float bt = bT[j][r], mref = (j == 0) ? b7[r] : b23[r];
            kd[r] = kv[r] * hexp(b31[r] - bt);
            qp[r] = qv[r] * hexp(bt);
            qi[r] = qv[r] * hexp(bt - mref);
            ki[r] = kv[r] * hexp(mref - bt);
            x2[r] = (j == 0) ? kv[r] * hexp(b15[r] - bt) : qv[r] * hexp(bt - b15[r]);
        }
        const int trow = fr + 16 * j;
        const unsigned kd01 = cvt_pk_bf16(kd[0], kd[1]), kd23 = cvt_pk_bf16(kd[2], kd[3]);
        LAS unsigned char* kdp = buf + OFF_KDT + (16 * w + 4 * fq) * KDS + (X.slot0 + 4 * j) * 2;
        *(LAS unsigned short*)(kdp) = (unsigned short)(kd01 & 0xffffu); *(LAS unsigned short*)(kdp + KDS) = (unsigned short)(kd01 >> 16);
        *(LAS unsigned short*)(kdp + 2 * KDS) = (unsigned short)(kd23 & 0xffffu); *(LAS unsigned short*)(kdp + 3 * KDS) = (unsigned short)(kd23 >> 16);
        if (lat) {
            { u32x2 wv; wv.x = cvt_pk_bf16(ki[0], ki[1]); wv.y = cvt_pk_bf16(ki[2], ki[3]); *(LAS u32x2*)(buf + (j == 0 ? OFF_KA : OFF_KB) + swz(fr, (16 * w + 4 * fq) * 2)) = wv; }
            { u32x2 wv; wv.x = cvt_pk_bf16(qp[0], qp[1]); wv.y = cvt_pk_bf16(qp[2], qp[3]); *(LAS u32x2*)(buf + OFF_QP + swz(trow, (32 * (w >> 1) + 8 * fq + 4 * (w & 1)) * 2)) = wv; }
            if (CUM) { u32x2 wv; wv.x = cvt_pk_bf16(qv[0] * hexp(bT[j][0] + Bsum[0]), qv[1] * hexp(bT[j][1] + Bsum[1])); wv.y = cvt_pk_bf16(qv[2] * hexp(bT[j][2] + Bsum[2]), qv[3] * hexp(bT[j][3] + Bsum[3]));
                *(u32x2*)((char*)X.qcum + (unsigned)((32 * (c - 36) + trow) * 128 + 32 * (w >> 1) + 8 * fq + 4 * (w & 1)) * 2u) = wv; }
            { u32x2 wv; wv.x = cvt_pk_bf16(qi[0], qi[1]); wv.y = cvt_pk_bf16(qi[2], qi[3]); *(LAS u32x2*)(buf + (j == 0 ? OFF_QA : OFF_QB) + swz(fr, (16 * w + 4 * fq) * 2)) = wv; }
            { u32x2 wv; wv.x = cvt_pk_bf16(x2[0], x2[1]); wv.y = cvt_pk_bf16(x2[2], x2[3]); *(LAS u32x2*)(buf + (j == 0 ? OFF_KC : OFF_QC) + swz(fr, (16 * w + 4 * fq) * 2)) = wv; }
        }
    }
    if (fr == 0) { f32x4 dv; dv[0] = hexp(b31[0]); dv[1] = hexp(b31[1]); dv[2] = hexp(b31[2]); dv[3] = hexp(b31[3]); *(LAS f32x4*)(buf + OFF_D + (16 * w + 4 * fq) * 4) = dv; }
    if (CUM) Bsum += b31;
    return VTf;
}
template <bool LAT> __device__ __forceinline__ void products(const Ctx& X, int c, const bf16x8 VTf, f32x4 (&S)[8]) {
    const LAS unsigned char* buf = X.lds + (c & 1) * BUF;
    const int fr = X.fr, fq = X.fq;
    const f32x4 z4 = (f32x4){0.f, 0.f, 0.f, 0.f};
    if (LAT) {
        f32x4 X00 = z4, X11 = z4, X01 = z4;
#pragma unroll
        for (int a = 0; a < 4; ++a) {
            const int co = swz(fr, (32 * a + 8 * fq) * 2);
            const bf16x8 ka = *(const LAS bf16x8*)(buf + OFF_KA + co), qa = *(const LAS bf16x8*)(buf + OFF_QA + co);
            const bf16x8 kb = *(const LAS bf16x8*)(buf + OFF_KB + co), qb = *(const LAS bf16x8*)(buf + OFF_QB + co);
            const bf16x8 kc = *(const LAS bf16x8*)(buf + OFF_KC + co), qc = *(const LAS bf16x8*)(buf + OFF_QC + co);
            X00 = __builtin_amdgcn_mfma_f32_16x16x32_bf16(ka, qa, X00, 0, 0, 0);
            X11 = __builtin_amdgcn_mfma_f32_16x16x32_bf16(kb, qb, X11, 0, 0, 0);
            X01 = __builtin_amdgcn_mfma_f32_16x16x32_bf16(kc, qc, X01, 0, 0, 0);
        }
#pragma unroll
        for (int r = 0; r < 4; ++r) { const bool keep = (4 * fq + r) <= fr; X00[r] = keep ? X00[r] : 0.f; X11[r] = keep ? X11[r] : 0.f; }
        bf16x8 P0, P1;
        { u32x4 t; t.x = cvt_pk_bf16(X00[0], X00[1]); t.y = cvt_pk_bf16(X00[2], X00[3]); t.z = 0u; t.w = 0u; P0 = __builtin_bit_cast(bf16x8, t);
          u32x4 u; u.x = cvt_pk_bf16(X01[0], X01[1]); u.y = cvt_pk_bf16(X01[2], X01[3]); u.z = cvt_pk_bf16(X11[0], X11[1]); u.w = cvt_pk_bf16(X11[2], X11[3]); P1 = __builtin_bit_cast(bf16x8, u); }
        f32x4 o0 = __builtin_amdgcn_mfma_f32_16x16x32_bf16(VTf, P0, z4, 0, 0, 0);
        f32x4 o1 = __builtin_amdgcn_mfma_f32_16x16x32_bf16(VTf, P1, z4, 0, 0, 0);
#pragma unroll
        for (int a = 0; a < 4; ++a) {
            u32x4 t; t.x = cvt_pk_bf16(S[2 * a][0], S[2 * a][1]); t.y = cvt_pk_bf16(S[2 * a][2], S[2 * a][3]); t.z = cvt_pk_bf16(S[2 * a + 1][0], S[2 * a + 1][1]); t.w = cvt_pk_bf16(S[2 * a + 1][2], S[2 * a + 1][3]);
            const bf16x8 Sb = __builtin_bit_cast(bf16x8, t);
            const bf16x8 qp0 = *(const LAS bf16x8*)(buf + OFF_QP + swz(fr, (32 * a + 8 * fq) * 2)), qp1 = *(const LAS bf16x8*)(buf + OFF_QP + swz(16 + fr, (32 * a + 8 * fq) * 2));
            o0 = __builtin_amdgcn_mfma_f32_16x16x32_bf16(Sb, qp0, o0, 0, 0, 0);
            o1 = __builtin_amdgcn_mfma_f32_16x16x32_bf16(Sb, qp1, o1, 0, 0, 0);
        }
        const int base = base_row(X, c);
        { u32x2 w0, w1; w0.x = cvt_pk_bf16(o0[0], o0[1]); w0.y = cvt_pk_bf16(o0[2], o0[3]); w1.x = cvt_pk_bf16(o1[0], o1[1]); w1.y = cvt_pk_bf16(o1[2], o1[3]);
          *(u32x2*)((char*)X.Op + (unsigned)((base + X.sgn * fr) * GW + X.colw + 4 * fq) * 2u) = w0;
          *(u32x2*)((char*)X.Op + (unsigned)((base + X.sgn * (fr + 16)) * GW + X.colw + 4 * fq) * 2u) = w1; }
    }
#pragma unroll
    for (int kt = 0; kt < 8; ++kt) {
        const bf16x8 kdf = *(const LAS bf16x8*)(buf + OFF_KDT + (16 * kt + fr) * KDS + 16 * fq);
        const f32x4 dv = *(const LAS f32x4*)(buf + OFF_D + (16 * kt + 4 * fq) * 4);
        S[kt] = __builtin_amdgcn_mfma_f32_16x16x32_bf16(kdf, VTf, S[kt] * dv, 0, 0, 0);
    }
}
__device__ __forceinline__ void lds_barrier() {
    asm volatile("s_waitcnt lgkmcnt(0)" ::: "memory"); __builtin_amdgcn_s_barrier(); asm volatile("" ::: "memory");
}
template <bool PL, bool SL, bool CUM> __device__ __forceinline__ void iter(const Ctx& X, int c, QK& qk, GV& gv, bf16x8& VTcur, f32x4 (&S)[8], f32x4& Bsum) {
    lds_barrier();
    products<PL>(X, c, VTcur, S);
    VTcur = stage<SL, CUM>(X, c + 1, qk, Bsum);
    load_qk<CUM>(X, c + 3 < X.cend ? c + 3 : X.cend - 1, qk);
    if (c + 2 < X.cend) raw_write(X, c + 2, gv);
    load_gv(X, c + 4 < X.cend ? c + 4 : X.cend - 1, gv);
}
}
#ifndef HG_SPLIT
#define HG_SPLIT 52
#endif
template <int half> __device__ __forceinline__ void hgrn_chain(const Frame& F, int chain) {
    using namespace hg;
    Ctx X;
    X.lds = F.lds; X.tid = threadIdx.x; const int lane = X.tid & 63; X.w = __builtin_amdgcn_readfirstlane(X.tid >> 6); X.fr = lane & 15; X.fq = lane >> 4;
    X.dir = chain & 1; X.h = (chain >> 1) & 3; X.b = chain >> 3; X.sgn = X.dir ? -1 : 1; X.colw = X.h * 128 + 16 * X.w;
    X.Gp = X.dir ? F.GB : F.GF; X.Kp = X.dir ? F.KB : F.KF; X.Ip = F.I; X.Qp = F.Q; X.Op = X.dir ? F.OB : F.OF;
    X.slot0 = 8 * (X.fr >> 2) + (X.fr & 3);
    X.qcum = nullptr;
    X.cend = half ? 72 : HG_SPLIT;
#pragma unroll
    for (int jj = 0; jj < 8; ++jj) {
        X.tri0[jj] = (jj < 4 && 4 * X.fq + jj <= X.fr) ? (short)0x3F80 : (short)0;
        X.tri1[jj] = (jj < 4) ? (short)0x3F80 : ((4 * X.fq + jj - 4 <= X.fr) ? (short)0x3F80 : (short)0);
    }
    f32x4 S[8];
#pragma unroll
    for (int kt = 0; kt < 8; ++kt) S[kt] = (f32x4){0.f, 0.f, 0.f, 0.f};
    f32x4 Bsum = (f32x4){0.f, 0.f, 0.f, 0.f};
    QK qkA, qkB; GV gvA, gvB;
    load_gv(X, 0, gvA); load_gv(X, 1, gvB); load_qk<false>(X, 0, qkA); load_qk<false>(X, 1, qkB);
    raw_write(X, 0, gvA); load_gv(X, 2, gvA);
    lds_barrier();
    bf16x8 VTcur = stage<false, false>(X, 0, qkA, Bsum); load_qk<false>(X, 2, qkA);
    raw_write(X, 1, gvB); load_gv(X, 3, gvB);
    if constexpr (half == 0) {
        for (int c = 0; c < 6; c += 2) { iter<false, false, false>(X, c, qkB, gvA, VTcur, S, Bsum); iter<false, false, false>(X, c + 1, qkA, gvB, VTcur, S, Bsum); }
        iter<false, false, false>(X, 6, qkB, gvA, VTcur, S, Bsum); iter<false, true, false>(X, 7, qkA, gvB, VTcur, S, Bsum);
        for (int c = 8; c < HG_SPLIT - 2; c += 2) { iter<true, true, false>(X, c, qkB, gvA, VTcur, S, Bsum); iter<true, true, false>(X, c + 1, qkA, gvB, VTcur, S, Bsum); }
        iter<true, true, false>(X, HG_SPLIT - 2, qkB, gvA, VTcur, S, Bsum);
        lds_barrier();
        products<true>(X, HG_SPLIT - 1, VTcur, S);
    } else {
        for (int c = 0; c < HG_SPLIT - 2; c += 2) { iter<false, false, false>(X, c, qkB, gvA, VTcur, S, Bsum); iter<false, false, false>(X, c + 1, qkA, gvB, VTcur, S, Bsum); }
        iter<false, false, false>(X, HG_SPLIT - 2, qkB, gvA, VTcur, S, Bsum); iter<false, true, false>(X, HG_SPLIT - 1, qkA, gvB, VTcur, S, Bsum);
        for (int c = HG_SPLIT; c < 70; c += 2) { iter<true, true, false>(X, c, qkB, gvA, VTcur, S, Bsum); iter<true, true, false>(X, c + 1, qkA, gvB, VTcur, S, Bsum); }
        iter<true, true, false>(X, 70, qkB, gvA, VTcur, S, Bsum);
        lds_barrier();
        products<true>(X, 71, VTcur, S);
    }
    __syncthreads();
}

constexpr int CONV_P2_PER_WG = 38, CONV_P2_ITEMS = 20 * CONV_P2_PER_WG + 8;
constexpr int CONV_PER_WG = (CONV_ITEMS - CONV_P2_ITEMS) / 128;
#ifndef CONV_CHAIN_SHARE
#define CONV_CHAIN_SHARE 0
#endif
__device__ __forceinline__ void phase3(const Frame& F) {
    const int G = gridDim.x, bid = blockIdx.x;
    if (bid < 128) {
        if (bid & 1) hgrn_chain<1>(F, bid >> 1); else hgrn_chain<0>(F, bid >> 1);
        conv8_run(F, CONV_P2_ITEMS + bid + 128 * (CONV_PER_WG - CONV_CHAIN_SHARE), 128, CONV_CHAIN_SHARE);
    } else {
        const int j = bid - 128, nw = G - 128;
        for (int rep = 0; rep < ((DBG_REP3 & 2) ? 2 : 1); ++rep) for (int item = j; item < 512; item += nw) sgu_item(F, item);
        if (j < 128) conv8_run(F, CONV_P2_ITEMS + j, 128, CONV_PER_WG - CONV_CHAIN_SHARE);
    }
}

constexpr int N_PHASES = 10;
#ifndef DBG_NO_MOE
#define DBG_NO_MOE 0
#endif
#ifndef DBG_MAX_PHASE
#define DBG_MAX_PHASE 9
#endif
__global__ void __launch_bounds__(NTHREADS, 2) fwd_kernel(Args a) {
    extern __shared__ __attribute__((aligned(16))) unsigned char lds_raw[];
    Frame F;
    F.x = a.in[0]; F.c = a.in[1]; F.ctx = a.in[2]; F.c_ctx = a.in[3]; F.w_mod = a.in[4]; F.b_mod = a.in[5]; F.norm1 = a.in[6]; F.w_in = a.in[7]; F.sgu_ln = a.in[8]; F.sgu_w = a.in[9];
    F.sgu_b = a.in[10]; F.lb_fwd = a.in[11]; F.lb_bwd = a.in[12]; F.hgrn_norm = a.in[13]; F.w_out = a.in[14]; F.norm2 = a.in[15]; F.router_w = a.in[16]; F.router_b = a.in[17];
    F.w1 = a.in[18]; F.b1 = a.in[19]; F.w2 = a.in[20]; F.b2 = a.in[21]; F.final_norm = a.in[22];
    F.out = a.out; F.ws = a.ws; unsigned char* ws = a.ws;
    F.ctl = (unsigned*)(ws + WS_CTL); F.mod = (float*)(ws + WS_MOD);
    F.WinT = (bf16_t*)(ws + WS_WIN); F.WoutT = (bf16_t*)(ws + WS_WOUT); F.W1T = ws + WS_W1; F.W2T = ws + WS_W2;
    F.H = (bf16_t*)(ws + WS_H); F.U = (bf16_t*)(ws + WS_U); F.VG = (bf16_t*)(ws + WS_VG); F.Q = (bf16_t*)(ws + WS_Q); F.GS = (bf16_t*)(ws + WS_GS); F.I = (bf16_t*)(ws + WS_I);
    F.GF = (bf16_t*)(ws + WS_GF); F.KF = (bf16_t*)(ws + WS_KF); F.GB = (bf16_t*)(ws + WS_GB); F.KB = (bf16_t*)(ws + WS_KB);
    F.YCAT = (bf16_t*)(ws + WS_YCAT); F.H2 = ws + WS_H2; F.ACT = ws + WS_ACT; F.DOUT = ws + WS_DOUT;
    F.OF = (bf16_t*)(ws + WS_OF); F.OB = (bf16_t*)(ws + WS_OB); F.X1 = (bf16_t*)(ws + WS_X1); F.SS = (float*)(ws + WS_SS); F.TW = (float*)(ws + WS_TW);
    F.LIST = (int*)(ws + WS_LIST); F.TSLOT = (int*)(ws + WS_TSLOT); F.QCUM = (bf16_t*)(ws + WS_QCUM); F.SMID = ws + WS_SMID;
    F.lds = (LAS unsigned char*)lds_raw;
    if (threadIdx.x < 64) ((LAS unsigned*)(F.lds + LDS_MISC_OFF))[threadIdx.x] = 0u;
    __syncthreads();
    const int lo = a.ph_lo, hi = a.ph_hi, G = gridDim.x, cid = blockIdx.x;
    XcdBarrier bar; bar.bar = F.ctl + CW_BAR; bar.x = 0; bar.st = nullptr;
    if (hi - lo > 1) bar = xcd_barrier_post(F.ctl + CW_BAR, (volatile LAS unsigned*)(F.lds + LDS_MISC_OFF));
#define IN(k) (lo <= (k) && (k) < hi)
#define SEAM(k) do { if (IN(k) && IN((k) + 1)) xcd_barrier(bar); } while (0)
#define REP(k) for (int _r = 0; _r < (((DBG_REP >> (k)) & 1) ? 2 : 1); ++_r)
    if (IN(0)) REP(0) phase0(F);
    if (IN(1)) REP(1) phase1(F, IN(0));
    SEAM(1);
    for (int _b = 0; _b < DBG_BARX; ++_b) xcd_barrier(bar);
    if (IN(2)) REP(2) {
        const int GG = (G >= 256) ? 236 : G;
        if (cid < GG) { SchedInProj S{(const unsigned char*)F.WinT, GG, cid}; EpiInProj E{F.U, F.VG, F.Q, F.GS, F.I, F.GF, F.KF, F.GB, F.KB, F.lb_fwd, F.lb_bwd};
            pg::gemm_phase<EpiInProj, SchedInProj, INPROJ_FP8 != 0>(F.lds, (const char*)F.H, D, S, E); }
        else if (cid < 256) { const int k = cid - 236; conv8_run(F, k, 20, CONV_P2_PER_WG); if (k < 8) conv8_run(F, 20 * CONV_P2_PER_WG + k, 20, 1); }
    }
    SEAM(2);
    if (IN(3)) REP(3) phase3(F);
    SEAM(3);
    if (IN(4)) REP(4) phase4(F);
    SEAM(4);
    if (IN(5)) REP(5) {
        SchedOutProj S{F.WoutT, G, cid}; EpiOutProj E{F.x, F.mod, F.X1, F.SS};
        pg::gemm_phase<EpiOutProj, SchedOutProj, OUTPROJ_FP8 != 0>(F.lds, (const char*)F.YCAT, D, S, E);
    }
    SEAM(5);
    if (IN(6)) phase6(F);
    SEAM(6);
    if (IN(7)) {
        moe_tables(F);
        SchedMoe S{F.W1T, F.W2T, F.LIST, moe_tab(F.lds), G, cid, F.lds, F.ctl, (unsigned)WS_H2, (unsigned)WS_ACT, 0}; S.init();
        EpiMoe E{F.b1, F.b2, F.ACT, F.DOUT, F.lds, &S};
        S.preload(F.b1, F.b2);
        pg::gemm_phase<EpiMoe, SchedMoe, true>(F.lds, (const char*)F.ws, D, S, E);
    }
    SEAM(7);
    if (IN(9)) REP(9) phase9(F);
#undef IN
#undef SEAM
}

extern "C" void kernel_launch(void* const* d_in, const int* in_sizes, int n_in, void* d_out, int out_size, void* d_ws, size_t ws_size, hipStream_t stream) {
    static int grid = 0;
    if (grid == 0) {
        if (n_in != 23 || in_sizes[0] != NTOK * D || out_size != NTOK * D || ws_size < WS_END) {
            fprintf(stderr, "kernel_launch: unexpected shapes / workspace (n_in %d, in0 %d, out %d, ws %zu, need %zu); nothing launched\n", n_in, n_in > 0 ? in_sizes[0] : -1, out_size, ws_size, (size_t)WS_END);
            grid = -1; return;
        }
        int dev = 0, cus = 0;
        if (hipGetDevice(&dev) != hipSuccess || hipDeviceGetAttribute(&cus, hipDeviceAttributeMultiprocessorCount, dev) != hipSuccess) { grid = -1; return; }
        if (hipFuncSetAttribute((const void*)fwd_kernel, hipFuncAttributeMaxDynamicSharedMemorySize, LDS_BYTES) != hipSuccess) { fprintf(stderr, "kernel_launch: hipFuncSetAttribute failed\n"); grid = -1; return; }
        (void)hipGetLastError();
        grid = cus;
        if (grid < 256) { fprintf(stderr, "kernel_launch: needs >= 256 CUs\n"); grid = -1; return; }
    }
    if (grid < 0) return;
    (void)hipMemsetAsync((char*)d_ws + WS_CTL, 0, CTL_BYTES, stream);
    Args a{};
    for (int i = 0; i < 23; ++i) a.in[i] = (const float*)d_in[i];
    a.out = (float*)d_out; a.ws = (unsigned char*)d_ws;
#if N_LAUNCH_MODE == 1
    a.ph_lo = 0; a.ph_hi = N_PHASES;
    hipLaunchKernelGGL(fwd_kernel, dim3(grid), dim3(NTHREADS), LDS_BYTES, stream, a);
#else
    for (int p = 0; p < N_PHASES; ++p) { if (DBG_NO_MOE && p >= 6 && p <= 8) continue; a.ph_lo = p; a.ph_hi = p + 1; hipLaunchKernelGGL(fwd_kernel, dim3(grid), dim3(NTHREADS), LDS_BYTES, stream, a); }
#endif
}
```

```cpp
#include <hip/hip_runtime.h>
#include <cstdio>
#include <cstdint>

#ifndef N_LAUNCH_MODE
#define N_LAUNCH_MODE 1
#endif

#ifndef DBG_NO_MOE
#define DBG_NO_MOE 0
#endif
#ifndef DBG_REP
#define DBG_REP 0
#endif
#ifndef DBG_REP3
#define DBG_REP3 0
#endif
#ifndef DBG_REP6
#define DBG_REP6 0
#endif
#ifndef DBG_BARX
#define DBG_BARX 0
#endif
#ifndef FOLD_P4
#define FOLD_P4 1
#endif
#ifndef OUTPROJ_FP8
#define OUTPROJ_FP8 0
#endif
#ifndef INPROJ_FP8
#define INPROJ_FP8 0
#endif
#ifndef STAGGER_MOE_US
#define STAGGER_MOE_US 0
#endif
#ifndef STAGGER_MOE_SLOT
#define STAGGER_MOE_SLOT ((cid >> 6) & 3)
#endif
#ifndef STAGGER_INP_US
#define STAGGER_INP_US 0
#endif
#ifndef DBG_EPIWAIT
#define DBG_EPIWAIT 0
#endif
#ifndef DBG_MIX
#define DBG_MIX 1
#endif
#define LAS __attribute__((address_space(3)))
typedef unsigned short bf16_t;
typedef short bf16x8 __attribute__((ext_vector_type(8)));
typedef float f32x4 __attribute__((ext_vector_type(4)));
typedef float f32x2 __attribute__((ext_vector_type(2)));
typedef unsigned u32x4 __attribute__((ext_vector_type(4)));
typedef unsigned u32x2 __attribute__((ext_vector_type(2)));

constexpr int D = 1024, NB = 8, SEQ = 2048, CTXL = 256;
constexpr int NTOK = NB * SEQ;
constexpr int NCTX = NB * CTXL;
constexpr int NROW = NTOK + NCTX;
constexpr int DIN = 3584, GW = 512, NE = 32, DE = 1024, TOPK = 4;
constexpr int ACT_ROWS = NTOK * TOPK + NE * 256;
constexpr float EPS = 1e-6f;
constexpr int NTHREADS = 512;

constexpr int LDS_STAGE = 131072;
constexpr int LDS_EXTRA_OFF = LDS_STAGE;
constexpr int LDS_MISC_OFF = 155648;
constexpr int LDS_BYTES = LDS_MISC_OFF + 256;

constexpr size_t al256(size_t x) { return (x + 255) & ~(size_t)255; }
constexpr size_t WS_CTL = 0;
constexpr size_t CTL_BYTES = 65536;
constexpr int CW_BAR = 0;
constexpr int CW_CNT = 4096;
constexpr size_t WS_MOD = WS_CTL + CTL_BYTES;
constexpr size_t WS_LBT = WS_MOD + al256((size_t)9 * 6144 * 4);
constexpr size_t WS_WIN = WS_LBT + 4096;
constexpr size_t WS_WOUT = WS_WIN + (size_t)DIN * D * 2;
constexpr size_t WS_W1 = WS_WOUT + (size_t)D * D * 2;
constexpr size_t WS_W2 = WS_W1 + (size_t)NE * 2 * DE * D * 2;
constexpr size_t WS_YCAT = WS_W2 + (size_t)NE * D * DE * 2;
constexpr size_t WS_OF = WS_YCAT + (size_t)NTOK * D * 2;
constexpr size_t WS_OB = WS_OF + (size_t)NTOK * GW * 4;
constexpr size_t WS_X1 = WS_OB + (size_t)NTOK * GW * 4;
constexpr size_t WS_SS = WS_X1 + (size_t)NTOK * D * 4;
constexpr size_t WS_H2 = WS_SS + (size_t)NTOK * 16 * 4;
constexpr size_t WS_LIST = WS_H2 + (size_t)NTOK * D * 2;
constexpr size_t WS_TSLOT = WS_LIST + (size_t)NE * NTOK * 4;
constexpr size_t WS_TW = WS_TSLOT + (size_t)NTOK * 4 * 4;
constexpr size_t WS_QCUM = WS_TW + (size_t)NTOK * 4 * 4;
constexpr size_t WS_SMID = WS_QCUM + (size_t)64 * 1152 * 128 * 2;
constexpr size_t WS_ACT = WS_SMID + (size_t)64 * 8 * 4 * 64 * 16;
constexpr size_t WS_REGA = WS_ACT + (size_t)ACT_ROWS * DE * 2;
constexpr size_t WS_H = WS_REGA;
constexpr size_t WS_U = WS_H + (size_t)NROW * D * 2;
constexpr size_t WS_VG = WS_U + (size_t)NTOK * GW * 2;
constexpr size_t WS_Q = WS_VG + (size_t)NTOK * GW * 2;
constexpr size_t WS_GS = WS_Q + (size_t)NTOK * GW * 2;
constexpr size_t WS_I = WS_GS + (size_t)NTOK * GW * 2;
constexpr size_t WS_GF = WS_I + (size_t)NROW * GW * 2;
constexpr size_t WS_KF = WS_GF + (size_t)NROW * GW * 2;
constexpr size_t WS_GB = WS_KF + (size_t)NROW * GW * 2;
constexpr size_t WS_KB = WS_GB + (size_t)NROW * GW * 2;
constexpr size_t WS_REGA_END = WS_KB + (size_t)NROW * GW * 2;
constexpr size_t WS_DOUT = WS_REGA;
constexpr size_t WS_END0 = WS_DOUT + (size_t)ACT_ROWS * D * 2;
constexpr size_t WS_END = WS_END0 > WS_REGA_END ? WS_END0 : WS_REGA_END;

typedef __bf16 bf16x2_t __attribute__((ext_vector_type(2)));
__device__ __forceinline__ unsigned cvt_pk_bf16(float lo, float hi) { bf16x2_t v; v[0] = (__bf16)lo; v[1] = (__bf16)hi; return __builtin_bit_cast(unsigned, v); }
__device__ __forceinline__ float bf2f(unsigned b) { return __uint_as_float(b << 16); }
__device__ __forceinline__ float bflo(unsigned w) { return __uint_as_float(w << 16); }
__device__ __forceinline__ float bfhi(unsigned w) { return __uint_as_float(w & 0xffff0000u); }
__device__ __forceinline__ float fast_exp(float x) { return __builtin_amdgcn_exp2f(x * 1.44269504089f); }
__device__ __forceinline__ float fast_rcp(float x) { return __builtin_amdgcn_rcpf(x); }
__device__ __forceinline__ float sigmoidf_(float x) { return fast_rcp(1.0f + fast_exp(-x)); }
__device__ __forceinline__ float gelu_tanh(float x) { const float u = 1.5957691216f * (x + 0.044715f * x * x * x); return x * fast_rcp(1.0f + fast_exp(-u)); }
__device__ __forceinline__ float clampf(float x, float lo, float hi) { return fminf(fmaxf(x, lo), hi); }
typedef float f32x2 __attribute__((ext_vector_type(2)));
__device__ __forceinline__ f32x2 rcp_pair(f32x2 d) { const float r = fast_rcp(d.x * d.y); return (f32x2){d.y, d.x} * r; }
__device__ __forceinline__ float wave_sum(float v) {
#pragma unroll
    for (int o = 32; o >= 1; o >>= 1) v += __shfl_xor(v, o);
    return v;
}
__device__ __forceinline__ unsigned pack_fp8x4_nc(float a, float b, float c, float d) {
    int p = __builtin_amdgcn_cvt_pk_fp8_f32(a, b, 0, false); p = __builtin_amdgcn_cvt_pk_fp8_f32(c, d, p, true); return (unsigned)p;
}
__device__ __forceinline__ unsigned pack_fp8x4(float a, float b, float c, float d) {
    a = __builtin_amdgcn_fmed3f(a, -448.f, 448.f); b = __builtin_amdgcn_fmed3f(b, -448.f, 448.f); c = __builtin_amdgcn_fmed3f(c, -448.f, 448.f); d = __builtin_amdgcn_fmed3f(d, -448.f, 448.f);
    int p = __builtin_amdgcn_cvt_pk_fp8_f32(a, b, 0, false); p = __builtin_amdgcn_cvt_pk_fp8_f32(c, d, p, true); return (unsigned)p;
}
#define VM_WAIT() asm volatile("s_waitcnt vmcnt(0)" ::: "memory")
#define LDS_WAIT() asm volatile("s_waitcnt lgkmcnt(0)" ::: "memory")

#define XB_TMO      128
#define XB_XCNT(j)  (256  + 64 * (j))
#define XB_XSUB(j)  (1280 + 64 * (j))
#define XB_XGEN(j)  (2304 + 64 * (j))
#define XB_TOP      3328
#define XB_TOPGEN   3392
#define XCD_BAR_WORDS 3456
#define XB_SPIN_CAP (1u << 18)
__device__ __forceinline__ unsigned xb_ld(unsigned* p)              { return __hip_atomic_load(p, __ATOMIC_RELAXED, __HIP_MEMORY_SCOPE_AGENT); }
__device__ __forceinline__ unsigned xb_add(unsigned* p, unsigned v) { return __hip_atomic_fetch_add(p, v, __ATOMIC_RELAXED, __HIP_MEMORY_SCOPE_AGENT); }
__device__ __forceinline__ unsigned xb_xcc_id() { return (unsigned)__builtin_amdgcn_s_getreg((3 << 11) | 20) & 0xFu; }
#define XB_SPIN(cond, bar) do { unsigned _sp = 0; while (cond) { __builtin_amdgcn_s_sleep(1); \
    if ((++_sp & 255u) == 0u) { if (xb_ld(&(bar)[XB_TMO])) break; if (_sp > XB_SPIN_CAP) { atomicAdd(&(bar)[XB_TMO], 1u); break; } } } } while (0)
struct XcdBarrier { unsigned* bar; unsigned x; volatile LAS unsigned* st; };
__device__ __forceinline__ XcdBarrier xcd_barrier_post(unsigned* bar, volatile LAS unsigned* st) {
    XcdBarrier b; b.bar = bar; b.x = xb_xcc_id(); b.st = st;
    if (threadIdx.x == 0) (void)xb_add(&bar[XB_XCNT(b.x)], 1u);
    return b;
}
__device__ __forceinline__ void xcd_barrier_complete(unsigned* bar, unsigned x, unsigned& nloc, unsigned& nx) {
    const unsigned G = gridDim.x * gridDim.y * gridDim.z;
    unsigned sum, cnt, mine, sp = 0u;
    for (;;) {
        sum = 0u; cnt = 0u; mine = 0u;
#pragma unroll
        for (unsigned j = 0; j < 16; ++j) { const unsigned c = xb_ld(&bar[XB_XCNT(j)]); sum += c; cnt += (c > 0u) ? 1u : 0u; mine = (j == x) ? c : mine; }
        if (sum == G) break;
        __builtin_amdgcn_s_sleep(1);
        if ((++sp & 255u) == 0u) { if (xb_ld(&bar[XB_TMO])) break; if (sp > XB_SPIN_CAP) { atomicAdd(&bar[XB_TMO], 1u); break; } }
    }
    nloc = mine > 0u ? mine : 1u; nx = cnt > 0u ? cnt : 1u;
}
__device__ __forceinline__ void xcd_barrier(const XcdBarrier& b) {
    asm volatile("s_waitcnt vmcnt(0)" ::: "memory");
    __syncthreads();
    if (threadIdx.x == 0) {
        unsigned* bar = b.bar;
        __builtin_amdgcn_s_waitcnt(0);
        unsigned nloc = b.st[0], nx = b.st[1];
        if (nloc == 0u) { xcd_barrier_complete(bar, b.x, nloc, nx); b.st[0] = nloc; b.st[1] = nx; }
        const unsigned old = xb_add(&bar[XB_XSUB(b.x)], 1u);
        const unsigned gen = old / nloc;
        if (old + 1u == (gen + 1u) * nloc) {
            __builtin_amdgcn_fence(__ATOMIC_RELEASE, "agent");
            asm volatile("s_waitcnt vmcnt(0)" ::: "memory");
            const unsigned og = xb_add(&bar[XB_TOP], 1u);
            const unsigned tg = og / nx;
            if (og + 1u == (tg + 1u) * nx) xb_add(&bar[XB_TOPGEN], 1u);
            else XB_SPIN(xb_ld(&bar[XB_TOPGEN]) == tg, bar);
            __builtin_amdgcn_fence(__ATOMIC_ACQUIRE, "agent");
            xb_add(&bar[XB_XGEN(b.x)], 1u);
            asm volatile("s_waitcnt vmcnt(0)" ::: "memory");
        } else {
            XB_SPIN(xb_ld(&bar[XB_XGEN(b.x)]) == gen, bar);
            __builtin_amdgcn_fence(__ATOMIC_ACQUIRE, "agent");
            asm volatile("s_waitcnt vmcnt(0)" ::: "memory");
        }
    }
    __syncthreads();
}

struct Args { const float* in[23]; float* out; unsigned char* ws; int ph_lo, ph_hi; };
struct Frame {
    const float *x, *c, *ctx, *c_ctx, *w_mod, *b_mod, *norm1, *w_in, *sgu_ln, *sgu_w, *sgu_b, *lb_fwd, *lb_bwd, *hgrn_norm, *w_out, *norm2,
                *router_w, *router_b, *w1, *b1, *w2, *b2, *final_norm;
    float* out; unsigned char* ws;
    unsigned* ctl; float* mod; float* LBT;
    bf16_t *WinT, *WoutT, *H, *U, *VG, *Q, *GS, *I, *GF, *KF, *GB, *KB, *YCAT; unsigned char* DOUT;
    unsigned char *W1T, *W2T, *H2, *ACT;
    float *SS, *TW; bf16_t *OF, *OB, *X1;
    bf16_t* QCUM; unsigned char* SMID;
    int *LIST, *TSLOT;
    LAS unsigned char* lds;
};

namespace pg {
constexpr int BM = 256, BK = 64, HALF = 128, HTB = HALF * BK * 2, NXCD = 8, WGM = 8;
__device__ __forceinline__ int lds_byte(int r, int c) { const int st = (r >> 4) * 2 + (c >> 5), rr = r & 15, cc = c & 31, ob = rr * 64 + cc * 2; return st * 1024 + (ob ^ (((ob >> 9) & 1) << 5)); }
__device__ __forceinline__ void stage_rc(int b, int& R, int& C) { const int st = b / 1024, sb = b % 1024, swz = sb ^ (((sb >> 9) & 1) << 5); R = (st >> 1) * 16 + swz / 64; C = (st & 1) * 32 + (swz % 64) / 2; }
__device__ __forceinline__ int perm32(int rho) { const int n = rho >> 4, i = rho & 15; return 8 * (i >> 2) + 4 * n + (i & 3); }

struct Unit { const char* bptr; int arow, orow, pn, e, cnt, pad, kind, idx; };

__device__ __forceinline__ bool static_order(int nM, int nN, int L, int& pm, int& pn) {
    const int nwg = nM * nN; if (L >= nwg) return false;
    int wgid = L; { const int q = nwg / NXCD, r = nwg % NXCD, xcd = wgid % NXCD, off = wgid / NXCD; wgid = (xcd < r ? xcd * (q + 1) : r * (q + 1) + (xcd - r) * q) + off; }
    const int nig = WGM * nN, gid = wgid / nig, fm = gid * WGM, gsz = (nM - fm) < WGM ? (nM - fm) : WGM;
    pm = fm + ((wgid % nig) % gsz); pn = (wgid % nig) / gsz; return true;
}

typedef int v8i __attribute__((ext_vector_type(8)));
typedef int v4i __attribute__((ext_vector_type(4)));
template <class Epi, class Sched, bool FP8>
__device__ __forceinline__ void gemm_phase(LAS unsigned char* lds, const char* Abase, const int K, const Sched& S, const Epi& E) {
    const int tid = threadIdx.x, wid = __builtin_amdgcn_readfirstlane(tid >> 6), lane = tid & 63, wr = wid >> 2, wc = wid & 3, fr = lane & 15, fq = lane >> 4;
    const int pitch = FP8 ? K : 2 * K;
    const int nt = pitch / 128;
    int sR[2], sC[2]; unsigned voffB[2];
#pragma unroll
    for (int i = 0; i < 2; ++i) { stage_rc(tid * 16 + i * 8192, sR[i], sC[i]); const int Rb = Epi::PERM ? ((sR[i] & ~31) + perm32(sR[i] & 31)) : sR[i]; voffB[i] = (unsigned)(Rb * pitch + 2 * sC[i]); }
    const size_t kstep = (size_t)(BK * 2);
    const size_t hstep = (size_t)HALF * pitch;
    const unsigned ldsw = (unsigned)wid * 1024u;
    const int aoff = lds_byte(wr * 64 + fr, fq * 8), boff = lds_byte(wc * 32 + fr, fq * 8);
#define PG_SA(b, h) (((b) * 2 + (h)) * HTB)
#define PG_SB(b, h) ((4 + (b) * 2 + (h)) * HTB)
#define PG_STAGE(bufoff, gbase, voff) do { _Pragma("unroll") for (int _i = 0; _i < 2; ++_i) \
        __builtin_amdgcn_global_load_lds((const unsigned*)((const char*)(gbase) + (voff)[_i]), (LAS unsigned*)(lds + (bufoff) + ldsw + _i * 8192), 16, 0, 0); } while (0)
#define PG_LDA(dst, b, h) do { _Pragma("unroll") for (int m = 0; m < 4; ++m) { dst[m].lo = *(const LAS v4i*)(lds + PG_SA(b, h) + aoff + m * 2048); dst[m].hi = *(const LAS v4i*)(lds + PG_SA(b, h) + aoff + m * 2048 + 1024); } } while (0)
#define PG_LDB(dst, b, h) do { _Pragma("unroll") for (int n = 0; n < 2; ++n) { dst[n].lo = *(const LAS v4i*)(lds + PG_SB(b, h) + boff + n * 2048); dst[n].hi = *(const LAS v4i*)(lds + PG_SB(b, h) + boff + n * 2048 + 1024); } } while (0)
#define PG_MMA(ai, bj, At, Bt) do { __builtin_amdgcn_s_setprio(1); _Pragma("unroll") for (int m = 0; m < 4; ++m) _Pragma("unroll") for (int n = 0; n < 2; ++n) { \
        if constexpr (FP8) acc[ai][bj][m][n] = __builtin_amdgcn_mfma_scale_f32_16x16x128_f8f6f4(Bt[n], At[m], acc[ai][bj][m][n], 0, 0, 0, 0x7a7a7a7a, 0, 0x7f7f7f7f); \
        else { const v4i _bl = Bt[n].lo, _bh = Bt[n].hi, _al = At[m].lo, _ah = At[m].hi;     \
               acc[ai][bj][m][n] = __builtin_amdgcn_mfma_f32_16x16x32_bf16(__builtin_bit_cast(bf16x8, _bl), __builtin_bit_cast(bf16x8, _al), acc[ai][bj][m][n], 0, 0, 0); \
               acc[ai][bj][m][n] = __builtin_amdgcn_mfma_f32_16x16x32_bf16(__builtin_bit_cast(bf16x8, _bh), __builtin_bit_cast(bf16x8, _ah), acc[ai][bj][m][n], 0, 0, 0); } } \
        __builtin_amdgcn_s_setprio(0); } while (0)
#define PG_WAIT_V(n) asm volatile("s_waitcnt vmcnt(" #n ")" ::: "memory")
#define PG_WAIT_L(n) asm volatile("s_waitcnt lgkmcnt(" #n ")" ::: "memory")
#define PG_BAR __builtin_amdgcn_s_barrier()
#define PG_SCHED __builtin_amdgcn_sched_barrier(0)
    Unit cur, nxt, nn; int ui = 0;
    if (!S.next(0, cur)) return;
    bool has_next = S.next(1, nxt);
    unsigned vA[2][2], vN[2][2];
    S.a_ready(cur);
    S.aoff(cur, sR, sC, vA);
    if (has_next) S.aoff(nxt, sR, sC, vN); else { vN[0][0] = vA[0][0]; vN[0][1] = vA[0][1]; vN[1][0] = vA[1][0]; vN[1][1] = vA[1][1]; }
    f32x4 acc[2][2][4][2];
#pragma unroll
    for (int a = 0; a < 2; ++a)
#pragma unroll
        for (int b = 0; b < 2; ++b)
#pragma unroll
            for (int m = 0; m < 4; ++m)
#pragma unroll
                for (int n = 0; n < 2; ++n) acc[a][b][m][n] = (f32x4){0.f, 0.f, 0.f, 0.f};
    v8i At[4], B0[2], B1[2];
    const char* cB = cur.bptr;
    PG_STAGE(PG_SB(0, 0), cB, voffB); PG_STAGE(PG_SA(0, 0), Abase, vA[0]); PG_STAGE(PG_SB(0, 1), cB + hstep, voffB); PG_STAGE(PG_SA(0, 1), Abase, vA[1]);
    if (wr == 1) PG_BAR;
    PG_WAIT_V(4); PG_BAR;
    PG_STAGE(PG_SB(1, 0), cB + kstep, voffB); PG_STAGE(PG_SA(1, 0), Abase + kstep, vA[0]); PG_STAGE(PG_SB(1, 1), cB + hstep + kstep, voffB);
    PG_WAIT_V(6); PG_BAR;
    for (;;) {
        const char* nB = has_next ? nxt.bptr : cB;
#pragma unroll 1
        for (int t = 0; t < nt; t += 2) {
            const bool last = (t == nt - 2);
            if (last && has_next) S.a_ready(nxt);
            const char* a1 = Abase + (size_t)(t + 1) * kstep;
            const char* a2 = last ? Abase : Abase + (size_t)(t + 2) * kstep; const char* b2 = last ? nB : cB + (size_t)(t + 2) * kstep;
            const char* a3 = a2 + kstep; const char* b3 = b2 + kstep;
            PG_LDB(B0, 0, 0); PG_SCHED; PG_LDA(At, 0, 0); PG_STAGE(PG_SA(1, 1), a1, vA[1]);
            if (last) { vA[0][0] = vN[0][0]; vA[0][1] = vN[0][1]; vA[1][0] = vN[1][0]; vA[1][1] = vN[1][1]; }
            PG_WAIT_L(8); PG_BAR; PG_WAIT_L(0); PG_MMA(0, 0, At, B0); PG_BAR; PG_SCHED;
            PG_LDB(B1, 0, 1); PG_STAGE(PG_SB(0, 0), b2, voffB);
            PG_BAR; PG_WAIT_L(0); PG_MMA(0, 1, At, B1); PG_BAR;
            PG_LDA(At, 0, 1); PG_STAGE(PG_SA(0, 0), a2, vA[0]);
            PG_BAR; PG_WAIT_L(0); PG_MMA(1, 0, At, B0); PG_BAR; PG_SCHED;
            PG_STAGE(PG_SB(0, 1), b2 + hstep, voffB);
            PG_WAIT_V(6); PG_BAR; PG_MMA(1, 1, At, B1); PG_BAR;
            PG_LDB(B0, 1, 0); PG_SCHED; PG_LDA(At, 1, 0); PG_STAGE(PG_SA(0, 1), a2, vA[1]);
            PG_WAIT_L(8); PG_BAR; PG_WAIT_L(0); PG_MMA(0, 0, At, B0); PG_BAR; PG_SCHED;
            PG_LDB(B1, 1, 1); PG_STAGE(PG_SB(1, 0), b3, voffB);
            PG_BAR; PG_WAIT_L(0); PG_MMA(0, 1, At, B1); PG_BAR;
            PG_LDA(At, 1, 1); PG_STAGE(PG_SA(1, 0), a3, vA[0]);
            PG_BAR; PG_WAIT_L(0); PG_MMA(1, 0, At, B0); PG_BAR; PG_SCHED;
            PG_STAGE(PG_SB(1, 1), b3 + hstep, voffB);
            PG_WAIT_V(6); PG_BAR; PG_MMA(1, 1, At, B1); PG_BAR;
        }
        if (DBG_EPIWAIT) asm volatile("s_waitcnt vmcnt(0)" ::: "memory");
        E(acc, cur, wr, wc, fr, fq);
        S.done(cur);
        if (!has_next) break;
#pragma unroll
        for (int a = 0; a < 2; ++a)
#pragma unroll
            for (int b = 0; b < 2; ++b)
#pragma unroll
                for (int m = 0; m < 4; ++m)
#pragma unroll
                    for (int n = 0; n < 2; ++n) acc[a][b][m][n] = (f32x4){0.f, 0.f, 0.f, 0.f};
        cur = nxt; cB = nB; ++ui;
        has_next = S.next(ui + 1, nn);
        if (has_next) { nxt = nn; S.aoff(nxt, sR, sC, vN); }
    }
    PG_WAIT_V(0);
    if (wr == 0) PG_BAR;
    PG_BAR;
#undef PG_SA
#undef PG_SB
#undef PG_STAGE
#undef PG_LDA
#undef PG_LDB
#undef PG_MMA
#undef PG_WAIT_V
#undef PG_WAIT_L
#undef PG_BAR
#undef PG_SCHED
}
}

typedef f32x4 Acc[2][2][4][2];

constexpr unsigned short INP_ORDER[4][236] = {
  {0,1,2,3,4,5,6,7,8,9,10,11,12,13,14,15,16,17,18,19,20,21,22,23,24,25,26,27,28,29,30,31,32,33,34,35,36,37,38,39,40,41,42,43,44,45,46,47,48,49,50,51,52,53,54,55,56,57,58,59,60,61,62,63,64,65,66,67,68,69,70,71,72,73,74,75,76,77,78,79,80,81,82,83,84,85,86,87,88,89,90,91,92,93,94,95,96,97,98,99,100,101,102,103,104,105,106,107,108,109,110,111,112,113,114,115,116,117,118,119,120,121,122,123,124,125,126,127,128,129,130,131,132,133,134,135,136,137,138,139,140,141,142,143,144,145,146,147,148,149,150,151,152,153,154,155,156,157,158,159,160,161,162,163,164,165,166,167,168,169,170,171,172,173,174,175,176,177,178,179,180,181,182,183,184,185,186,187,188,189,190,191,192,193,194,195,196,197,198,199,200,201,202,203,204,205,206,207,208,209,210,211,212,213,214,215,216,217,218,219,220,221,222,223,224,225,226,227,228,229,230,231,232,233,234,235},
  {236,237,238,239,240,241,242,243,244,245,246,247,248,249,250,251,252,253,254,255,256,257,258,259,260,261,262,263,264,265,266,267,268,269,270,271,272,273,274,275,276,277,278,279,280,281,282,283,284,285,286,287,288,289,290,291,292,293,294,295,296,297,298,299,300,301,302,303,304,305,306,307,308,309,310,311,312,313,314,315,316,317,318,319,320,321,322,323,324,325,326,327,328,329,330,331,332,333,334,335,336,337,338,339,340,341,342,343,344,345,346,347,348,349,350,351,352,353,354,355,356,357,358,359,360,361,362,363,364,365,366,367,368,369,370,371,372,373,374,375,376,377,378,379,380,381,382,383,384,385,386,387,388,389,390,391,392,393,394,395,396,397,398,399,400,401,402,403,404,405,406,407,408,409,410,411,412,413,414,415,416,417,418,419,420,421,422,423,424,425,426,427,428,429,430,431,432,433,434,435,436,437,438,439,440,441,442,443,444,445,446,447,448,449,450,451,452,453,454,455,456,457,458,459,460,461,462,463,464,465,466,467,468,469,470,471},
  {488,489,490,491,500,501,502,503,496,497,498,499,508,509,510,511,504,505,506,507,516,517,518,519,512,513,514,515,524,525,526,527,520,521,522,523,532,533,534,535,528,529,530,531,540,541,542,543,536,537,538,539,548,549,550,551,544,545,546,547,556,557,558,559,552,553,554,555,564,565,566,567,560,561,562,563,572,573,574,575,568,569,570,571,580,581,582,583,576,577,578,579,588,589,590,591,584,585,586,587,596,597,598,599,592,593,594,595,604,605,606,607,600,601,602,603,612,613,614,615,608,609,610,611,620,621,622,623,616,617,618,619,628,629,630,631,624,625,626,627,636,637,638,639,632,633,634,635,644,645,646,647,640,641,642,643,652,653,654,655,648,649,650,651,660,661,662,663,656,657,658,659,668,669,670,671,664,665,666,667,676,677,678,679,672,673,674,675,684,685,686,687,680,681,682,683,692,693,694,695,688,689,690,691,700,701,702,703,696,697,698,699,476,477,478,479,704,705,706,707,484,485,486,487,472,473,474,475,492,493,494,495,480,481,482,483},
  {724,725,726,727,736,737,738,739,732,733,734,735,744,745,746,747,740,741,742,743,752,753,754,755,748,749,750,751,760,761,762,763,756,757,758,759,768,769,770,771,764,765,766,767,776,777,778,779,772,773,774,775,784,785,786,787,780,781,782,783,792,793,794,795,788,789,790,791,800,801,802,803,796,797,798,799,808,809,810,811,804,805,806,807,816,817,818,819,812,813,814,815,824,825,826,827,820,821,822,823,832,833,834,835,828,829,830,831,840,841,842,843,836,837,838,839,848,849,850,851,844,845,846,847,856,857,858,859,852,853,854,855,864,865,866,867,860,861,862,863,872,873,874,875,868,869,870,871,880,881,882,883,876,877,878,879,888,889,890,891,884,885,886,887,928,929,930,931,892,893,894,895,936,937,938,939,932,933,934,935,896,897,898,899,940,941,942,943,904,905,906,907,900,901,902,903,912,913,914,915,908,909,910,911,920,921,922,923,916,917,918,919,712,713,714,715,924,925,926,927,720,721,722,723,708,709,710,711,728,729,730,731,716,717,718,719}
};
struct SchedInProj {
    __device__ __forceinline__ void a_ready(const pg::Unit&) const {}
    __device__ __forceinline__ void done(const pg::Unit&) const {}
    const unsigned char* WinT; int G, c;
    static constexpr int ESZ = INPROJ_FP8 ? 1 : 2;
    __device__ __forceinline__ bool next(int i, pg::Unit& u) const {
        if (i >= 4 && G == 236) return false;
        const int L = (G == 236) ? (int)INP_ORDER[i][c] : i * G + c; int pm, pn;
        if (L < 64 * 14) { pg::static_order(64, 14, L, pm, pn); }
        else { const int x = L - 64 * 14; if (x >= 48) return false; pm = 64 + (x & 7); pn = 6 + (x >> 3); }
        u.bptr = (const char*)(WinT + (size_t)pn * 256 * D * ESZ); u.arow = pm * 256; u.orow = pm * 256; u.pn = pn; u.e = 0; u.cnt = 0; u.pad = 0; return true;
    }
    __device__ __forceinline__ void aoff(const pg::Unit& u, const int (&R)[2], const int (&C)[2], unsigned (&v)[2][2]) const {
#pragma unroll
        for (int h = 0; h < 2; ++h)
#pragma unroll
            for (int i = 0; i < 2; ++i) v[h][i] = (unsigned)((u.arow + h * 128 + R[i]) * D * ESZ + 2 * C[i]);
    }
};
struct EpiInProj {
    static constexpr bool PERM = true;
    bf16_t *U, *VG, *Q, *GS, *I, *GF, *KF, *GB, *KB; const float* lbt;
    __device__ __forceinline__ void operator()(const Acc& acc, const pg::Unit& u, int wr, int wc, int fr, int fq) const {
        const int cg = u.pn >> 1;
        const int cbase = (u.pn & 1) * 256 + wc * 32 + 8 * fq;
        const int row0 = u.orow + wr * 64 + fr;
        if (cg == 3 || cg == 4) {
            const float* tab = lbt + (cg == 3 ? 0 : GW); bf16_t* Gd = (cg == 3) ? GF : GB; bf16_t* Kd = (cg == 3) ? KF : KB;
#pragma unroll
            for (int bj = 0; bj < 2; ++bj) {
                const int col = cbase + bj * 128;
                const f32x4 l0 = *(const f32x4*)(tab + col), l1 = *(const f32x4*)(tab + col + 4);
                f32x2 lb2[4], om2[4];
                lb2[0] = l0.lo; lb2[1] = l0.hi; lb2[2] = l1.lo; lb2[3] = l1.hi;
#pragma unroll
                for (int k = 0; k < 4; ++k) om2[k] = 1.0f - lb2[k];
#pragma unroll
                for (int ai = 0; ai < 2; ++ai)
#pragma unroll
                    for (int m = 0; m < 4; ++m) {
                        const size_t off = (size_t)(row0 + ai * 128 + m * 16) * GW + col;
                        unsigned wgv[4], wkv[4];
#pragma unroll
                        for (int k = 0; k < 4; ++k) {
                            const f32x4 a4 = acc[ai][bj][m][k >> 1];
                            f32x2 z = (k & 1) ? a4.hi : a4.lo;
                            z.x = __builtin_amdgcn_fmed3f(z.x, -30.f, 30.f); z.y = __builtin_amdgcn_fmed3f(z.y, -30.f, 30.f);
                            const f32x2 t = z * -1.44269504089f;
                            f32x2 e; e.x = __builtin_amdgcn_exp2f(t.x); e.y = __builtin_amdgcn_exp2f(t.y);
                            const f32x2 r = rcp_pair(e + 1.0f);
                            const f32x2 f = om2[k] * r + lb2[k];
                            const f32x2 kk = (om2[k] * e) * r;
                            wgv[k] = cvt_pk_bf16(__builtin_amdgcn_logf(f.x), __builtin_amdgcn_logf(f.y)); wkv[k] = cvt_pk_bf16(kk.x, kk.y);
                        }
                        u32x4 wg, wk; wg.x = wgv[0]; wg.y = wgv[1]; wg.z = wgv[2]; wg.w = wgv[3]; wk.x = wkv[0]; wk.y = wkv[1]; wk.z = wkv[2]; wk.w = wkv[3];
                        *(u32x4*)(Gd + off) = wg; *(u32x4*)(Kd + off) = wk;
                    }
            }
        } else {
            bf16_t* Od = (cg == 0) ? U : (cg == 1) ? VG : (cg == 2) ? Q : (cg == 5) ? I : GS;
            const int act = 0;
#pragma unroll
            for (int ai = 0; ai < 2; ++ai)
#pragma unroll
                for (int m = 0; m < 4; ++m)
#pragma unroll
                    for (int bj = 0; bj < 2; ++bj) {
                        const size_t off = (size_t)(row0 + ai * 128 + m * 16) * GW + cbase + bj * 128;
                        float v[8];
#pragma unroll
                        for (int n = 0; n < 2; ++n)
#pragma unroll
                            for (int j = 0; j < 4; ++j) { float z = acc[ai][bj][m][n][j]; if (act == 1) z = gelu_tanh(z); else if (act == 2) z = z * sigmoidf_(z); v[4 * n + j] = z; }
                        u32x4 w; w.x = cvt_pk_bf16(v[0], v[1]); w.y = cvt_pk_bf16(v[2], v[3]); w.z = cvt_pk_bf16(v[4], v[5]); w.w = cvt_pk_bf16(v[6], v[7]);
                        *(u32x4*)(Od + off) = w;
                    }
        }
    }
};

struct SchedOutProj {
    __device__ __forceinline__ void a_ready(const pg::Unit&) const {}
    __device__ __forceinline__ void done(const pg::Unit&) const {}
    const bf16_t* WoutT; int G, c;
    __device__ __forceinline__ bool next(int i, pg::Unit& u) const {
        const int L = i * G + c; int pm, pn; if (!pg::static_order(64, 4, L, pm, pn)) return false;
        u.bptr = (const char*)WoutT + (size_t)pn * 256 * D * (OUTPROJ_FP8 ? 1 : 2); u.arow = pm * 256; u.orow = pm * 256; u.pn = pn; u.e = 0; u.cnt = 0; u.pad = 0; return true;
    }
    __device__ __forceinline__ void aoff(const pg::Unit& u, const int (&R)[2], const int (&C)[2], unsigned (&v)[2][2]) const {
#pragma unroll
        for (int h = 0; h < 2; ++h)
#pragma unroll
            for (int i = 0; i < 2; ++i) v[h][i] = (unsigned)((u.arow + h * 128 + R[i]) * D * (OUTPROJ_FP8 ? 1 : 2) + 2 * C[i]);
    }
};
struct EpiOutProj {
    static constexpr bool PERM = false;
    const float* x; const float* mod; bf16_t* X1; float* SS;
    __device__ __forceinline__ void operator()(const Acc& acc, const pg::Unit& u, int wr, int wc, int fr, int fq) const {
        const int row0 = u.orow + wr * 64 + fr, col0 = u.pn * 256 + wc * 32 + 4 * fq;
        const float* g1 = mod + (size_t)(u.orow >> 11) * 6144 + 2048;
        f32x4 gv[2][2];
#pragma unroll
        for (int bj = 0; bj < 2; ++bj)
#pragma unroll
            for (int n = 0; n < 2; ++n) gv[bj][n] = *(const f32x4*)(g1 + col0 + bj * 128 + n * 16);
#pragma unroll
        for (int ai = 0; ai < 2; ++ai) {
            f32x4 xv[4][2][2];
#pragma unroll
            for (int m = 0; m < 4; ++m)
#pragma unroll
                for (int bj = 0; bj < 2; ++bj)
#pragma unroll
                    for (int n = 0; n < 2; ++n) xv[m][bj][n] = *(const f32x4*)(x + (size_t)(row0 + ai * 128 + m * 16) * D + col0 + bj * 128 + n * 16);
#pragma unroll
            for (int m = 0; m < 4; ++m) {
                const int row = row0 + ai * 128 + m * 16; const size_t off = (size_t)row * D + col0; float s = 0.f;
#pragma unroll
                for (int bj = 0; bj < 2; ++bj)
#pragma unroll
                    for (int n = 0; n < 2; ++n) {
                        const f32x4 o = xv[m][bj][n] + gv[bj][n] * acc[ai][bj][m][n] * (float)DBG_MIX;
                        { u32x2 w; w.x = cvt_pk_bf16(o[0], o[1]); w.y = cvt_pk_bf16(o[2], o[3]); *(u32x2*)(X1 + off + bj * 128 + n * 16) = w; }
                        s += (o[0] * o[0] + o[1] * o[1]) + (o[2] * o[2] + o[3] * o[3]);
                    }
                s += __shfl_xor(s, 16); s += __shfl_xor(s, 32);
                if (fq == 0) SS[(size_t)row * 16 + u.pn * 4 + wc] = s;
            }
        }
    }
};

struct MoeTab { LAS int* cnt; LAS int* tstart; LAS int* ent; };
__device__ __forceinline__ MoeTab moe_tab(LAS unsigned char* lds) { MoeTab t; t.cnt = (LAS int*)(lds + LDS_EXTRA_OFF); t.tstart = t.cnt + 32; t.ent = t.tstart + 64; return t; }
__device__ __forceinline__ void moe_tables(const Frame& F) {
    const MoeTab T = moe_tab(F.lds);
    if (threadIdx.x < 64) {
        const int lane = threadIdx.x;
        const int c = (lane < NE) ? (int)__hip_atomic_load(F.ctl + CW_CNT + 64 * lane, __ATOMIC_RELAXED, __HIP_MEMORY_SCOPE_AGENT) : 0;
        const int t = (c + 255) >> 8;
        int incl = t;
#pragma unroll
        for (int o = 1; o < 64; o <<= 1) { const int v = __shfl_up(incl, o); if (lane >= o) incl += v; }
        const int start = incl - t;
        if (lane < NE) { T.cnt[lane] = c; T.tstart[lane] = start; for (int k = 0; k < t; ++k) T.ent[start + k] = lane; }
        if (lane == NE) T.tstart[NE] = start;
    }
    __syncthreads();
}
constexpr int META_OFF = LDS_EXTRA_OFF + 2048, META_MAXU = 11;
__device__ __forceinline__ LAS float* meta_bias(LAS unsigned char* lds, int i, int stride) { return (LAS float*)(lds + META_OFF + i * stride); }
constexpr int CW_P4RDY = 13312;
constexpr int CW_MODRDY = 14336;
constexpr int CW_RDY = 8192;
constexpr int MOE_MAXGU = 10, MOE_MAXD = 6;
struct SchedMoe {
    const unsigned char *W1T, *W2T; const int* LIST; MoeTab T; int G, c; LAS unsigned char* lds; unsigned* ctl; unsigned aH2, aACT; int nGU; int r0 = 0, nrt = 0; mutable int pend = -1;
    __device__ __forceinline__ int total() const { return __builtin_amdgcn_readfirstlane(T.tstart[32]); }
    __device__ __forceinline__ void init() { const int tot = total(), x = c & 7, j = c >> 3, per = G >> 3; r0 = (tot * x) >> 3; nrt = ((tot * (x + 1)) >> 3) - r0;
        const int nq = 8 * nrt; nGU = (j < nq) ? (nq - j + per - 1) / per : 0; }
    __device__ __forceinline__ bool next(int i, pg::Unit& u) const {
        const int per = G >> 3, j = c >> 3;
        int idx, pn, kind;
        if (i < nGU) { const int q = j + per * i; kind = 0; pn = q & 7; idx = r0 + (q >> 3); }
        else { const int q = (per - 1 - j) + per * (i - nGU); if (q >= 4 * nrt) return false; kind = 1; pn = q & 3; idx = r0 + (q >> 2); }
        const int e = __builtin_amdgcn_readfirstlane(T.ent[idx]); const int ts = __builtin_amdgcn_readfirstlane(T.tstart[e]); const int mt = idx - ts;
        u.kind = kind; u.idx = idx; u.pn = pn; u.e = e; u.orow = ts * 256 + mt * 256; u.pad = i;
        if (kind == 0) { u.bptr = (const char*)(W1T + ((size_t)e * 2048 + (size_t)pn * 256) * D); u.arow = mt * 256; u.cnt = __builtin_amdgcn_readfirstlane(T.cnt[e]); }
        else { u.bptr = (const char*)(W2T + ((size_t)e * 1024 + (size_t)pn * 256) * DE); u.arow = u.orow; u.cnt = 0; }
        return true;
    }
    __device__ __forceinline__ int meta_off(const pg::Unit& u) const {
        if (u.kind == 0) return (u.pad < MOE_MAXGU) ? META_OFF + u.pad * 1536 : -1;
        const int k = u.pad - nGU, ng = nGU < MOE_MAXGU ? nGU : MOE_MAXGU; return (k < MOE_MAXD) ? META_OFF + ng * 1536 + k * 1024 : -1;
    }
    __device__ __forceinline__ void aoff(const pg::Unit& u, const int (&R)[2], const int (&C)[2], unsigned (&v)[2][2]) const {
        if (u.kind == 1) {
#pragma unroll
            for (int h = 0; h < 2; ++h)
#pragma unroll
                for (int i = 0; i < 2; ++i) v[h][i] = aACT + (unsigned)((u.arow + h * 128 + R[i]) * DE + 2 * C[i]);
            return;
        }
        const int mo = meta_off(u);
        if (mo >= 0) {
            const LAS unsigned short* L = (const LAS unsigned short*)(lds + mo + 1024);
#pragma unroll
            for (int h = 0; h < 2; ++h)
#pragma unroll
                for (int i = 0; i < 2; ++i) v[h][i] = aH2 + (unsigned)((int)L[h * 128 + R[i]] * D + 2 * C[i]);
        } else {
#pragma unroll
            for (int h = 0; h < 2; ++h)
#pragma unroll
                for (int i = 0; i < 2; ++i) { int sl = u.arow + h * 128 + R[i]; sl = sl < u.cnt ? sl : u.cnt - 1; v[h][i] = aH2 + (unsigned)(LIST[u.e * NTOK + sl] * D + 2 * C[i]); }
        }
    }
    __device__ __forceinline__ void preload(const float* b1, const float* b2) const {
        const int t = threadIdx.x;
        constexpr int NU = MOE_MAXGU + MOE_MAXD;
        unsigned val[NU]; int moff[NU];
#pragma unroll
        for (int i = 0; i < NU; ++i) {
            pg::Unit u; moff[i] = -1; val[i] = 0u;
            if (next(i, u)) {
                const int mo = meta_off(u);
                if (mo >= 0) {
                    if (u.kind == 0) {
                        if (t < 256) { moff[i] = mo + 4 * t; val[i] = __float_as_uint(b1[(size_t)u.e * 2048 + (t < 128 ? u.pn * 128 + t : 1024 + u.pn * 128 + (t - 128))]); }
                        else { int sl = u.arow + (t - 256); sl = sl < u.cnt ? sl : u.cnt - 1; moff[i] = -(mo + 1024 + 2 * (t - 256)) - 2; val[i] = (unsigned)LIST[u.e * NTOK + sl]; }
                    } else if (t < 256) { moff[i] = mo + 4 * t; val[i] = __float_as_uint(b2[(size_t)u.e * D + u.pn * 256 + t]); }
                }
            }
        }
#pragma unroll
        for (int i = 0; i < NU; ++i) {
            if (moff[i] >= 0) *(LAS unsigned*)(lds + moff[i]) = val[i];
            else if (moff[i] < -1) *(LAS unsigned short*)(lds + (-(moff[i] + 2))) = (unsigned short)val[i];
        }
        __syncthreads();
    }
    __device__ __forceinline__ void a_ready(const pg::Unit& u) const {
        if (u.kind != 1) return;
        if (threadIdx.x < 64) {
            unsigned* w = ctl + CW_RDY + 16 * u.idx; unsigned sp = 0;
            while ((unsigned)__builtin_amdgcn_readfirstlane(__hip_atomic_load(w, __ATOMIC_RELAXED, __HIP_MEMORY_SCOPE_AGENT)) < 64u) { __builtin_amdgcn_s_sleep(2); if (++sp > (1u << 22)) break; }
            __builtin_amdgcn_fence(__ATOMIC_ACQUIRE, "agent");
            asm volatile("s_waitcnt vmcnt(0)" ::: "memory");
        }
        asm volatile("" ::: "memory"); __builtin_amdgcn_s_barrier(); asm volatile("" ::: "memory");
    }
    __device__ __forceinline__ void done(const pg::Unit& u) const {
        const bool lane0 = (threadIdx.x & 63) == 0;
        if (pend >= 0) { if (lane0) __hip_atomic_fetch_add(ctl + CW_RDY + 16 * pend, 1u, __ATOMIC_RELAXED, __HIP_MEMORY_SCOPE_AGENT); pend = -1; }
        if (u.kind != 0) return;
        if (u.pad == nGU - 1) { asm volatile("s_waitcnt vmcnt(0)" ::: "memory"); if (lane0) __hip_atomic_fetch_add(ctl + CW_RDY + 16 * u.idx, 1u, __ATOMIC_RELAXED, __HIP_MEMORY_SCOPE_AGENT); }
        else pend = u.idx;
    }
};
struct EpiMoe {
    static constexpr bool PERM = true;
    const float *b1, *b2; unsigned char* ACT; unsigned char* DOUT; LAS unsigned char* lds; const SchedMoe* S;
    __device__ __forceinline__ void operator()(const Acc& acc, const pg::Unit& u, int wr, int wc, int fr, int fq) const {
        const int mo = S->meta_off(u);
        const int row0 = u.orow + wr * 64 + fr;
        if (u.kind == 0) {
            const int col = u.pn * 128 + wc * 32 + 8 * fq;
            float vg[8], vu[8];
            if (mo >= 0) { const LAS float* B = (const LAS float*)(lds + mo) + wc * 32 + 8 * fq;
                const f32x4 g0 = *(const LAS f32x4*)B, g1 = *(const LAS f32x4*)(B + 4), u0 = *(const LAS f32x4*)(B + 128), u1 = *(const LAS f32x4*)(B + 132);
#pragma unroll
                for (int j = 0; j < 4; ++j) { vg[j] = g0[j]; vg[4 + j] = g1[j]; vu[j] = u0[j]; vu[4 + j] = u1[j]; } }
            else { const float* bg = b1 + (size_t)u.e * 2048 + col; const float* bu = bg + 1024;
#pragma unroll
                for (int j = 0; j < 8; ++j) { vg[j] = bg[j]; vu[j] = bu[j]; } }
            f32x2 vg2[4], vu2[4];
#pragma unroll
            for (int k = 0; k < 4; ++k) { vg2[k] = (f32x2){vg[2 * k], vg[2 * k + 1]}; vu2[k] = (f32x2){vu[2 * k] + 1.0f, vu[2 * k + 1] + 1.0f}; }
#pragma unroll
            for (int ai = 0; ai < 2; ++ai)
#pragma unroll
                for (int m = 0; m < 4; ++m) {
                    float a[8];
#pragma unroll
                    for (int k = 0; k < 4; ++k) {
                        const f32x4 G4 = acc[ai][0][m][k >> 1], U4 = acc[ai][1][m][k >> 1];
                        f32x2 g = ((k & 1) ? G4.hi : G4.lo) + vg2[k], up1 = ((k & 1) ? U4.hi : U4.lo) + vu2[k];
                        g.x = __builtin_amdgcn_fmed3f(g.x, -24.0f, 7.0f); g.y = __builtin_amdgcn_fmed3f(g.y, -24.0f, 7.0f);
                        up1.x = __builtin_amdgcn_fmed3f(up1.x, -6.0f, 8.0f); up1.y = __builtin_amdgcn_fmed3f(up1.y, -6.0f, 8.0f);
                        const f32x2 t = g * -2.45546696f;
                        f32x2 d; d.x = __builtin_amdgcn_exp2f(t.x); d.y = __builtin_amdgcn_exp2f(t.y);
                        const f32x2 o = (g * up1) * rcp_pair(d + 1.0f);
                        a[2 * k] = o.x; a[2 * k + 1] = o.y;
                    }
                    const unsigned long long w = (unsigned long long)pack_fp8x4_nc(a[0], a[1], a[2], a[3]) | ((unsigned long long)pack_fp8x4_nc(a[4], a[5], a[6], a[7]) << 32);
                    __hip_atomic_store((unsigned long long*)(ACT + (size_t)(row0 + ai * 128 + m * 16) * DE + col), w, __ATOMIC_RELAXED, __HIP_MEMORY_SCOPE_AGENT);
                }
        } else {
            const int col0 = u.pn * 256 + wc * 32 + 8 * fq;
            float bv[2][8];
            if (mo >= 0) { const LAS float* B = (const LAS float*)(lds + mo) + wc * 32 + 8 * fq;
#pragma unroll
                for (int bj = 0; bj < 2; ++bj) { const f32x4 a = *(const LAS f32x4*)(B + bj * 128), b = *(const LAS f32x4*)(B + bj * 128 + 4);
#pragma unroll
                    for (int j = 0; j < 4; ++j) { bv[bj][j] = a[j]; bv[bj][4 + j] = b[j]; } } }
            else {
#pragma unroll
                for (int bj = 0; bj < 2; ++bj)
#pragma unroll
                    for (int j = 0; j < 8; ++j) bv[bj][j] = b2[(size_t)u.e * D + col0 + bj * 128 + j]; }
            f32x2 b4[2][4];
#pragma unroll
            for (int bj = 0; bj < 2; ++bj)
#pragma unroll
                for (int k = 0; k < 4; ++k) b4[bj][k] = (f32x2){4.0f * bv[bj][2 * k], 4.0f * bv[bj][2 * k + 1]};
#pragma unroll
            for (int ai = 0; ai < 2; ++ai)
#pragma unroll
                for (int m = 0; m < 4; ++m)
#pragma unroll
                    for (int bj = 0; bj < 2; ++bj) {
                        const f32x4 v0 = acc[ai][bj][m][0], v1 = acc[ai][bj][m][1];
                        const f32x2 p0 = v0.lo * 4.0f + b4[bj][0], p1 = v0.hi * 4.0f + b4[bj][1], p2 = v1.lo * 4.0f + b4[bj][2], p3 = v1.hi * 4.0f + b4[bj][3];
                        u32x2 w; w.x = pack_fp8x4(p0.x, p0.y, p1.x, p1.y); w.y = pack_fp8x4(p2.x, p2.y, p3.x, p3.y);
                        *(u32x2*)(DOUT + (size_t)(row0 + ai * 128 + m * 16) * D + col0 + bj * 128) = w;
                    }
        }
    }
};

__device__ __forceinline__ void conv_tile(const float* src, int ld, int k0, int n0, bf16_t* dst, int drow0, LAS unsigned char* lds) {
    const int tid = threadIdx.x, p = tid >> 4, q = tid & 15;
    f32x4 v[4];
#pragma unroll
    for (int r = 0; r < 4; ++r) v[r] = *(const f32x4*)(src + (size_t)(k0 + 4 * p + r) * ld + n0 + 4 * q);
#pragma unroll
    for (int i = 0; i < 4; ++i) {
        u32x2 w; w.x = cvt_pk_bf16(v[0][i], v[1][i]); w.y = cvt_pk_bf16(v[2][i], v[3][i]);
        *(LAS u32x2*)(lds + (4 * q + i) * 256 + ((p ^ q) * 8)) = w;
    }
    __syncthreads();
#pragma unroll
    for (int jj = 0; jj < 2; ++jj) {
        const int n = (tid >> 4) + 32 * jj, c = tid & 15, qn = (n >> 2) & 15;
        u32x4 w = *(const LAS u32x4*)(lds + n * 256 + ((c ^ (qn >> 1)) * 16));
        if (qn & 1) { const unsigned t0 = w.x, t1 = w.y; w.x = w.z; w.y = w.w; w.z = t0; w.w = t1; }
        *(u32x4*)(dst + (size_t)(drow0 + n) * 1024 + k0 + 8 * c) = w;
    }
    __syncthreads();
}
constexpr int CONV_ITEMS = 32 * 128 + 32 * 64;
struct ConvDesc { const float* src; unsigned char* dst; int ld, k0, n0, drow0; };
__device__ __forceinline__ ConvDesc conv8_desc(const Frame& F, int it) {
    ConvDesc d;
    if (it < 4096) { const int e = it >> 7, r = it & 127, nt = r & 15, kt = r >> 4, n0 = nt * 128;
        d.src = F.w1 + (size_t)e * D * 2048; d.ld = 2048; d.k0 = kt * 128; d.n0 = n0; d.dst = F.W1T + (size_t)e * 2048 * D;
        d.drow0 = (n0 < 1024) ? ((n0 >> 7) * 256) : (((n0 - 1024) >> 7) * 256 + 128); }
    else { const int i2 = it - 4096, e = i2 >> 6, r = i2 & 63, nt = r & 7, kt = r >> 3;
        d.src = F.w2 + (size_t)e * DE * D; d.ld = 1024; d.k0 = kt * 128; d.n0 = nt * 128; d.dst = F.W2T + (size_t)e * D * DE; d.drow0 = nt * 128; }
    return d;
}
__device__ __forceinline__ void conv8_load(const ConvDesc& d, f32x4 (&v)[8]) {
    const int p = threadIdx.x >> 5, q = threadIdx.x & 31;
#pragma unroll
    for (int g = 0; g < 2; ++g)
#pragma unroll
        for (int r = 0; r < 4; ++r) v[4 * g + r] = *(const f32x4*)(d.src + (size_t)(d.k0 + 64 * g + 4 * p + r) * d.ld + d.n0 + 4 * q);
}
__device__ __forceinline__ void conv8_lds_write(const f32x4 (&v)[8], LAS unsigned char* buf) {
    const int p = threadIdx.x >> 5, q = threadIdx.x & 31;
#pragma unroll
    for (int g = 0; g < 2; ++g)
#pragma unroll
        for (int i = 0; i < 4; ++i)
            *(LAS unsigned*)(buf + (4 * q + i) * 128 + (((16 * g + p) ^ q) * 4)) = pack_fp8x4(32.f * v[4 * g][i], 32.f * v[4 * g + 1][i], 32.f * v[4 * g + 2][i], 32.f * v[4 * g + 3][i]);
}
__device__ __forceinline__ void conv8_store(const ConvDesc& d, const LAS unsigned char* buf) {
#pragma unroll
    for (int jj = 0; jj < 2; ++jj) {
        const int n = (threadIdx.x >> 3) + 64 * jj, c = threadIdx.x & 7, qn = (n >> 2) & 31;
        u32x4 w = *(const LAS u32x4*)(buf + n * 128 + ((c ^ (qn >> 2)) * 16));
        if (qn & 1) { unsigned t = w.x; w.x = w.y; w.y = t; t = w.z; w.z = w.w; w.w = t; }
        if (qn & 2) { unsigned t = w.x; w.x = w.z; w.z = t; t = w.y; w.y = w.w; w.w = t; }
        *(u32x4*)(d.dst + (size_t)(d.drow0 + n) * 1024 + d.k0 + 16 * c) = w;
    }
}
__device__ __forceinline__ void conv8_run(const Frame& F, int first, int stride, int n) {
    if (n <= 0) return;
    f32x4 vA[8], vB[8], vC[8];
    const int last = first + (n - 1) * stride;
#define CV_IT(i) ((first + (i) * stride) < last ? (first + (i) * stride) : last)
#define CV_STEP(V, D_, BUF, NEXT) do { conv8_lds_write(V, F.lds + (BUF)); const ConvDesc _dn = conv8_desc(F, CV_IT(NEXT)); conv8_load(_dn, V);        \
        asm volatile("s_waitcnt lgkmcnt(0)" ::: "memory"); __builtin_amdgcn_s_barrier(); asm volatile("" ::: "memory"); conv8_store(D_, F.lds + (BUF)); D_ = _dn; } while (0)
    ConvDesc dA = conv8_desc(F, CV_IT(0)), dB = conv8_desc(F, CV_IT(1)), dC = conv8_desc(F, CV_IT(2));
    conv8_load(dA, vA); conv8_load(dB, vB); conv8_load(dC, vC);
    for (int i = 0; i < n; i += 3) {
        CV_STEP(vA, dA, 0, i + 3);
        CV_STEP(vB, dB, 16384, i + 4);
        CV_STEP(vC, dC, 32768, i + 5);
    }
#undef CV_STEP
#undef CV_IT
    __syncthreads();
}

__device__ __forceinline__ void mod_item(const Frame& F, int item) {
    LAS float* S = (LAS float*)F.lds;
    LAS float* RED = (LAS float*)(F.lds + 40960);
    const int tid = threadIdx.x, lane = tid & 63, wv = tid >> 6, c0 = item * 64;
    for (int idx = tid; idx < 9 * 1024; idx += NTHREADS) { const int r = idx >> 10, k = idx & 1023; const float v = (r < 8) ? F.c[r * 1024 + k] : F.c_ctx[k]; S[idx] = v * sigmoidf_(v); }
    __syncthreads();
    const int cq = tid & 15, kg = tid >> 4;
    f32x4 acc[9];
#pragma unroll
    for (int r = 0; r < 9; ++r) acc[r] = (f32x4){0.f, 0.f, 0.f, 0.f};
    for (int k0 = kg; k0 < 1024; k0 += 256) {
        f32x4 wv4[8];
#pragma unroll
        for (int u = 0; u < 8; ++u) wv4[u] = *(const f32x4*)(F.w_mod + (size_t)(k0 + 32 * u) * 6144 + c0 + 4 * cq);
#pragma unroll
        for (int u = 0; u < 8; ++u)
#pragma unroll
            for (int r = 0; r < 9; ++r) acc[r] += S[r * 1024 + k0 + 32 * u] * wv4[u];
    }
#pragma unroll
    for (int r = 0; r < 9; ++r)
#pragma unroll
        for (int j = 0; j < 4; ++j) { float v = acc[r][j]; v += __shfl_xor(v, 16); v += __shfl_xor(v, 32); if (lane < 16) RED[(wv * 9 + r) * 64 + 4 * cq + j] = v; }
    __syncthreads();
    for (int idx = tid; idx < 9 * 64; idx += NTHREADS) {
        const int r = idx >> 6, cc = idx & 63; float s = F.b_mod[c0 + cc];
#pragma unroll
        for (int w8 = 0; w8 < 8; ++w8) s += RED[(w8 * 9 + r) * 64 + cc];
        F.mod[r * 6144 + c0 + cc] = s;
    }
    asm volatile("s_waitcnt vmcnt(0)" ::: "memory");
    __syncthreads();
    if (threadIdx.x == 0) { __builtin_amdgcn_fence(__ATOMIC_RELEASE, "agent"); asm volatile("s_waitcnt vmcnt(0)" ::: "memory"); __hip_atomic_fetch_add(F.ctl + CW_MODRDY, 1u, __ATOMIC_RELAXED, __HIP_MEMORY_SCOPE_AGENT); }
}
__device__ __forceinline__ void phase0(const Frame& F) {
    if (blockIdx.x == gridDim.x - 1) {
        for (int i = threadIdx.x; i < 2 * GW; i += NTHREADS) { const float* tab = (i < GW) ? F.lb_fwd : F.lb_bwd; const int c = i & (GW - 1); F.LBT[i] = 1.0f / (1.0f + __expf(tab[GW + c] - tab[c])); }
    }
    for (int item = blockIdx.x; item < 96 + 448 + 128; item += gridDim.x) {
        if (item < 96) mod_item(F, item);
        else if (item < 96 + 448) { const int it = item - 96, nt = it % 56, kt = it / 56;
            if (INPROJ_FP8) { if (nt & 1) continue;
                ConvDesc d; d.src = F.w_in; d.ld = DIN; d.k0 = kt * 128; d.n0 = nt * 64; d.dst = (unsigned char*)F.WinT; d.drow0 = nt * 64;
                f32x4 v[8]; conv8_load(d, v); conv8_lds_write(v, F.lds); __syncthreads(); conv8_store(d, F.lds); __syncthreads(); }
            else conv_tile(F.w_in, DIN, kt * 128, nt * 64, F.WinT, nt * 64, F.lds); }
        else { const int it = item - 544, nt = it & 15, kt = it >> 4;
            if (OUTPROJ_FP8) { if (nt & 1) continue;
                ConvDesc d; d.src = F.w_out; d.ld = D; d.k0 = kt * 128; d.n0 = nt * 64; d.dst = (unsigned char*)F.WoutT; d.drow0 = nt * 64;
                f32x4 v[8]; conv8_load(d, v); conv8_lds_write(v, F.lds); __syncthreads(); conv8_store(d, F.lds); __syncthreads(); }
            else conv_tile(F.w_out, D, kt * 128, nt * 64, F.WoutT, nt * 64, F.lds); }
    }
}

__device__ __forceinline__ void phase1(const Frame& F, bool wait_mod) {
    if (wait_mod) {
        if (threadIdx.x == 0) { unsigned sp = 0; while (__hip_atomic_load(F.ctl + CW_MODRDY, __ATOMIC_RELAXED, __HIP_MEMORY_SCOPE_AGENT) < 96u) { __builtin_amdgcn_s_sleep(2); if (++sp > (1u << 22)) break; }
            __builtin_amdgcn_fence(__ATOMIC_ACQUIRE, "agent"); asm volatile("s_waitcnt vmcnt(0)" ::: "memory"); }
        __syncthreads();
    }
    const int lane = threadIdx.x & 63, wv = threadIdx.x >> 6;
    const int nw = gridDim.x * 8, per = (NROW + nw - 1) / nw, r0 = (blockIdx.x * 8 + wv) * per, r1 = (r0 + per < NROW) ? r0 + per : NROW;
    int curb = -1; f32x4 ca[4], cs[4];
    for (int rb = r0; rb < r1; rb += 3) {
        f32x4 v[3][4];
#pragma unroll
        for (int u = 0; u < 3; ++u) {
            const int r = (rb + u < r1) ? rb + u : r1 - 1;
            const float* src = (r < NTOK) ? F.x + (size_t)r * D : F.ctx + (size_t)(r - NTOK) * D;
#pragma unroll
            for (int j = 0; j < 4; ++j) v[u][j] = *(const f32x4*)(src + 4 * lane + 256 * j);
        }
#pragma unroll
        for (int u = 0; u < 3; ++u) {
            const int r = rb + u; if (r >= r1) break;
            const int bsel = (r < NTOK) ? (r >> 11) : 8;
            if (bsel != curb) { curb = bsel; const float* md = F.mod + (size_t)bsel * 6144;
#pragma unroll
                for (int j = 0; j < 4; ++j) { const int c = 4 * lane + 256 * j; const f32x4 nwv = *(const f32x4*)(F.norm1 + c), sc = *(const f32x4*)(md + 1024 + c); ca[j] = nwv * (1.0f + sc); cs[j] = *(const f32x4*)(md + c); } }
            float ss = 0.f;
#pragma unroll
            for (int j = 0; j < 4; ++j) ss += (v[u][j][0] * v[u][j][0] + v[u][j][1] * v[u][j][1]) + (v[u][j][2] * v[u][j][2] + v[u][j][3] * v[u][j][3]);
            ss = wave_sum(ss);
            const float rstd = __builtin_amdgcn_rsqf(ss * (1.0f / 1024.0f) + EPS);
#pragma unroll
            for (int j = 0; j < 4; ++j) {
                const int c = 4 * lane + 256 * j;
                const f32x4 o = v[u][j] * rstd * ca[j] + cs[j];
                if (INPROJ_FP8) *(unsigned*)((unsigned char*)F.H + (size_t)r * D + c) = pack_fp8x4(o[0], o[1], o[2], o[3]);
                else { u32x2 w; w.x = cvt_pk_bf16(o[0], o[1]); w.y = cvt_pk_bf16(o[2], o[3]); *(u32x2*)(F.H + (size_t)r * D + c) = w; }
            }
        }
    }
}

__device__ __forceinline__ void phase4_rows(const Frame& F, int t0, int t1, int tstep) {
    const int lane = threadIdx.x & 63, wv = threadIdx.x >> 6;
#pragma unroll 2
    for (int t = t0 + wv; t < t1; t += tstep) {
        const size_t o = (size_t)t * GW + 8 * lane;
        const u32x4 fa = *(const u32x4*)(F.OF + o), fb = *(const u32x4*)(F.OB + o);
        const f32x4 s0 = (f32x4){bflo(fa.x) + bflo(fb.x), bfhi(fa.x) + bfhi(fb.x), bflo(fa.y) + bflo(fb.y), bfhi(fa.y) + bfhi(fb.y)};
        const f32x4 s1 = (f32x4){bflo(fa.z) + bflo(fb.z), bfhi(fa.z) + bfhi(fb.z), bflo(fa.w) + bflo(fb.w), bfhi(fa.w) + bfhi(fb.w)};
        float ss = (s0[0] * s0[0] + s0[1] * s0[1]) + (s0[2] * s0[2] + s0[3] * s0[3]) + (s1[0] * s1[0] + s1[1] * s1[1]) + (s1[2] * s1[2] + s1[3] * s1[3]);
        ss += __shfl_xor(ss, 1); ss += __shfl_xor(ss, 2); ss += __shfl_xor(ss, 4); ss += __shfl_xor(ss, 8);
        const float rstd = __builtin_amdgcn_rsqf(ss * (1.0f / 128.0f) + EPS);
        const f32x4 n0 = *(const f32x4*)(F.hgrn_norm + 8 * lane), n1 = *(const f32x4*)(F.hgrn_norm + 8 * lane + 4);
        const u32x4 g = *(const u32x4*)(F.GS + o);
        u32x4 w;
        float gg[8] = {bflo(g.x), bfhi(g.x), bflo(g.y), bfhi(g.y), bflo(g.z), bfhi(g.z), bflo(g.w), bfhi(g.w)};
#pragma unroll
        for (int i = 0; i < 8; ++i) gg[i] = gg[i] * sigmoidf_(gg[i]);
        w.x = cvt_pk_bf16(s0[0] * rstd * n0[0] * gg[0], s0[1] * rstd * n0[1] * gg[1]);
        w.y = cvt_pk_bf16(s0[2] * rstd * n0[2] * gg[2], s0[3] * rstd * n0[3] * gg[3]);
        w.z = cvt_pk_bf16(s1[0] * rstd * n1[0] * gg[4], s1[1] * rstd * n1[1] * gg[5]);
        w.w = cvt_pk_bf16(s1[2] * rstd * n1[2] * gg[6], s1[3] * rstd * n1[3] * gg[7]);
        if (OUTPROJ_FP8) { u32x2 w8; w8.x = pack_fp8x4(bflo(w.x), bfhi(w.x), bflo(w.y), bfhi(w.y)); w8.y = pack_fp8x4(bflo(w.z), bfhi(w.z), bflo(w.w), bfhi(w.w)); *(u32x2*)((unsigned char*)F.YCAT + (size_t)t * D + GW + 8 * lane) = w8; }
        else *(u32x4*)(F.YCAT + (size_t)t * D + GW + 8 * lane) = w;
    }
}

__device__ __forceinline__ void phase4(const Frame& F) { phase4_rows(F, blockIdx.x * 8, NTOK, gridDim.x * 8); }

__device__ __forceinline__ void phase6(const Frame& F) {
    LAS unsigned char* WH = F.lds;
    LAS unsigned char* WL = F.lds + 65536;
    LAS float* LG = (LAS float*)(F.lds + 131072);
    LAS float* RSTD = LG + 64 * 32;
    LAS float* B2 = RSTD + 64;
    LAS float* B2P = B2 + 32;
    LAS int* lcnt = (LAS int*)(B2P + 512);
    LAS int* lbase = lcnt + 32;
    LAS int* sel = lbase + 32;
    LAS float* selw = (LAS float*)(sel + 256);
    const int tid = threadIdx.x, lane = tid & 63, wv = __builtin_amdgcn_readfirstlane(tid >> 6), fr = lane & 15, fq = lane >> 4;
    if (tid < 32) lcnt[tid] = 0;
    int cur_b = -1;
    for (int rep6 = 0; rep6 < (DBG_REP6 ? 2 : 1); ++rep6)
    for (int grp = blockIdx.x; grp < NTOK / 64; grp += gridDim.x) {
        const int b = (grp * 64) >> 11;
        const float* md = F.mod + (size_t)b * 6144;
        if (b != cur_b) {
            cur_b = b;
            __syncthreads();
            const int e = tid & 31;
            float bp = 0.f;
#pragma unroll 4
            for (int it = 0; it < 8; ++it) {
                const int c0 = ((tid >> 5) + 16 * it) * 8;
                const f32x4 n0 = *(const f32x4*)(F.norm2 + c0), n1 = *(const f32x4*)(F.norm2 + c0 + 4), s0 = *(const f32x4*)(md + 4096 + c0), s1 = *(const f32x4*)(md + 4096 + c0 + 4);
                const f32x4 h0 = *(const f32x4*)(md + 3072 + c0), h1 = *(const f32x4*)(md + 3072 + c0 + 4);
                float wa[8], lo[8];
#pragma unroll
                for (int j = 0; j < 8; ++j) { const float rw = F.router_w[(size_t)(c0 + j) * NE + e]; const float a = (j < 4 ? n0[j] * (1.0f + s0[j]) : n1[j - 4] * (1.0f + s1[j - 4])); wa[j] = rw * a; bp += rw * (j < 4 ? h0[j] : h1[j - 4]); }
                u32x4 hw; hw.x = cvt_pk_bf16(wa[0], wa[1]); hw.y = cvt_pk_bf16(wa[2], wa[3]); hw.z = cvt_pk_bf16(wa[4], wa[5]); hw.w = cvt_pk_bf16(wa[6], wa[7]);
                lo[0] = wa[0] - bflo(hw.x); lo[1] = wa[1] - bfhi(hw.x); lo[2] = wa[2] - bflo(hw.y); lo[3] = wa[3] - bfhi(hw.y); lo[4] = wa[4] - bflo(hw.z); lo[5] = wa[5] - bfhi(hw.z); lo[6] = wa[6] - bflo(hw.w); lo[7] = wa[7] - bfhi(hw.w);
                u32x4 lw; lw.x = cvt_pk_bf16(lo[0], lo[1]); lw.y = cvt_pk_bf16(lo[2], lo[3]); lw.z = cvt_pk_bf16(lo[4], lo[5]); lw.w = cvt_pk_bf16(lo[6], lo[7]);
                const int off = e * 2048 + (((c0 >> 3) ^ (e & 15)) << 4);
                *(LAS u32x4*)(WH + off) = hw; *(LAS u32x4*)(WL + off) = lw;
            }
            B2P[(tid >> 5) * 32 + e] = bp;
            __syncthreads();
            if (tid < 32) { float sb = F.router_b[tid];
#pragma unroll
                for (int k = 0; k < 16; ++k) sb += B2P[k * 32 + tid];
                B2[tid] = sb; }
        }
        f32x4 ca[4], cs[4];
#pragma unroll
        for (int j = 0; j < 4; ++j) { const int c = 4 * lane + 256 * j; const f32x4 nw = *(const f32x4*)(F.norm2 + c), sc = *(const f32x4*)(md + 4096 + c); ca[j] = nw * (1.0f + sc); cs[j] = *(const f32x4*)(md + 3072 + c); }
#pragma unroll 2
        for (int i = 0; i < 8; ++i) {
            const int tl = wv * 8 + i, t = grp * 64 + tl;
            float ss = (lane < 16) ? F.SS[(size_t)t * 16 + lane] : 0.f;
            u32x2 xw[4];
#pragma unroll
            for (int j = 0; j < 4; ++j) xw[j] = *(const u32x2*)(F.X1 + (size_t)t * D + 4 * lane + 256 * j);
            ss = wave_sum(ss);
            const float rstd = __builtin_amdgcn_rsqf(ss * (1.0f / 1024.0f) + EPS);
            if (lane == 0) RSTD[tl] = rstd;
#pragma unroll
            for (int j = 0; j < 4; ++j) {
                const f32x4 xv = (f32x4){bflo(xw[j].x), bfhi(xw[j].x), bflo(xw[j].y), bfhi(xw[j].y)};
                const f32x4 hv = xv * rstd * ca[j] + cs[j];
                *(unsigned*)(F.H2 + (size_t)t * D + 4 * lane + 256 * j) = pack_fp8x4(hv[0], hv[1], hv[2], hv[3]);
            }
        }
        {
            const int mt = wv & 3, nt = wv >> 2;
            const bf16_t* xa = F.X1 + (size_t)(grp * 64 + 16 * mt + fr) * D + 8 * fq;
            const int erow = 16 * nt + fr;
            f32x4 acc = (f32x4){0.f, 0.f, 0.f, 0.f};
            u32x4 af[8], an[8];
#pragma unroll
            for (int k = 0; k < 8; ++k) af[k] = *(const u32x4*)(xa + 32 * k);
#pragma unroll
            for (int kb = 0; kb < 4; ++kb) {
                if (kb < 3) {
#pragma unroll
                    for (int k = 0; k < 8; ++k) an[k] = *(const u32x4*)(xa + 32 * (8 * (kb + 1) + k));
                }
#pragma unroll
                for (int k = 0; k < 8; ++k) {
                    const int ks = 8 * kb + k;
                    const int off = erow * 2048 + ((((32 * ks) >> 3) + fq) ^ (erow & 15)) * 16;
                    const bf16x8 bh = *(const LAS bf16x8*)(WH + off), bl = *(const LAS bf16x8*)(WL + off);
                    acc = __builtin_amdgcn_mfma_f32_16x16x32_bf16(__builtin_bit_cast(bf16x8, af[k]), bh, acc, 0, 0, 0);
                    acc = __builtin_amdgcn_mfma_f32_16x16x32_bf16(__builtin_bit_cast(bf16x8, af[k]), bl, acc, 0, 0, 0);
                }
                if (kb < 3) {
#pragma unroll
                    for (int k = 0; k < 8; ++k) af[k] = an[k];
                }
            }
            __syncthreads();
            const float b2 = B2[erow];
#pragma unroll
            for (int r = 0; r < 4; ++r) { const int tl = 16 * mt + 4 * fq + r; LG[tl * 32 + erow] = RSTD[tl] * acc[r] + b2; }
        }
        __syncthreads();
        for (int i = 0; i < 8; ++i) {
            const int tl = wv * 8 + i;
            const int myexp = (lane >> 1) & 31;
            const float v = LG[tl * 32 + myexp];
            int rank = 0;
#pragma unroll
            for (int e = 0; e < NE; ++e) { const float o = __builtin_bit_cast(float, __builtin_amdgcn_readlane(__builtin_bit_cast(int, v), 2 * e)); rank += (o > v || (o == v && e < myexp)) ? 1 : 0; }
            const bool even = (lane & 1) == 0;
            float tv[4]; int te[4];
#pragma unroll
            for (int k = 0; k < 4; ++k) { const unsigned long long bal = __ballot(even && rank == k); const int src = (__ffsll((long long)bal) - 1) & 63; tv[k] = __shfl(v, src); te[k] = src >> 1; }
            const float e1 = __expf(tv[1] - tv[0]), e2 = __expf(tv[2] - tv[0]), e3 = __expf(tv[3] - tv[0]);
            const float inv = 1.0f / (1.0f + e1 + e2 + e3);
            if (lane < 4 && rep6 == 0) {
                const int e = (lane == 0) ? te[0] : (lane == 1) ? te[1] : (lane == 2) ? te[2] : te[3];
                const float wgt = ((lane == 0) ? 1.0f : (lane == 1) ? e1 : (lane == 2) ? e2 : e3) * inv;
                const int rk = __hip_atomic_fetch_add(lcnt + e, 1, __ATOMIC_RELAXED, __HIP_MEMORY_SCOPE_WORKGROUP);
                sel[tl * 4 + lane] = e | (rk << 8); selw[tl * 4 + lane] = wgt;
            }
        }
        __syncthreads();
        if (tid < 32 && rep6 == 0) { const int n = lcnt[tid]; lbase[tid] = n ? (int)__hip_atomic_fetch_add(F.ctl + CW_CNT + 64 * tid, (unsigned)n, __ATOMIC_RELAXED, __HIP_MEMORY_SCOPE_AGENT) : 0; lcnt[tid] = 0; }
        __syncthreads();
        if (tid < 256 && rep6 == 0) {
            const int sv = sel[tid], e = sv & 255, idx = lbase[e] + (sv >> 8), t = grp * 64 + (tid >> 2);
            F.LIST[e * NTOK + idx] = t; F.TSLOT[t * 4 + (tid & 3)] = e * NTOK + idx; F.TW[t * 4 + (tid & 3)] = selw[tid];
        }
        __syncthreads();
    }
}

__device__ __forceinline__ void phase9(const Frame& F) {
    moe_tables(F);
    const MoeTab T = moe_tab(F.lds);
    const int lane = threadIdx.x & 63, wv = threadIdx.x >> 6;
    for (int tb = (blockIdx.x * 8 + wv) * 8; tb < NTOK; tb += gridDim.x * 64) {
        const float* g2 = F.mod + (size_t)(tb >> 11) * 6144 + 5120;
        const int slw = (lane < 32) ? F.TSLOT[tb * 4 + lane] : 0; const float wkw = (lane < 32) ? F.TW[tb * 4 + lane] : 0.f;
        int rowv = 0; { const int e = slw >> 14, idx = slw & (NTOK - 1); rowv = (lane < 32) ? (T.tstart[e & 31] * 256 + idx) : 0; }
        f32x4 ga[2], gb[2], fa[2], fb[2];
#pragma unroll
        for (int j = 0; j < 2; ++j) { const int c = 8 * lane + 512 * j; ga[j] = *(const f32x4*)(g2 + c); gb[j] = *(const f32x4*)(g2 + c + 4); fa[j] = *(const f32x4*)(F.final_norm + c); fb[j] = *(const f32x4*)(F.final_norm + c + 4); }
#pragma unroll 1
        for (int i2 = 0; i2 < 8; i2 += 2) {
            u32x2 d[2][4][2]; u32x4 xw[2][2]; float wq[2][4];
#pragma unroll
            for (int u = 0; u < 2; ++u) {
                const int t = tb + i2 + u;
#pragma unroll
                for (int k = 0; k < 4; ++k) {
                    const int row = __shfl(rowv, 4 * (i2 + u) + k);
                    wq[u][k] = 0.25f * __shfl(wkw, 4 * (i2 + u) + k);
#pragma unroll
                    for (int j = 0; j < 2; ++j) d[u][k][j] = *(const u32x2*)(F.DOUT + (size_t)row * D + 8 * lane + 512 * j);
                }
#pragma unroll
                for (int j = 0; j < 2; ++j) xw[u][j] = *(const u32x4*)(F.X1 + (size_t)t * D + 8 * lane + 512 * j);
            }
#pragma unroll
            for (int u = 0; u < 2; ++u) {
                const int t = tb + i2 + u;
                float xf[2][8]; float ss = 0.f;
#pragma unroll
                for (int j = 0; j < 2; ++j) {
                    float y[8];
#pragma unroll
                    for (int i = 0; i < 8; ++i) y[i] = 0.f;
#pragma unroll
                    for (int k = 0; k < (DBG_NO_MOE ? 0 : 4); ++k) {
                        const f32x2 p0 = __builtin_amdgcn_cvt_pk_f32_fp8((int)d[u][k][j].x, false), p1 = __builtin_amdgcn_cvt_pk_f32_fp8((int)d[u][k][j].x, true), p2 = __builtin_amdgcn_cvt_pk_f32_fp8((int)d[u][k][j].y, false), p3 = __builtin_amdgcn_cvt_pk_f32_fp8((int)d[u][k][j].y, true);
                        const float w = wq[u][k];
                        y[0] += w * p0[0]; y[1] += w * p0[1]; y[2] += w * p1[0]; y[3] += w * p1[1]; y[4] += w * p2[0]; y[5] += w * p2[1]; y[6] += w * p3[0]; y[7] += w * p3[1];
                    }
                    const f32x4 x0 = (f32x4){bflo(xw[u][j].x), bfhi(xw[u][j].x), bflo(xw[u][j].y), bfhi(xw[u][j].y)}, x1v = (f32x4){bflo(xw[u][j].z), bfhi(xw[u][j].z), bflo(xw[u][j].w), bfhi(xw[u][j].w)};
#pragma unroll
                    for (int i = 0; i < 4; ++i) { xf[j][i] = x0[i] + ga[j][i] * y[i]; xf[j][4 + i] = x1v[i] + gb[j][i] * y[4 + i]; }
#pragma unroll
                    for (int i = 0; i < 8; ++i) ss += xf[j][i] * xf[j][i];
                }
                ss = wave_sum(ss);
                const float rstd = __builtin_amdgcn_rsqf(ss * (1.0f / 1024.0f) + EPS);
#pragma unroll
                for (int j = 0; j < 2; ++j) {
                    const int c = 8 * lane + 512 * j;
                    f32x4 o0, o1;
#pragma unroll
                    for (int i = 0; i < 4; ++i) { o0[i] = xf[j][i] * rstd * fa[j][i]; o1[i] = xf[j][4 + i] * rstd * fb[j][i]; }
                    *(f32x4*)(F.out + (size_t)t * D + c) = o0; *(f32x4*)(F.out + (size_t)t * D + c + 4) = o1;
                }
            }
        }
    }
}

__device__ __forceinline__ void sgu_item(const Frame& F, int item) {
    constexpr int RS = 272;
    LAS unsigned char* WL = F.lds;
    LAS unsigned char* VT = F.lds + 128 * RS;
    const int tid = threadIdx.x, lane = tid & 63, wv = __builtin_amdgcn_readfirstlane(tid >> 6), fr = lane & 15, fq = lane >> 4;
    const int h = item & 3, n = (item >> 2) & 15, b = item >> 6;
    const int row0 = b * SEQ + n * 128;
    u32x2 uu[8];
    { const size_t row = (size_t)(row0 + 16 * wv + fr);
#pragma unroll
      for (int nt = 0; nt < 8; ++nt) uu[nt] = *(const u32x2*)(F.U + row * GW + h * 128 + 16 * nt + 4 * fq); }
    {
        const int t = tid >> 2, s0 = (tid & 3) * 32;
        const float* wp = F.sgu_w + ((size_t)h * 128 + t) * 128 + s0;
#pragma unroll
        for (int j = 0; j < 4; ++j) {
            const f32x4 a = *(const f32x4*)(wp + 8 * j), c = *(const f32x4*)(wp + 8 * j + 4);
            u32x4 w; w.x = cvt_pk_bf16(a[0], a[1]); w.y = cvt_pk_bf16(a[2], a[3]); w.z = cvt_pk_bf16(c[0], c[1]); w.w = cvt_pk_bf16(c[2], c[3]);
            *(LAS u32x4*)(WL + t * RS + (s0 + 8 * j) * 2) = w;
        }
    }
    {
        const int s = tid >> 2, d0 = (tid & 3) * 32;
        const bf16_t* vp = F.VG + (size_t)(row0 + s) * GW + h * 128 + d0;
        float v[32];
#pragma unroll
        for (int j = 0; j < 4; ++j) { const u32x4 w = *(const u32x4*)(vp + 8 * j);
            v[8 * j + 0] = bflo(w.x); v[8 * j + 1] = bfhi(w.x); v[8 * j + 2] = bflo(w.y); v[8 * j + 3] = bfhi(w.y); v[8 * j + 4] = bflo(w.z); v[8 * j + 5] = bfhi(w.z); v[8 * j + 6] = bflo(w.w); v[8 * j + 7] = bfhi(w.w); }
#pragma unroll
        for (int i = 0; i < 32; ++i) v[i] = gelu_tanh(v[i]);
        float sm = 0.f;
#pragma unroll
        for (int i = 0; i < 32; ++i) sm += v[i];
        sm += __shfl_xor(sm, 1); sm += __shfl_xor(sm, 2);
        const float mu = sm * (1.0f / 128.0f); float q = 0.f;
#pragma unroll
        for (int i = 0; i < 32; ++i) { const float dd = v[i] - mu; q += dd * dd; }
        q += __shfl_xor(q, 1); q += __shfl_xor(q, 2);
        const float rstd = __builtin_amdgcn_rsqf(q * (1.0f / 128.0f) + EPS);
        const float* lg = F.sgu_ln + h * 128 + d0;
#pragma unroll
        for (int i = 0; i < 32; i += 2) {
            const unsigned pk = cvt_pk_bf16((v[i] - mu) * rstd * lg[i], (v[i + 1] - mu) * rstd * lg[i + 1]);
            *(LAS unsigned short*)(VT + (d0 + i) * RS + s * 2) = (unsigned short)(pk & 0xffffu);
            *(LAS unsigned short*)(VT + (d0 + i + 1) * RS + s * 2) = (unsigned short)(pk >> 16);
        }
    }
    __syncthreads();
    f32x4 acc[8];
#pragma unroll
    for (int nt = 0; nt < 8; ++nt) acc[nt] = (f32x4){0.f, 0.f, 0.f, 0.f};
#pragma unroll
    for (int a = 0; a < 4; ++a) {
        const bf16x8 wf = *(const LAS bf16x8*)(WL + (16 * wv + fr) * RS + (32 * a + 8 * fq) * 2);
#pragma unroll
        for (int nt = 0; nt < 8; ++nt) {
            const bf16x8 vf = *(const LAS bf16x8*)(VT + (16 * nt + fr) * RS + (32 * a + 8 * fq) * 2);
            acc[nt] = __builtin_amdgcn_mfma_f32_16x16x32_bf16(vf, wf, acc[nt], 0, 0, 0);
        }
    }
    {
        const int t = 16 * wv + fr; const size_t row = (size_t)(row0 + t);
        const float bias = F.sgu_b[h * 128 + t];
#pragma unroll
        for (int nt = 0; nt < 8; ++nt) {
            const int d = h * 128 + 16 * nt + 4 * fq;
            u32x2 w; w.x = cvt_pk_bf16(gelu_tanh(bflo(uu[nt].x)) * (acc[nt][0] + bias), gelu_tanh(bfhi(uu[nt].x)) * (acc[nt][1] + bias)); w.y = cvt_pk_bf16(gelu_tanh(bflo(uu[nt].y)) * (acc[nt][2] + bias), gelu_tanh(bfhi(uu[nt].y)) * (acc[nt][3] + bias));
            if (OUTPROJ_FP8) *(unsigned*)((unsigned char*)F.YCAT + row * D + d) = pack_fp8x4(bflo(w.x), bfhi(w.x), bflo(w.y), bfhi(w.y));
            else *(u32x2*)(F.YCAT + row * D + d) = w;
        }
    }
    __syncthreads();
}

__device__ __forceinline__ float hexp(float x) { return __builtin_amdgcn_exp2f(__builtin_amdgcn_fmed3f(x, -125.0f, 86.0f)); }
namespace hg {
constexpr int RS = 256, OFF_QP = 0, OFF_QX = 8192, OFF_KX = 16384,
              KDS = 96, OFF_KDT = 24576, OFF_D = OFF_KDT + 128 * KDS, BUF = OFF_D + 512;
constexpr int RRS = 272;
constexpr int RAW_OFF = 2 * BUF, RAWBUF = 2 * 32 * RRS;
__device__ __forceinline__ int swz(int row, int byteoff) { return row * RS + (byteoff ^ ((row & 15) << 4)); }
struct QK { u32x2 kk[2], q[2]; };
struct GV { u32x4 g, v; };
struct Ctx {
    LAS unsigned char* lds; const bf16_t *Gp, *Kp, *Ip, *Qp; bf16_t* Op;
    int b, dir, sgn, colw, h, w, fr, fq, tid, slot0, cend;
    bf16_t* qcum;
    bf16x8 tri0, tri1;
};
__device__ __forceinline__ int base_row(const Ctx& X, int c) {
    return c < 8 ? (NTOK + X.b * CTXL + (X.dir ? (CTXL - 1 - 32 * c) : 32 * c)) : (X.b * SEQ + (X.dir ? (SEQ - 1 - 32 * (c - 8)) : 32 * (c - 8)));
}
template <bool ALLLAT> __device__ __forceinline__ void load_qk(const Ctx& X, int c, QK& r) {
    const int base = base_row(X, c);
#pragma unroll
    for (int j = 0; j < 2; ++j) {
        const int row = base + X.sgn * (X.fr + 16 * j);
        const unsigned o = (unsigned)(row * GW + X.colw + 4 * X.fq) * 2u;
        r.kk[j] = *(const u32x2*)((const char*)X.Kp + o);
        if (ALLLAT) r.q[j] = *(const u32x2*)((const char*)X.Qp + o);
        else { const unsigned oq = (unsigned)((row < NTOK ? row : row - NTOK) * GW + X.colw + 4 * X.fq) * 2u; r.q[j] = *(const u32x2*)((const char*)X.Qp + oq); }
    }
}
__device__ __forceinline__ void load_gv(const Ctx& X, int c, GV& r) {
    const int base = base_row(X, c);
    const unsigned o = (unsigned)((base + X.sgn * (X.tid >> 4)) * GW + X.h * 128 + 8 * (X.tid & 15)) * 2u;
    r.g = *(const u32x4*)((const char*)X.Gp + o); r.v = *(const u32x4*)((const char*)X.Ip + o);
}
__device__ __forceinline__ void raw_write(const Ctx& X, int c, const GV& r) {
    LAS unsigned char* rb = X.lds + RAW_OFF + (c & 1) * RAWBUF + (X.tid >> 4) * RRS + (X.tid & 15) * 16;
    *(LAS u32x4*)(rb) = r.g; *(LAS u32x4*)(rb + 32 * RRS) = r.v;
}
template <bool LAT, bool CUM> __device__ __forceinline__ bf16x8 stage(const Ctx& X, int c, const QK& qk, f32x4& Bsum) {
    LAS unsigned char* buf = X.lds + (c & 1) * BUF;
    const LAS unsigned char* rg = X.lds + RAW_OFF + (c & 1) * RAWBUF + (16 * X.w + X.fr) * 2;
    const int fr = X.fr, fq = X.fq, w = X.w;
    constexpr bool lat = LAT;
    unsigned gs[8], vs[8];
#pragma unroll
    for (int jj = 0; jj < 8; ++jj) {
        const int p = (jj < 4) ? (4 * fq + jj) : (16 + 4 * fq + jj - 4);
        gs[jj] = *(const LAS unsigned short*)(rg + p * RRS); vs[jj] = *(const LAS unsigned short*)(rg + 32 * RRS + p * RRS);
    }
    bf16x8 gT, VTf;
    { u32x4 t; t.x = gs[0] | (gs[1] << 16); t.y = gs[2] | (gs[3] << 16); t.z = gs[4] | (gs[5] << 16); t.w = gs[6] | (gs[7] << 16); gT = __builtin_bit_cast(bf16x8, t);
      u32x4 u; u.x = vs[0] | (vs[1] << 16); u.y = vs[2] | (vs[3] << 16); u.z = vs[4] | (vs[5] << 16); u.w = vs[6] | (vs[7] << 16); VTf = __builtin_bit_cast(bf16x8, u); }
    const f32x4 z4 = (f32x4){0.f, 0.f, 0.f, 0.f};
    f32x4 bT[2];
    bT[0] = __builtin_amdgcn_mfma_f32_16x16x32_bf16(gT, X.tri0, z4, 0, 0, 0);
    bT[1] = __builtin_amdgcn_mfma_f32_16x16x32_bf16(gT, X.tri1, z4, 0, 0, 0);
    f32x4 b15, b31;
#pragma unroll
    for (int r = 0; r < 4; ++r) { b15[r] = __shfl(bT[0][r], 16 * fq + 15); b31[r] = __shfl(bT[1][r], 16 * fq + 15); }
    f32x4 E15, E3115;
#pragma unroll
    for (int r = 0; r < 4; ++r) { E15[r] = hexp(b15[r]); E3115[r] = hexp(b31[r] - b15[r]); }
#pragma unroll
    for (int j = 0; j < 2; ++j) {
        const float kv[4] = {bflo(qk.kk[j].x), bfhi(qk.kk[j].x), bflo(qk.kk[j].y), bfhi(qk.kk[j].y)};
        const float qv[4] = {bflo(qk.q[j].x), bfhi(qk.q[j].x), bflo(qk.q[j].y), bfhi(qk.q[j].y)};
        float kd[4], qp[4], qx[4], kx[4];
#pragma unroll
        for (int r = 0; r < 4; ++r) {
            const float bt = bT[j][r];
            if (lat) { qx[r] = qv[r] * hexp(bt - b15[r]); kx[r] = kv[r] * hexp(b15[r] - bt); qp[r] = qx[r] * E15[r]; kd[r] = kx[r] * E3115[r]; }
            else { kd[r] = kv[r] * hexp(b31[r] - bt); qx[r] = kx[r] = qp[r] = 0.f; }
        }
        const int trow = fr + 16 * j;
        const unsigned kd01 = cvt_pk_bf16(kd[0], kd[1]), kd23 = cvt_pk_bf16(kd[2], kd[3]);
        LAS unsigned char* kdp = buf + OFF_KDT + (16 * w + 4 * fq) * KDS + (X.slot0 + 4 * j) * 2;
        *(LAS unsigned short*)(kdp) = (unsigned short)(kd01 & 0xffffu); *(LAS unsigned short*)(kdp + KDS) = (unsigned short)(kd01 >> 16);
        *(LAS unsigned short*)(kdp + 2 * KDS) = (unsigned short)(kd23 & 0xffffu); *(LAS unsigned short*)(kdp + 3 * KDS) = (unsigned short)(kd23 >> 16);
        if (lat) {
            { u32x2 wv; wv.x = cvt_pk_bf16(kx[0], kx[1]); wv.y = cvt_pk_bf16(kx[2], kx[3]); *(LAS u32x2*)(buf + OFF_KX + swz(trow, (16 * w + 4 * fq) * 2)) = wv; }
            { u32x2 wv; wv.x = cvt_pk_bf16(qx[0], qx[1]); wv.y = cvt_pk_bf16(qx[2], qx[3]); *(LAS u32x2*)(buf + OFF_QX + swz(trow, (16 * w + 4 * fq) * 2)) = wv; }
            { u32x2 wv; wv.x = cvt_pk_bf16(qp[0], qp[1]); wv.y = cvt_pk_bf16(qp[2], qp[3]); *(LAS u32x2*)(buf + OFF_QP + swz(trow, (32 * (w >> 1) + 8 * fq + 4 * (w & 1)) * 2)) = wv; }
        }
    }
    if (fr == 0) { f32x4 dv; dv[0] = hexp(b31[0]); dv[1] = hexp(b31[1]); dv[2] = hexp(b31[2]); dv[3] = hexp(b31[3]); *(LAS f32x4*)(buf + OFF_D + (16 * w + 4 * fq) * 4) = dv; }
    if (CUM) Bsum += b31;
    return VTf;
}
template <bool LAT> __device__ __forceinline__ void products(const Ctx& X, int c, const bf16x8 VTf, f32x4 (&S)[8]) {
    const LAS unsigned char* buf = X.lds + (c & 1) * BUF;
    const int fr = X.fr, fq = X.fq;
    const f32x4 z4 = (f32x4){0.f, 0.f, 0.f, 0.f};
    if (LAT) {
        f32x4 X00 = z4, X11 = z4, X01 = z4;
#pragma unroll
        for (int a = 0; a < 4; ++a) {
            const int c0 = swz(fr, (32 * a + 8 * fq) * 2), c1 = swz(16 + fr, (32 * a + 8 * fq) * 2);
            const bf16x8 k0 = *(const LAS bf16x8*)(buf + OFF_KX + c0), k1 = *(const LAS bf16x8*)(buf + OFF_KX + c1);
            const bf16x8 q0 = *(const LAS bf16x8*)(buf + OFF_QX + c0), q1 = *(const LAS bf16x8*)(buf + OFF_QX + c1);
            X00 = __builtin_amdgcn_mfma_f32_16x16x32_bf16(k0, q0, X00, 0, 0, 0);
            X11 = __builtin_amdgcn_mfma_f32_16x16x32_bf16(k1, q1, X11, 0, 0, 0);
            X01 = __builtin_amdgcn_mfma_f32_16x16x32_bf16(k0, q1, X01, 0, 0, 0);
        }
#pragma unroll
        for (int r = 0; r < 4; ++r) { const bool keep = (4 * fq + r) <= fr; X00[r] = keep ? X00[r] : 0.f; X11[r] = keep ? X11[r] : 0.f; }
        bf16x8 P0, P1;
        { u32x4 t; t.x = cvt_pk_bf16(X00[0], X00[1]); t.y = cvt_pk_bf16(X00[2], X00[3]); t.z = 0u; t.w = 0u; P0 = __builtin_bit_cast(bf16x8, t);
          u32x4 u; u.x = cvt_pk_bf16(X01[0], X01[1]); u.y = cvt_pk_bf16(X01[2], X01[3]); u.z = cvt_pk_bf16(X11[0], X11[1]); u.w = cvt_pk_bf16(X11[2], X11[3]); P1 = __builtin_bit_cast(bf16x8, u); }
        f32x4 o0 = __builtin_amdgcn_mfma_f32_16x16x32_bf16(VTf, P0, z4, 0, 0, 0);
        f32x4 o1 = __builtin_amdgcn_mfma_f32_16x16x32_bf16(VTf, P1, z4, 0, 0, 0);
#pragma unroll
        for (int a = 0; a < 4; ++a) {
            u32x4 t; t.x = cvt_pk_bf16(S[2 * a][0], S[2 * a][1]); t.y = cvt_pk_bf16(S[2 * a][2], S[2 * a][3]); t.z = cvt_pk_bf16(S[2 * a + 1][0], S[2 * a + 1][1]); t.w = cvt_pk_bf16(S[2 * a + 1][2], S[2 * a + 1][3]);
            const bf16x8 Sb = __builtin_bit_cast(bf16x8, t);
            const bf16x8 qp0 = *(const LAS bf16x8*)(buf + OFF_QP + swz(fr, (32 * a + 8 * fq) * 2)), qp1 = *(const LAS bf16x8*)(buf + OFF_QP + swz(16 + fr, (32 * a + 8 * fq) * 2));
            o0 = __builtin_amdgcn_mfma_f32_16x16x32_bf16(Sb, qp0, o0, 0, 0, 0);
            o1 = __builtin_amdgcn_mfma_f32_16x16x32_bf16(Sb, qp1, o1, 0, 0, 0);
        }
        const int base = base_row(X, c);
        { u32x2 w0, w1; w0.x = cvt_pk_bf16(o0[0], o0[1]); w0.y = cvt_pk_bf16(o0[2], o0[3]); w1.x = cvt_pk_bf16(o1[0], o1[1]); w1.y = cvt_pk_bf16(o1[2], o1[3]);
          *(u32x2*)((char*)X.Op + (unsigned)((base + X.sgn * fr) * GW + X.colw + 4 * fq) * 2u) = w0;
          *(u32x2*)((char*)X.Op + (unsigned)((base + X.sgn * (fr + 16)) * GW + X.colw + 4 * fq) * 2u) = w1; }
    }
#pragma unroll
    for (int kt = 0; kt < 8; ++kt) {
        const bf16x8 kdf = *(const LAS bf16x8*)(buf + OFF_KDT + (16 * kt + fr) * KDS + 16 * fq);
        const f32x4 dv = *(const LAS f32x4*)(buf + OFF_D + (16 * kt + 4 * fq) * 4);
        S[kt] = __builtin_amdgcn_mfma_f32_16x16x32_bf16(kdf, VTf, S[kt] * dv, 0, 0, 0);
    }
}
__device__ __forceinline__ void lds_barrier() {
    asm volatile("s_waitcnt lgkmcnt(0)" ::: "memory"); __builtin_amdgcn_s_barrier(); asm volatile("" ::: "memory");
}
template <bool PL, bool SL, bool CUM> __device__ __forceinline__ void iter(const Ctx& X, int c, QK& qk, GV& gv, bf16x8& VTcur, f32x4 (&S)[8], f32x4& Bsum) {
    lds_barrier();
    products<PL>(X, c, VTcur, S);
    VTcur = stage<SL, CUM>(X, c + 1, qk, Bsum);
    load_qk<CUM>(X, c + 3 < X.cend ? c + 3 : X.cend - 1, qk);
    if (c + 2 < X.cend) raw_write(X, c + 2, gv);
    load_gv(X, c + 4 < X.cend ? c + 4 : X.cend - 1, gv);
}
}
#ifndef HG_SPLIT
#define HG_SPLIT 52
#endif
template <int half> __device__ __forceinline__ void hgrn_chain(const Frame& F, int chain) {
    using namespace hg;
    Ctx X;
    X.lds = F.lds; X.tid = threadIdx.x; const int lane = X.tid & 63; X.w = __builtin_amdgcn_readfirstlane(X.tid >> 6); X.fr = lane & 15; X.fq = lane >> 4;
    X.dir = chain & 1; X.h = (chain >> 1) & 3; X.b = chain >> 3; X.sgn = X.dir ? -1 : 1; X.colw = X.h * 128 + 16 * X.w;
    X.Gp = X.dir ? F.GB : F.GF; X.Kp = X.dir ? F.KB : F.KF; X.Ip = F.I; X.Qp = F.Q; X.Op = X.dir ? F.OB : F.OF;
    X.slot0 = 8 * (X.fr >> 2) + (X.fr & 3);
    X.qcum = nullptr;
    X.cend = half ? 72 : HG_SPLIT;
#pragma unroll
    for (int jj = 0; jj < 8; ++jj) {
        X.tri0[jj] = (jj < 4 && 4 * X.fq + jj <= X.fr) ? (short)0x3F80 : (short)0;
        X.tri1[jj] = (jj < 4) ? (short)0x3F80 : ((4 * X.fq + jj - 4 <= X.fr) ? (short)0x3F80 : (short)0);
    }
    f32x4 S[8];
#pragma unroll
    for (int kt = 0; kt < 8; ++kt) S[kt] = (f32x4){0.f, 0.f, 0.f, 0.f};
    f32x4 Bsum = (f32x4){0.f, 0.f, 0.f, 0.f};
    QK qkA, qkB; GV gvA, gvB;
    load_gv(X, 0, gvA); load_gv(X, 1, gvB); load_qk<false>(X, 0, qkA); load_qk<false>(X, 1, qkB);
    raw_write(X, 0, gvA); load_gv(X, 2, gvA);
    lds_barrier();
    bf16x8 VTcur = stage<false, false>(X, 0, qkA, Bsum); load_qk<false>(X, 2, qkA);
    raw_write(X, 1, gvB); load_gv(X, 3, gvB);
    if constexpr (half == 0) {
        for (int c = 0; c < 6; c += 2) { iter<false, false, false>(X, c, qkB, gvA, VTcur, S, Bsum); iter<false, false, false>(X, c + 1, qkA, gvB, VTcur, S, Bsum); }
        iter<false, false, false>(X, 6, qkB, gvA, VTcur, S, Bsum); iter<false, true, false>(X, 7, qkA, gvB, VTcur, S, Bsum);
        for (int c = 8; c < HG_SPLIT - 2; c += 2) { iter<true, true, false>(X, c, qkB, gvA, VTcur, S, Bsum); iter<true, true, false>(X, c + 1, qkA, gvB, VTcur, S, Bsum); }
        iter<true, true, false>(X, HG_SPLIT - 2, qkB, gvA, VTcur, S, Bsum);
        lds_barrier();
        products<true>(X, HG_SPLIT - 1, VTcur, S);
    } else {
        for (int c = 0; c < HG_SPLIT - 2; c += 2) { iter<false, false, false>(X, c, qkB, gvA, VTcur, S, Bsum); iter<false, false, false>(X, c + 1, qkA, gvB, VTcur, S, Bsum); }
        iter<false, false, false>(X, HG_SPLIT - 2, qkB, gvA, VTcur, S, Bsum); iter<false, true, false>(X, HG_SPLIT - 1, qkA, gvB, VTcur, S, Bsum);
        for (int c = HG_SPLIT; c < 70; c += 2) { iter<true, true, false>(X, c, qkB, gvA, VTcur, S, Bsum); iter<true, true, false>(X, c + 1, qkA, gvB, VTcur, S, Bsum); }
        iter<true, true, false>(X, 70, qkB, gvA, VTcur, S, Bsum);
        lds_barrier();
        products<true>(X, 71, VTcur, S);
    }
    __syncthreads();
}

constexpr int CONV_P2_PER_WG = 44, CONV_P2_EXTRA = 16, CONV_P2_ITEMS = 20 * CONV_P2_PER_WG + CONV_P2_EXTRA;
constexpr int CONV_PER_WG = (CONV_ITEMS - CONV_P2_ITEMS) / 128;
#ifndef CONV_CHAIN_SHARE
#define CONV_CHAIN_SHARE 2
#endif
__device__ __forceinline__ void phase3(const Frame& F) {
    const int G = gridDim.x, bid = blockIdx.x;
    if (bid < 128) {
        if (bid & 1) hgrn_chain<1>(F, bid >> 1); else hgrn_chain<0>(F, bid >> 1);
        conv8_run(F, CONV_P2_ITEMS + bid + 128 * (CONV_PER_WG - CONV_CHAIN_SHARE), 128, CONV_CHAIN_SHARE);
    } else {
        const int j = bid - 128, nw = G - 128;
        for (int rep = 0; rep < ((DBG_REP3 & 2) ? 2 : 1); ++rep) for (int item = j; item < 512; item += nw) sgu_item(F, item);
        if (j < 128) { conv8_run(F, CONV_P2_ITEMS + j, 128, CONV_PER_WG - CONV_CHAIN_SHARE); if (DBG_REP3 & 4) conv8_run(F, CONV_P2_ITEMS + j, 128, 6); }
    }
}

__device__ __forceinline__ void stagger_start(int slot, int us) {
    if (slot > 0 && us > 0) { const unsigned long long t0 = __builtin_amdgcn_s_memrealtime(); const unsigned long long dt = (unsigned long long)(slot * us) * 100ull;
        while (__builtin_amdgcn_s_memrealtime() - t0 < dt) __builtin_amdgcn_s_sleep(8); }
    __syncthreads();
}
constexpr int N_PHASES = 10;
#ifndef DBG_NO_MOE
#define DBG_NO_MOE 0
#endif
#ifndef DBG_MAX_PHASE
#define DBG_MAX_PHASE 9
#endif
__global__ void __launch_bounds__(NTHREADS, 2) fwd_kernel(Args a) {
    extern __shared__ __attribute__((aligned(16))) unsigned char lds_raw[];
    Frame F;
    F.x = a.in[0]; F.c = a.in[1]; F.ctx = a.in[2]; F.c_ctx = a.in[3]; F.w_mod = a.in[4]; F.b_mod = a.in[5]; F.norm1 = a.in[6]; F.w_in = a.in[7]; F.sgu_ln = a.in[8]; F.sgu_w = a.in[9];
    F.sgu_b = a.in[10]; F.lb_fwd = a.in[11]; F.lb_bwd = a.in[12]; F.hgrn_norm = a.in[13]; F.w_out = a.in[14]; F.norm2 = a.in[15]; F.router_w = a.in[16]; F.router_b = a.in[17];
    F.w1 = a.in[18]; F.b1 = a.in[19]; F.w2 = a.in[20]; F.b2 = a.in[21]; F.final_norm = a.in[22];
    F.out = a.out; F.ws = a.ws; unsigned char* ws = a.ws;
    F.ctl = (unsigned*)(ws + WS_CTL); F.mod = (float*)(ws + WS_MOD); F.LBT = (float*)(ws + WS_LBT);
    F.WinT = (bf16_t*)(ws + WS_WIN); F.WoutT = (bf16_t*)(ws + WS_WOUT); F.W1T = ws + WS_W1; F.W2T = ws + WS_W2;
    F.H = (bf16_t*)(ws + WS_H); F.U = (bf16_t*)(ws + WS_U); F.VG = (bf16_t*)(ws + WS_VG); F.Q = (bf16_t*)(ws + WS_Q); F.GS = (bf16_t*)(ws + WS_GS); F.I = (bf16_t*)(ws + WS_I);
    F.GF = (bf16_t*)(ws + WS_GF); F.KF = (bf16_t*)(ws + WS_KF); F.GB = (bf16_t*)(ws + WS_GB); F.KB = (bf16_t*)(ws + WS_KB);
    F.YCAT = (bf16_t*)(ws + WS_YCAT); F.H2 = ws + WS_H2; F.ACT = ws + WS_ACT; F.DOUT = ws + WS_DOUT;
    F.OF = (bf16_t*)(ws + WS_OF); F.OB = (bf16_t*)(ws + WS_OB); F.X1 = (bf16_t*)(ws + WS_X1); F.SS = (float*)(ws + WS_SS); F.TW = (float*)(ws + WS_TW);
    F.LIST = (int*)(ws + WS_LIST); F.TSLOT = (int*)(ws + WS_TSLOT); F.QCUM = (bf16_t*)(ws + WS_QCUM); F.SMID = ws + WS_SMID;
    F.lds = (LAS unsigned char*)lds_raw;
    if (threadIdx.x < 64) ((LAS unsigned*)(F.lds + LDS_MISC_OFF))[threadIdx.x] = 0u;
    __syncthreads();
    const int lo = a.ph_lo, hi = a.ph_hi, G = gridDim.x, cid = blockIdx.x;
    XcdBarrier bar; bar.bar = F.ctl + CW_BAR; bar.x = 0; bar.st = nullptr;
    if (hi - lo > 1) bar = xcd_barrier_post(F.ctl + CW_BAR, (volatile LAS unsigned*)(F.lds + LDS_MISC_OFF));
#define IN(k) (lo <= (k) && (k) < hi)
#define SEAM(k) do { if (IN(k) && IN((k) + 1)) xcd_barrier(bar); } while (0)
#define REP(k) for (int _r = 0; _r < (((DBG_REP >> (k)) & 1) ? 2 : 1); ++_r)
    if (IN(0)) REP(0) phase0(F);
    if (IN(1)) REP(1) phase1(F, IN(0));
    SEAM(1);
    for (int _b = 0; _b < DBG_BARX; ++_b) xcd_barrier(bar);
    if (IN(2)) REP(2) {
        const int GG = (G >= 256) ? 236 : G;
        if (cid < GG) { stagger_start((cid >> 3) & 3, STAGGER_INP_US); SchedInProj S{(const unsigned char*)F.WinT, GG, cid}; EpiInProj E{F.U, F.VG, F.Q, F.GS, F.I, F.GF, F.KF, F.GB, F.KB, F.LBT};
            pg::gemm_phase<EpiInProj, SchedInProj, INPROJ_FP8 != 0>(F.lds, (const char*)F.H, D, S, E); }
        else if (cid < 256) { const int k = cid - 236; conv8_run(F, k, 20, CONV_P2_PER_WG); if (k < CONV_P2_EXTRA) conv8_run(F, 20 * CONV_P2_PER_WG + k, 20, 1); }
    }
    SEAM(2);
    if (IN(3)) REP(3) phase3(F);
    SEAM(3);
    if (IN(4) && !FOLD_P4) REP(4) phase4(F);
    if (!FOLD_P4) SEAM(4);
    if (IN(5)) REP(5) {
        SchedOutProj S{F.WoutT, G, cid}; EpiOutProj E{F.x, F.mod, F.X1, F.SS};
        if (FOLD_P4) {
            pg::Unit u;
            if (S.next(0, u)) {
                const int r0 = u.arow + 64 * u.pn;
                phase4_rows(F, r0, r0 + 64, 8);
                asm volatile("s_waitcnt vmcnt(0)" ::: "memory"); __syncthreads();
                if (threadIdx.x == 0) {
                    unsigned* w = F.ctl + CW_P4RDY + 16 * (u.arow >> 8); unsigned sp = 0;
                    __builtin_amdgcn_fence(__ATOMIC_RELEASE, "agent"); asm volatile("s_waitcnt vmcnt(0)" ::: "memory");
                    __hip_atomic_fetch_add(w, 1u, __ATOMIC_RELAXED, __HIP_MEMORY_SCOPE_AGENT);
                    while (__hip_atomic_load(w, __ATOMIC_RELAXED, __HIP_MEMORY_SCOPE_AGENT) < 4u) { __builtin_amdgcn_s_sleep(2); if (++sp > (1u << 22)) break; }
                    __builtin_amdgcn_fence(__ATOMIC_ACQUIRE, "agent"); asm volatile("s_waitcnt vmcnt(0)" ::: "memory");
                }
                __syncthreads();
            }
        }
        pg::gemm_phase<EpiOutProj, SchedOutProj, OUTPROJ_FP8 != 0>(F.lds, (const char*)F.YCAT, D, S, E);
    }
    SEAM(5);
    if (IN(6)) phase6(F);
    SEAM(6);
    if (IN(7)) {
        moe_tables(F);
        SchedMoe S{F.W1T, F.W2T, F.LIST, moe_tab(F.lds), G, cid, F.lds, F.ctl, (unsigned)WS_H2, (unsigned)WS_ACT, 0}; S.init();
        EpiMoe E{F.b1, F.b2, F.ACT, F.DOUT, F.lds, &S};
        S.preload(F.b1, F.b2);
        stagger_start(STAGGER_MOE_SLOT, STAGGER_MOE_US);
        pg::gemm_phase<EpiMoe, SchedMoe, true>(F.lds, (const char*)F.ws, D, S, E);
    }
    SEAM(7);
    if (IN(9)) REP(9) phase9(F);
#undef IN
#undef SEAM
}

extern "C" void kernel_launch(void* const* d_in, const int* in_sizes, int n_in, void* d_out, int out_size, void* d_ws, size_t ws_size, hipStream_t stream) {
    static int grid = 0;
    if (grid == 0) {
        if (n_in != 23 || in_sizes[0] != NTOK * D || out_size != NTOK * D || ws_size < WS_END) {
            fprintf(stderr, "kernel_launch: unexpected shapes / workspace (n_in %d, in0 %d, out %d, ws %zu, need %zu); nothing launched\n", n_in, n_in > 0 ? in_sizes[0] : -1, out_size, ws_size, (size_t)WS_END);
            grid = -1; return;
        }
        int dev = 0, cus = 0;
        if (hipGetDevice(&dev) != hipSuccess || hipDeviceGetAttribute(&cus, hipDeviceAttributeMultiprocessorCount, dev) != hipSuccess) { grid = -1; return; }
        if (hipFuncSetAttribute((const void*)fwd_kernel, hipFuncAttributeMaxDynamicSharedMemorySize, LDS_BYTES) != hipSuccess) { fprintf(stderr, "kernel_launch: hipFuncSetAttribute failed\n"); grid = -1; return; }
        int per_cu = 0;
        if (hipOccupancyMaxActiveBlocksPerMultiprocessor(&per_cu, (const void*)fwd_kernel, NTHREADS, LDS_BYTES) != hipSuccess || per_cu < 1)
            fprintf(stderr, "kernel_launch: note: the occupancy query reports %d workgroups per CU; launching one per CU (%d bytes of LDS each)\n", per_cu, LDS_BYTES);
        (void)hipGetLastError();
        grid = cus;
        if (grid < 256) { fprintf(stderr, "kernel_launch: needs >= 256 CUs\n"); grid = -1; return; }
    }
    if (grid < 0) return;
    (void)hipMemsetAsync((char*)d_ws + WS_CTL, 0, CTL_BYTES, stream);
    Args a{};
    for (int i = 0; i < 23; ++i) a.in[i] = (const float*)d_in[i];
    a.out = (float*)d_out; a.ws = (unsigned char*)d_ws;
#if N_LAUNCH_MODE == 1
    a.ph_lo = 0; a.ph_hi = N_PHASES;
    hipLaunchKernelGGL(fwd_kernel, dim3(grid), dim3(NTHREADS), LDS_BYTES, stream, a);
#else
    for (int p = 0; p < N_PHASES; ++p) { if (DBG_NO_MOE && p >= 6 && p <= 8) continue; a.ph_lo = p; a.ph_hi = p + 1; hipLaunchKernelGGL(fwd_kernel, dim3(grid), dim3(NTHREADS), LDS_BYTES, stream, a); }
#endif
}
```

```cpp
#include <hip/hip_runtime.h>
#include <cstdio>
#include <cstdint>

#ifndef N_LAUNCH_MODE
#define N_LAUNCH_MODE 1
#endif

#ifndef DBG_NO_MOE
#define DBG_NO_MOE 0
#endif
#ifndef DBG_REP
#define DBG_REP 0
#endif
#ifndef DBG_REP3
#define DBG_REP3 0
#endif
#ifndef DBG_REP6
#define DBG_REP6 0
#endif
#ifndef DBG_BARX
#define DBG_BARX 0
#endif
#ifndef FOLD_P4
#define FOLD_P4 1
#endif
#ifndef OUTPROJ_FP8
#define OUTPROJ_FP8 1
#endif
#ifndef INPROJ_FP8
#define INPROJ_FP8 0
#endif
#ifndef INPROJ_MIX
#define INPROJ_MIX 1
#endif
#ifndef STAGGER_MOE_US
#define STAGGER_MOE_US 0
#endif
#ifndef STAGGER_MOE_SLOT
#define STAGGER_MOE_SLOT ((cid >> 6) & 3)
#endif
#ifndef STAGGER_INP_US
#define STAGGER_INP_US 0
#endif
#ifndef DBG_EPIWAIT
#define DBG_EPIWAIT 0
#endif
#ifndef DBG_MIX
#define DBG_MIX 1
#endif
#define LAS __attribute__((address_space(3)))
typedef unsigned short bf16_t;
typedef short bf16x8 __attribute__((ext_vector_type(8)));
typedef float f32x4 __attribute__((ext_vector_type(4)));
typedef float f32x2 __attribute__((ext_vector_type(2)));
typedef unsigned u32x4 __attribute__((ext_vector_type(4)));
typedef unsigned u32x2 __attribute__((ext_vector_type(2)));

constexpr int D = 1024, NB = 8, SEQ = 2048, CTXL = 256;
constexpr int NTOK = NB * SEQ;
constexpr int NCTX = NB * CTXL;
constexpr int NROW = NTOK + NCTX;
constexpr int DIN = 3584, GW = 512, NE = 32, DE = 1024, TOPK = 4;
constexpr int ACT_ROWS = NTOK * TOPK + NE * 256;
constexpr float EPS = 1e-6f;
constexpr int NTHREADS = 512;

constexpr int LDS_STAGE = 131072;
constexpr int LDS_EXTRA_OFF = LDS_STAGE;
constexpr int LDS_MISC_OFF = 155648;
constexpr int LDS_BYTES = LDS_MISC_OFF + 256;

constexpr size_t al256(size_t x) { return (x + 255) & ~(size_t)255; }
constexpr size_t WS_CTL = 0;
constexpr size_t CTL_BYTES = 65536;
constexpr int CW_BAR = 0;
constexpr int CW_CNT = 4096;
constexpr size_t WS_MOD = WS_CTL + CTL_BYTES;
constexpr size_t WS_LBT = WS_MOD + al256((size_t)9 * 6144 * 4);
constexpr size_t WS_WIN = WS_LBT + 4096;
constexpr size_t WS_WOUT = WS_WIN + (size_t)DIN * D * 2;
constexpr size_t WS_W1 = WS_WOUT + (size_t)D * D * 2;
constexpr size_t WS_W2 = WS_W1 + (size_t)NE * 2 * DE * D * 2;
constexpr size_t WS_YCAT = WS_W2 + (size_t)NE * D * DE * 2;
constexpr size_t WS_OF = WS_YCAT + (size_t)NTOK * D * 2;
constexpr size_t WS_OB = WS_OF + (size_t)NTOK * GW * 4;
constexpr size_t WS_X1 = WS_OB + (size_t)NTOK * GW * 4;
constexpr size_t WS_SS = WS_X1 + (size_t)NTOK * D * 4;
constexpr size_t WS_H2 = WS_SS + (size_t)NTOK * 16 * 4;
constexpr size_t WS_LIST = WS_H2 + (size_t)NTOK * D * 2;
constexpr size_t WS_TSLOT = WS_LIST + (size_t)NE * NTOK * 4;
constexpr size_t WS_TW = WS_TSLOT + (size_t)NTOK * 4 * 4;
constexpr size_t WS_QCUM = WS_TW + (size_t)NTOK * 4 * 4;
constexpr size_t WS_SMID = WS_QCUM + (size_t)64 * 1152 * 128 * 2;
constexpr size_t WS_ACT = WS_SMID + (size_t)64 * 8 * 4 * 64 * 16;
constexpr size_t WS_REGA = WS_ACT + (size_t)ACT_ROWS * DE * 2;
constexpr size_t WS_H = WS_REGA;
constexpr size_t WS_U = WS_H + (size_t)NROW * D * 2;
constexpr size_t WS_VG = WS_U + (size_t)NTOK * GW * 2;
constexpr size_t WS_Q = WS_VG + (size_t)NTOK * GW * 2;
constexpr size_t WS_GS = WS_Q + (size_t)NTOK * GW * 2;
constexpr size_t WS_I = WS_GS + (size_t)NTOK * GW * 2;
constexpr size_t WS_GF = WS_I + (size_t)NROW * GW * 2;
constexpr size_t WS_KF = WS_GF + (size_t)NROW * GW * 2;
constexpr size_t WS_GB = WS_KF + (size_t)NROW * GW * 2;
constexpr size_t WS_KB = WS_GB + (size_t)NROW * GW * 2;
constexpr size_t WS_REGA_END = WS_KB + (size_t)NROW * GW * 2;
constexpr size_t WS_DOUT = WS_REGA;
constexpr size_t WS_END0 = WS_DOUT + (size_t)ACT_ROWS * D * 2;
constexpr size_t WS_END_A = WS_END0 > WS_REGA_END ? WS_END0 : WS_REGA_END;
constexpr size_t WS_WIN8 = (WS_END_A + 255) / 256 * 256;
constexpr size_t WS_H8 = WS_WIN8 + (size_t)DIN * D;
constexpr size_t WS_END = INPROJ_MIX ? WS_H8 + (size_t)NROW * D : WS_END_A;

typedef __bf16 bf16x2_t __attribute__((ext_vector_type(2)));
__device__ __forceinline__ unsigned cvt_pk_bf16(float lo, float hi) { bf16x2_t v; v[0] = (__bf16)lo; v[1] = (__bf16)hi; return __builtin_bit_cast(unsigned, v); }
__device__ __forceinline__ float bf2f(unsigned b) { return __uint_as_float(b << 16); }
__device__ __forceinline__ float bflo(unsigned w) { return __uint_as_float(w << 16); }
__device__ __forceinline__ float bfhi(unsigned w) { return __uint_as_float(w & 0xffff0000u); }
__device__ __forceinline__ float fast_exp(float x) { return __builtin_amdgcn_exp2f(x * 1.44269504089f); }
__device__ __forceinline__ float fast_rcp(float x) { return __builtin_amdgcn_rcpf(x); }
__device__ __forceinline__ float sigmoidf_(float x) { return fast_rcp(1.0f + fast_exp(-x)); }
__device__ __forceinline__ float gelu_tanh(float x) { const float u = 1.5957691216f * (x + 0.044715f * x * x * x); return x * fast_rcp(1.0f + fast_exp(-u)); }
__device__ __forceinline__ float clampf(float x, float lo, float hi) { return fminf(fmaxf(x, lo), hi); }
typedef float f32x2 __attribute__((ext_vector_type(2)));
__device__ __forceinline__ f32x2 rcp_pair(f32x2 d) { const float r = fast_rcp(d.x * d.y); return (f32x2){d.y, d.x} * r; }
__device__ __forceinline__ float wave_sum(float v) {
#pragma unroll
    for (int o = 32; o >= 1; o >>= 1) v += __shfl_xor(v, o);
    return v;
}
__device__ __forceinline__ unsigned pack_fp8x4_nc(float a, float b, float c, float d) {
    int p = __builtin_amdgcn_cvt_pk_fp8_f32(a, b, 0, false); p = __builtin_amdgcn_cvt_pk_fp8_f32(c, d, p, true); return (unsigned)p;
}
__device__ __forceinline__ unsigned pack_fp8x4(float a, float b, float c, float d) {
    a = __builtin_amdgcn_fmed3f(a, -448.f, 448.f); b = __builtin_amdgcn_fmed3f(b, -448.f, 448.f); c = __builtin_amdgcn_fmed3f(c, -448.f, 448.f); d = __builtin_amdgcn_fmed3f(d, -448.f, 448.f);
    int p = __builtin_amdgcn_cvt_pk_fp8_f32(a, b, 0, false); p = __builtin_amdgcn_cvt_pk_fp8_f32(c, d, p, true); return (unsigned)p;
}
#define VM_WAIT() asm volatile("s_waitcnt vmcnt(0)" ::: "memory")
#define LDS_WAIT() asm volatile("s_waitcnt lgkmcnt(0)" ::: "memory")
__device__ __forceinline__ unsigned lds_addr(const LAS void* p) { return (unsigned)(unsigned long)p; }
__device__ __forceinline__ int lds_ld_i32(const LAS void* p) { int v; asm volatile("ds_read_b32 %0, %1\n\ts_waitcnt lgkmcnt(0)" : "=v"(v) : "v"(lds_addr(p)) : "memory"); return v; }
__device__ __forceinline__ void lds_ld_4u16(const LAS void* p0, const LAS void* p1, const LAS void* p2, const LAS void* p3, int& a, int& b, int& c, int& d) {
    asm volatile("ds_read_u16 %0, %4\n\tds_read_u16 %1, %5\n\tds_read_u16 %2, %6\n\tds_read_u16 %3, %7\n\ts_waitcnt lgkmcnt(0)"
                 : "=&v"(a), "=&v"(b), "=&v"(c), "=&v"(d) : "v"(lds_addr(p0)), "v"(lds_addr(p1)), "v"(lds_addr(p2)), "v"(lds_addr(p3)) : "memory");
}
__device__ __forceinline__ void lds_ld_2x128(const LAS void* p, f32x4& a, f32x4& b) {
    asm volatile("ds_read_b128 %0, %2\n\tds_read_b128 %1, %2 offset:16\n\ts_waitcnt lgkmcnt(0)" : "=&v"(a), "=&v"(b) : "v"(lds_addr(p)) : "memory");
}
__device__ __forceinline__ void lds_ld_4x128(const LAS void* p, f32x4& a, f32x4& b, f32x4& c, f32x4& d) {
    asm volatile("ds_read_b128 %0, %4\n\tds_read_b128 %1, %4 offset:16\n\tds_read_b128 %2, %4 offset:512\n\tds_read_b128 %3, %4 offset:528\n\ts_waitcnt lgkmcnt(0)"
                 : "=&v"(a), "=&v"(b), "=&v"(c), "=&v"(d) : "v"(lds_addr(p)) : "memory");
}

#define XB_TMO      128
#define XB_XCNT(j)  (256  + 64 * (j))
#define XB_XSUB(j)  (1280 + 64 * (j))
#define XB_XGEN(j)  (2304 + 64 * (j))
#define XB_TOP      3328
#define XB_TOPGEN   3392
#define XCD_BAR_WORDS 3456
#define XB_SPIN_CAP (1u << 18)
__device__ __forceinline__ unsigned xb_ld(unsigned* p)              { return __hip_atomic_load(p, __ATOMIC_RELAXED, __HIP_MEMORY_SCOPE_AGENT); }
__device__ __forceinline__ unsigned xb_add(unsigned* p, unsigned v) { return __hip_atomic_fetch_add(p, v, __ATOMIC_RELAXED, __HIP_MEMORY_SCOPE_AGENT); }
__device__ __forceinline__ unsigned xb_xcc_id() { return (unsigned)__builtin_amdgcn_s_getreg((3 << 11) | 20) & 0xFu; }
#define XB_SPIN(cond, bar) do { unsigned _sp = 0; while (cond) { __builtin_amdgcn_s_sleep(1); \
    if ((++_sp & 255u) == 0u) { if (xb_ld(&(bar)[XB_TMO])) break; if (_sp > XB_SPIN_CAP) { atomicAdd(&(bar)[XB_TMO], 1u); break; } } } } while (0)
struct XcdBarrier { unsigned* bar; unsigned x; volatile LAS unsigned* st; };
__device__ __forceinline__ XcdBarrier xcd_barrier_post(unsigned* bar, volatile LAS unsigned* st) {
    XcdBarrier b; b.bar = bar; b.x = xb_xcc_id(); b.st = st;
    if (threadIdx.x == 0) (void)xb_add(&bar[XB_XCNT(b.x)], 1u);
    return b;
}
__device__ __forceinline__ void xcd_barrier_complete(unsigned* bar, unsigned x, unsigned& nloc, unsigned& nx) {
    const unsigned G = gridDim.x * gridDim.y * gridDim.z;
    unsigned sum, cnt, mine, sp = 0u;
    for (;;) {
        sum = 0u; cnt = 0u; mine = 0u;
#pragma unroll
        for (unsigned j = 0; j < 16; ++j) { const unsigned c = xb_ld(&bar[XB_XCNT(j)]); sum += c; cnt += (c > 0u) ? 1u : 0u; mine = (j == x) ? c : mine; }
        if (sum == G) break;
        __builtin_amdgcn_s_sleep(1);
        if ((++sp & 255u) == 0u) { if (xb_ld(&bar[XB_TMO])) break; if (sp > XB_SPIN_CAP) { atomicAdd(&bar[XB_TMO], 1u); break; } }
    }
    nloc = mine > 0u ? mine : 1u; nx = cnt > 0u ? cnt : 1u;
}
__device__ __forceinline__ void xcd_barrier(const XcdBarrier& b) {
    asm volatile("s_waitcnt vmcnt(0)" ::: "memory");
    __syncthreads();
    if (threadIdx.x == 0) {
        unsigned* bar = b.bar;
        __builtin_amdgcn_s_waitcnt(0);
        unsigned nloc = b.st[0], nx = b.st[1];
        if (nloc == 0u) { xcd_barrier_complete(bar, b.x, nloc, nx); b.st[0] = nloc; b.st[1] = nx; }
        const unsigned old = xb_add(&bar[XB_XSUB(b.x)], 1u);
        const unsigned gen = old / nloc;
        if (old + 1u == (gen + 1u) * nloc) {
            __builtin_amdgcn_fence(__ATOMIC_RELEASE, "agent");
            asm volatile("s_waitcnt vmcnt(0)" ::: "memory");
            const unsigned og = xb_add(&bar[XB_TOP], 1u);
            const unsigned tg = og / nx;
            if (og + 1u == (tg + 1u) * nx) xb_add(&bar[XB_TOPGEN], 1u);
            else XB_SPIN(xb_ld(&bar[XB_TOPGEN]) == tg, bar);
            __builtin_amdgcn_fence(__ATOMIC_ACQUIRE, "agent");
            xb_add(&bar[XB_XGEN(b.x)], 1u);
            asm volatile("s_waitcnt vmcnt(0)" ::: "memory");
        } else {
            XB_SPIN(xb_ld(&bar[XB_XGEN(b.x)]) == gen, bar);
            __builtin_amdgcn_fence(__ATOMIC_ACQUIRE, "agent");
            asm volatile("s_waitcnt vmcnt(0)" ::: "memory");
        }
    }
    __syncthreads();
}

struct Args { const float* in[23]; float* out; unsigned char* ws; int ph_lo, ph_hi; };
struct Frame {
    const float *x, *c, *ctx, *c_ctx, *w_mod, *b_mod, *norm1, *w_in, *sgu_ln, *sgu_w, *sgu_b, *lb_fwd, *lb_bwd, *hgrn_norm, *w_out, *norm2,
                *router_w, *router_b, *w1, *b1, *w2, *b2, *final_norm;
    float* out; unsigned char* ws;
    unsigned* ctl; float* mod; float* LBT;
    bf16_t *WinT, *WoutT, *H, *U, *VG, *Q, *GS, *I, *GF, *KF, *GB, *KB, *YCAT; unsigned char* DOUT;
    unsigned char *W1T, *W2T, *H2, *ACT;
    float *SS, *TW; bf16_t *OF, *OB, *X1;
    bf16_t* QCUM; unsigned char* SMID;
    int *LIST, *TSLOT;
    LAS unsigned char* lds;
};

namespace pg {
constexpr int BM = 256, BK = 64, HALF = 128, HTB = HALF * BK * 2, NXCD = 8, WGM = 8;
__device__ __forceinline__ int lds_byte(int r, int c) { const int st = (r >> 4) * 2 + (c >> 5), rr = r & 15, cc = c & 31, ob = rr * 64 + cc * 2; return st * 1024 + (ob ^ (((ob >> 9) & 1) << 5)); }
__device__ __forceinline__ void stage_rc(int b, int& R, int& C) { const int st = b / 1024, sb = b % 1024, swz = sb ^ (((sb >> 9) & 1) << 5); R = (st >> 1) * 16 + swz / 64; C = (st & 1) * 32 + (swz % 64) / 2; }
__device__ __forceinline__ int perm32(int rho) { const int n = rho >> 4, i = rho & 15; return 8 * (i >> 2) + 4 * n + (i & 3); }

struct Unit { const char* bptr; int arow, orow, pn, e, cnt, pad, kind, idx; };

__device__ __forceinline__ bool static_order(int nM, int nN, int L, int& pm, int& pn) {
    const int nwg = nM * nN; if (L >= nwg) return false;
    int wgid = L; { const int q = nwg / NXCD, r = nwg % NXCD, xcd = wgid % NXCD, off = wgid / NXCD; wgid = (xcd < r ? xcd * (q + 1) : r * (q + 1) + (xcd - r) * q) + off; }
    const int nig = WGM * nN, gid = wgid / nig, fm = gid * WGM, gsz = (nM - fm) < WGM ? (nM - fm) : WGM;
    pm = fm + ((wgid % nig) % gsz); pn = (wgid % nig) / gsz; return true;
}

typedef int v8i __attribute__((ext_vector_type(8)));
typedef int v4i __attribute__((ext_vector_type(4)));
template <class Epi, class Sched, bool FP8>
__device__ __forceinline__ void gemm_phase(LAS unsigned char* lds, const char* Abase, const int K, const Sched& S, const Epi& E) {
    const int tid = threadIdx.x, wid = __builtin_amdgcn_readfirstlane(tid >> 6), lane = tid & 63, wr = wid >> 2, wc = wid & 3, fr = lane & 15, fq = lane >> 4;
    const int pitch = FP8 ? K : 2 * K;
    const int nt = pitch / 128;
    int sR[2], sC[2]; unsigned voffB[2];
#pragma unroll
    for (int i = 0; i < 2; ++i) { stage_rc(tid * 16 + i * 8192, sR[i], sC[i]); const int Rb = Epi::PERM ? ((sR[i] & ~31) + perm32(sR[i] & 31)) : sR[i]; voffB[i] = (unsigned)(Rb * pitch + 2 * sC[i]); }
    const size_t kstep = (size_t)(BK * 2);
    const size_t hstep = (size_t)HALF * pitch;
    const unsigned ldsw = (unsigned)wid * 1024u;
    const int aoff = lds_byte(wr * 64 + fr, fq * 8), boff = lds_byte(wc * 32 + fr, fq * 8);
#define PG_SA(b, h) (((b) * 2 + (h)) * HTB)
#define PG_SB(b, h) ((4 + (b) * 2 + (h)) * HTB)
#define PG_STAGE(bufoff, gbase, voff) do { _Pragma("unroll") for (int _i = 0; _i < 2; ++_i) \
        __builtin_amdgcn_global_load_lds((const unsigned*)((const char*)(gbase) + (voff)[_i]), (LAS unsigned*)(lds + (bufoff) + ldsw + _i * 8192), 16, 0, 0); } while (0)
#define PG_LDA(dst, b, h) do { _Pragma("unroll") for (int m = 0; m < 4; ++m) { dst[m].lo = *(const LAS v4i*)(lds + PG_SA(b, h) + aoff + m * 2048); dst[m].hi = *(const LAS v4i*)(lds + PG_SA(b, h) + aoff + m * 2048 + 1024); } } while (0)
#define PG_LDB(dst, b, h) do { _Pragma("unroll") for (int n = 0; n < 2; ++n) { dst[n].lo = *(const LAS v4i*)(lds + PG_SB(b, h) + boff + n * 2048); dst[n].hi = *(const LAS v4i*)(lds + PG_SB(b, h) + boff + n * 2048 + 1024); } } while (0)
#define PG_MMA(ai, bj, At, Bt) do { __builtin_amdgcn_s_setprio(1); _Pragma("unroll") for (int m = 0; m < 4; ++m) _Pragma("unroll") for (int n = 0; n < 2; ++n) { \
        if constexpr (FP8) acc[ai][bj][m][n] = __builtin_amdgcn_mfma_scale_f32_16x16x128_f8f6f4(Bt[n], At[m], acc[ai][bj][m][n], 0, 0, 0, 0x7a7a7a7a, 0, 0x7f7f7f7f); \
        else { const v4i _bl = Bt[n].lo, _bh = Bt[n].hi, _al = At[m].lo, _ah = At[m].hi;     \
               acc[ai][bj][m][n] = __builtin_amdgcn_mfma_f32_16x16x32_bf16(__builtin_bit_cast(bf16x8, _bl), __builtin_bit_cast(bf16x8, _al), acc[ai][bj][m][n], 0, 0, 0); \
               acc[ai][bj][m][n] = __builtin_amdgcn_mfma_f32_16x16x32_bf16(__builtin_bit_cast(bf16x8, _bh), __builtin_bit_cast(bf16x8, _ah), acc[ai][bj][m][n], 0, 0, 0); } } \
        __builtin_amdgcn_s_setprio(0); } while (0)
#define PG_WAIT_V(n) asm volatile("s_waitcnt vmcnt(" #n ")" ::: "memory")
#define PG_WAIT_L(n) asm volatile("s_waitcnt lgkmcnt(" #n ")" ::: "memory")
#define PG_BAR __builtin_amdgcn_s_barrier()
#define PG_SCHED __builtin_amdgcn_sched_barrier(0)
    Unit cur, nxt, nn; int ui = 0;
    if (!S.next(0, cur)) return;
    bool has_next = S.next(1, nxt);
    unsigned vA[2][2], vN[2][2];
    S.a_ready(cur);
    S.aoff(cur, sR, sC, vA);
    if (has_next) S.aoff(nxt, sR, sC, vN); else { vN[0][0] = vA[0][0]; vN[0][1] = vA[0][1]; vN[1][0] = vA[1][0]; vN[1][1] = vA[1][1]; }
    f32x4 acc[2][2][4][2];
#pragma unroll
    for (int a = 0; a < 2; ++a)
#pragma unroll
        for (int b = 0; b < 2; ++b)
#pragma unroll
            for (int m = 0; m < 4; ++m)
#pragma unroll
                for (int n = 0; n < 2; ++n) acc[a][b][m][n] = (f32x4){0.f, 0.f, 0.f, 0.f};
    v8i At[4], B0[2], B1[2];
    const char* cB = cur.bptr;
    PG_STAGE(PG_SB(0, 0), cB, voffB); PG_STAGE(PG_SA(0, 0), Abase, vA[0]); PG_STAGE(PG_SB(0, 1), cB + hstep, voffB); PG_STAGE(PG_SA(0, 1), Abase, vA[1]);
    if (wr == 1) PG_BAR;
    PG_WAIT_V(4); PG_BAR;
    PG_STAGE(PG_SB(1, 0), cB + kstep, voffB); PG_STAGE(PG_SA(1, 0), Abase + kstep, vA[0]); PG_STAGE(PG_SB(1, 1), cB + hstep + kstep, voffB);
    PG_WAIT_V(6); PG_BAR;
    for (;;) {
        const char* nB = has_next ? nxt.bptr : cB;
#pragma unroll 1
        for (int t = 0; t < nt; t += 2) {
            const bool last = (t == nt - 2);
            if (last && has_next) S.a_ready(nxt);
            const char* a1 = Abase + (size_t)(t + 1) * kstep;
            const char* a2 = last ? Abase : Abase + (size_t)(t + 2) * kstep; const char* b2 = last ? nB : cB + (size_t)(t + 2) * kstep;
            const char* a3 = a2 + kstep; const char* b3 = b2 + kstep;
            PG_LDB(B0, 0, 0); PG_SCHED; PG_LDA(At, 0, 0); PG_STAGE(PG_SA(1, 1), a1, vA[1]);
            if (last) { vA[0][0] = vN[0][0]; vA[0][1] = vN[0][1]; vA[1][0] = vN[1][0]; vA[1][1] = vN[1][1]; }
            PG_WAIT_L(8); PG_BAR; PG_WAIT_L(0); PG_MMA(0, 0, At, B0); PG_BAR; PG_SCHED;
            PG_LDB(B1, 0, 1); PG_STAGE(PG_SB(0, 0), b2, voffB);
            PG_BAR; PG_WAIT_L(0); PG_MMA(0, 1, At, B1); PG_BAR;
            PG_LDA(At, 0, 1); PG_STAGE(PG_SA(0, 0), a2, vA[0]);
            PG_BAR; PG_WAIT_L(0); PG_MMA(1, 0, At, B0); PG_BAR; PG_SCHED;
            PG_STAGE(PG_SB(0, 1), b2 + hstep, voffB);
            PG_WAIT_V(6); PG_BAR; PG_MMA(1, 1, At, B1); PG_BAR;
            PG_LDB(B0, 1, 0); PG_SCHED; PG_LDA(At, 1, 0); PG_STAGE(PG_SA(0, 1), a2, vA[1]);
            PG_WAIT_L(8); PG_BAR; PG_WAIT_L(0); PG_MMA(0, 0, At, B0); PG_BAR; PG_SCHED;
            PG_LDB(B1, 1, 1); PG_STAGE(PG_SB(1, 0), b3, voffB);
            PG_BAR; PG_WAIT_L(0); PG_MMA(0, 1, At, B1); PG_BAR;
            PG_LDA(At, 1, 1); PG_STAGE(PG_SA(1, 0), a3, vA[0]);
            PG_BAR; PG_WAIT_L(0); PG_MMA(1, 0, At, B0); PG_BAR; PG_SCHED;
            PG_STAGE(PG_SB(1, 1), b3 + hstep, voffB);
            PG_WAIT_V(6); PG_BAR; PG_MMA(1, 1, At, B1); PG_BAR;
        }
        if (DBG_EPIWAIT) asm volatile("s_waitcnt vmcnt(0)" ::: "memory");
        E(acc, cur, wr, wc, fr, fq);
        S.done(cur);
        if (!has_next) break;
#pragma unroll
        for (int a = 0; a < 2; ++a)
#pragma unroll
            for (int b = 0; b < 2; ++b)
#pragma unroll
                for (int m = 0; m < 4; ++m)
#pragma unroll
                    for (int n = 0; n < 2; ++n) acc[a][b][m][n] = (f32x4){0.f, 0.f, 0.f, 0.f};
        cur = nxt; cB = nB; ++ui;
        has_next = S.next(ui + 1, nn);
        if (has_next) { nxt = nn; S.aoff(nxt, sR, sC, vN); }
    }
    PG_WAIT_V(0);
    if (wr == 0) PG_BAR;
    PG_BAR;
#undef PG_SA
#undef PG_SB
#undef PG_STAGE
#undef PG_LDA
#undef PG_LDB
#undef PG_MMA
#undef PG_WAIT_V
#undef PG_WAIT_L
#undef PG_BAR
#undef PG_SCHED
}
}

typedef f32x4 Acc[2][2][4][2];

constexpr unsigned short INP_ORDER[4][236] = {
  {0,1,2,3,4,5,6,7,8,9,10,11,12,13,14,15,16,17,18,19,20,21,22,23,24,25,26,27,28,29,30,31,32,33,34,35,36,37,38,39,40,41,42,43,44,45,46,47,48,49,50,51,52,53,54,55,56,57,58,59,60,61,62,63,64,65,66,67,68,69,70,71,72,73,74,75,76,77,78,79,80,81,82,83,84,85,86,87,88,89,90,91,92,93,94,95,96,97,98,99,100,101,102,103,104,105,106,107,108,109,110,111,112,113,114,115,116,117,118,119,120,121,122,123,124,125,126,127,128,129,130,131,132,133,134,135,136,137,138,139,140,141,142,143,144,145,146,147,148,149,150,151,152,153,154,155,156,157,158,159,160,161,162,163,164,165,166,167,168,169,170,171,172,173,174,175,176,177,178,179,180,181,182,183,184,185,186,187,188,189,190,191,192,193,194,195,196,197,198,199,200,201,202,203,204,205,206,207,208,209,210,211,212,213,214,215,216,217,218,219,220,221,222,223,224,225,226,227,228,229,230,231,232,233,234,235},
  {236,237,238,239,240,241,242,243,244,245,246,247,248,249,250,251,252,253,254,255,256,257,258,259,260,261,262,263,264,265,266,267,268,269,270,271,272,273,274,275,276,277,278,279,280,281,282,283,284,285,286,287,288,289,290,291,292,293,294,295,296,297,298,299,300,301,302,303,304,305,306,307,308,309,310,311,312,313,314,315,316,317,318,319,320,321,322,323,324,325,326,327,328,329,330,331,332,333,334,335,336,337,338,339,340,341,342,343,344,345,346,347,348,349,350,351,352,353,354,355,356,357,358,359,360,361,362,363,364,365,366,367,368,369,370,371,372,373,374,375,376,377,378,379,380,381,382,383,384,385,386,387,388,389,390,391,392,393,394,395,396,397,398,399,400,401,402,403,404,405,406,407,408,409,410,411,412,413,414,415,416,417,418,419,420,421,422,423,424,425,426,427,428,429,430,431,432,433,434,435,436,437,438,439,440,441,442,443,444,445,446,447,448,449,450,451,452,453,454,455,456,457,458,459,460,461,462,463,464,465,466,467,468,469,470,471},
  {488,489,490,491,500,501,502,503,496,497,498,499,508,509,510,511,504,505,506,507,516,517,518,519,512,513,514,515,524,525,526,527,520,521,522,523,532,533,534,535,528,529,530,531,540,541,542,543,536,537,538,539,548,549,550,551,544,545,546,547,556,557,558,559,552,553,554,555,564,565,566,567,560,561,562,563,572,573,574,575,568,569,570,571,580,581,582,583,576,577,578,579,588,589,590,591,584,585,586,587,596,597,598,599,592,593,594,595,604,605,606,607,600,601,602,603,612,613,614,615,608,609,610,611,620,621,622,623,616,617,618,619,628,629,630,631,624,625,626,627,636,637,638,639,632,633,634,635,644,645,646,647,640,641,642,643,652,653,654,655,648,649,650,651,660,661,662,663,656,657,658,659,668,669,670,671,664,665,666,667,676,677,678,679,672,673,674,675,684,685,686,687,680,681,682,683,692,693,694,695,688,689,690,691,700,701,702,703,696,697,698,699,476,477,478,479,704,705,706,707,484,485,486,487,472,473,474,475,492,493,494,495,480,481,482,483},
  {724,725,726,727,736,737,738,739,732,733,734,735,744,745,746,747,740,741,742,743,752,753,754,755,748,749,750,751,760,761,762,763,756,757,758,759,768,769,770,771,764,765,766,767,776,777,778,779,772,773,774,775,784,785,786,787,780,781,782,783,792,793,794,795,788,789,790,791,800,801,802,803,796,797,798,799,808,809,810,811,804,805,806,807,816,817,818,819,812,813,814,815,824,825,826,827,820,821,822,823,832,833,834,835,828,829,830,831,840,841,842,843,836,837,838,839,848,849,850,851,844,845,846,847,856,857,858,859,852,853,854,855,864,865,866,867,860,861,862,863,872,873,874,875,868,869,870,871,880,881,882,883,876,877,878,879,888,889,890,891,884,885,886,887,928,929,930,931,892,893,894,895,936,937,938,939,932,933,934,935,896,897,898,899,940,941,942,943,904,905,906,907,900,901,902,903,912,913,914,915,908,909,910,911,920,921,922,923,916,917,918,919,712,713,714,715,924,925,926,927,720,721,722,723,708,709,710,711,728,729,730,731,716,717,718,719}
};
struct SchedInProj {
    __device__ __forceinline__ void a_ready(const pg::Unit&) const {}
    __device__ __forceinline__ void done(const pg::Unit&) const {}
    const unsigned char* WinT; int G, c;
    static constexpr int ESZ = INPROJ_FP8 ? 1 : 2;
    __device__ __forceinline__ bool next(int i, pg::Unit& u) const {
        if (i >= 4 && G == 236) return false;
        const int L = (G == 236) ? (int)INP_ORDER[i][c] : i * G + c; int pm, pn;
        if (L < 64 * 14) { pg::static_order(64, 14, L, pm, pn); }
        else { const int x = L - 64 * 14; if (x >= 48) return false; pm = 64 + (x & 7); pn = 6 + (x >> 3); }
        u.bptr = (const char*)(WinT + (size_t)pn * 256 * D * ESZ); u.arow = pm * 256; u.orow = pm * 256; u.pn = pn; u.e = 0; u.cnt = 0; u.pad = 0; return true;
    }
    __device__ __forceinline__ void aoff(const pg::Unit& u, const int (&R)[2], const int (&C)[2], unsigned (&v)[2][2]) const {
#pragma unroll
        for (int h = 0; h < 2; ++h)
#pragma unroll
            for (int i = 0; i < 2; ++i) v[h][i] = (unsigned)((u.arow + h * 128 + R[i]) * D * ESZ + 2 * C[i]);
    }
};
constexpr int INP_GG = 228;
constexpr int INP_LCB[6] = {0, 1, 2, 3, 4, 5};
constexpr int INP_LC8[8] = {12, 6, 13, 7, 10, 8, 11, 9};
constexpr int INP_CC8[6] = {6, 10, 7, 11, 8, 9};
constexpr unsigned char INP_TB[2][29][2] = {{{0,28},{1,29},{2,30},{3,31},{4,32},{5,33},{6,34},{7,35},{8,36},{9,37},{10,38},{11,39},{12,40},{13,41},{14,42},{15,43},{16,44},{17,45},{18,46},{19,47},{20,255},{21,255},{22,255},{23,255},{24,255},{25,255},{26,255},{27,255},{255,255}},
  {{0,29},{1,30},{2,31},{3,32},{4,33},{5,34},{6,35},{7,36},{8,37},{9,38},{10,39},{11,40},{12,41},{13,42},{14,43},{15,44},{16,45},{17,46},{18,47},{19,255},{20,255},{21,255},{22,255},{23,255},{24,255},{25,255},{26,255},{27,255},{28,255}}};
constexpr unsigned char INP_T8[2][29][4] = {{{16,40,255,255},{17,41,255,255},{18,42,255,255},{19,43,255,255},{20,44,255,255},{21,45,255,255},{22,46,255,255},{23,47,255,255},{32,56,255,255},{33,57,255,255},{34,58,255,255},{35,59,255,255},{36,60,255,255},{37,61,255,255},{38,62,255,255},{39,63,255,255},{48,64,255,255},{49,66,255,255},{50,68,255,255},{51,69,255,255},{0,8,24,52},{1,9,25,53},{2,10,26,54},{3,11,27,55},{4,12,28,65},{5,13,29,67},{6,14,30,255},{7,15,31,255},{255,255,255,255}},
  {{32,44,255,255},{33,45,255,255},{34,46,255,255},{35,47,255,255},{36,56,255,255},{37,57,255,255},{38,58,255,255},{39,59,255,255},{48,60,255,255},{49,61,255,255},{50,62,255,255},{51,63,255,255},{52,64,255,255},{53,66,255,255},{54,68,255,255},{55,69,255,255},{0,3,65,255},{1,4,67,255},{2,5,255,255},{6,8,26,255},{7,9,27,255},{10,16,28,255},{11,17,29,255},{12,18,30,255},{13,19,31,255},{14,20,40,255},{15,21,41,255},{22,24,42,255},{23,25,43,255}}};
template <bool F8> struct SchedInMix {
    __device__ __forceinline__ void a_ready(const pg::Unit&) const {}
    __device__ __forceinline__ void done(const pg::Unit&) const {}
    const unsigned char* W; int c;
    static constexpr int ESZ = F8 ? 1 : 2;
    __device__ __forceinline__ bool next(int i, pg::Unit& u) const {
        const int x = c & 7, j = c >> 3, n = (INP_GG - x + 7) >> 3;
        constexpr int NL = F8 ? 8 : 6, NCX = F8 ? 6 : 0, total = 8 * NL + NCX;
        static_assert(INP_GG == 228, "the tables are built for classes of 29 (x < 4) and 28 workgroups");
        if (i >= (F8 ? 4 : 2)) return false;
        const int idx = F8 ? (int)INP_T8[n - 28][j][i] : (int)INP_TB[n - 28][j][i]; if (idx >= total) return false;
        int pm, pn;
        if (idx < 8 * NL) { pn = F8 ? INP_LC8[idx >> 3] : INP_LCB[idx >> 3]; pm = 8 * x + (idx & 7); } else { pn = INP_CC8[idx - 8 * NL]; pm = 64 + x; }
        u.bptr = (const char*)(W + (size_t)pn * 256 * D * ESZ); u.arow = pm * 256; u.orow = pm * 256; u.pn = pn; u.e = 0; u.cnt = 0; u.pad = 0; return true;
    }
    __device__ __forceinline__ void aoff(const pg::Unit& u, const int (&R)[2], const int (&C)[2], unsigned (&v)[2][2]) const {
#pragma unroll
        for (int h = 0; h < 2; ++h)
#pragma unroll
            for (int i = 0; i < 2; ++i) v[h][i] = (unsigned)((u.arow + h * 128 + R[i]) * D * ESZ + 2 * C[i]);
    }
};
struct EpiInProj {
    static constexpr bool PERM = true;
    bf16_t *U, *VG, *Q, *GS, *I, *GF, *KF, *GB, *KB; const LAS float* lbt;
    __device__ __forceinline__ void operator()(const Acc& acc, const pg::Unit& u, int wr, int wc, int fr, int fq) const {
        const int cg = u.pn >> 1;
        const int cbase = (u.pn & 1) * 256 + wc * 32 + 8 * fq;
        const int row0 = u.orow + wr * 64 + fr;
        if (cg == 3 || cg == 4) {
            const LAS float* tab = lbt + (cg == 3 ? 0 : GW); bf16_t* Gd = (cg == 3) ? GF : GB; bf16_t* Kd = (cg == 3) ? KF : KB;
#pragma unroll
            for (int bj = 0; bj < 2; ++bj) {
                const int col = cbase + bj * 128;
                f32x4 l0, l1; lds_ld_2x128(tab + col, l0, l1);
                f32x2 lb2[4], om2[4];
                lb2[0] = l0.lo; lb2[1] = l0.hi; lb2[2] = l1.lo; lb2[3] = l1.hi;
#pragma unroll
                for (int k = 0; k < 4; ++k) om2[k] = 1.0f - lb2[k];
#pragma unroll
                for (int ai = 0; ai < 2; ++ai)
#pragma unroll
                    for (int m = 0; m < 4; ++m) {
                        const size_t off = (size_t)(row0 + ai * 128 + m * 16) * GW + col;
                        unsigned wgv[4], wkv[4];
#pragma unroll
                        for (int k = 0; k < 4; ++k) {
                            const f32x4 a4 = acc[ai][bj][m][k >> 1];
                            f32x2 z = (k & 1) ? a4.hi : a4.lo;
                            z.x = __builtin_amdgcn_fmed3f(z.x, -30.f, 30.f); z.y = __builtin_amdgcn_fmed3f(z.y, -30.f, 30.f);
                            const f32x2 t = z * -1.44269504089f;
                            f32x2 e; e.x = __builtin_amdgcn_exp2f(t.x); e.y = __builtin_amdgcn_exp2f(t.y);
                            const f32x2 r = rcp_pair(e + 1.0f);
                            const f32x2 f = om2[k] * r + lb2[k];
                            const f32x2 kk = (om2[k] * e) * r;
                            wgv[k] = cvt_pk_bf16(__builtin_amdgcn_logf(f.x), __builtin_amdgcn_logf(f.y)); wkv[k] = cvt_pk_bf16(kk.x, kk.y);
                        }
                        u32x4 wg, wk; wg.x = wgv[0]; wg.y = wgv[1]; wg.z = wgv[2]; wg.w = wgv[3]; wk.x = wkv[0]; wk.y = wkv[1]; wk.z = wkv[2]; wk.w = wkv[3];
                        *(u32x4*)(Gd + off) = wg; *(u32x4*)(Kd + off) = wk;
                    }
            }
        } else {
            bf16_t* Od = (cg == 0) ? U : (cg == 1) ? VG : (cg == 2) ? Q : (cg == 5) ? I : GS;
            const int act = 0;
#pragma unroll
            for (int ai = 0; ai < 2; ++ai)
#pragma unroll
                for (int m = 0; m < 4; ++m)
#pragma unroll
                    for (int bj = 0; bj < 2; ++bj) {
                        const size_t off = (size_t)(row0 + ai * 128 + m * 16) * GW + cbase + bj * 128;
                        float v[8];
#pragma unroll
                        for (int n = 0; n < 2; ++n)
#pragma unroll
                            for (int j = 0; j < 4; ++j) { float z = acc[ai][bj][m][n][j]; if (act == 1) z = gelu_tanh(z); else if (act == 2) z = z * sigmoidf_(z); v[4 * n + j] = z; }
                        u32x4 w; w.x = cvt_pk_bf16(v[0], v[1]); w.y = cvt_pk_bf16(v[2], v[3]); w.z = cvt_pk_bf16(v[4], v[5]); w.w = cvt_pk_bf16(v[6], v[7]);
                        *(u32x4*)(Od + off) = w;
                    }
        }
    }
};

struct SchedOutProj {
    __device__ __forceinline__ void a_ready(const pg::Unit&) const {}
    __device__ __forceinline__ void done(const pg::Unit&) const {}
    const bf16_t* WoutT; int G, c;
    __device__ __forceinline__ bool next(int i, pg::Unit& u) const {
        const int L = i * G + c; int pm, pn; if (!pg::static_order(64, 4, L, pm, pn)) return false;
        u.bptr = (const char*)WoutT + (size_t)pn * 256 * D * (OUTPROJ_FP8 ? 1 : 2); u.arow = pm * 256; u.orow = pm * 256; u.pn = pn; u.e = 0; u.cnt = 0; u.pad = 0; return true;
    }
    __device__ __forceinline__ void aoff(const pg::Unit& u, const int (&R)[2], const int (&C)[2], unsigned (&v)[2][2]) const {
#pragma unroll
        for (int h = 0; h < 2; ++h)
#pragma unroll
            for (int i = 0; i < 2; ++i) v[h][i] = (unsigned)((u.arow + h * 128 + R[i]) * D * (OUTPROJ_FP8 ? 1 : 2) + 2 * C[i]);
    }
};
struct EpiOutProj {
    static constexpr bool PERM = false;
    const float* x; const float* mod; bf16_t* X1; float* SS;
    __device__ __forceinline__ void operator()(const Acc& acc, const pg::Unit& u, int wr, int wc, int fr, int fq) const {
        const int row0 = u.orow + wr * 64 + fr, col0 = u.pn * 256 + wc * 32 + 4 * fq;
        const float* g1 = mod + (size_t)(u.orow >> 11) * 6144 + 2048;
        f32x4 gv[2][2];
#pragma unroll
        for (int bj = 0; bj < 2; ++bj)
#pragma unroll
            for (int n = 0; n < 2; ++n) gv[bj][n] = *(const f32x4*)(g1 + col0 + bj * 128 + n * 16);
#pragma unroll
        for (int ai = 0; ai < 2; ++ai) {
            f32x4 xv[4][2][2];
#pragma unroll
            for (int m = 0; m < 4; ++m)
#pragma unroll
                for (int bj = 0; bj < 2; ++bj)
#pragma unroll
                    for (int n = 0; n < 2; ++n) xv[m][bj][n] = *(const f32x4*)(x + (size_t)(row0 + ai * 128 + m * 16) * D + col0 + bj * 128 + n * 16);
#pragma unroll
            for (int m = 0; m < 4; ++m) {
                const int row = row0 + ai * 128 + m * 16; const size_t off = (size_t)row * D + col0; float s = 0.f;
#pragma unroll
                for (int bj = 0; bj < 2; ++bj)
#pragma unroll
                    for (int n = 0; n < 2; ++n) {
                        const f32x4 o = xv[m][bj][n] + gv[bj][n] * acc[ai][bj][m][n] * (float)DBG_MIX;
                        { u32x2 w; w.x = cvt_pk_bf16(o[0], o[1]); w.y = cvt_pk_bf16(o[2], o[3]); *(u32x2*)(X1 + off + bj * 128 + n * 16) = w; }
                        s += (o[0] * o[0] + o[1] * o[1]) + (o[2] * o[2] + o[3] * o[3]);
                    }
                s += __shfl_xor(s, 16); s += __shfl_xor(s, 32);
                if (fq == 0) SS[(size_t)row * 16 + u.pn * 4 + wc] = s;
            }
        }
    }
};

struct MoeTab { LAS int* cnt; LAS int* tstart; LAS int* ent; };
__device__ __forceinline__ MoeTab moe_tab(LAS unsigned char* lds) { MoeTab t; t.cnt = (LAS int*)(lds + LDS_EXTRA_OFF); t.tstart = t.cnt + 32; t.ent = t.tstart + 64; return t; }
__device__ __forceinline__ void moe_tables(const Frame& F) {
    const MoeTab T = moe_tab(F.lds);
    if (threadIdx.x < 64) {
        const int lane = threadIdx.x;
        const int c = (lane < NE) ? (int)__hip_atomic_load(F.ctl + CW_CNT + 64 * lane, __ATOMIC_RELAXED, __HIP_MEMORY_SCOPE_AGENT) : 0;
        const int t = (c + 255) >> 8;
        int incl = t;
#pragma unroll
        for (int o = 1; o < 64; o <<= 1) { const int v = __shfl_up(incl, o); if (lane >= o) incl += v; }
        const int start = incl - t;
        if (lane < NE) { T.cnt[lane] = c; T.tstart[lane] = start; for (int k = 0; k < t; ++k) T.ent[start + k] = lane; }
        if (lane == NE) T.tstart[NE] = start;
    }
    __syncthreads();
}
constexpr int META_OFF = LDS_EXTRA_OFF + 2048, META_MAXU = 11;
__device__ __forceinline__ LAS float* meta_bias(LAS unsigned char* lds, int i, int stride) { return (LAS float*)(lds + META_OFF + i * stride); }
constexpr int CW_P4RDY = 13312;
constexpr int CW_MODRDY = 14336;
constexpr int CW_RDY = 8192;
constexpr int MOE_MAXGU = 10, MOE_MAXD = 6;
struct SchedMoe {
    const unsigned char *W1T, *W2T; const int* LIST; MoeTab T; int G, c; LAS unsigned char* lds; unsigned* ctl; unsigned aH2, aACT; int nGU; int r0 = 0, nrt = 0; mutable int pend = -1;
    __device__ __forceinline__ int total() const { return __builtin_amdgcn_readfirstlane(T.tstart[32]); }
    __device__ __forceinline__ void init() { const int tot = total(), x = c & 7, j = c >> 3, per = G >> 3; r0 = (tot * x) >> 3; nrt = ((tot * (x + 1)) >> 3) - r0;
        const int nq = 8 * nrt; nGU = (j < nq) ? (nq - j + per - 1) / per : 0; }
    __device__ __forceinline__ bool next(int i, pg::Unit& u) const {
        const int per = G >> 3, j = c >> 3;
        int idx, pn, kind;
        if (i < nGU) { const int q = j + per * i; kind = 0; pn = q & 7; idx = r0 + (q >> 3); }
        else { const int q = (per - 1 - j) + per * (i - nGU); if (q >= 4 * nrt) return false; kind = 1; pn = q & 3; idx = r0 + (q >> 2); }
        const int e = __builtin_amdgcn_readfirstlane(lds_ld_i32(T.ent + idx)); const int ts = __builtin_amdgcn_readfirstlane(lds_ld_i32(T.tstart + e)); const int mt = idx - ts;
        u.kind = kind; u.idx = idx; u.pn = pn; u.e = e; u.orow = ts * 256 + mt * 256; u.pad = i;
        if (kind == 0) { u.bptr = (const char*)(W1T + ((size_t)e * 2048 + (size_t)pn * 256) * D); u.arow = mt * 256; u.cnt = __builtin_amdgcn_readfirstlane(lds_ld_i32(T.cnt + e)); }
        else { u.bptr = (const char*)(W2T + ((size_t)e * 1024 + (size_t)pn * 256) * DE); u.arow = u.orow; u.cnt = 0; }
        return true;
    }
    __device__ __forceinline__ int meta_off(const pg::Unit& u) const {
        if (u.kind == 0) return (u.pad < MOE_MAXGU) ? META_OFF + u.pad * 1536 : -1;
        const int k = u.pad - nGU, ng = nGU < MOE_MAXGU ? nGU : MOE_MAXGU; return (k < MOE_MAXD) ? META_OFF + ng * 1536 + k * 1024 : -1;
    }
    __device__ __forceinline__ void aoff(const pg::Unit& u, const int (&R)[2], const int (&C)[2], unsigned (&v)[2][2]) const {
        if (u.kind == 1) {
#pragma unroll
            for (int h = 0; h < 2; ++h)
#pragma unroll
                for (int i = 0; i < 2; ++i) v[h][i] = aACT + (unsigned)((u.arow + h * 128 + R[i]) * DE + 2 * C[i]);
            return;
        }
        const int mo = meta_off(u);
        {
            const LAS unsigned short* L = (const LAS unsigned short*)(lds + mo + 1024);
            int t00, t01, t10, t11; lds_ld_4u16(L + R[0], L + R[1], L + 128 + R[0], L + 128 + R[1], t00, t01, t10, t11);
            v[0][0] = aH2 + (unsigned)(t00 * D + 2 * C[0]); v[0][1] = aH2 + (unsigned)(t01 * D + 2 * C[1]); v[1][0] = aH2 + (unsigned)(t10 * D + 2 * C[0]); v[1][1] = aH2 + (unsigned)(t11 * D + 2 * C[1]);
        }
    }
    __device__ __forceinline__ void preload(const float* b1, const float* b2) const {
        const int t = threadIdx.x;
        constexpr int NU = MOE_MAXGU + MOE_MAXD;
        unsigned val[NU]; int moff[NU];
#pragma unroll
        for (int i = 0; i < NU; ++i) {
            pg::Unit u; moff[i] = -1; val[i] = 0u;
            if (next(i, u)) {
                const int mo = meta_off(u);
                if (mo >= 0) {
                    if (u.kind == 0) {
                        if (t < 256) { moff[i] = mo + 4 * t; val[i] = __float_as_uint(b1[(size_t)u.e * 2048 + (t < 128 ? u.pn * 128 + t : 1024 + u.pn * 128 + (t - 128))]); }
                        else { int sl = u.arow + (t - 256); sl = sl < u.cnt ? sl : u.cnt - 1; moff[i] = -(mo + 1024 + 2 * (t - 256)) - 2; val[i] = (unsigned)LIST[u.e * NTOK + sl]; }
                    } else if (t < 256) { moff[i] = mo + 4 * t; val[i] = __float_as_uint(b2[(size_t)u.e * D + u.pn * 256 + t]); }
                }
            }
        }
#pragma unroll
        for (int i = 0; i < NU; ++i) {
            if (moff[i] >= 0) *(LAS unsigned*)(lds + moff[i]) = val[i];
            else if (moff[i] < -1) *(LAS unsigned short*)(lds + (-(moff[i] + 2))) = (unsigned short)val[i];
        }
        __syncthreads();
    }
    __device__ __forceinline__ void a_ready(const pg::Unit& u) const {
        if (u.kind != 1) return;
        if (threadIdx.x < 64) {
            unsigned* w = ctl + CW_RDY + 16 * u.idx; unsigned sp = 0;
            while ((unsigned)__builtin_amdgcn_readfirstlane(__hip_atomic_load(w, __ATOMIC_RELAXED, __HIP_MEMORY_SCOPE_AGENT)) < 64u) { __builtin_amdgcn_s_sleep(2); if (++sp > (1u << 22)) break; }
            __builtin_amdgcn_fence(__ATOMIC_ACQUIRE, "agent");
            asm volatile("s_waitcnt vmcnt(0)" ::: "memory");
        }
        asm volatile("" ::: "memory"); __builtin_amdgcn_s_barrier(); asm volatile("" ::: "memory");
    }
    __device__ __forceinline__ void done(const pg::Unit& u) const {
        const bool lane0 = (threadIdx.x & 63) == 0;
        if (pend >= 0) { if (lane0) __hip_atomic_fetch_add(ctl + CW_RDY + 16 * pend, 1u, __ATOMIC_RELAXED, __HIP_MEMORY_SCOPE_AGENT); pend = -1; }
        if (u.kind != 0) return;
        if (u.pad == nGU - 1) { asm volatile("s_waitcnt vmcnt(0)" ::: "memory"); if (lane0) __hip_atomic_fetch_add(ctl + CW_RDY + 16 * u.idx, 1u, __ATOMIC_RELAXED, __HIP_MEMORY_SCOPE_AGENT); }
        else pend = u.idx;
    }
};
struct EpiMoe {
    static constexpr bool PERM = true;
    const float *b1, *b2; unsigned char* ACT; unsigned char* DOUT; LAS unsigned char* lds; const SchedMoe* S;
    __device__ __forceinline__ void operator()(const Acc& acc, const pg::Unit& u, int wr, int wc, int fr, int fq) const {
        const int mo = S->meta_off(u);
        const int row0 = u.orow + wr * 64 + fr;
        if (u.kind == 0) {
            const int col = u.pn * 128 + wc * 32 + 8 * fq;
            float vg[8], vu[8];
            {
                f32x4 g0, g1, u0, u1; lds_ld_4x128((const LAS float*)(lds + mo) + wc * 32 + 8 * fq, g0, g1, u0, u1);
#pragma unroll
                for (int j = 0; j < 4; ++j) { vg[j] = g0[j]; vg[4 + j] = g1[j]; vu[j] = u0[j]; vu[4 + j] = u1[j]; }
            }
            f32x2 vg2[4], vu2[4];
#pragma unroll
            for (int k = 0; k < 4; ++k) { vg2[k] = (f32x2){vg[2 * k], vg[2 * k + 1]}; vu2[k] = (f32x2){vu[2 * k] + 1.0f, vu[2 * k + 1] + 1.0f}; }
#pragma unroll
            for (int ai = 0; ai < 2; ++ai)
#pragma unroll
                for (int m = 0; m < 4; ++m) {
                    float a[8];
#pragma unroll
                    for (int k = 0; k < 4; ++k) {
                        const f32x4 G4 = acc[ai][0][m][k >> 1], U4 = acc[ai][1][m][k >> 1];
                        f32x2 g = ((k & 1) ? G4.hi : G4.lo) + vg2[k], up1 = ((k & 1) ? U4.hi : U4.lo) + vu2[k];
                        g.x = __builtin_amdgcn_fmed3f(g.x, -24.0f, 7.0f); g.y = __builtin_amdgcn_fmed3f(g.y, -24.0f, 7.0f);
                        up1.x = __builtin_amdgcn_fmed3f(up1.x, -6.0f, 8.0f); up1.y = __builtin_amdgcn_fmed3f(up1.y, -6.0f, 8.0f);
                        const f32x2 t = g * -2.45546696f;
                        f32x2 d; d.x = __builtin_amdgcn_exp2f(t.x); d.y = __builtin_amdgcn_exp2f(t.y);
                        const f32x2 o = (g * up1) * rcp_pair(d + 1.0f);
                        a[2 * k] = o.x; a[2 * k + 1] = o.y;
                    }
                    const unsigned long long w = (unsigned long long)pack_fp8x4_nc(a[0], a[1], a[2], a[3]) | ((unsigned long long)pack_fp8x4_nc(a[4], a[5], a[6], a[7]) << 32);
                    __hip_atomic_store((unsigned long long*)(ACT + (size_t)(row0 + ai * 128 + m * 16) * DE + col), w, __ATOMIC_RELAXED, __HIP_MEMORY_SCOPE_AGENT);
                }
        } else {
            const int col0 = u.pn * 256 + wc * 32 + 8 * fq;
            float bv[2][8];
            {
                f32x4 a0, a1, c0, c1; lds_ld_4x128((const LAS float*)(lds + mo) + wc * 32 + 8 * fq, a0, a1, c0, c1);
#pragma unroll
                for (int j = 0; j < 4; ++j) { bv[0][j] = a0[j]; bv[0][4 + j] = a1[j]; bv[1][j] = c0[j]; bv[1][4 + j] = c1[j]; }
            }
            f32x2 b4[2][4];
#pragma unroll
            for (int bj = 0; bj < 2; ++bj)
#pragma unroll
                for (int k = 0; k < 4; ++k) b4[bj][k] = (f32x2){4.0f * bv[bj][2 * k], 4.0f * bv[bj][2 * k + 1]};
#pragma unroll
            for (int ai = 0; ai < 2; ++ai)
#pragma unroll
                for (int m = 0; m < 4; ++m)
#pragma unroll
                    for (int bj = 0; bj < 2; ++bj) {
                        const f32x4 v0 = acc[ai][bj][m][0], v1 = acc[ai][bj][m][1];
                        const f32x2 p0 = v0.lo * 4.0f + b4[bj][0], p1 = v0.hi * 4.0f + b4[bj][1], p2 = v1.lo * 4.0f + b4[bj][2], p3 = v1.hi * 4.0f + b4[bj][3];
                        u32x2 w; w.x = pack_fp8x4(p0.x, p0.y, p1.x, p1.y); w.y = pack_fp8x4(p2.x, p2.y, p3.x, p3.y);
                        *(u32x2*)(DOUT + (size_t)(row0 + ai * 128 + m * 16) * D + col0 + bj * 128) = w;
                    }
        }
    }
};

__device__ __forceinline__ void conv_tile(const float* src, int ld, int k0, int n0, bf16_t* dst, int drow0, LAS unsigned char* lds) {
    const int tid = threadIdx.x, p = tid >> 4, q = tid & 15;
    f32x4 v[4];
#pragma unroll
    for (int r = 0; r < 4; ++r) v[r] = *(const f32x4*)(src + (size_t)(k0 + 4 * p + r) * ld + n0 + 4 * q);
#pragma unroll
    for (int i = 0; i < 4; ++i) {
        u32x2 w; w.x = cvt_pk_bf16(v[0][i], v[1][i]); w.y = cvt_pk_bf16(v[2][i], v[3][i]);
        *(LAS u32x2*)(lds + (4 * q + i) * 256 + ((p ^ q) * 8)) = w;
    }
    __syncthreads();
#pragma unroll
    for (int jj = 0; jj < 2; ++jj) {
        const int n = (tid >> 4) + 32 * jj, c = tid & 15, qn = (n >> 2) & 15;
        u32x4 w = *(const LAS u32x4*)(lds + n * 256 + ((c ^ (qn >> 1)) * 16));
        if (qn & 1) { const unsigned t0 = w.x, t1 = w.y; w.x = w.z; w.y = w.w; w.z = t0; w.w = t1; }
        *(u32x4*)(dst + (size_t)(drow0 + n) * 1024 + k0 + 8 * c) = w;
    }
    __syncthreads();
}
constexpr int CONV_ITEMS = 32 * 128 + 32 * 64;
__device__ __forceinline__ constexpr bool inp_is8(int cg) { return cg == 6 || (cg >= 3 && cg <= 5); }
struct ConvDesc { const float* src; unsigned char* dst; int ld, k0, n0, drow0; };
__device__ __forceinline__ ConvDesc conv8_desc(const Frame& F, int it) {
    ConvDesc d;
    if (it < 4096) { const int e = it >> 7, r = it & 127, nt = r & 15, kt = r >> 4, n0 = nt * 128;
        d.src = F.w1 + (size_t)e * D * 2048; d.ld = 2048; d.k0 = kt * 128; d.n0 = n0; d.dst = F.W1T + (size_t)e * 2048 * D;
        d.drow0 = (n0 < 1024) ? ((n0 >> 7) * 256) : (((n0 - 1024) >> 7) * 256 + 128); }
    else { const int i2 = it - 4096, e = i2 >> 6, r = i2 & 63, nt = r & 7, kt = r >> 3;
        d.src = F.w2 + (size_t)e * DE * D; d.ld = 1024; d.k0 = kt * 128; d.n0 = nt * 128; d.dst = F.W2T + (size_t)e * D * DE; d.drow0 = nt * 128; }
    return d;
}
__device__ __forceinline__ void conv8_load(const ConvDesc& d, f32x4 (&v)[8]) {
    const int p = threadIdx.x >> 5, q = threadIdx.x & 31;
#pragma unroll
    for (int g = 0; g < 2; ++g)
#pragma unroll
        for (int r = 0; r < 4; ++r) v[4 * g + r] = *(const f32x4*)(d.src + (size_t)(d.k0 + 64 * g + 4 * p + r) * d.ld + d.n0 + 4 * q);
}
__device__ __forceinline__ void conv8_lds_write(const f32x4 (&v)[8], LAS unsigned char* buf) {
    const int p = threadIdx.x >> 5, q = threadIdx.x & 31;
    f32x4 w[8];
#pragma unroll
    for (int r = 0; r < 8; ++r) w[r] = v[r] * 32.0f;
#pragma unroll
    for (int g = 0; g < 2; ++g)
#pragma unroll
        for (int i = 0; i < 4; ++i)
            *(LAS unsigned*)(buf + (4 * q + i) * 128 + (((16 * g + p) ^ q) * 4)) = pack_fp8x4(w[4 * g][i], w[4 * g + 1][i], w[4 * g + 2][i], w[4 * g + 3][i]);
}
__device__ __forceinline__ void conv8_store(const ConvDesc& d, const LAS unsigned char* buf) {
#pragma unroll
    for (int jj = 0; jj < 2; ++jj) {
        const int n = (threadIdx.x >> 3) + 64 * jj, c = threadIdx.x & 7, qn = (n >> 2) & 31;
        u32x4 w = *(const LAS u32x4*)(buf + n * 128 + ((c ^ (qn >> 2)) * 16));
        if (qn & 1) { unsigned t = w.x; w.x = w.y; w.y = t; t = w.z; w.z = w.w; w.w = t; }
        if (qn & 2) { unsigned t = w.x; w.x = w.z; w.z = t; t = w.y; w.y = w.w; w.w = t; }
        *(u32x4*)(d.dst + (size_t)(d.drow0 + n) * 1024 + d.k0 + 16 * c) = w;
    }
}
__device__ __forceinline__ void conv8_run(const Frame& F, int first, int stride, int n) {
    if (n <= 0) return;
    f32x4 vA[8], vB[8], vC[8];
    const int last = first + (n - 1) * stride;
#define CV_IT(i) ((first + (i) * stride) < last ? (first + (i) * stride) : last)
#define CV_STEP(V, D_, BUF, NEXT) do { conv8_lds_write(V, F.lds + (BUF)); const ConvDesc _dn = conv8_desc(F, CV_IT(NEXT)); conv8_load(_dn, V);        \
        asm volatile("s_waitcnt lgkmcnt(0)" ::: "memory"); __builtin_amdgcn_s_barrier(); asm volatile("" ::: "memory"); conv8_store(D_, F.lds + (BUF)); D_ = _dn; } while (0)
    ConvDesc dA = conv8_desc(F, CV_IT(0)), dB = conv8_desc(F, CV_IT(1)), dC = conv8_desc(F, CV_IT(2));
    conv8_load(dA, vA); conv8_load(dB, vB); conv8_load(dC, vC);
    for (int i = 0; i < n; i += 3) {
        CV_STEP(vA, dA, 0, i + 3);
        CV_STEP(vB, dB, 16384, i + 4);
        CV_STEP(vC, dC, 32768, i + 5);
    }
#undef CV_STEP
#undef CV_IT
    __syncthreads();
}

struct ConvPipe {
    f32x4 vA[8], vB[8], vC[8]; ConvDesc dA, dB, dC; int first, stride, last, i, n; LAS unsigned char* base;
    __device__ __forceinline__ int it(int k) const { const int x = first + k * stride; return x < last ? x : last; }
    __device__ __forceinline__ void start(const Frame& F, LAS unsigned char* b, int first_, int stride_, int n_) { base = b; first = first_; stride = stride_; n = n_; last = first_ + (n_ - 1) * stride_; i = 0;
        dA = conv8_desc(F, it(0)); dB = conv8_desc(F, it(1)); dC = conv8_desc(F, it(2)); conv8_load(dA, vA); conv8_load(dB, vB); conv8_load(dC, vC); }
    template <int S> __device__ __forceinline__ void step(const Frame& F) {
        f32x4 (&V)[8] = (S == 0) ? vA : (S == 1) ? vB : vC; ConvDesc& D_ = (S == 0) ? dA : (S == 1) ? dB : dC; LAS unsigned char* buf = base + S * 16384;
        conv8_lds_write(V, buf); const ConvDesc dn = conv8_desc(F, it(i + 3)); conv8_load(dn, V);
        asm volatile("s_waitcnt lgkmcnt(0)" ::: "memory"); __builtin_amdgcn_s_barrier(); asm volatile("" ::: "memory"); conv8_store(D_, buf); D_ = dn; ++i;
    }
    __device__ __forceinline__ void finish(const Frame& F) {
        for (; i < n; ) { step<0>(F); step<1>(F); step<2>(F); }
        __syncthreads();
    }
};

__device__ __forceinline__ void mod_item(const Frame& F, int item) {
    LAS float* S = (LAS float*)F.lds;
    LAS float* RED = (LAS float*)(F.lds + 40960);
    const int tid = threadIdx.x, lane = tid & 63, wv = tid >> 6, c0 = item * 64;
    for (int idx = tid; idx < 9 * 1024; idx += NTHREADS) { const int r = idx >> 10, k = idx & 1023; const float v = (r < 8) ? F.c[r * 1024 + k] : F.c_ctx[k]; S[idx] = v * sigmoidf_(v); }
    __syncthreads();
    const int cq = tid & 15, kg = tid >> 4;
    f32x4 acc[9];
#pragma unroll
    for (int r = 0; r < 9; ++r) acc[r] = (f32x4){0.f, 0.f, 0.f, 0.f};
    for (int k0 = kg; k0 < 1024; k0 += 256) {
        f32x4 wv4[8];
#pragma unroll
        for (int u = 0; u < 8; ++u) wv4[u] = *(const f32x4*)(F.w_mod + (size_t)(k0 + 32 * u) * 6144 + c0 + 4 * cq);
#pragma unroll
        for (int u = 0; u < 8; ++u)
#pragma unroll
            for (int r = 0; r < 9; ++r) acc[r] += S[r * 1024 + k0 + 32 * u] * wv4[u];
    }
#pragma unroll
    for (int r = 0; r < 9; ++r)
#pragma unroll
        for (int j = 0; j < 4; ++j) { float v = acc[r][j]; v += __shfl_xor(v, 16); v += __shfl_xor(v, 32); if (lane < 16) RED[(wv * 9 + r) * 64 + 4 * cq + j] = v; }
    __syncthreads();
    for (int idx = tid; idx < 9 * 64; idx += NTHREADS) {
        const int r = idx >> 6, cc = idx & 63; float s = F.b_mod[c0 + cc];
#pragma unroll
        for (int w8 = 0; w8 < 8; ++w8) s += RED[(w8 * 9 + r) * 64 + cc];
        F.mod[r * 6144 + c0 + cc] = s;
    }
    asm volatile("s_waitcnt vmcnt(0)" ::: "memory");
    __syncthreads();
    if (threadIdx.x == 0) { __builtin_amdgcn_fence(__ATOMIC_RELEASE, "agent"); asm volatile("s_waitcnt vmcnt(0)" ::: "memory"); __hip_atomic_fetch_add(F.ctl + CW_MODRDY, 1u, __ATOMIC_RELAXED, __HIP_MEMORY_SCOPE_AGENT); }
}
__device__ __forceinline__ void phase0(const Frame& F) {
    if (blockIdx.x == gridDim.x - 1) {
        for (int i = threadIdx.x; i < 2 * GW; i += NTHREADS) { const float* tab = (i < GW) ? F.lb_fwd : F.lb_bwd; const int c = i & (GW - 1); F.LBT[i] = 1.0f / (1.0f + __expf(tab[GW + c] - tab[c])); }
    }
    for (int item = blockIdx.x; item < 96 + 448 + 128; item += gridDim.x) {
        if (item < 96) mod_item(F, item);
        else if (item < 96 + 448) { const int it = item - 96, nt = it % 56, kt = it / 56;
            if (INPROJ_FP8) { if (nt & 1) continue;
                ConvDesc d; d.src = F.w_in; d.ld = DIN; d.k0 = kt * 128; d.n0 = nt * 64; d.dst = (unsigned char*)F.WinT; d.drow0 = nt * 64;
                f32x4 v[8]; conv8_load(d, v); conv8_lds_write(v, F.lds); __syncthreads(); conv8_store(d, F.lds); __syncthreads(); }
            else { const bool is8 = INPROJ_MIX && inp_is8((nt * 64) >> 9);
                if (!is8) conv_tile(F.w_in, DIN, kt * 128, nt * 64, F.WinT, nt * 64, F.lds);
                else if (!(nt & 1)) {
                    ConvDesc d; d.src = F.w_in; d.ld = DIN; d.k0 = kt * 128; d.n0 = nt * 64; d.dst = F.ws + WS_WIN8; d.drow0 = nt * 64;
                    f32x4 v[8]; conv8_load(d, v); conv8_lds_write(v, F.lds); __syncthreads(); conv8_store(d, F.lds); __syncthreads(); } } }
        else { const int it = item - 544, nt = it & 15, kt = it >> 4;
            if (OUTPROJ_FP8) { if (nt & 1) continue;
                ConvDesc d; d.src = F.w_out; d.ld = D; d.k0 = kt * 128; d.n0 = nt * 64; d.dst = (unsigned char*)F.WoutT; d.drow0 = nt * 64;
                f32x4 v[8]; conv8_load(d, v); conv8_lds_write(v, F.lds); __syncthreads(); conv8_store(d, F.lds); __syncthreads(); }
            else conv_tile(F.w_out, D, kt * 128, nt * 64, F.WoutT, nt * 64, F.lds); }
    }
}

__device__ __forceinline__ void phase1(const Frame& F, bool wait_mod) {
    if (wait_mod) {
        if (threadIdx.x == 0) { unsigned sp = 0; while (__hip_atomic_load(F.ctl + CW_MODRDY, __ATOMIC_RELAXED, __HIP_MEMORY_SCOPE_AGENT) < 96u) { __builtin_amdgcn_s_sleep(2); if (++sp > (1u << 22)) break; }
            __builtin_amdgcn_fence(__ATOMIC_ACQUIRE, "agent"); asm volatile("s_waitcnt vmcnt(0)" ::: "memory"); }
        __syncthreads();
    }
    const int lane = threadIdx.x & 63, wv = threadIdx.x >> 6;
    const int nw = gridDim.x * 8, per = (NROW + nw - 1) / nw, r0 = (blockIdx.x * 8 + wv) * per, r1 = (r0 + per < NROW) ? r0 + per : NROW;
    int curb = -1; f32x4 ca[4], cs[4];
    for (int rb = r0; rb < r1; rb += 3) {
        f32x4 v[3][4];
#pragma unroll
        for (int u = 0; u < 3; ++u) {
            const int r = (rb + u < r1) ? rb + u : r1 - 1;
            const float* src = (r < NTOK) ? F.x + (size_t)r * D : F.ctx + (size_t)(r - NTOK) * D;
#pragma unroll
            for (int j = 0; j < 4; ++j) v[u][j] = *(const f32x4*)(src + 4 * lane + 256 * j);
        }
#pragma unroll
        for (int u = 0; u < 3; ++u) {
            const int r = rb + u; if (r >= r1) break;
            const int bsel = (r < NTOK) ? (r >> 11) : 8;
            if (bsel != curb) { curb = bsel; const float* md = F.mod + (size_t)bsel * 6144;
#pragma unroll
                for (int j = 0; j < 4; ++j) { const int c = 4 * lane + 256 * j; const f32x4 nwv = *(const f32x4*)(F.norm1 + c), sc = *(const f32x4*)(md + 1024 + c); ca[j] = nwv * (1.0f + sc); cs[j] = *(const f32x4*)(md + c); } }
            float ss = 0.f;
#pragma unroll
            for (int j = 0; j < 4; ++j) ss += (v[u][j][0] * v[u][j][0] + v[u][j][1] * v[u][j][1]) + (v[u][j][2] * v[u][j][2] + v[u][j][3] * v[u][j][3]);
            ss = wave_sum(ss);
            const float rstd = __builtin_amdgcn_rsqf(ss * (1.0f / 1024.0f) + EPS);
#pragma unroll
            for (int j = 0; j < 4; ++j) {
                const int c = 4 * lane + 256 * j;
                const f32x4 o = v[u][j] * rstd * ca[j] + cs[j];
                if (INPROJ_FP8) *(unsigned*)((unsigned char*)F.H + (size_t)r * D + c) = pack_fp8x4(o[0], o[1], o[2], o[3]);
                else { u32x2 w; w.x = cvt_pk_bf16(o[0], o[1]); w.y = cvt_pk_bf16(o[2], o[3]); *(u32x2*)(F.H + (size_t)r * D + c) = w; }
                if (INPROJ_MIX) *(unsigned*)(F.ws + WS_H8 + (size_t)r * D + c) = pack_fp8x4(o[0], o[1], o[2], o[3]);
            }
        }
    }
}

__device__ __forceinline__ void phase4_rows(const Frame& F, int t0, int t1, int tstep) {
    const int lane = threadIdx.x & 63, wv = threadIdx.x >> 6;
#pragma unroll 2
    for (int t = t0 + wv; t < t1; t += tstep) {
        const size_t o = (size_t)t * GW + 8 * lane;
        const u32x4 fa = *(const u32x4*)(F.OF + o), fb = *(const u32x4*)(F.OB + o);
        const f32x4 s0 = (f32x4){bflo(fa.x) + bflo(fb.x), bfhi(fa.x) + bfhi(fb.x), bflo(fa.y) + bflo(fb.y), bfhi(fa.y) + bfhi(fb.y)};
        const f32x4 s1 = (f32x4){bflo(fa.z) + bflo(fb.z), bfhi(fa.z) + bfhi(fb.z), bflo(fa.w) + bflo(fb.w), bfhi(fa.w) + bfhi(fb.w)};
        float ss = (s0[0] * s0[0] + s0[1] * s0[1]) + (s0[2] * s0[2] + s0[3] * s0[3]) + (s1[0] * s1[0] + s1[1] * s1[1]) + (s1[2] * s1[2] + s1[3] * s1[3]);
        ss += __shfl_xor(ss, 1); ss += __shfl_xor(ss, 2); ss += __shfl_xor(ss, 4); ss += __shfl_xor(ss, 8);
        const float rstd = __builtin_amdgcn_rsqf(ss * (1.0f / 128.0f) + EPS);
        const f32x4 n0 = *(const f32x4*)(F.hgrn_norm + 8 * lane), n1 = *(const f32x4*)(F.hgrn_norm + 8 * lane + 4);
        const u32x4 g = *(const u32x4*)(F.GS + o);
        u32x4 w;
        float gg[8] = {bflo(g.x), bfhi(g.x), bflo(g.y), bfhi(g.y), bflo(g.z), bfhi(g.z), bflo(g.w), bfhi(g.w)};
#pragma unroll
        for (int i = 0; i < 8; ++i) gg[i] = gg[i] * sigmoidf_(gg[i]);
        w.x = cvt_pk_bf16(s0[0] * rstd * n0[0] * gg[0], s0[1] * rstd * n0[1] * gg[1]);
        w.y = cvt_pk_bf16(s0[2] * rstd * n0[2] * gg[2], s0[3] * rstd * n0[3] * gg[3]);
        w.z = cvt_pk_bf16(s1[0] * rstd * n1[0] * gg[4], s1[1] * rstd * n1[1] * gg[5]);
        w.w = cvt_pk_bf16(s1[2] * rstd * n1[2] * gg[6], s1[3] * rstd * n1[3] * gg[7]);
        if (OUTPROJ_FP8) { u32x2 w8; w8.x = pack_fp8x4(bflo(w.x), bfhi(w.x), bflo(w.y), bfhi(w.y)); w8.y = pack_fp8x4(bflo(w.z), bfhi(w.z), bflo(w.w), bfhi(w.w)); *(u32x2*)((unsigned char*)F.YCAT + (size_t)t * D + GW + 8 * lane) = w8; }
        else *(u32x4*)(F.YCAT + (size_t)t * D + GW + 8 * lane) = w;
    }
}

__device__ __forceinline__ void phase4(const Frame& F) { phase4_rows(F, blockIdx.x * 8, NTOK, gridDim.x * 8); }

__device__ __forceinline__ void phase6(const Frame& F) {
    LAS unsigned char* WH = F.lds;
    LAS unsigned char* WL = F.lds + 65536;
    LAS float* LG = (LAS float*)(F.lds + 131072);
    LAS float* RSTD = LG + 64 * 32;
    LAS float* B2 = RSTD + 64;
    LAS float* B2P = B2 + 32;
    LAS int* lcnt = (LAS int*)(B2P + 512);
    LAS int* lbase = lcnt + 32;
    LAS int* sel = lbase + 32;
    LAS float* selw = (LAS float*)(sel + 256);
    const int tid = threadIdx.x, lane = tid & 63, wv = __builtin_amdgcn_readfirstlane(tid >> 6), fr = lane & 15, fq = lane >> 4;
    if (tid < 32) lcnt[tid] = 0;
    int cur_b = -1;
    for (int rep6 = 0; rep6 < (DBG_REP6 ? 2 : 1); ++rep6)
    for (int grp = blockIdx.x; grp < NTOK / 64; grp += gridDim.x) {
        const int b = (grp * 64) >> 11;
        const float* md = F.mod + (size_t)b * 6144;
        if (b != cur_b) {
            cur_b = b;
            __syncthreads();
            const int e = tid & 31;
            float bp = 0.f;
#pragma unroll 4
            for (int it = 0; it < 8; ++it) {
                const int c0 = ((tid >> 5) + 16 * it) * 8;
                const f32x4 n0 = *(const f32x4*)(F.norm2 + c0), n1 = *(const f32x4*)(F.norm2 + c0 + 4), s0 = *(const f32x4*)(md + 4096 + c0), s1 = *(const f32x4*)(md + 4096 + c0 + 4);
                const f32x4 h0 = *(const f32x4*)(md + 3072 + c0), h1 = *(const f32x4*)(md + 3072 + c0 + 4);
                float wa[8], lo[8];
#pragma unroll
                for (int j = 0; j < 8; ++j) { const float rw = F.router_w[(size_t)(c0 + j) * NE + e]; const float a = (j < 4 ? n0[j] * (1.0f + s0[j]) : n1[j - 4] * (1.0f + s1[j - 4])); wa[j] = rw * a; bp += rw * (j < 4 ? h0[j] : h1[j - 4]); }
                u32x4 hw; hw.x = cvt_pk_bf16(wa[0], wa[1]); hw.y = cvt_pk_bf16(wa[2], wa[3]); hw.z = cvt_pk_bf16(wa[4], wa[5]); hw.w = cvt_pk_bf16(wa[6], wa[7]);
                lo[0] = wa[0] - bflo(hw.x); lo[1] = wa[1] - bfhi(hw.x); lo[2] = wa[2] - bflo(hw.y); lo[3] = wa[3] - bfhi(hw.y); lo[4] = wa[4] - bflo(hw.z); lo[5] = wa[5] - bfhi(hw.z); lo[6] = wa[6] - bflo(hw.w); lo[7] = wa[7] - bfhi(hw.w);
                u32x4 lw; lw.x = cvt_pk_bf16(lo[0], lo[1]); lw.y = cvt_pk_bf16(lo[2], lo[3]); lw.z = cvt_pk_bf16(lo[4], lo[5]); lw.w = cvt_pk_bf16(lo[6], lo[7]);
                const int off = e * 2048 + (((c0 >> 3) ^ (e & 15)) << 4);
                *(LAS u32x4*)(WH + off) = hw; *(LAS u32x4*)(WL + off) = lw;
            }
            B2P[(tid >> 5) * 32 + e] = bp;
            __syncthreads();
            if (tid < 32) { float sb = F.router_b[tid];
#pragma unroll
                for (int k = 0; k < 16; ++k) sb += B2P[k * 32 + tid];
                B2[tid] = sb; }
        }
        f32x4 ca[4], cs[4];
#pragma unroll
        for (int j = 0; j < 4; ++j) { const int c = 4 * lane + 256 * j; const f32x4 nw = *(const f32x4*)(F.norm2 + c), sc = *(const f32x4*)(md + 4096 + c); ca[j] = nw * (1.0f + sc); cs[j] = *(const f32x4*)(md + 3072 + c); }
#pragma unroll 2
        for (int i = 0; i < 8; ++i) {
            const int tl = wv * 8 + i, t = grp * 64 + tl;
            float ss = (lane < 16) ? F.SS[(size_t)t * 16 + lane] : 0.f;
            u32x2 xw[4];
#pragma unroll
            for (int j = 0; j < 4; ++j) xw[j] = *(const u32x2*)(F.X1 + (size_t)t * D + 4 * lane + 256 * j);
            ss = wave_sum(ss);
            const float rstd = __builtin_amdgcn_rsqf(ss * (1.0f / 1024.0f) + EPS);
            if (lane == 0) RSTD[tl] = rstd;
#pragma unroll
            for (int j = 0; j < 4; ++j) {
                const f32x4 xv = (f32x4){bflo(xw[j].x), bfhi(xw[j].x), bflo(xw[j].y), bfhi(xw[j].y)};
                const f32x4 hv = xv * rstd * ca[j] + cs[j];
                *(unsigned*)(F.H2 + (size_t)t * D + 4 * lane + 256 * j) = pack_fp8x4(hv[0], hv[1], hv[2], hv[3]);
            }
        }
        {
            const int mt = wv & 3, nt = wv >> 2;
            const bf16_t* xa = F.X1 + (size_t)(grp * 64 + 16 * mt + fr) * D + 8 * fq;
            const int erow = 16 * nt + fr;
            f32x4 acc = (f32x4){0.f, 0.f, 0.f, 0.f};
            u32x4 af[8], an[8];
#pragma unroll
            for (int k = 0; k < 8; ++k) af[k] = *(const u32x4*)(xa + 32 * k);
#pragma unroll
            for (int kb = 0; kb < 4; ++kb) {
                if (kb < 3) {
#pragma unroll
                    for (int k = 0; k < 8; ++k) an[k] = *(const u32x4*)(xa + 32 * (8 * (kb + 1) + k));
                }
#pragma unroll
                for (int k = 0; k < 8; ++k) {
                    const int ks = 8 * kb + k;
                    const int off = erow * 2048 + ((((32 * ks) >> 3) + fq) ^ (erow & 15)) * 16;
                    const bf16x8 bh = *(const LAS bf16x8*)(WH + off), bl = *(const LAS bf16x8*)(WL + off);
                    acc = __builtin_amdgcn_mfma_f32_16x16x32_bf16(__builtin_bit_cast(bf16x8, af[k]), bh, acc, 0, 0, 0);
                    acc = __builtin_amdgcn_mfma_f32_16x16x32_bf16(__builtin_bit_cast(bf16x8, af[k]), bl, acc, 0, 0, 0);
                }
                if (kb < 3) {
#pragma unroll
                    for (int k = 0; k < 8; ++k) af[k] = an[k];
                }
            }
            __syncthreads();
            const float b2 = B2[erow];
#pragma unroll
            for (int r = 0; r < 4; ++r) { const int tl = 16 * mt + 4 * fq + r; LG[tl * 32 + erow] = RSTD[tl] * acc[r] + b2; }
        }
        __syncthreads();
        for (int i = 0; i < 8; ++i) {
            const int tl = wv * 8 + i;
            const int myexp = (lane >> 1) & 31;
            const float v = LG[tl * 32 + myexp];
            int rank = 0;
#pragma unroll
            for (int e = 0; e < NE; ++e) { const float o = __builtin_bit_cast(float, __builtin_amdgcn_readlane(__builtin_bit_cast(int, v), 2 * e)); rank += (o > v || (o == v && e < myexp)) ? 1 : 0; }
            const bool even = (lane & 1) == 0;
            float tv[4]; int te[4];
#pragma unroll
            for (int k = 0; k < 4; ++k) { const unsigned long long bal = __ballot(even && rank == k); const int src = (__ffsll((long long)bal) - 1) & 63; tv[k] = __shfl(v, src); te[k] = src >> 1; }
            const float e1 = __expf(tv[1] - tv[0]), e2 = __expf(tv[2] - tv[0]), e3 = __expf(tv[3] - tv[0]);
            const float inv = 1.0f / (1.0f + e1 + e2 + e3);
            if (lane < 4 && rep6 == 0) {
                const int e = (lane == 0) ? te[0] : (lane == 1) ? te[1] : (lane == 2) ? te[2] : te[3];
                const float wgt = ((lane == 0) ? 1.0f : (lane == 1) ? e1 : (lane == 2) ? e2 : e3) * inv;
                const int rk = __hip_atomic_fetch_add(lcnt + e, 1, __ATOMIC_RELAXED, __HIP_MEMORY_SCOPE_WORKGROUP);
                sel[tl * 4 + lane] = e | (rk << 8); selw[tl * 4 + lane] = wgt;
            }
        }
        __syncthreads();
        if (tid < 32 && rep6 == 0) { const int n = lcnt[tid]; lbase[tid] = n ? (int)__hip_atomic_fetch_add(F.ctl + CW_CNT + 64 * tid, (unsigned)n, __ATOMIC_RELAXED, __HIP_MEMORY_SCOPE_AGENT) : 0; lcnt[tid] = 0; }
        __syncthreads();
        if (tid < 256 && rep6 == 0) {
            const int sv = sel[tid], e = sv & 255, idx = lbase[e] + (sv >> 8), t = grp * 64 + (tid >> 2);
            F.LIST[e * NTOK + idx] = t; F.TSLOT[t * 4 + (tid & 3)] = e * NTOK + idx; F.TW[t * 4 + (tid & 3)] = selw[tid];
        }
        __syncthreads();
    }
}

__device__ __forceinline__ void phase9(const Frame& F) {
    moe_tables(F);
    const MoeTab T = moe_tab(F.lds);
    const int lane = threadIdx.x & 63, wv = threadIdx.x >> 6;
    for (int tb = (blockIdx.x * 8 + wv) * 8; tb < NTOK; tb += gridDim.x * 64) {
        const float* g2 = F.mod + (size_t)(tb >> 11) * 6144 + 5120;
        const int slw = (lane < 32) ? F.TSLOT[tb * 4 + lane] : 0; const float wkw = (lane < 32) ? F.TW[tb * 4 + lane] : 0.f;
        int rowv = 0; { const int e = slw >> 14, idx = slw & (NTOK - 1); rowv = (lane < 32) ? (T.tstart[e & 31] * 256 + idx) : 0; }
        f32x4 ga[2], gb[2], fa[2], fb[2];
#pragma unroll
        for (int j = 0; j < 2; ++j) { const int c = 8 * lane + 512 * j; ga[j] = *(const f32x4*)(g2 + c); gb[j] = *(const f32x4*)(g2 + c + 4); fa[j] = *(const f32x4*)(F.final_norm + c); fb[j] = *(const f32x4*)(F.final_norm + c + 4); }
#pragma unroll 1
        for (int i2 = 0; i2 < 8; i2 += 2) {
            u32x2 d[2][4][2]; u32x4 xw[2][2]; float wq[2][4];
#pragma unroll
            for (int u = 0; u < 2; ++u) {
                const int t = tb + i2 + u;
#pragma unroll
                for (int k = 0; k < 4; ++k) {
                    const int row = __shfl(rowv, 4 * (i2 + u) + k);
                    wq[u][k] = 0.25f * __shfl(wkw, 4 * (i2 + u) + k);
#pragma unroll
                    for (int j = 0; j < 2; ++j) d[u][k][j] = *(const u32x2*)(F.DOUT + (size_t)row * D + 8 * lane + 512 * j);
                }
#pragma unroll
                for (int j = 0; j < 2; ++j) xw[u][j] = *(const u32x4*)(F.X1 + (size_t)t * D + 8 * lane + 512 * j);
            }
#pragma unroll
            for (int u = 0; u < 2; ++u) {
                const int t = tb + i2 + u;
                float xf[2][8]; float ss = 0.f;
#pragma unroll
                for (int j = 0; j < 2; ++j) {
                    float y[8];
#pragma unroll
                    for (int i = 0; i < 8; ++i) y[i] = 0.f;
#pragma unroll
                    for (int k = 0; k < (DBG_NO_MOE ? 0 : 4); ++k) {
                        const f32x2 p0 = __builtin_amdgcn_cvt_pk_f32_fp8((int)d[u][k][j].x, false), p1 = __builtin_amdgcn_cvt_pk_f32_fp8((int)d[u][k][j].x, true), p2 = __builtin_amdgcn_cvt_pk_f32_fp8((int)d[u][k][j].y, false), p3 = __builtin_amdgcn_cvt_pk_f32_fp8((int)d[u][k][j].y, true);
                        const float w = wq[u][k];
                        y[0] += w * p0[0]; y[1] += w * p0[1]; y[2] += w * p1[0]; y[3] += w * p1[1]; y[4] += w * p2[0]; y[5] += w * p2[1]; y[6] += w * p3[0]; y[7] += w * p3[1];
                    }
                    const f32x4 x0 = (f32x4){bflo(xw[u][j].x), bfhi(xw[u][j].x), bflo(xw[u][j].y), bfhi(xw[u][j].y)}, x1v = (f32x4){bflo(xw[u][j].z), bfhi(xw[u][j].z), bflo(xw[u][j].w), bfhi(xw[u][j].w)};
#pragma unroll
                    for (int i = 0; i < 4; ++i) { xf[j][i] = x0[i] + ga[j][i] * y[i]; xf[j][4 + i] = x1v[i] + gb[j][i] * y[4 + i]; }
#pragma unroll
                    for (int i = 0; i < 8; ++i) ss += xf[j][i] * xf[j][i];
                }
                ss = wave_sum(ss);
                const float rstd = __builtin_amdgcn_rsqf(ss * (1.0f / 1024.0f) + EPS);
#pragma unroll
                for (int j = 0; j < 2; ++j) {
                    const int c = 8 * lane + 512 * j;
                    f32x4 o0, o1;
#pragma unroll
                    for (int i = 0; i < 4; ++i) { o0[i] = xf[j][i] * rstd * fa[j][i]; o1[i] = xf[j][4 + i] * rstd * fb[j][i]; }
                    *(f32x4*)(F.out + (size_t)t * D + c) = o0; *(f32x4*)(F.out + (size_t)t * D + c + 4) = o1;
                }
            }
        }
    }
}

template <bool PIPE> __device__ __forceinline__ void sgu_item(const Frame& F, int item, ConvPipe* cp) {
    constexpr int RS = 272;
    LAS unsigned char* WL = F.lds;
    LAS unsigned char* VT = F.lds + 128 * RS;
    const int tid = threadIdx.x, lane = tid & 63, wv = __builtin_amdgcn_readfirstlane(tid >> 6), fr = lane & 15, fq = lane >> 4;
    const int h = item & 3, n = (item >> 2) & 15, b = item >> 6;
    const int row0 = b * SEQ + n * 128;
    u32x2 uu[8];
    { const size_t row = (size_t)(row0 + 16 * wv + fr);
#pragma unroll
      for (int nt = 0; nt < 8; ++nt) uu[nt] = *(const u32x2*)(F.U + row * GW + h * 128 + 16 * nt + 4 * fq); }
    if (PIPE) cp->template step<0>(F);
    {
        const int t = tid >> 2, s0 = (tid & 3) * 32;
        const float* wp = F.sgu_w + ((size_t)h * 128 + t) * 128 + s0;
#pragma unroll
        for (int j = 0; j < 4; ++j) {
            const f32x4 a = *(const f32x4*)(wp + 8 * j), c = *(const f32x4*)(wp + 8 * j + 4);
            u32x4 w; w.x = cvt_pk_bf16(a[0], a[1]); w.y = cvt_pk_bf16(a[2], a[3]); w.z = cvt_pk_bf16(c[0], c[1]); w.w = cvt_pk_bf16(c[2], c[3]);
            *(LAS u32x4*)(WL + t * RS + (s0 + 8 * j) * 2) = w;
        }
    }
    if (PIPE) cp->template step<1>(F);
    {
        const int s = tid >> 2, d0 = (tid & 3) * 32;
        const bf16_t* vp = F.VG + (size_t)(row0 + s) * GW + h * 128 + d0;
        float v[32];
#pragma unroll
        for (int j = 0; j < 4; ++j) { const u32x4 w = *(const u32x4*)(vp + 8 * j);
            v[8 * j + 0] = bflo(w.x); v[8 * j + 1] = bfhi(w.x); v[8 * j + 2] = bflo(w.y); v[8 * j + 3] = bfhi(w.y); v[8 * j + 4] = bflo(w.z); v[8 * j + 5] = bfhi(w.z); v[8 * j + 6] = bflo(w.w); v[8 * j + 7] = bfhi(w.w); }
#pragma unroll
        for (int i = 0; i < 32; ++i) v[i] = gelu_tanh(v[i]);
        float sm = 0.f;
#pragma unroll
        for (int i = 0; i < 32; ++i) sm += v[i];
        sm += __shfl_xor(sm, 1); sm += __shfl_xor(sm, 2);
        const float mu = sm * (1.0f / 128.0f); float q = 0.f;
#pragma unroll
        for (int i = 0; i < 32; ++i) { const float dd = v[i] - mu; q += dd * dd; }
        q += __shfl_xor(q, 1); q += __shfl_xor(q, 2);
        const float rstd = __builtin_amdgcn_rsqf(q * (1.0f / 128.0f) + EPS);
        const float* lg = F.sgu_ln + h * 128 + d0;
#pragma unroll
        for (int i = 0; i < 32; i += 2) {
            const unsigned pk = cvt_pk_bf16((v[i] - mu) * rstd * lg[i], (v[i + 1] - mu) * rstd * lg[i + 1]);
            *(LAS unsigned short*)(VT + (d0 + i) * RS + s * 2) = (unsigned short)(pk & 0xffffu);
            *(LAS unsigned short*)(VT + (d0 + i + 1) * RS + s * 2) = (unsigned short)(pk >> 16);
        }
    }
    if (PIPE) cp->template step<2>(F);
    __syncthreads();
    if (PIPE) cp->template step<0>(F);
    f32x4 acc[8];
#pragma unroll
    for (int nt = 0; nt < 8; ++nt) acc[nt] = (f32x4){0.f, 0.f, 0.f, 0.f};
#pragma unroll
    for (int a = 0; a < 4; ++a) {
        const bf16x8 wf = *(const LAS bf16x8*)(WL + (16 * wv + fr) * RS + (32 * a + 8 * fq) * 2);
#pragma unroll
        for (int nt = 0; nt < 8; ++nt) {
            const bf16x8 vf = *(const LAS bf16x8*)(VT + (16 * nt + fr) * RS + (32 * a + 8 * fq) * 2);
            acc[nt] = __builtin_amdgcn_mfma_f32_16x16x32_bf16(vf, wf, acc[nt], 0, 0, 0);
        }
    }
    if (PIPE) cp->template step<1>(F);
    {
        const int t = 16 * wv + fr; const size_t row = (size_t)(row0 + t);
        const float bias = F.sgu_b[h * 128 + t];
#pragma unroll
        for (int nt = 0; nt < 8; ++nt) {
            const int d = h * 128 + 16 * nt + 4 * fq;
            u32x2 w; w.x = cvt_pk_bf16(gelu_tanh(bflo(uu[nt].x)) * (acc[nt][0] + bias), gelu_tanh(bfhi(uu[nt].x)) * (acc[nt][1] + bias)); w.y = cvt_pk_bf16(gelu_tanh(bflo(uu[nt].y)) * (acc[nt][2] + bias), gelu_tanh(bfhi(uu[nt].y)) * (acc[nt][3] + bias));
            if (OUTPROJ_FP8) *(unsigned*)((unsigned char*)F.YCAT + row * D + d) = pack_fp8x4(bflo(w.x), bfhi(w.x), bflo(w.y), bfhi(w.y));
            else *(u32x2*)(F.YCAT + row * D + d) = w;
        }
    }
    if (PIPE) cp->template step<2>(F);
    __syncthreads();
}

__device__ __forceinline__ float hexp(float x) { return __builtin_amdgcn_exp2f(__builtin_amdgcn_fmed3f(x, -125.0f, 86.0f)); }
__device__ __forceinline__ float ex2n(float x) { return __builtin_amdgcn_exp2f(x); }
__device__ __forceinline__ float ex2p(float x) { return __builtin_amdgcn_exp2f(fminf(x, 86.0f)); }
namespace hg {
constexpr int RS = 256, OFF_QP = 0, OFF_QX = 8192, OFF_KX = 16384,
              KDS = 96, OFF_KDT = 24576, OFF_D = OFF_KDT + 128 * KDS, BUF = OFF_D + 512;
constexpr int RRS = 272;
constexpr int RAW_OFF = 2 * BUF, RAWBUF = 2 * 32 * RRS;
__device__ __forceinline__ int swz(int row, int byteoff) { return row * RS + (byteoff ^ ((row & 15) << 4)); }
struct QK { u32x2 kk[2], q[2]; };
struct GV { u32x4 g, v; };
struct Ctx {
    LAS unsigned char* lds; const bf16_t *Gp, *Kp, *Ip, *Qp; bf16_t* Op;
    int b, dir, sgn, colw, h, w, fr, fq, tid, slot0, cend, nrev;
    bf16_t* qcum;
    bf16x8 tri0, tri1;
};
__device__ __forceinline__ int base_row(const Ctx& X, int c) {
    c = c < X.nrev ? X.nrev - 1 - c : c;
    return c < 8 ? (NTOK + X.b * CTXL + (X.dir ? (CTXL - 1 - 32 * c) : 32 * c)) : (X.b * SEQ + (X.dir ? (SEQ - 1 - 32 * (c - 8)) : 32 * (c - 8)));
}
template <bool ALLLAT, bool NOQ = false> __device__ __forceinline__ void load_qk(const Ctx& X, int c, QK& r) {
    const int base = base_row(X, c);
#pragma unroll
    for (int j = 0; j < 2; ++j) {
        const int row = base + X.sgn * (X.fr + 16 * j);
        const unsigned o = (unsigned)(row * GW + X.colw + 4 * X.fq) * 2u;
        r.kk[j] = *(const u32x2*)((const char*)X.Kp + o);
        if (NOQ) r.q[j] = (u32x2){0u, 0u};
        else if (ALLLAT) r.q[j] = *(const u32x2*)((const char*)X.Qp + o);
        else { const unsigned oq = (unsigned)((row < NTOK ? row : row - NTOK) * GW + X.colw + 4 * X.fq) * 2u; r.q[j] = *(const u32x2*)((const char*)X.Qp + oq); }
    }
}
__device__ __forceinline__ void load_gv(const Ctx& X, int c, GV& r) {
    const int base = base_row(X, c);
    const unsigned o = (unsigned)((base + X.sgn * (X.tid >> 4)) * GW + X.h * 128 + 8 * (X.tid & 15)) * 2u;
    r.g = *(const u32x4*)((const char*)X.Gp + o); r.v = *(const u32x4*)((const char*)X.Ip + o);
}
__device__ __forceinline__ void raw_write(const Ctx& X, int c, const GV& r) {
    LAS unsigned char* rb = X.lds + RAW_OFF + (c & 1) * RAWBUF + (X.tid >> 4) * RRS + (X.tid & 15) * 16;
    *(LAS u32x4*)(rb) = r.g; *(LAS u32x4*)(rb + 32 * RRS) = r.v;
}
template <bool LAT, bool CUM> __device__ __forceinline__ bf16x8 stage(const Ctx& X, int c, const QK& qk, f32x4& Bsum) {
    LAS unsigned char* buf = X.lds + (c & 1) * BUF;
    const LAS unsigned char* rg = X.lds + RAW_OFF + (c & 1) * RAWBUF + (16 * X.w + X.fr) * 2;
    const int fr = X.fr, fq = X.fq, w = X.w;
    constexpr bool lat = LAT;
    typedef short v4s __attribute__((ext_vector_type(4)));
    const LAS unsigned char* rt = X.lds + RAW_OFF + (c & 1) * RAWBUF + (4 * fq + (fr >> 2)) * RRS + (16 * w + 4 * (fr & 3)) * 2;
    const v4s g0 = __builtin_amdgcn_ds_read_tr16_b64_v4i16((LAS v4s*)rt), g1 = __builtin_amdgcn_ds_read_tr16_b64_v4i16((LAS v4s*)(rt + 16 * RRS));
    const v4s v0 = __builtin_amdgcn_ds_read_tr16_b64_v4i16((LAS v4s*)(rt + 32 * RRS)), v1 = __builtin_amdgcn_ds_read_tr16_b64_v4i16((LAS v4s*)(rt + 48 * RRS));
    const bf16x8 gT = (bf16x8){g0.x, g0.y, g0.z, g0.w, g1.x, g1.y, g1.z, g1.w}, VTf = (bf16x8){v0.x, v0.y, v0.z, v0.w, v1.x, v1.y, v1.z, v1.w};
    const f32x4 z4 = (f32x4){0.f, 0.f, 0.f, 0.f};
    f32x4 bT[2];
    bT[0] = __builtin_amdgcn_mfma_f32_16x16x32_bf16(gT, X.tri0, z4, 0, 0, 0);
    bT[1] = __builtin_amdgcn_mfma_f32_16x16x32_bf16(gT, X.tri1, z4, 0, 0, 0);
    f32x4 b15, b31;
#pragma unroll
    for (int r = 0; r < 4; ++r) { b15[r] = __shfl(bT[0][r], 16 * fq + 15); b31[r] = __shfl(bT[1][r], 16 * fq + 15); }
    f32x4 E15, E3115;
#pragma unroll
    for (int r = 0; r < 4; ++r) { E15[r] = ex2n(b15[r]); E3115[r] = ex2n(b31[r] - b15[r]); }
    const f32x4 bb = b31 + Bsum;
#pragma unroll
    for (int j = 0; j < 2; ++j) {
        const float kv[4] = {bflo(qk.kk[j].x), bfhi(qk.kk[j].x), bflo(qk.kk[j].y), bfhi(qk.kk[j].y)};
        const float qv[4] = {bflo(qk.q[j].x), bfhi(qk.q[j].x), bflo(qk.q[j].y), bfhi(qk.q[j].y)};
        float kd[4], qp[4], qx[4], kx[4];
#pragma unroll
        for (int r = 0; r < 4; ++r) {
            const float bt = bT[j][r];
            if (lat) {
                const float dd = bt - b15[r];
                if (j == 0) { qx[r] = qv[r] * __builtin_amdgcn_exp2f(fminf(dd, 86.0f)); kx[r] = kv[r] * __builtin_amdgcn_exp2f(-dd); }
                else { qx[r] = qv[r] * __builtin_amdgcn_exp2f(dd); kx[r] = kv[r] * __builtin_amdgcn_exp2f(-fmaxf(dd, -86.0f)); }
                qp[r] = qx[r] * E15[r]; kd[r] = kx[r] * E3115[r]; }
            else { kd[r] = kv[r] * ex2n(bb[r] - bt); qx[r] = kx[r] = qp[r] = 0.f; }
        }
        const int trow = fr + 16 * j;
        const unsigned kd01 = cvt_pk_bf16(kd[0], kd[1]), kd23 = cvt_pk_bf16(kd[2], kd[3]);
        LAS unsigned char* kdp = buf + OFF_KDT + (16 * w + 4 * fq) * KDS + (X.slot0 + 4 * j) * 2;
        *(LAS unsigned short*)(kdp) = (unsigned short)(kd01 & 0xffffu); *(LAS unsigned short*)(kdp + KDS) = (unsigned short)(kd01 >> 16);
        *(LAS unsigned short*)(kdp + 2 * KDS) = (unsigned short)(kd23 & 0xffffu); *(LAS unsigned short*)(kdp + 3 * KDS) = (unsigned short)(kd23 >> 16);
        if (lat) {
            { u32x2 wv; wv.x = cvt_pk_bf16(kx[0], kx[1]); wv.y = cvt_pk_bf16(kx[2], kx[3]); *(LAS u32x2*)(buf + OFF_KX + swz(trow, (16 * w + 4 * fq) * 2)) = wv; }
            { u32x2 wv; wv.x = cvt_pk_bf16(qx[0], qx[1]); wv.y = cvt_pk_bf16(qx[2], qx[3]); *(LAS u32x2*)(buf + OFF_QX + swz(trow, (16 * w + 4 * fq) * 2)) = wv; }
            { u32x2 wv; wv.x = cvt_pk_bf16(qp[0], qp[1]); wv.y = cvt_pk_bf16(qp[2], qp[3]); *(LAS u32x2*)(buf + OFF_QP + swz(trow, (32 * (w >> 1) + 8 * fq + 4 * (w & 1)) * 2)) = wv; }
        }
    }
    if (lat) { if (fr == 0) { const f32x4 dv = E15 * E3115;
       *(LAS f32x4*)(buf + OFF_D + (16 * w + 4 * fq) * 4) = dv; } }
    else Bsum = bb;
    return VTf;
}
template <bool LAT> __device__ __forceinline__ void products(const Ctx& X, int c, const bf16x8 VTf, f32x4 (&S)[8]) {
    const LAS unsigned char* buf = X.lds + (c & 1) * BUF;
    const int fr = X.fr, fq = X.fq;
    const f32x4 z4 = (f32x4){0.f, 0.f, 0.f, 0.f};
    if (LAT) {
        f32x4 X00 = z4, X11 = z4, X01 = z4;
#pragma unroll
        for (int a = 0; a < 4; ++a) {
            const int c0 = swz(fr, (32 * a + 8 * fq) * 2), c1 = swz(16 + fr, (32 * a + 8 * fq) * 2);
            const bf16x8 k0 = *(const LAS bf16x8*)(buf + OFF_KX + c0), k1 = *(const LAS bf16x8*)(buf + OFF_KX + c1);
            const bf16x8 q0 = *(const LAS bf16x8*)(buf + OFF_QX + c0), q1 = *(const LAS bf16x8*)(buf + OFF_QX + c1);
            X00 = __builtin_amdgcn_mfma_f32_16x16x32_bf16(k0, q0, X00, 0, 0, 0);
            X11 = __builtin_amdgcn_mfma_f32_16x16x32_bf16(k1, q1, X11, 0, 0, 0);
            X01 = __builtin_amdgcn_mfma_f32_16x16x32_bf16(k0, q1, X01, 0, 0, 0);
        }
#pragma unroll
        for (int r = 0; r < 4; ++r) { const bool keep = (4 * fq + r) <= fr; X00[r] = keep ? X00[r] : 0.f; X11[r] = keep ? X11[r] : 0.f; }
        bf16x8 P0, P1;
        { u32x4 t; t.x = cvt_pk_bf16(X00[0], X00[1]); t.y = cvt_pk_bf16(X00[2], X00[3]); t.z = 0u; t.w = 0u; P0 = __builtin_bit_cast(bf16x8, t);
          u32x4 u; u.x = cvt_pk_bf16(X01[0], X01[1]); u.y = cvt_pk_bf16(X01[2], X01[3]); u.z = cvt_pk_bf16(X11[0], X11[1]); u.w = cvt_pk_bf16(X11[2], X11[3]); P1 = __builtin_bit_cast(bf16x8, u); }
        f32x4 o0 = __builtin_amdgcn_mfma_f32_16x16x32_bf16(VTf, P0, z4, 0, 0, 0);
        f32x4 o1 = __builtin_amdgcn_mfma_f32_16x16x32_bf16(VTf, P1, z4, 0, 0, 0);
#pragma unroll
        for (int a = 0; a < 4; ++a) {
            u32x4 t; t.x = cvt_pk_bf16(S[2 * a][0], S[2 * a][1]); t.y = cvt_pk_bf16(S[2 * a][2], S[2 * a][3]); t.z = cvt_pk_bf16(S[2 * a + 1][0], S[2 * a + 1][1]); t.w = cvt_pk_bf16(S[2 * a + 1][2], S[2 * a + 1][3]);
            const bf16x8 Sb = __builtin_bit_cast(bf16x8, t);
            const bf16x8 qp0 = *(const LAS bf16x8*)(buf + OFF_QP + swz(fr, (32 * a + 8 * fq) * 2)), qp1 = *(const LAS bf16x8*)(buf + OFF_QP + swz(16 + fr, (32 * a + 8 * fq) * 2));
            o0 = __builtin_amdgcn_mfma_f32_16x16x32_bf16(Sb, qp0, o0, 0, 0, 0);
            o1 = __builtin_amdgcn_mfma_f32_16x16x32_bf16(Sb, qp1, o1, 0, 0, 0);
        }
        const int base = base_row(X, c);
        { u32x2 w0, w1; w0.x = cvt_pk_bf16(o0[0], o0[1]); w0.y = cvt_pk_bf16(o0[2], o0[3]); w1.x = cvt_pk_bf16(o1[0], o1[1]); w1.y = cvt_pk_bf16(o1[2], o1[3]);
          *(u32x2*)((char*)X.Op + (unsigned)((base + X.sgn * fr) * GW + X.colw + 4 * fq) * 2u) = w0;
          *(u32x2*)((char*)X.Op + (unsigned)((base + X.sgn * (fr + 16)) * GW + X.colw + 4 * fq) * 2u) = w1; }
    }
#pragma unroll
    for (int kt = 0; kt < 8; ++kt) {
        const bf16x8 kdf = *(const LAS bf16x8*)(buf + OFF_KDT + (16 * kt + fr) * KDS + 16 * fq);
        if (LAT) { const f32x4 dv = *(const LAS f32x4*)(buf + OFF_D + (16 * kt + 4 * fq) * 4);
            S[kt] = __builtin_amdgcn_mfma_f32_16x16x32_bf16(kdf, VTf, S[kt] * dv, 0, 0, 0); }
        else S[kt] = __builtin_amdgcn_mfma_f32_16x16x32_bf16(kdf, VTf, S[kt], 0, 0, 0);
    }
}
__device__ __forceinline__ void lds_barrier() {
    asm volatile("s_waitcnt lgkmcnt(0)" ::: "memory"); __builtin_amdgcn_s_barrier(); asm volatile("" ::: "memory");
}
template <bool PL, bool SL, bool CUM> __device__ __forceinline__ void iter(const Ctx& X, int c, QK& qk, GV& gv, bf16x8& VTcur, f32x4 (&S)[8], f32x4& Bsum) {
    lds_barrier();
    products<PL>(X, c, VTcur, S);
    VTcur = stage<SL, CUM>(X, c + 1, qk, Bsum);
    load_qk<false, CUM>(X, c + 3 < X.cend ? c + 3 : X.cend - 1, qk);
    if (c + 2 < X.cend) raw_write(X, c + 2, gv);
    load_gv(X, c + 4 < X.cend ? c + 4 : X.cend - 1, gv);
}
}
#ifndef HG_SPLIT
#define HG_SPLIT 52
#endif
template <int half> __device__ __forceinline__ void hgrn_chain(const Frame& F, int chain) {
    using namespace hg;
    Ctx X;
    X.lds = F.lds; X.tid = threadIdx.x; const int lane = X.tid & 63; X.w = __builtin_amdgcn_readfirstlane(X.tid >> 6); X.fr = lane & 15; X.fq = lane >> 4;
    X.dir = chain & 1; X.h = (chain >> 1) & 3; X.b = chain >> 3; X.sgn = X.dir ? -1 : 1; X.colw = X.h * 128 + 16 * X.w;
    X.Gp = X.dir ? F.GB : F.GF; X.Kp = X.dir ? F.KB : F.KF; X.Ip = F.I; X.Qp = F.Q; X.Op = X.dir ? F.OB : F.OF;
    X.slot0 = 8 * (X.fr >> 2) + (X.fr & 3);
    X.qcum = nullptr;
    X.cend = half ? 72 : HG_SPLIT; X.nrev = half ? HG_SPLIT : 8;
#pragma unroll
    for (int jj = 0; jj < 8; ++jj) {
        X.tri0[jj] = (jj < 4 && 4 * X.fq + jj <= X.fr) ? (short)0x3F80 : (short)0;
        X.tri1[jj] = (jj < 4) ? (short)0x3F80 : ((4 * X.fq + jj - 4 <= X.fr) ? (short)0x3F80 : (short)0);
    }
    f32x4 S[8];
#pragma unroll
    for (int kt = 0; kt < 8; ++kt) S[kt] = (f32x4){0.f, 0.f, 0.f, 0.f};
    f32x4 Bsum = (f32x4){0.f, 0.f, 0.f, 0.f};
    QK qkA, qkB; GV gvA, gvB;
    load_gv(X, 0, gvA); load_gv(X, 1, gvB); load_qk<false, true>(X, 0, qkA); load_qk<false, true>(X, 1, qkB);
    raw_write(X, 0, gvA); load_gv(X, 2, gvA);
    lds_barrier();
    bf16x8 VTcur = stage<false, false>(X, 0, qkA, Bsum); load_qk<false, true>(X, 2, qkA);
    raw_write(X, 1, gvB); load_gv(X, 3, gvB);
    if constexpr (half == 0) {
        for (int c = 0; c < 4; c += 2) { iter<false, false, true>(X, c, qkB, gvA, VTcur, S, Bsum); iter<false, false, true>(X, c + 1, qkA, gvB, VTcur, S, Bsum); }
        iter<false, false, true>(X, 4, qkB, gvA, VTcur, S, Bsum); iter<false, false, false>(X, 5, qkA, gvB, VTcur, S, Bsum);
        iter<false, false, false>(X, 6, qkB, gvA, VTcur, S, Bsum); iter<false, true, false>(X, 7, qkA, gvB, VTcur, S, Bsum);
        for (int c = 8; c < HG_SPLIT - 2; c += 2) { iter<true, true, false>(X, c, qkB, gvA, VTcur, S, Bsum); iter<true, true, false>(X, c + 1, qkA, gvB, VTcur, S, Bsum); }
        iter<true, true, false>(X, HG_SPLIT - 2, qkB, gvA, VTcur, S, Bsum);
        lds_barrier();
        products<true>(X, HG_SPLIT - 1, VTcur, S);
    } else {
        for (int c = 0; c < HG_SPLIT - 4; c += 2) { iter<false, false, true>(X, c, qkB, gvA, VTcur, S, Bsum); iter<false, false, true>(X, c + 1, qkA, gvB, VTcur, S, Bsum); }
        iter<false, false, true>(X, HG_SPLIT - 4, qkB, gvA, VTcur, S, Bsum); iter<false, false, false>(X, HG_SPLIT - 3, qkA, gvB, VTcur, S, Bsum);
        iter<false, false, false>(X, HG_SPLIT - 2, qkB, gvA, VTcur, S, Bsum); iter<false, true, false>(X, HG_SPLIT - 1, qkA, gvB, VTcur, S, Bsum);
        for (int c = HG_SPLIT; c < 70; c += 2) { iter<true, true, false>(X, c, qkB, gvA, VTcur, S, Bsum); iter<true, true, false>(X, c + 1, qkA, gvB, VTcur, S, Bsum); }
        iter<true, true, false>(X, 70, qkB, gvA, VTcur, S, Bsum);
        lds_barrier();
        products<true>(X, 71, VTcur, S);
    }
    __syncthreads();
}

constexpr int CONV_P2_PER_WG = INPROJ_MIX ? 32 : 44, CONV_P2_EXTRA = INPROJ_MIX ? 0 : 16, CONV_P2_ITEMS = (INPROJ_MIX ? 28 : 20) * CONV_P2_PER_WG + CONV_P2_EXTRA;
constexpr int CONV_PER_WG = (CONV_ITEMS - CONV_P2_ITEMS) / 128;
#ifndef CONV_CHAIN_SHARE
#define CONV_CHAIN_SHARE 2
#endif
__device__ __forceinline__ void phase3(const Frame& F) {
    const int G = gridDim.x, bid = blockIdx.x;
    if (bid < 128) {
        if (bid & 1) hgrn_chain<1>(F, bid >> 1); else hgrn_chain<0>(F, bid >> 1);
        conv8_run(F, CONV_P2_ITEMS + bid + 128 * (CONV_PER_WG - CONV_CHAIN_SHARE), 128, CONV_CHAIN_SHARE);
    } else {
        const int j = bid - 128, nw = G - 128;
        if (j < 128) {
            ConvPipe cp; cp.start(F, F.lds + 73728, CONV_P2_ITEMS + j, 128, CONV_PER_WG - CONV_CHAIN_SHARE);
            for (int item = j; item < 512; item += nw) sgu_item<true>(F, item, &cp);
            cp.finish(F);
        } else for (int item = j; item < 512; item += nw) sgu_item<false>(F, item, nullptr);
    }
}

__device__ __forceinline__ void stagger_start(int slot, int us) {
    if (slot > 0 && us > 0) { const unsigned long long t0 = __builtin_amdgcn_s_memrealtime(); const unsigned long long dt = (unsigned long long)(slot * us) * 100ull;
        while (__builtin_amdgcn_s_memrealtime() - t0 < dt) __builtin_amdgcn_s_sleep(8); }
    __syncthreads();
}
constexpr int N_PHASES = 10;
#ifndef DBG_NO_MOE
#define DBG_NO_MOE 0
#endif
#ifndef DBG_MAX_PHASE
#define DBG_MAX_PHASE 9
#endif
__global__ void __launch_bounds__(NTHREADS, 2) fwd_kernel(Args a) {
    extern __shared__ __attribute__((aligned(16))) unsigned char lds_raw[];
    Frame F;
    F.x = a.in[0]; F.c = a.in[1]; F.ctx = a.in[2]; F.c_ctx = a.in[3]; F.w_mod = a.in[4]; F.b_mod = a.in[5]; F.norm1 = a.in[6]; F.w_in = a.in[7]; F.sgu_ln = a.in[8]; F.sgu_w = a.in[9];
    F.sgu_b = a.in[10]; F.lb_fwd = a.in[11]; F.lb_bwd = a.in[12]; F.hgrn_norm = a.in[13]; F.w_out = a.in[14]; F.norm2 = a.in[15]; F.router_w = a.in[16]; F.router_b = a.in[17];
    F.w1 = a.in[18]; F.b1 = a.in[19]; F.w2 = a.in[20]; F.b2 = a.in[21]; F.final_norm = a.in[22];
    F.out = a.out; F.ws = a.ws; unsigned char* ws = a.ws;
    F.ctl = (unsigned*)(ws + WS_CTL); F.mod = (float*)(ws + WS_MOD); F.LBT = (float*)(ws + WS_LBT);
    F.WinT = (bf16_t*)(ws + WS_WIN); F.WoutT = (bf16_t*)(ws + WS_WOUT); F.W1T = ws + WS_W1; F.W2T = ws + WS_W2;
    F.H = (bf16_t*)(ws + WS_H); F.U = (bf16_t*)(ws + WS_U); F.VG = (bf16_t*)(ws + WS_VG); F.Q = (bf16_t*)(ws + WS_Q); F.GS = (bf16_t*)(ws + WS_GS); F.I = (bf16_t*)(ws + WS_I);
    F.GF = (bf16_t*)(ws + WS_GF); F.KF = (bf16_t*)(ws + WS_KF); F.GB = (bf16_t*)(ws + WS_GB); F.KB = (bf16_t*)(ws + WS_KB);
    F.YCAT = (bf16_t*)(ws + WS_YCAT); F.H2 = ws + WS_H2; F.ACT = ws + WS_ACT; F.DOUT = ws + WS_DOUT;
    F.OF = (bf16_t*)(ws + WS_OF); F.OB = (bf16_t*)(ws + WS_OB); F.X1 = (bf16_t*)(ws + WS_X1); F.SS = (float*)(ws + WS_SS); F.TW = (float*)(ws + WS_TW);
    F.LIST = (int*)(ws + WS_LIST); F.TSLOT = (int*)(ws + WS_TSLOT); F.QCUM = (bf16_t*)(ws + WS_QCUM); F.SMID = ws + WS_SMID;
    F.lds = (LAS unsigned char*)lds_raw;
    if (threadIdx.x < 64) ((LAS unsigned*)(F.lds + LDS_MISC_OFF))[threadIdx.x] = 0u;
    __syncthreads();
    const int lo = a.ph_lo, hi = a.ph_hi, G = gridDim.x, cid = blockIdx.x;
    XcdBarrier bar; bar.bar = F.ctl + CW_BAR; bar.x = 0; bar.st = nullptr;
    if (hi - lo > 1) bar = xcd_barrier_post(F.ctl + CW_BAR, (volatile LAS unsigned*)(F.lds + LDS_MISC_OFF));
#define IN(k) (lo <= (k) && (k) < hi)
#define SEAM(k) do { if (IN(k) && IN((k) + 1)) xcd_barrier(bar); } while (0)
#define REP(k) for (int _r = 0; _r < (((DBG_REP >> (k)) & 1) ? 2 : 1); ++_r)
    if (IN(0)) REP(0) phase0(F);
    if (IN(1)) REP(1) phase1(F, IN(0));
    SEAM(1);
    for (int _b = 0; _b < DBG_BARX; ++_b) xcd_barrier(bar);
    if (IN(2)) REP(2) {
        if (INPROJ_MIX) {
            if (cid < INP_GG) {
                { LAS float* lt = (LAS float*)(F.lds + LDS_EXTRA_OFF); for (int i = threadIdx.x; i < 2 * GW; i += NTHREADS) lt[i] = F.LBT[i]; __syncthreads(); }
                EpiInProj E{F.U, F.VG, F.Q, F.GS, F.I, F.GF, F.KF, F.GB, F.KB, (const LAS float*)(F.lds + LDS_EXTRA_OFF)};
                { SchedInMix<false> S{(const unsigned char*)F.WinT, cid}; pg::gemm_phase<EpiInProj, SchedInMix<false>, false>(F.lds, (const char*)F.H, D, S, E); }
                { SchedInMix<true> S{F.ws + WS_WIN8, cid}; pg::gemm_phase<EpiInProj, SchedInMix<true>, true>(F.lds, (const char*)(F.ws + WS_H8), D, S, E); }
            } else if (cid < 256) conv8_run(F, cid - INP_GG, 256 - INP_GG, CONV_P2_PER_WG);
        } else {
        const int GG = (G >= 256) ? 236 : G;
        if (cid < GG) { stagger_start((cid >> 3) & 3, STAGGER_INP_US);
            { LAS float* lt = (LAS float*)(F.lds + LDS_EXTRA_OFF); for (int i = threadIdx.x; i < 2 * GW; i += NTHREADS) lt[i] = F.LBT[i]; __syncthreads(); }
            SchedInProj S{(const unsigned char*)F.WinT, GG, cid}; EpiInProj E{F.U, F.VG, F.Q, F.GS, F.I, F.GF, F.KF, F.GB, F.KB, (const LAS float*)(F.lds + LDS_EXTRA_OFF)};
            pg::gemm_phase<EpiInProj, SchedInProj, INPROJ_FP8 != 0>(F.lds, (const char*)F.H, D, S, E); }
        else if (cid < 256) { const int k = cid - 236; conv8_run(F, k, 20, CONV_P2_PER_WG); if (k < CONV_P2_EXTRA) conv8_run(F, 20 * CONV_P2_PER_WG + k, 20, 1); }
        }
    }
    SEAM(2);
    if (IN(3)) REP(3) phase3(F);
    SEAM(3);
    if (IN(4) && !FOLD_P4) REP(4) phase4(F);
    if (!FOLD_P4) SEAM(4);
    if (IN(5)) REP(5) {
        SchedOutProj S{F.WoutT, G, cid}; EpiOutProj E{F.x, F.mod, F.X1, F.SS};
        if (FOLD_P4) {
            pg::Unit u;
            if (S.next(0, u)) {
                const int r0 = u.arow + 64 * u.pn;
                phase4_rows(F, r0, r0 + 64, 8);
                asm volatile("s_waitcnt vmcnt(0)" ::: "memory"); __syncthreads();
                if (threadIdx.x == 0) {
                    unsigned* w = F.ctl + CW_P4RDY + 16 * (u.arow >> 8); unsigned sp = 0;
                    __builtin_amdgcn_fence(__ATOMIC_RELEASE, "agent"); asm volatile("s_waitcnt vmcnt(0)" ::: "memory");
                    __hip_atomic_fetch_add(w, 1u, __ATOMIC_RELAXED, __HIP_MEMORY_SCOPE_AGENT);
                    while (__hip_atomic_load(w, __ATOMIC_RELAXED, __HIP_MEMORY_SCOPE_AGENT) < 4u) { __builtin_amdgcn_s_sleep(2); if (++sp > (1u << 22)) break; }
                    __builtin_amdgcn_fence(__ATOMIC_ACQUIRE, "agent"); asm volatile("s_waitcnt vmcnt(0)" ::: "memory");
                }
                __syncthreads();
            }
        }
        pg::gemm_phase<EpiOutProj, SchedOutProj, OUTPROJ_FP8 != 0>(F.lds, (const char*)F.YCAT, D, S, E);
    }
    SEAM(5);
    if (IN(6)) phase6(F);
    SEAM(6);
    if (IN(7)) {
        moe_tables(F);
        SchedMoe S{F.W1T, F.W2T, F.LIST, moe_tab(F.lds), G, cid, F.lds, F.ctl, (unsigned)WS_H2, (unsigned)WS_ACT, 0}; S.init();
        EpiMoe E{F.b1, F.b2, F.ACT, F.DOUT, F.lds, &S};
        S.preload(F.b1, F.b2);
        stagger_start(STAGGER_MOE_SLOT, STAGGER_MOE_US);
        pg::gemm_phase<EpiMoe, SchedMoe, true>(F.lds, (const char*)F.ws, D, S, E);
    }
    SEAM(7);
    if (IN(9)) REP(9) phase9(F);
#undef IN
#undef SEAM
}

extern "C" void kernel_launch(void* const* d_in, const int* in_sizes, int n_in, void* d_out, int out_size, void* d_ws, size_t ws_size, hipStream_t stream) {
    static int grid = 0;
    if (grid == 0) {
        if (n_in != 23 || in_sizes[0] != NTOK * D || out_size != NTOK * D || ws_size < WS_END) {
            fprintf(stderr, "kernel_launch: unexpected shapes / workspace (n_in %d, in0 %d, out %d, ws %zu, need %zu); nothing launched\n", n_in, n_in > 0 ? in_sizes[0] : -1, out_size, ws_size, (size_t)WS_END);
            grid = -1; return;
        }
        int dev = 0, cus = 0;
        if (hipGetDevice(&dev) != hipSuccess || hipDeviceGetAttribute(&cus, hipDeviceAttributeMultiprocessorCount, dev) != hipSuccess) { grid = -1; return; }
        if (hipFuncSetAttribute((const void*)fwd_kernel, hipFuncAttributeMaxDynamicSharedMemorySize, LDS_BYTES) != hipSuccess) { fprintf(stderr, "kernel_launch: hipFuncSetAttribute failed\n"); grid = -1; return; }
        int per_cu = 0;
        if (hipOccupancyMaxActiveBlocksPerMultiprocessor(&per_cu, (const void*)fwd_kernel, NTHREADS, LDS_BYTES) != hipSuccess || per_cu < 1)
            fprintf(stderr, "kernel_launch: note: the occupancy query reports %d workgroups per CU; launching one per CU (%d bytes of LDS each)\n", per_cu, LDS_BYTES);
        (void)hipGetLastError();
        grid = cus;
        if (grid < 256) { fprintf(stderr, "kernel_launch: needs >= 256 CUs\n"); grid = -1; return; }
    }
    if (grid < 0) return;
    (void)hipMemsetAsync((char*)d_ws + WS_CTL, 0, CTL_BYTES, stream);
    Args a{};
    for (int i = 0; i < 23; ++i) a.in[i] = (const float*)d_in[i];
    a.out = (float*)d_out; a.ws = (unsigned char*)d_ws;
#if N_LAUNCH_MODE == 1
    a.ph_lo = 0; a.ph_hi = N_PHASES;
    hipLaunchKernelGGL(fwd_kernel, dim3(grid), dim3(NTHREADS), LDS_BYTES, stream, a);
#else
    for (int p = 0; p < N_PHASES; ++p) { if (DBG_NO_MOE && p >= 6 && p <= 8) continue; a.ph_lo = p; a.ph_hi = p + 1; hipLaunchKernelGGL(fwd_kernel, dim3(grid), dim3(NTHREADS), LDS_BYTES, stream, a); }
#endif
}
```
